# Optimizing an MI355X kernel written in HIP

```python
import jax, jax.numpy as jnp
from jax import lax
import numpy as np

D_MODEL = 1024
BATCH = 4
SEQ = 8192
DEPTH = 1

CHUNK = 64
Q_BLOCK = 128
EPS = 1e-6
MLA_HEADS = 8
MLA_NOPE = 64
MLA_ROPE = 32
MLA_V = 64
MLA_Q_RANK = 384
MLA_KV_RANK = 256
ROPE_BASE = 10000.0
MLA_WIDTH = MLA_HEADS * MLA_V
DSA_HEADS = 8
DSA_HEAD_DIM = 64
DSA_WIDTH = DSA_HEADS * DSA_HEAD_DIM
IDX_HEADS = 8
IDX_DIM = 32
TOPK_MAX = 256
REL_BUCKETS = 32
REL_MAX_DIST = 128

IN_SPLITS = (MLA_Q_RANK, MLA_KV_RANK, MLA_ROPE, MLA_WIDTH,
             DSA_WIDTH, DSA_WIDTH, DSA_WIDTH, DSA_WIDTH,
             IDX_HEADS * IDX_DIM, IDX_DIM, IDX_HEADS,
             D_MODEL, D_MODEL)
IN_TOTAL = sum(IN_SPLITS)

kernel_name = 'hybrid_mla_dsa_gated_parallel'


def rmsnorm(x, g):
    xf = x.astype(jnp.float32)
    y = xf * lax.rsqrt(jnp.mean(xf * xf, axis=-1, keepdims=True) + EPS)
    return (y * g.astype(jnp.float32)).astype(x.dtype)


def rope(x, pos):
    half = x.shape[-1] // 2
    freqs = ROPE_BASE ** (-jnp.arange(half, dtype=jnp.float32) / half)
    ang = pos.astype(jnp.float32)[:, None] * freqs[None, :]
    cos = jnp.cos(ang)[None, :, None, :].astype(x.dtype)
    sin = jnp.sin(ang)[None, :, None, :].astype(x.dtype)
    x1, x2 = x[..., :half], x[..., half:]
    return jnp.concatenate([x1 * cos - x2 * sin, x1 * sin + x2 * cos], axis=-1)


def t5_bucket(rel):
    nb = REL_BUCKETS // 2
    max_exact = nb // 2
    ret = (rel > 0).astype(jnp.int32) * nb
    n = jnp.abs(rel)
    nf = jnp.maximum(n, 1).astype(jnp.float32)
    large = max_exact + (jnp.log(nf / max_exact) / np.log(REL_MAX_DIST / max_exact)
                         * (nb - max_exact)).astype(jnp.int32)
    large = jnp.minimum(large, nb - 1)
    return ret + jnp.where(n < max_exact, n, large)


def to_blocks(a):
    return jnp.moveaxis(a.reshape((a.shape[0], -1, Q_BLOCK) + a.shape[2:]), 1, 0)


def from_blocks(a):
    a = jnp.moveaxis(a, 0, 1)
    return a.reshape((a.shape[0], -1) + a.shape[3:])


def mla_attention(q_nope, q_pe, k_nope, k_pe, v, pos):
    scale = (MLA_NOPE + MLA_ROPE) ** -0.5
    key_chunk = pos // CHUNK

    def block(args):
        qn, qp, qpos = args
        logits = (jnp.einsum('bqhd,bkhd->bhqk', qn, k_nope)
                  + jnp.einsum('bqhr,bkr->bhqk', qp, k_pe))
        logits = logits.astype(jnp.float32) * scale
        mask = key_chunk[None, :] <= (qpos // CHUNK)[:, None]
        logits = jnp.where(mask[None, None], logits, -jnp.inf)
        p = jax.nn.softmax(logits, axis=-1).astype(v.dtype)
        return jnp.einsum('bhqk,bkhd->bqhd', p, v)

    out = lax.map(block, (to_blocks(q_nope), to_blocks(q_pe), pos.reshape(-1, Q_BLOCK)))
    return from_blocks(out)


def dsa_attention(q, k, v, q_idx, k_idx, w_idx, rel_bias, pos, topk):
    scale = DSA_HEAD_DIM ** -0.5
    key_chunk = pos // CHUNK
    gather = jax.vmap(lambda src, ids: src[ids])

    def block(args):
        qb, qi, wi, qpos = args
        qchunk = qpos // CHUNK
        s = jnp.einsum('bqhd,bkd->bqhk', qi, k_idx).astype(jnp.float32) * (IDX_DIM ** -0.5)
        score = jnp.einsum('bqhk,bqh->bqk', jax.nn.relu(s),
                           wi.astype(jnp.float32) * (IDX_HEADS ** -0.5))
        admissible = key_chunk[None, :] <= qchunk[:, None]
        score = jnp.where(admissible[None], score, -jnp.inf)
        _, idx = lax.top_k(score, topk)
        valid = (idx // CHUNK) <= qchunk[None, :, None]
        k_sel = gather(k, idx)
        v_sel = gather(v, idx)
        logits = jnp.einsum('bqhd,bqkhd->bhqk', qb, k_sel).astype(jnp.float32) * scale
        bias = rel_bias[t5_bucket(idx - qpos[None, :, None])]
        logits = logits + jnp.transpose(bias, (0, 3, 1, 2)).astype(jnp.float32)
        logits = jnp.where(valid[:, None], logits, -jnp.inf)
        p = jax.nn.softmax(logits, axis=-1).astype(v.dtype)
        return jnp.einsum('bhqk,bqkhd->bqhd', p, v_sel)

    out = lax.map(block, (to_blocks(q), to_blocks(q_idx), to_blocks(w_idx),
                          pos.reshape(-1, Q_BLOCK)))
    return from_blocks(out)


def setup_inputs(seed: int = 0) -> dict:
    key = jax.random.key(seed)
    ks = jax.random.split(key, 13)

    def dense(k, shape):
        return jax.random.normal(k, shape, jnp.float32) * shape[-2] ** -0.5

    def gain(k, shape):
        return 1.0 + 0.05 * jax.random.normal(k, shape, jnp.float32)

    return {
        'x': jax.random.normal(ks[0], (BATCH, SEQ, D_MODEL), jnp.float32),
        'norm_g': gain(ks[1], (DEPTH, D_MODEL)),
        'w_in': dense(ks[2], (DEPTH, D_MODEL, IN_TOTAL)),
        'g_q_lat': gain(ks[3], (DEPTH, MLA_Q_RANK)),
        'w_uq': dense(ks[4], (DEPTH, MLA_Q_RANK, MLA_HEADS * (MLA_NOPE + MLA_ROPE))),
        'g_kv_lat': gain(ks[5], (DEPTH, MLA_KV_RANK)),
        'w_ukv': dense(ks[6], (DEPTH, MLA_KV_RANK, MLA_HEADS * (MLA_NOPE + MLA_V))),
        'w_o_a': dense(ks[7], (DEPTH, MLA_WIDTH, D_MODEL)),
        'w_o_b': dense(ks[8], (DEPTH, DSA_WIDTH, D_MODEL)),
        'w_out': dense(ks[9], (DEPTH, D_MODEL, D_MODEL)),
        'rel_bias': 0.5 * jax.random.normal(ks[10], (REL_BUCKETS, DSA_HEADS), jnp.float32),
        'final_g': gain(ks[11], (D_MODEL,)),
    }


def reference(x, norm_g, w_in, g_q_lat, w_uq, g_kv_lat, w_ukv, w_o_a, w_o_b, w_out,
              rel_bias, final_g):
    B, S, _ = x.shape
    pos = jnp.arange(S, dtype=jnp.int32)
    topk = min(TOPK_MAX, S // 4)
    cuts = np.cumsum(IN_SPLITS)[:-1].tolist()
    for l in range(DEPTH):
        h = rmsnorm(x, norm_g[l])
        (q_lat, c_kv, k_rope, z_a, q_b, k_b, v_b, z_b,
         q_idx, k_idx, w_idx, gate_a, gate_b) = jnp.split(h @ w_in[l], cuts, axis=-1)

        q = (rmsnorm(q_lat, g_q_lat[l]) @ w_uq[l]).reshape(B, S, MLA_HEADS, MLA_NOPE + MLA_ROPE)
        q_nope, q_pe = q[..., :MLA_NOPE], rope(q[..., MLA_NOPE:], pos)
        kv = (rmsnorm(c_kv, g_kv_lat[l]) @ w_ukv[l]).reshape(B, S, MLA_HEADS, MLA_NOPE + MLA_V)
        k_nope, v_a = kv[..., :MLA_NOPE], kv[..., MLA_NOPE:]
        k_pe = rope(k_rope[:, :, None, :], pos)[:, :, 0, :]
        y_a = mla_attention(q_nope, q_pe, k_nope, k_pe, v_a, pos).reshape(B, S, MLA_WIDTH)
        y_a = y_a * jax.nn.silu(z_a)

        y_b = dsa_attention(q_b.reshape(B, S, DSA_HEADS, DSA_HEAD_DIM),
                            k_b.reshape(B, S, DSA_HEADS, DSA_HEAD_DIM),
                            v_b.reshape(B, S, DSA_HEADS, DSA_HEAD_DIM),
                            q_idx.reshape(B, S, IDX_HEADS, IDX_DIM), k_idx, w_idx,
                            rel_bias, pos, topk).reshape(B, S, DSA_WIDTH)
        y_b = y_b * jax.nn.silu(z_b)

        merged = (jax.nn.sigmoid(gate_a) * (y_a @ w_o_a[l])
                  + jax.nn.sigmoid(gate_b) * (y_b @ w_o_b[l]))
        x = x + merged @ w_out[l]
    return rmsnorm(x, final_g)
```

```cpp
#include <hip/hip_runtime.h>
#include <stdint.h>
#include <stdio.h>

typedef unsigned short bf16_t;
constexpr int NB = 4, S = 8192, DM = 1024, T = NB * S;
constexpr int NIN = 5576;
constexpr int C_QLAT = 0, C_CKV = 384, C_KROPE = 640, C_ZA = 672, C_QB = 1184, C_KB = 1696, C_VB = 2208, C_ZB = 2720,
              C_QIDX = 3232, C_KIDX = 3488, C_WIDX = 3520, C_GA = 3528, C_GB = 4552;
constexpr size_t MiB = 1u << 20;
constexpr size_t OFF_H = 0, OFF_P = 64 * MiB, OFF_Q = 416 * MiB, OFF_R = 464 * MiB, WS_NEED = 465 * MiB;

__device__ __forceinline__ float bf2f(bf16_t v) { return __uint_as_float(((unsigned)v) << 16); }
__device__ __forceinline__ bf16_t f2bf(float f) { unsigned u = __float_as_uint(f); return (bf16_t)((u + 0x7fffu + ((u >> 16) & 1u)) >> 16); }
__device__ __forceinline__ float wave_sum(float v) {
#pragma unroll
    for (int o = 1; o < 64; o <<= 1) v += __shfl_xor(v, o);
    return v;
}

__global__ void __launch_bounds__(256) k_rms_x(const float* __restrict__ x, const float* __restrict__ g, bf16_t* __restrict__ H) {
    const int row = blockIdx.x * 4 + (threadIdx.x >> 6), lane = threadIdx.x & 63;
    const float4* xr = (const float4*)(x + (size_t)row * DM);
    float4 v[4]; float s = 0.f;
#pragma unroll
    for (int j = 0; j < 4; ++j) { v[j] = xr[lane + 64 * j]; s += v[j].x * v[j].x + v[j].y * v[j].y + v[j].z * v[j].z + v[j].w * v[j].w; }
    s = wave_sum(s);
    const float r = rsqrtf(s * (1.f / DM) + 1e-6f);
#pragma unroll
    for (int j = 0; j < 4; ++j) {
        const float4 gg = ((const float4*)g)[lane + 64 * j];
        ushort4 o; o.x = f2bf(v[j].x * r * gg.x); o.y = f2bf(v[j].y * r * gg.y); o.z = f2bf(v[j].z * r * gg.z); o.w = f2bf(v[j].w * r * gg.w);
        ((ushort4*)(H + (size_t)row * DM))[lane + 64 * j] = o;
    }
}

__global__ void __launch_bounds__(256) k_rowscale(const bf16_t* __restrict__ A, int lda, int K, float* __restrict__ r) {
    const int row = blockIdx.x * 4 + (threadIdx.x >> 6), lane = threadIdx.x & 63;
    float s = 0.f;
    for (int k = lane; k < K; k += 64) { const float a = bf2f(A[(size_t)row * lda + k]); s += a * a; }
    s = wave_sum(s);
    if (lane == 0) r[row] = rsqrtf(s / (float)K + 1e-6f);
}

template <bool AG>
__device__ __forceinline__ void gemm_acc(float (&acc)[4][4], const bf16_t* __restrict__ A, int lda, const float* __restrict__ Bw, int ldb, int K, int N,
                                         int m0, int n0, const float* __restrict__ gk, float (*As)[68], float (*Bs)[68]) {
    const int tid = threadIdx.x, ty = tid >> 4, tx = tid & 15;
    const int arow = tid >> 2, akq = (tid & 3) * 4, bk = tid >> 4, bn4 = (tid & 15) * 4;
    for (int k0 = 0; k0 < K; k0 += 16) {
        const ushort4 av = *(const ushort4*)(A + (size_t)(m0 + arow) * lda + k0 + akq);
        float a0 = bf2f(av.x), a1 = bf2f(av.y), a2 = bf2f(av.z), a3 = bf2f(av.w);
        if (AG) { a0 *= gk[k0 + akq]; a1 *= gk[k0 + akq + 1]; a2 *= gk[k0 + akq + 2]; a3 *= gk[k0 + akq + 3]; }
        float4 bv = make_float4(0.f, 0.f, 0.f, 0.f);
        if (n0 + bn4 < N) bv = *(const float4*)(Bw + (size_t)(k0 + bk) * ldb + n0 + bn4);
        __syncthreads();
        As[akq][arow] = a0; As[akq + 1][arow] = a1; As[akq + 2][arow] = a2; As[akq + 3][arow] = a3;
        *(float4*)&Bs[bk][bn4] = bv;
        __syncthreads();
#pragma unroll
        for (int k = 0; k < 16; ++k) {
            const float4 a = *(const float4*)&As[k][ty * 4];
            const float4 b = *(const float4*)&Bs[k][tx * 4];
            const float aa[4] = {a.x, a.y, a.z, a.w}, bb[4] = {b.x, b.y, b.z, b.w};
#pragma unroll
            for (int i = 0; i < 4; ++i)
#pragma unroll
                for (int j = 0; j < 4; ++j) acc[i][j] = fmaf(aa[i], bb[j], acc[i][j]);
        }
    }
}

template <bool AG>
__global__ void __launch_bounds__(256) k_gemm_bf16out(const bf16_t* __restrict__ A, int lda, const float* __restrict__ Bw, int ldb, int K, int N,
                                                       const float* __restrict__ gk, const float* __restrict__ rs, bf16_t* __restrict__ C, int ldc) {
    __shared__ float As[16][68], Bs[16][68];
    const int m0 = blockIdx.y * 64, n0 = blockIdx.x * 64, ty = threadIdx.x >> 4, tx = threadIdx.x & 15;
    float acc[4][4] = {};
    gemm_acc<AG>(acc, A, lda, Bw, ldb, K, N, m0, n0, gk, As, Bs);
#pragma unroll
    for (int i = 0; i < 4; ++i) {
        const int m = m0 + ty * 4 + i; const float sc = rs ? rs[m] : 1.f;
#pragma unroll
        for (int j = 0; j < 4; ++j) { const int n = n0 + tx * 4 + j; if (n < N) C[(size_t)m * ldc + n] = f2bf(acc[i][j] * sc); }
    }
}

__global__ void __launch_bounds__(256) k_merge(const bf16_t* __restrict__ P, const float* __restrict__ woa, const float* __restrict__ wob, bf16_t* __restrict__ MG) {
    __shared__ float As[16][68], Bs[16][68];
    const int m0 = blockIdx.y * 64, n0 = blockIdx.x * 64, ty = threadIdx.x >> 4, tx = threadIdx.x & 15;
    float acca[4][4] = {}, accb[4][4] = {};
    gemm_acc<false>(acca, P + C_ZA, NIN, woa, DM, 512, DM, m0, n0, nullptr, As, Bs);
    gemm_acc<false>(accb, P + C_ZB, NIN, wob, DM, 512, DM, m0, n0, nullptr, As, Bs);
#pragma unroll
    for (int i = 0; i < 4; ++i) {
        const int m = m0 + ty * 4 + i;
#pragma unroll
        for (int j = 0; j < 4; ++j) {
            const int n = n0 + tx * 4 + j;
            const float ga = bf2f(P[(size_t)m * NIN + C_GA + n]), gb = bf2f(P[(size_t)m * NIN + C_GB + n]);
            const float v = acca[i][j] / (1.f + expf(-ga)) + accb[i][j] / (1.f + expf(-gb));
            MG[(size_t)m * DM + n] = f2bf(v);
        }
    }
}

__global__ void __launch_bounds__(256) k_outproj(const bf16_t* __restrict__ MG, const float* __restrict__ wout, const float* __restrict__ x, float* __restrict__ out) {
    __shared__ float As[16][68], Bs[16][68];
    const int m0 = blockIdx.y * 64, n0 = blockIdx.x * 64, ty = threadIdx.x >> 4, tx = threadIdx.x & 15;
    float acc[4][4] = {};
    gemm_acc<false>(acc, MG, DM, wout, DM, DM, DM, m0, n0, nullptr, As, Bs);
#pragma unroll
    for (int i = 0; i < 4; ++i) {
        const int m = m0 + ty * 4 + i;
#pragma unroll
        for (int j = 0; j < 4; ++j) { const int n = n0 + tx * 4 + j; out[(size_t)m * DM + n] = x[(size_t)m * DM + n] + acc[i][j]; }
    }
}

__global__ void __launch_bounds__(256) k_rms_final(float* __restrict__ out, const float* __restrict__ g) {
    const int row = blockIdx.x * 4 + (threadIdx.x >> 6), lane = threadIdx.x & 63;
    float4* xr = (float4*)(out + (size_t)row * DM);
    float4 v[4]; float s = 0.f;
#pragma unroll
    for (int j = 0; j < 4; ++j) { v[j] = xr[lane + 64 * j]; s += v[j].x * v[j].x + v[j].y * v[j].y + v[j].z * v[j].z + v[j].w * v[j].w; }
    s = wave_sum(s);
    const float r = rsqrtf(s * (1.f / DM) + 1e-6f);
#pragma unroll
    for (int j = 0; j < 4; ++j) {
        const float4 gg = ((const float4*)g)[lane + 64 * j];
        xr[lane + 64 * j] = make_float4(v[j].x * r * gg.x, v[j].y * r * gg.y, v[j].z * r * gg.z, v[j].w * r * gg.w);
    }
}

__global__ void __launch_bounds__(256) k_rope(bf16_t* __restrict__ Q, bf16_t* __restrict__ P) {
    const int gid = blockIdx.x * 256 + threadIdx.x;
    const int i = gid & 15, slot = (gid >> 4) % 9, m = gid / 144;
    if (m >= T) return;
    const int pos = m & (S - 1);
    const float freq = powf(10000.f, -(float)i / 16.f);
    const float ang = (float)pos * freq;
    const float c = cosf(ang), s = sinf(ang);
    bf16_t* p = (slot < 8) ? (Q + (size_t)m * 768 + slot * 96 + 64) : (P + (size_t)m * NIN + C_KROPE);
    const float x1 = bf2f(p[i]), x2 = bf2f(p[16 + i]);
    p[i] = f2bf(x1 * c - x2 * s); p[16 + i] = f2bf(x1 * s + x2 * c);
}

__global__ void __launch_bounds__(64) k_mla(const bf16_t* __restrict__ Q, const bf16_t* __restrict__ KV, bf16_t* __restrict__ P) {
    __shared__ float Ks[32][96];
    __shared__ float Vs[32][64];
    const int c = blockIdx.x, h = blockIdx.y, b = blockIdx.z, t = threadIdx.x;
    const size_t m = (size_t)b * S + c * 64 + t;
    const float scale = 0.10206207261596577f;
    float q[96], o[64];
#pragma unroll
    for (int d = 0; d < 96; ++d) q[d] = bf2f(Q[m * 768 + h * 96 + d]) * scale;
#pragma unroll
    for (int d = 0; d < 64; ++d) o[d] = 0.f;
    float mx = -INFINITY, l = 0.f;
    const int nkeys = (c + 1) * 64;
    for (int k0 = 0; k0 < nkeys; k0 += 32) {
        __syncthreads();
        for (int e = t; e < 32 * 96; e += 64) {
            const int j = e / 96, d = e % 96; const size_t n = (size_t)b * S + k0 + j;
            Ks[j][d] = (d < 64) ? bf2f(KV[n * 1024 + h * 128 + d]) : bf2f(P[n * NIN + C_KROPE + (d - 64)]);
        }
        for (int e = t; e < 32 * 64; e += 64) { const int j = e >> 6, d = e & 63; const size_t n = (size_t)b * S + k0 + j; Vs[j][d] = bf2f(KV[n * 1024 + h * 128 + 64 + d]); }
        __syncthreads();
        for (int j = 0; j < 32; ++j) {
            float s = 0.f;
#pragma unroll
            for (int d = 0; d < 96; ++d) s = fmaf(q[d], Ks[j][d], s);
            const float mn = fmaxf(mx, s), al = __expf(mx - mn), p = __expf(s - mn);
            l = l * al + p; mx = mn;
#pragma unroll
            for (int d = 0; d < 64; ++d) o[d] = fmaf(p, Vs[j][d], o[d] * al);
        }
    }
    const float li = 1.f / l;
#pragma unroll
    for (int d = 0; d < 64; ++d) {
        bf16_t* zp = P + m * NIN + C_ZA + h * 64 + d;
        const float z = bf2f(*zp);
        *zp = f2bf(o[d] * li * (z / (1.f + __expf(-z))));
    }
}

__device__ __forceinline__ unsigned f2key(float f) { const unsigned u = __float_as_uint(f); return (u & 0x80000000u) ? ~u : (u | 0x80000000u); }
__device__ __forceinline__ int t5_bucket(int rel) {
    const int n = rel < 0 ? -rel : rel; int r = rel > 0 ? 16 : 0;
    int v;
    if (n < 8) v = n;
    else { v = 8 + (int)(logf((float)n / 8.f) / 2.772588722239781f * 8.f); if (v > 15) v = 15; }
    return r + v;
}
__global__ void __launch_bounds__(256) k_dsa(bf16_t* __restrict__ P, const float* __restrict__ rel_bias) {
    __shared__ float sc[8192];
    __shared__ float lg[8][256];
    __shared__ float qi[8][32];
    __shared__ float qb[512];
    __shared__ float wv[8];
    __shared__ float linv[8];
    __shared__ int sel[256];
    __shared__ int red[8];
    __shared__ int cnt_s;
    const int tid = threadIdx.x, lane = tid & 63, wid = tid >> 6;
    const int m = blockIdx.x, b = m >> 13, qpos = m & (S - 1);
    const size_t mb = (size_t)b * S;
    const bf16_t* prow = P + (size_t)m * NIN;
    qi[tid >> 5][tid & 31] = bf2f(prow[C_QIDX + tid]);
    qb[tid] = bf2f(prow[C_QB + tid]); qb[tid + 256] = bf2f(prow[C_QB + tid + 256]);
    if (tid < 8) wv[tid] = bf2f(prow[C_WIDX + tid]) * 0.35355339059327373f;
    if (tid == 0) cnt_s = 0;
    __syncthreads();
    const int nkeys = ((qpos >> 6) + 1) * 64;
    for (int k = tid; k < nkeys; k += 256) {
        const bf16_t* kp = P + (mb + k) * NIN + C_KIDX;
        float kf[32];
#pragma unroll
        for (int d = 0; d < 32; ++d) kf[d] = bf2f(kp[d]);
        float score = 0.f;
#pragma unroll 1
        for (int h = 0; h < 8; ++h) {
            float s = 0.f;
#pragma unroll
            for (int d = 0; d < 32; ++d) s = fmaf(qi[h][d], kf[d], s);
            s *= 0.17677669529663687f;
            score += fmaxf(s, 0.f) * wv[h];
        }
        sc[k] = score;
    }
    __syncthreads();
    int nsel;
    if (nkeys <= 256) {
        nsel = nkeys;
        if (tid < nkeys) sel[tid] = tid;
    } else {
        unsigned th = 0u;
        for (int bit = 31; bit >= 0; --bit) {
            const unsigned tt = th | (1u << bit);
            int c = 0;
            for (int k = tid; k < nkeys; k += 256) c += (f2key(sc[k]) >= tt) ? 1 : 0;
#pragma unroll
            for (int o = 1; o < 64; o <<= 1) c += __shfl_xor(c, o);
            if (lane == 0) red[wid] = c;
            __syncthreads();
            const int tot = red[0] + red[1] + red[2] + red[3];
            __syncthreads();
            if (tot >= 256) th = tt;
        }
        int cg = 0, ce = 0;
        for (int k = tid; k < nkeys; k += 256) { const unsigned kk = f2key(sc[k]); cg += (kk > th) ? 1 : 0; ce += (kk == th) ? 1 : 0; }
#pragma unroll
        for (int o = 1; o < 64; o <<= 1) { cg += __shfl_xor(cg, o); ce += __shfl_xor(ce, o); }
        if (lane == 0) { red[wid] = cg; red[4 + wid] = ce; }
        __syncthreads();
        const int totg = red[0] + red[1] + red[2] + red[3], tote = red[4] + red[5] + red[6] + red[7];
        const int need = 256 - totg;
        for (int k = tid; k < nkeys; k += 256) {
            const unsigned kk = f2key(sc[k]);
            if (kk > th || (kk == th && tote == need)) { const int p = atomicAdd(&cnt_s, 1); sel[p] = k; }
        }
        __syncthreads();
        if (tote != need && tid == 0) {
            int p = cnt_s, left = need;
            for (int k = 0; k < nkeys && left > 0; ++k) if (f2key(sc[k]) == th) { sel[p++] = k; --left; }
        }
        nsel = 256;
    }
    __syncthreads();
    if (tid < nsel) {
        const int key = sel[tid];
        const bf16_t* kp = P + (mb + key) * NIN + C_KB;
        const int bk = t5_bucket(key - qpos);
#pragma unroll 1
        for (int h = 0; h < 8; ++h) {
            float s = 0.f;
#pragma unroll 1
            for (int d8 = 0; d8 < 8; ++d8) {
                const uint4 kv = *(const uint4*)(kp + h * 64 + d8 * 8);
                const unsigned w[4] = {kv.x, kv.y, kv.z, kv.w};
#pragma unroll
                for (int e = 0; e < 4; ++e) {
                    s = fmaf(qb[h * 64 + d8 * 8 + 2 * e], __uint_as_float(w[e] << 16), s);
                    s = fmaf(qb[h * 64 + d8 * 8 + 2 * e + 1], __uint_as_float(w[e] & 0xffff0000u), s);
                }
            }
            lg[h][tid] = s * 0.125f + rel_bias[bk * 8 + h];
        }
    }
    __syncthreads();
    {
        const int h = tid >> 5, i = tid & 31;
        float mxv = -INFINITY;
        for (int j = i; j < nsel; j += 32) mxv = fmaxf(mxv, lg[h][j]);
#pragma unroll
        for (int o = 1; o < 32; o <<= 1) mxv = fmaxf(mxv, __shfl_xor(mxv, o));
        float sm = 0.f;
        for (int j = i; j < nsel; j += 32) { const float p = __expf(lg[h][j] - mxv); lg[h][j] = p; sm += p; }
#pragma unroll
        for (int o = 1; o < 32; o <<= 1) sm += __shfl_xor(sm, o);
        if (i == 0) linv[h] = 1.f / sm;
    }
    __syncthreads();
    {
        const int h = tid >> 5, d2 = (tid & 31) * 2;
        float a0 = 0.f, a1 = 0.f;
        for (int j = 0; j < nsel; ++j) {
            const float p = lg[h][j];
            const unsigned vv = *(const unsigned*)(P + (mb + sel[j]) * NIN + C_VB + h * 64 + d2);
            a0 = fmaf(p, __uint_as_float(vv << 16), a0); a1 = fmaf(p, __uint_as_float(vv & 0xffff0000u), a1);
        }
        bf16_t* zp = P + (size_t)m * NIN + C_ZB + h * 64 + d2;
        const float z0 = bf2f(zp[0]), z1 = bf2f(zp[1]);
        zp[0] = f2bf(a0 * linv[h] * (z0 / (1.f + __expf(-z0))));
        zp[1] = f2bf(a1 * linv[h] * (z1 / (1.f + __expf(-z1))));
    }
}

extern "C" void kernel_launch(void* const* d_in, const int* in_sizes, int n_in, void* d_out, int out_size, void* d_ws, size_t ws_size, hipStream_t stream) {
    if (ws_size < WS_NEED) { fprintf(stderr, "kernel_launch: workspace too small: %zu < %zu\n", ws_size, (size_t)WS_NEED); return; }
    const float* x = (const float*)d_in[0];
    const float* norm_g = (const float*)d_in[1];
    const float* w_in = (const float*)d_in[2];
    const float* g_q = (const float*)d_in[3];
    const float* w_uq = (const float*)d_in[4];
    const float* g_kv = (const float*)d_in[5];
    const float* w_ukv = (const float*)d_in[6];
    const float* w_oa = (const float*)d_in[7];
    const float* w_ob = (const float*)d_in[8];
    const float* w_out = (const float*)d_in[9];
    const float* rel_bias = (const float*)d_in[10];
    const float* final_g = (const float*)d_in[11];
    float* out = (float*)d_out;
    char* ws = (char*)d_ws;
    bf16_t* H = (bf16_t*)(ws + OFF_H);
    bf16_t* P = (bf16_t*)(ws + OFF_P);
    bf16_t* Q = (bf16_t*)(ws + OFF_Q);
    float* rq = (float*)(ws + OFF_R);
    float* rkv = rq + T;

    k_rms_x<<<T / 4, 256, 0, stream>>>(x, norm_g, H);
    k_gemm_bf16out<false><<<dim3((NIN + 63) / 64, T / 64), 256, 0, stream>>>(H, DM, w_in, NIN, DM, NIN, nullptr, nullptr, P, NIN);
    k_rowscale<<<T / 4, 256, 0, stream>>>(P + C_QLAT, NIN, 384, rq);
    k_rowscale<<<T / 4, 256, 0, stream>>>(P + C_CKV, NIN, 256, rkv);
    k_gemm_bf16out<true><<<dim3(768 / 64, T / 64), 256, 0, stream>>>(P + C_QLAT, NIN, w_uq, 768, 384, 768, g_q, rq, Q, 768);
    bf16_t* KV = H;
    k_gemm_bf16out<true><<<dim3(1024 / 64, T / 64), 256, 0, stream>>>(P + C_CKV, NIN, w_ukv, 1024, 256, 1024, g_kv, rkv, KV, 1024);
    k_rope<<<(T * 144) / 256, 256, 0, stream>>>(Q, P);
    k_mla<<<dim3(S / 64, 8, NB), 64, 0, stream>>>(Q, KV, P);
    k_dsa<<<T, 256, 0, stream>>>(P, rel_bias);
    bf16_t* MG = H;
    k_merge<<<dim3(DM / 64, T / 64), 256, 0, stream>>>(P, w_oa, w_ob, MG);
    k_outproj<<<dim3(DM / 64, T / 64), 256, 0, stream>>>(MG, w_out, x, out);
    k_rms_final<<<T / 4, 256, 0, stream>>>(out, final_g);
}
```

```cpp
#include <hip/hip_runtime.h>
#include <stdint.h>
#include <stdio.h>

namespace pg8 {
#define PG8_LAS __attribute__((address_space(3)))
typedef unsigned short bf16_t;
typedef short bf16x8 __attribute__((ext_vector_type(8)));
typedef float f32x4 __attribute__((ext_vector_type(4)));
typedef unsigned u32x4 __attribute__((ext_vector_type(4)));
constexpr int BM = 256, BK = 64, HALF = 128, HTB = HALF * BK * 2  , STAGE_BYTES = 8 * HTB, NXCD = 8, WGM = 8;

__host__ __device__ __forceinline__ int lds_byte(int r, int c) { const int st = (r >> 4) * 2 + (c >> 5), rr = r & 15, cc = c & 31, ob = rr * 64 + cc * 2; return st * 1024 + (ob ^ (((ob >> 9) & 1) << 5)); }
__host__ __device__ __forceinline__ void stage_rc(int b, int& R, int& C) { const int st = b / 1024, sb = b % 1024, swz = sb ^ (((sb >> 9) & 1) << 5); R = (st >> 1) * 16 + swz / 64; C = (st & 1) * 32 + (swz % 64) / 2; }
__host__ __device__ __forceinline__ int perm32(int rho) { const int n = rho >> 4, i = rho & 15; return 8 * (i >> 2) + 4 * n + (i & 3); }

struct Unit { int pm, pn; };
struct Gemm { const bf16_t* A; int lda; const bf16_t* Bt; int M, N, K; };

struct StaticOrder {
    int nM, nN, nwg, G, c;
    __host__ __device__ void init(int M, int N, int G_, int c_) { nM = M / BM; nN = N / BM; nwg = nM * nN; G = G_; c = c_; }
    __host__ __device__ bool next(int i, Unit& u) const {
        const long L = (long)i * G + c; if (L >= nwg) return false;
        int wgid = (int)L; { const int q = nwg / NXCD, r = nwg % NXCD, xcd = wgid % NXCD, off = wgid / NXCD; wgid = (xcd < r ? xcd * (q + 1) : r * (q + 1) + (xcd - r) * q) + off; }
        const int nig = WGM * nN, gid = wgid / nig, fm = gid * WGM, gsz = (nM - fm) < WGM ? (nM - fm) : WGM;
        u.pm = fm + ((wgid % nig) % gsz); u.pn = (wgid % nig) / gsz; return true;
    }
    __device__ __forceinline__ void a_ready(const Unit&) const {}
    __device__ __forceinline__ void done(const Unit&) const {}
};

__device__ __forceinline__ unsigned cvt_pk_bf16(float lo, float hi) { unsigned r; asm volatile("v_cvt_pk_bf16_f32 %0, %1, %2" : "=v"(r) : "v"(lo), "v"(hi)); return r; }
template <class Epi, class Sched, bool ALIGN_EPI = false, bool SP2 = false>
__device__ __forceinline__ void gemm_phase(PG8_LAS unsigned char* lds, const Gemm g, const Sched& S, const Epi& E) {
    int tid_ = threadIdx.x; asm volatile("" : "+v"(tid_));
    const int tid = tid_, wid = __builtin_amdgcn_readfirstlane(tid >> 6), lane = tid & 63, wr = wid >> 2, wc = wid & 3, fr = lane & 15, fq = lane >> 4;
    int K_ = g.K; asm volatile("" : "+s"(K_));
    const int K = K_, nt = K / BK;
    unsigned voffA[2], voffB[2];
#pragma unroll
    for (int i = 0; i < 2; ++i) { int R, C; stage_rc(tid * 16 + i * 8192, R, C); const int Rb = Epi::PERM ? ((R & ~31) + perm32(R & 31)) : R;
        voffA[i] = (unsigned)(R * g.lda + C) * 2u; voffB[i] = (unsigned)(Rb * K + C) * 2u; }
    const size_t kstep = (size_t)(BK * 2);
    const size_t hstepA = (size_t)HALF * g.lda * 2, hstepB = (size_t)HALF * K * 2;
    const size_t tstepA = 2 * hstepA, tstepB = 2 * hstepB;
    const unsigned ldsw = (unsigned)wid * 1024u;
    const int aoff = lds_byte(wr * 64 + fr, fq * 8), boff = lds_byte(wc * 32 + fr, fq * 8);
#define PG8_SA(b, h) (((b) * 2 + (h)) * HTB)
#define PG8_SB(b, h) ((4 + (b) * 2 + (h)) * HTB)
#define PG8_STAGE(bufoff, gbase, voff) do { _Pragma("unroll") for (int _i = 0; _i < 2; ++_i) \
        __builtin_amdgcn_global_load_lds((const unsigned*)((const char*)(gbase) + (voff)[_i]), (PG8_LAS unsigned*)(lds + (bufoff) + ldsw + _i * 8192), 16, 0, 0); } while (0)
#define PG8_LDA(dst, b, h) do { _Pragma("unroll") for (int m = 0; m < 4; ++m) _Pragma("unroll") for (int k = 0; k < 2; ++k) dst[m][k] = *(const PG8_LAS bf16x8*)(lds + PG8_SA(b, h) + aoff + m * 2048 + k * 1024); } while (0)
#define PG8_LDB(dst, b, h) do { _Pragma("unroll") for (int n = 0; n < 2; ++n) _Pragma("unroll") for (int k = 0; k < 2; ++k) dst[n][k] = *(const PG8_LAS bf16x8*)(lds + PG8_SB(b, h) + boff + n * 2048 + k * 1024); } while (0)
#define PG8_MMA(ai, bj, At, Bt) do { __builtin_amdgcn_s_setprio(1); _Pragma("unroll") for (int m = 0; m < 4; ++m) _Pragma("unroll") for (int n = 0; n < 2; ++n) _Pragma("unroll") for (int k = 0; k < 2; ++k) \
        acc[ai][bj][m][n] = __builtin_amdgcn_mfma_f32_16x16x32_bf16(Bt[n][k], At[m][k], acc[ai][bj][m][n], 0, 0, 0); __builtin_amdgcn_s_setprio(0); } while (0)
#define PG8_WAIT_V(n) asm volatile("s_waitcnt vmcnt(" #n ")" ::: "memory")
#define PG8_WAIT_L(n) asm volatile("s_waitcnt lgkmcnt(" #n ")" ::: "memory")
#define PG8_BAR __builtin_amdgcn_s_barrier()
#define PG8_SCHED __builtin_amdgcn_sched_barrier(0)
    Unit cur, nxt; int ui = 0;
    if (!S.next(0, cur)) return;
    f32x4 acc[2][2][4][2];
#pragma unroll
    for (int a = 0; a < 2; ++a)
#pragma unroll
        for (int b = 0; b < 2; ++b)
#pragma unroll
            for (int m = 0; m < 4; ++m)
#pragma unroll
                for (int n = 0; n < 2; ++n) acc[a][b][m][n] = (f32x4){0.f, 0.f, 0.f, 0.f};
    bf16x8 At[4][2], B0[2][2], B1[2][2];
    const char* cA = (const char*)g.A + (size_t)cur.pm * tstepA; const char* cB = (const char*)g.Bt + (size_t)cur.pn * tstepB;
    S.a_ready(cur);
    if constexpr (SP2) {
        PG8_STAGE(PG8_SB(0, 0), cB, voffB); PG8_STAGE(PG8_SB(0, 1), cB + hstepB, voffB); PG8_STAGE(PG8_SA(0, 0), cA, voffA); PG8_STAGE(PG8_SA(0, 1), cA + hstepA, voffA);
        if (wr == 1) PG8_BAR;
        PG8_WAIT_V(2); PG8_BAR;
        PG8_STAGE(PG8_SB(1, 0), cB + kstep, voffB); PG8_STAGE(PG8_SA(1, 0), cA + kstep, voffA); PG8_STAGE(PG8_SB(1, 1), cB + hstepB + kstep, voffB);
        PG8_WAIT_V(6); PG8_BAR;
    } else {
        PG8_STAGE(PG8_SB(0, 0), cB, voffB); PG8_STAGE(PG8_SA(0, 0), cA, voffA); PG8_STAGE(PG8_SB(0, 1), cB + hstepB, voffB); PG8_STAGE(PG8_SA(0, 1), cA + hstepA, voffA);
        if (wr == 1) PG8_BAR;
        PG8_WAIT_V(4); PG8_BAR;
        PG8_STAGE(PG8_SB(1, 0), cB + kstep, voffB); PG8_STAGE(PG8_SA(1, 0), cA + kstep, voffA); PG8_STAGE(PG8_SB(1, 1), cB + hstepB + kstep, voffB);
        PG8_WAIT_V(6); PG8_BAR;
    }
    for (;;) {
        const bool has_next = S.next(ui + 1, nxt);
        const char* nA = has_next ? (const char*)g.A + (size_t)nxt.pm * tstepA : cA; const char* nB = has_next ? (const char*)g.Bt + (size_t)nxt.pn * tstepB : cB;
        for (int t = 0; t < nt; t += 2) {
            const bool last = (t == nt - 2);
            const char* a1 = cA + (size_t)(t + 1) * kstep;
            const char* a2 = last ? nA : cA + (size_t)(t + 2) * kstep; const char* b2 = last ? nB : cB + (size_t)(t + 2) * kstep;
            const char* a3 = a2 + kstep; const char* b3 = b2 + kstep;
            if (last && has_next) S.a_ready(nxt);
            if constexpr (SP2) {
            PG8_LDB(B0, 0, 0); PG8_LDB(B1, 0, 1); PG8_SCHED; PG8_LDA(At, 0, 0); PG8_STAGE(PG8_SA(1, 1), a1 + hstepA, voffA);
            PG8_WAIT_V(8); PG8_WAIT_L(0); PG8_BAR; PG8_MMA(0, 0, At, B0); PG8_MMA(0, 1, At, B1); PG8_BAR; PG8_SCHED;
            PG8_LDA(At, 0, 1); PG8_STAGE(PG8_SB(0, 0), b2, voffB); PG8_STAGE(PG8_SB(0, 1), b2 + hstepB, voffB); PG8_STAGE(PG8_SA(0, 0), a2, voffA);
            PG8_WAIT_V(8); PG8_WAIT_L(0); PG8_BAR; PG8_MMA(1, 0, At, B0); PG8_MMA(1, 1, At, B1); PG8_BAR; PG8_SCHED;
            PG8_LDB(B0, 1, 0); PG8_LDB(B1, 1, 1); PG8_SCHED; PG8_LDA(At, 1, 0); PG8_STAGE(PG8_SA(0, 1), a2 + hstepA, voffA);
            PG8_WAIT_V(8); PG8_WAIT_L(0); PG8_BAR; PG8_MMA(0, 0, At, B0); PG8_MMA(0, 1, At, B1); PG8_BAR; PG8_SCHED;
            PG8_LDA(At, 1, 1); PG8_STAGE(PG8_SB(1, 0), b3, voffB); PG8_STAGE(PG8_SB(1, 1), b3 + hstepB, voffB); PG8_STAGE(PG8_SA(1, 0), a3, voffA);
            PG8_WAIT_V(8); PG8_WAIT_L(0); PG8_BAR; PG8_MMA(1, 0, At, B0); PG8_MMA(1, 1, At, B1); PG8_BAR; PG8_SCHED;
            } else {
            PG8_LDB(B0, 0, 0); PG8_SCHED; PG8_LDA(At, 0, 0); PG8_STAGE(PG8_SA(1, 1), a1 + hstepA, voffA);
            PG8_WAIT_L(8); PG8_BAR; PG8_WAIT_L(0); PG8_MMA(0, 0, At, B0); PG8_BAR; PG8_SCHED;
            PG8_LDB(B1, 0, 1); PG8_STAGE(PG8_SB(0, 0), b2, voffB);
            PG8_BAR; PG8_WAIT_L(0); PG8_MMA(0, 1, At, B1); PG8_BAR;
            PG8_LDA(At, 0, 1); PG8_STAGE(PG8_SA(0, 0), a2, voffA);
            PG8_BAR; PG8_WAIT_L(0); PG8_MMA(1, 0, At, B0); PG8_BAR; PG8_SCHED;
            PG8_STAGE(PG8_SB(0, 1), b2 + hstepB, voffB);
            PG8_WAIT_V(6); PG8_BAR; PG8_MMA(1, 1, At, B1); PG8_BAR;
            PG8_LDB(B0, 1, 0); PG8_SCHED; PG8_LDA(At, 1, 0); PG8_STAGE(PG8_SA(0, 1), a2 + hstepA, voffA);
            PG8_WAIT_L(8); PG8_BAR; PG8_WAIT_L(0); PG8_MMA(0, 0, At, B0); PG8_BAR; PG8_SCHED;
            PG8_LDB(B1, 1, 1); PG8_STAGE(PG8_SB(1, 0), b3, voffB);
            PG8_BAR; PG8_WAIT_L(0); PG8_MMA(0, 1, At, B1); PG8_BAR;
            PG8_LDA(At, 1, 1); PG8_STAGE(PG8_SA(1, 0), a3, voffA);
            PG8_BAR; PG8_WAIT_L(0); PG8_MMA(1, 0, At, B0); PG8_BAR; PG8_SCHED;
            PG8_STAGE(PG8_SB(1, 1), b3 + hstepB, voffB);
            PG8_WAIT_V(6); PG8_BAR; PG8_MMA(1, 1, At, B1); PG8_BAR;
            }
        }
        if constexpr (ALIGN_EPI) { if (wr == 0) PG8_BAR; }
        if constexpr (!Epi::AFTER_DRAIN) { E(acc, cur, wr, wc, fr, fq); S.done(cur); }
        if (!has_next) break;
#pragma unroll
        for (int a = 0; a < 2; ++a)
#pragma unroll
            for (int b = 0; b < 2; ++b)
#pragma unroll
                for (int m = 0; m < 4; ++m)
#pragma unroll
                    for (int n = 0; n < 2; ++n) acc[a][b][m][n] = (f32x4){0.f, 0.f, 0.f, 0.f};
        cur = nxt; cA = nA; cB = nB; ++ui;
        if constexpr (ALIGN_EPI) { if (wr == 1) PG8_BAR; }
    }
    PG8_WAIT_V(0);
    if constexpr (!ALIGN_EPI) { if (wr == 0) PG8_BAR; }
    PG8_BAR;
    if constexpr (Epi::AFTER_DRAIN) { E.fused(acc, cur, wr, wc, fr, fq, lds, wid, lane); S.done(cur); }
#undef PG8_SA
#undef PG8_SB
#undef PG8_STAGE
#undef PG8_LDA
#undef PG8_LDB
#undef PG8_MMA
#undef PG8_WAIT_V
#undef PG8_WAIT_L
#undef PG8_BAR
#undef PG8_SCHED
}
}

typedef unsigned short bf16_t;
typedef float f32x4 __attribute__((ext_vector_type(4)));
typedef unsigned u32x4 __attribute__((ext_vector_type(4)));
#define LAS __attribute__((address_space(3)))
constexpr int NB = 4, S = 8192, DM = 1024, T = NB * S;
constexpr int NIN = 5576;
constexpr int LD1 = 5632;
constexpr int O_QLAT = 0, O_CKV = 384, O_KROPE = 640, O_KIDX = 672, O_WIDX = 704, O_ZA = 768, O_QB = 1280, O_KB = 1792, O_VB = 2304, O_ZB = 2816,
              O_QIDX = 3328, O_GA = 3584, O_GB = 4608;
constexpr size_t MiB = 1u << 20;
constexpr size_t WS_CTL = 0, WS_WUQT = 1 * MiB, WS_WUKVT = 2 * MiB, WS_WOAT = 3 * MiB, WS_WOBT = 4 * MiB, WS_WOUTT = 5 * MiB, WS_ROPE = 7 * MiB,
                 WS_WINT = 8 * MiB, WS_SSQO = 8 * MiB  , WS_SSQLAT = 19 * MiB, WS_KPE = 22 * MiB, WS_KIDX = 24 * MiB, WS_MASK = 26 * MiB,
                 WS_H = 44 * MiB  , WS_Q = 108 * MiB, WS_OUT1 = 156 * MiB, WS_END = 508 * MiB;
constexpr float LOG2E = 1.4426950408889634f;
constexpr float QSCALE_A = 0.10206207261596577f * LOG2E;
constexpr float QSCALE_B = 0.125f * LOG2E;
constexpr int GEMM_LDS = 131072;
constexpr int LDS_BYTES = 147456;

__device__ __forceinline__ float bf2f(bf16_t v) { return __uint_as_float(((unsigned)v) << 16); }
__device__ __forceinline__ bf16_t f2bf(float f) { unsigned u = __float_as_uint(f); return (bf16_t)((u + 0x7fffu + ((u >> 16) & 1u)) >> 16); }
__device__ __forceinline__ unsigned pk2(float lo, float hi) { return (unsigned)f2bf(lo) | ((unsigned)f2bf(hi) << 16); }
__device__ __forceinline__ float bflo(unsigned w) { return __uint_as_float(w << 16); }
__device__ __forceinline__ float bfhi(unsigned w) { return __uint_as_float(w & 0xffff0000u); }
__device__ __forceinline__ float wave_sum(float v) {
#pragma unroll
    for (int o = 1; o < 64; o <<= 1) v += __shfl_xor(v, o);
    return v;
}
__device__ __forceinline__ float sigmoidf_(float x) { return 1.f / (1.f + __expf(-x)); }

struct Ptrs {
    const float *x, *norm_g, *w_in, *g_q, *w_uq, *g_kv, *w_ukv, *w_oa, *w_ob, *w_out, *rel_bias, *final_g;
    float* out; unsigned char* ws;
};

namespace pg8 {
struct EpiIn {
    static constexpr bool PERM = true, AFTER_DRAIN = false;
    bf16_t* O; float* ssq;
    __device__ __forceinline__ void operator()(const f32x4 (&acc)[2][2][4][2], const Unit& u, int wr, int wc, int, int) const {
        int t_ = threadIdx.x; asm volatile("" : "+v"(t_));
        const int fr = t_ & 15, fq = (t_ >> 4) & 3;
        const int row0 = u.pm * BM + wr * 64 + fr;
#pragma unroll
        for (int bj = 0; bj < 2; ++bj) {
            const int g = u.pn * 2 + bj;
            const int col0 = g * 128 + wc * 32 + 8 * fq;
            int op = 0;
            if ((g >= 6 && g <= 9) || (g >= 22 && g <= 25)) op = 1; else if (g >= 28) op = 2; else if (g >= 10 && g <= 13) op = 3; else if (g <= 4) op = 4;
#pragma unroll
            for (int ai = 0; ai < 2; ++ai)
#pragma unroll
                for (int m = 0; m < 4; ++m) {
                    const int row = row0 + ai * HALF + m * 16;
                    f32x4 v0 = acc[ai][bj][m][0], v1 = acc[ai][bj][m][1];
                    if (op == 1) {
#pragma unroll
                        for (int e = 0; e < 4; ++e) { v0[e] = v0[e] * sigmoidf_(v0[e]); v1[e] = v1[e] * sigmoidf_(v1[e]); }
                    } else if (op == 2) {
#pragma unroll
                        for (int e = 0; e < 4; ++e) { v0[e] = sigmoidf_(v0[e]); v1[e] = sigmoidf_(v1[e]); }
                    } else if (op == 3) { v0 = v0 * QSCALE_B; v1 = v1 * QSCALE_B; }
                    else if (op == 4) {
                        float s = (v0[0] * v0[0] + v0[1] * v0[1]) + (v0[2] * v0[2] + v0[3] * v0[3]) + (v1[0] * v1[0] + v1[1] * v1[1]) + (v1[2] * v1[2] + v1[3] * v1[3]);
                        s += __shfl_xor(s, 16); s += __shfl_xor(s, 32);
                        if (fq == 0) ssq[(size_t)row * 20 + g * 4 + wc] = s;
                    }
                    u32x4 w; w.x = cvt_pk_bf16(v0[0], v0[1]); w.y = cvt_pk_bf16(v0[2], v0[3]); w.z = cvt_pk_bf16(v1[0], v1[1]); w.w = cvt_pk_bf16(v1[2], v1[3]);
                    *(u32x4*)(O + (size_t)row * LD1 + col0) = w;
                }
        }
    }
};
struct EpiQ {
    static constexpr bool PERM = true, AFTER_DRAIN = false;
    bf16_t* Q; const float* ssq; const float2* rope;
    __device__ __forceinline__ static f32x4 rope4(f32x4 v, const f32x4 ca, const f32x4 cb, bool first) {
        const float cs[4] = {ca[0], ca[2], cb[0], cb[2]}, sn[4] = {ca[1], ca[3], cb[1], cb[3]};
#pragma unroll
        for (int e = 0; e < 4; ++e) { const float pv = __shfl_xor(v[e], 32); v[e] = first ? (v[e] * cs[e] - pv * sn[e]) : (pv * sn[e] + v[e] * cs[e]); }
        return v;
    }
    __device__ __forceinline__ void operator()(const f32x4 (&acc)[2][2][4][2], const Unit& u, int wr, int wc, int, int) const {
        int t_ = threadIdx.x; asm volatile("" : "+v"(t_));
        const int fr = t_ & 15, fq = (t_ >> 4) & 3;
        const int row0 = u.pm * BM + wr * 64 + fr;
#pragma unroll
        for (int ai = 0; ai < 2; ++ai)
#pragma unroll
            for (int m = 0; m < 4; ++m) {
                const int row = row0 + ai * HALF + m * 16;
                const f32x4* sp = (const f32x4*)(ssq + (size_t)row * 20);
                float tot;
                { const f32x4 s0 = sp[0]; tot = (s0[0] + s0[1]) + (s0[2] + s0[3]); }
                { const f32x4 s1 = sp[1]; tot += (s1[0] + s1[1]) + (s1[2] + s1[3]); }
                { const f32x4 s2 = sp[2]; tot += (s2[0] + s2[1]) + (s2[2] + s2[3]); }
                const float rs = rsqrtf(tot * (1.f / 384.f) + 1e-6f) * QSCALE_A;
                const f32x4* rp = (const f32x4*)(rope + (size_t)(row & (S - 1)) * 16 + 8 * (fq & 1));
#pragma unroll
                for (int bj = 0; bj < 2; ++bj) {
                    const int sl = u.pn * 8 + bj * 4 + wc;
                    f32x4 v0 = acc[ai][bj][m][0] * rs, v1 = acc[ai][bj][m][1] * rs;
                    if (sl % 3 == 2) {
                        v0 = rope4(v0, rp[0], rp[1], fq < 2);
                        v1 = rope4(v1, rp[2], rp[3], fq < 2);
                    }
                    u32x4 w; w.x = cvt_pk_bf16(v0[0], v0[1]); w.y = cvt_pk_bf16(v0[2], v0[3]); w.z = cvt_pk_bf16(v1[0], v1[1]); w.w = cvt_pk_bf16(v1[2], v1[3]);
                    *(u32x4*)(Q + (size_t)row * 768 + sl * 32 + 8 * fq) = w;
                    asm volatile("" ::: "memory");
                }
            }
    }
};
struct EpiKV {
    static constexpr bool PERM = true, AFTER_DRAIN = false;
    bf16_t* KV; const float* ssq;
    __device__ __forceinline__ void operator()(const f32x4 (&acc)[2][2][4][2], const Unit& u, int wr, int wc, int, int) const {
        int t_ = threadIdx.x; asm volatile("" : "+v"(t_));
        const int fr = t_ & 15, fq = (t_ >> 4) & 3;
        const int row0 = u.pm * BM + wr * 64 + fr;
#pragma unroll
        for (int ai = 0; ai < 2; ++ai)
#pragma unroll
            for (int m = 0; m < 4; ++m) {
                const int row = row0 + ai * HALF + m * 16;
                const f32x4* sp = (const f32x4*)(ssq + (size_t)row * 20 + 12);
                const f32x4 s0 = sp[0], s1 = sp[1];
                const float tot = ((s0[0] + s0[1]) + (s0[2] + s0[3])) + ((s1[0] + s1[1]) + (s1[2] + s1[3]));
                const float rs = rsqrtf(tot * (1.f / 256.f) + 1e-6f);
#pragma unroll
                for (int bj = 0; bj < 2; ++bj) {
                    const int col0 = u.pn * BM + bj * HALF + wc * 32 + 8 * fq;
                    const f32x4 v0 = acc[ai][bj][m][0] * rs, v1 = acc[ai][bj][m][1] * rs;
                    u32x4 w; w.x = cvt_pk_bf16(v0[0], v0[1]); w.y = cvt_pk_bf16(v0[2], v0[3]); w.z = cvt_pk_bf16(v1[0], v1[1]); w.w = cvt_pk_bf16(v1[2], v1[3]);
                    *(u32x4*)(KV + (size_t)row * 1024 + col0) = w;
                }
                asm volatile("" ::: "memory");
            }
    }
};
template <bool ADD> struct EpiGate {
    static constexpr bool PERM = true, AFTER_DRAIN = false;
    bf16_t* MG; const bf16_t* O1; int gcol;
    __device__ __forceinline__ void operator()(const f32x4 (&acc)[2][2][4][2], const Unit& u, int wr, int wc, int, int) const {
        int t_ = threadIdx.x; asm volatile("" : "+v"(t_));
        const int fr = t_ & 15, fq = (t_ >> 4) & 3;
        const int row0 = u.pm * BM + wr * 64 + fr;
#pragma unroll
        for (int ai = 0; ai < 2; ++ai)
#pragma unroll
            for (int m = 0; m < 4; ++m) {
                const int row = row0 + ai * HALF + m * 16;
#pragma unroll
                for (int bj = 0; bj < 2; ++bj) {
                    const int col0 = u.pn * BM + bj * HALF + wc * 32 + 8 * fq;
                    const u32x4 gw = *(const u32x4*)(O1 + (size_t)row * LD1 + gcol + col0);
                    f32x4 v0 = acc[ai][bj][m][0], v1 = acc[ai][bj][m][1];
                    v0[0] *= bflo(gw.x); v0[1] *= bfhi(gw.x); v0[2] *= bflo(gw.y); v0[3] *= bfhi(gw.y);
                    v1[0] *= bflo(gw.z); v1[1] *= bfhi(gw.z); v1[2] *= bflo(gw.w); v1[3] *= bfhi(gw.w);
                    u32x4* dst = (u32x4*)(MG + (size_t)row * DM + col0);
                    if (ADD) { const u32x4 pw = *dst;
                        v0[0] += bflo(pw.x); v0[1] += bfhi(pw.x); v0[2] += bflo(pw.y); v0[3] += bfhi(pw.y);
                        v1[0] += bflo(pw.z); v1[1] += bfhi(pw.z); v1[2] += bflo(pw.w); v1[3] += bfhi(pw.w); }
                    u32x4 w; w.x = cvt_pk_bf16(v0[0], v0[1]); w.y = cvt_pk_bf16(v0[2], v0[3]); w.z = cvt_pk_bf16(v1[0], v1[1]); w.w = cvt_pk_bf16(v1[2], v1[3]);
                    *dst = w;
                }
                asm volatile("" ::: "memory");
            }
    }
};
struct EpiOut {
    static constexpr bool PERM = true, AFTER_DRAIN = false;
    const float* x; float* out; float* ssqo;
    __device__ __forceinline__ void operator()(const f32x4 (&acc)[2][2][4][2], const Unit& u, int wr, int wc, int, int) const {
        int t_ = threadIdx.x; asm volatile("" : "+v"(t_));
        const int fr = t_ & 15, fq = (t_ >> 4) & 3;
        const int row0 = u.pm * BM + wr * 64 + fr;
#pragma unroll
        for (int ai = 0; ai < 2; ++ai)
#pragma unroll
            for (int m = 0; m < 4; ++m) {
                const int row = row0 + ai * HALF + m * 16;
#pragma unroll
                for (int bj = 0; bj < 2; ++bj) {
                    const int col0 = u.pn * BM + bj * HALF + wc * 32 + 8 * fq;
                    const f32x4* xp = (const f32x4*)(x + (size_t)row * DM + col0);
                    const f32x4 v0 = acc[ai][bj][m][0] + xp[0], v1 = acc[ai][bj][m][1] + xp[1];
                    f32x4* op = (f32x4*)(out + (size_t)row * DM + col0);
                    op[0] = v0; op[1] = v1;
                    float s = (v0[0] * v0[0] + v0[1] * v0[1]) + (v0[2] * v0[2] + v0[3] * v0[3]) + (v1[0] * v1[0] + v1[1] * v1[1]) + (v1[2] * v1[2] + v1[3] * v1[3]);
                    s += __shfl_xor(s, 16); s += __shfl_xor(s, 32);
                    if (fq == 0) ssqo[(size_t)row * 32 + u.pn * 8 + bj * 4 + wc] = s;
                }
                asm volatile("" ::: "memory");
            }
    }
};
}

struct Frame { LAS unsigned char* lds; int tid, lane, wave, G, bid; Ptrs p; };

__device__ __forceinline__ int win_dest_row(int n) {
    if (n < 672) return n;
    if (n < 3488) return n + 96;
    if (n < 3528) return n - 3488 + 672;
    return n + 56;
}
template <bool MAP>
__device__ __forceinline__ void transpose_item(const float* __restrict__ W, int K, int N, bf16_t* __restrict__ WT, const float* __restrict__ gk, LAS float* scr, int item, int lane) {
    const int nblk = (N + 31) / 32, kb = item / nblk, nb = item % nblk, k0 = 64 * kb, n0 = 32 * nb;
    const int nn = n0 + (lane & 31);
#pragma unroll 8
    for (int i = 0; i < 32; ++i) { const int kk = 2 * i + (lane >> 5); float v = 0.f; if (nn < N) v = W[(size_t)(k0 + kk) * N + nn]; if (gk) v *= gk[k0 + kk]; scr[kk * 33 + (lane & 31)] = v; }
    asm volatile("s_waitcnt lgkmcnt(0)" ::: "memory");
    const int c = lane & 7;
#pragma unroll
    for (int j = 0; j < 4; ++j) { const int n = (lane >> 3) + 8 * j; const LAS float* s = scr + (8 * c) * 33 + n;
        u32x4 o; o.x = pk2(s[0 * 33], s[1 * 33]); o.y = pk2(s[2 * 33], s[3 * 33]); o.z = pk2(s[4 * 33], s[5 * 33]); o.w = pk2(s[6 * 33], s[7 * 33]);
        if (n0 + n < N) { const int dr = MAP ? win_dest_row(n0 + n) : (n0 + n); *(u32x4*)(WT + (size_t)dr * K + k0 + 8 * c) = o; } }
    asm volatile("s_waitcnt lgkmcnt(0)" ::: "memory");
}

__device__ __forceinline__ void phase0(Frame& F) {
    unsigned char* ws = F.p.ws;
    LAS float* scr = (LAS float*)(F.lds + F.wave * 16384);
    const int gw = F.bid * 8 + F.wave, NGW = F.G * 8;
    constexpr int I_IN = 16 * 175, I_UQ = 6 * 24, I_UKV = 4 * 32, I_OA = 8 * 32, I_OB = 8 * 32, I_OUT = 16 * 32;
    constexpr int NITEMS = I_IN + I_UQ + I_UKV + I_OA + I_OB + I_OUT;
    for (int it = gw; it < NITEMS; it += NGW) {
        int r = it;
        if (r < I_IN) { transpose_item<true>(F.p.w_in, 1024, NIN, (bf16_t*)(ws + WS_WINT), nullptr, scr, r, F.lane); continue; } r -= I_IN;
        if (r < I_UQ) { transpose_item<false>(F.p.w_uq, 384, 768, (bf16_t*)(ws + WS_WUQT), F.p.g_q, scr, r, F.lane); continue; } r -= I_UQ;
        if (r < I_UKV) { transpose_item<false>(F.p.w_ukv, 256, 1024, (bf16_t*)(ws + WS_WUKVT), F.p.g_kv, scr, r, F.lane); continue; } r -= I_UKV;
        if (r < I_OA) { transpose_item<false>(F.p.w_oa, 512, 1024, (bf16_t*)(ws + WS_WOAT), nullptr, scr, r, F.lane); continue; } r -= I_OA;
        if (r < I_OB) { transpose_item<false>(F.p.w_ob, 512, 1024, (bf16_t*)(ws + WS_WOBT), nullptr, scr, r, F.lane); continue; } r -= I_OB;
        transpose_item<false>(F.p.w_out, 1024, 1024, (bf16_t*)(ws + WS_WOUTT), nullptr, scr, r, F.lane);
    }
    { const int gt = F.bid * 512 + F.tid; if (gt < 7168) ((u32x4*)(ws + WS_WINT + (size_t)712 * 1024 * 2))[gt] = (u32x4){0u, 0u, 0u, 0u}; }
    for (int e = F.bid * 512 + F.tid; e < S * 16; e += F.G * 512) {
        const int pos = e >> 4, i = e & 15;
        const float freq = powf(10000.f, -(float)i / 16.f); const float ang = (float)pos * freq;
        ((float2*)(ws + WS_ROPE))[e] = make_float2(cosf(ang), sinf(ang));
    }
    bf16_t* H = (bf16_t*)(ws + WS_H);
    for (int row = gw; row < T; row += NGW) {
        const f32x4* xr = (const f32x4*)(F.p.x + (size_t)row * DM);
        f32x4 v[4]; float s = 0.f;
#pragma unroll
        for (int j = 0; j < 4; ++j) { v[j] = xr[F.lane + 64 * j]; s += (v[j][0] * v[j][0] + v[j][1] * v[j][1]) + (v[j][2] * v[j][2] + v[j][3] * v[j][3]); }
        s = wave_sum(s);
        const float r = rsqrtf(s * (1.f / DM) + 1e-6f);
#pragma unroll
        for (int j = 0; j < 4; ++j) {
            const f32x4 gg = ((const f32x4*)F.p.norm_g)[F.lane + 64 * j];
            uint2 o; o.x = pk2(v[j][0] * r * gg[0], v[j][1] * r * gg[1]); o.y = pk2(v[j][2] * r * gg[2], v[j][3] * r * gg[3]);
            ((uint2*)(H + (size_t)row * DM))[F.lane + 64 * j] = o;
        }
    }
}

__device__ __forceinline__ void phase1(Frame& F) {
    unsigned char* ws = F.p.ws;
    pg8::Gemm g{(const bf16_t*)(ws + WS_H), DM, (const bf16_t*)(ws + WS_WINT), T, LD1, DM};
    pg8::StaticOrder So; So.init(T, LD1, F.G, F.bid);
    pg8::EpiIn E{(bf16_t*)(ws + WS_OUT1), (float*)(ws + WS_SSQLAT)};
    pg8::gemm_phase<pg8::EpiIn, pg8::StaticOrder, true, true>(F.lds, g, So, E);
}

__device__ __forceinline__ void phase1b(Frame& F) {
    unsigned char* ws = F.p.ws;
    const bf16_t* O1 = (const bf16_t*)(ws + WS_OUT1);
    {
        bf16_t* KPE = (bf16_t*)(ws + WS_KPE); bf16_t* KIDX = (bf16_t*)(ws + WS_KIDX); const float2* rope = (const float2*)(ws + WS_ROPE);
        for (int e = F.bid * 512 + F.tid; e < T * 16; e += F.G * 512) {
            const int m = e >> 4, i = e & 15; const bf16_t* src = O1 + (size_t)m * LD1;
            const float2 cs = rope[(size_t)(m & (S - 1)) * 16 + i];
            const float x1 = bf2f(src[O_KROPE + i]), x2 = bf2f(src[O_KROPE + 16 + i]);
            KPE[(size_t)m * 32 + i] = f2bf(x1 * cs.x - x2 * cs.y); KPE[(size_t)m * 32 + 16 + i] = f2bf(x1 * cs.y + x2 * cs.x);
            KIDX[(size_t)m * 32 + i] = src[O_KIDX + i]; KIDX[(size_t)m * 32 + 16 + i] = src[O_KIDX + 16 + i];
        }
    }
    {
        pg8::Gemm g{O1 + O_QLAT, LD1, (const bf16_t*)(ws + WS_WUQT), T, 768, 384};
        pg8::StaticOrder So; So.init(T, 768, F.G, F.bid);
        pg8::EpiQ E{(bf16_t*)(ws + WS_Q), (const float*)(ws + WS_SSQLAT), (const float2*)(ws + WS_ROPE)};
        pg8::gemm_phase<pg8::EpiQ, pg8::StaticOrder, true, true>(F.lds, g, So, E);
    }
    {
        pg8::Gemm g{O1 + O_CKV, LD1, (const bf16_t*)(ws + WS_WUKVT), T, 1024, 256};
        pg8::StaticOrder So; So.init(T, 1024, F.G, F.bid);
        pg8::EpiKV E{(bf16_t*)(ws + WS_H), (const float*)(ws + WS_SSQLAT)};
        pg8::gemm_phase<pg8::EpiKV, pg8::StaticOrder, true, true>(F.lds, g, So, E);
    }
}

__device__ __forceinline__ void phase4ab(Frame& F) {
    unsigned char* ws = F.p.ws;
    const bf16_t* O1 = (const bf16_t*)(ws + WS_OUT1); bf16_t* MG = (bf16_t*)(ws + WS_H);
    {
        pg8::Gemm g{O1 + O_ZA, LD1, (const bf16_t*)(ws + WS_WOAT), T, 1024, 512};
        pg8::StaticOrder So; So.init(T, 1024, F.G, F.bid);
        pg8::EpiGate<false> E{MG, O1, O_GA};
        pg8::gemm_phase<pg8::EpiGate<false>, pg8::StaticOrder, true, true>(F.lds, g, So, E);
    }
    {
        pg8::Gemm g{O1 + O_ZB, LD1, (const bf16_t*)(ws + WS_WOBT), T, 1024, 512};
        pg8::StaticOrder So; So.init(T, 1024, F.G, F.bid);
        pg8::EpiGate<true> E{MG, O1, O_GB};
        pg8::gemm_phase<pg8::EpiGate<true>, pg8::StaticOrder, true, true>(F.lds, g, So, E);
    }
}

__device__ __forceinline__ void phase4c(Frame& F) {
    unsigned char* ws = F.p.ws;
    pg8::Gemm g{(const bf16_t*)(ws + WS_H), DM, (const bf16_t*)(ws + WS_WOUTT), T, 1024, 1024};
    pg8::StaticOrder So; So.init(T, 1024, F.G, F.bid);
    pg8::EpiOut E{F.p.x, F.p.out, (float*)(ws + WS_SSQO)};
    pg8::gemm_phase<pg8::EpiOut, pg8::StaticOrder, true, true>(F.lds, g, So, E);
}

__device__ __forceinline__ void phase5(Frame& F) {
    const float* ssqo = (const float*)(F.p.ws + WS_SSQO);
    const int gw = F.bid * 8 + F.wave, NGW = F.G * 8;
    for (int row = gw; row < T; row += NGW) {
        float s = (F.lane < 32) ? ssqo[(size_t)row * 32 + F.lane] : 0.f;
        s = wave_sum(s);
        const float r = rsqrtf(s * (1.f / DM) + 1e-6f);
        f32x4* xr = (f32x4*)(F.p.out + (size_t)row * DM);
#pragma unroll
        for (int j = 0; j < 4; ++j) { const f32x4 gg = ((const f32x4*)F.p.final_g)[F.lane + 64 * j]; xr[F.lane + 64 * j] = xr[F.lane + 64 * j] * r * gg; }
    }
}

__global__ void __launch_bounds__(64) k_mla(Ptrs p) {
    __shared__ float Ks[32][96];
    __shared__ float Vs[32][64];
    const bf16_t* Q = (const bf16_t*)(p.ws + WS_Q); const bf16_t* KV = (const bf16_t*)(p.ws + WS_H); const bf16_t* KPE = (const bf16_t*)(p.ws + WS_KPE);
    bf16_t* O1 = (bf16_t*)(p.ws + WS_OUT1);
    const int c = blockIdx.x, h = blockIdx.y, b = blockIdx.z, t = threadIdx.x;
    const size_t m = (size_t)b * S + c * 64 + t;
    float q[96], o[64];
#pragma unroll
    for (int d = 0; d < 96; ++d) q[d] = bf2f(Q[m * 768 + h * 96 + d]);
#pragma unroll
    for (int d = 0; d < 64; ++d) o[d] = 0.f;
    float mx = -INFINITY, l = 0.f;
    const int nkeys = (c + 1) * 64;
    for (int k0 = 0; k0 < nkeys; k0 += 32) {
        __syncthreads();
        for (int e = t; e < 32 * 96; e += 64) {
            const int j = e / 96, d = e % 96; const size_t n = (size_t)b * S + k0 + j;
            Ks[j][d] = (d < 64) ? bf2f(KV[n * 1024 + h * 128 + d]) : bf2f(KPE[n * 32 + (d - 64)]);
        }
        for (int e = t; e < 32 * 64; e += 64) { const int j = e >> 6, d = e & 63; const size_t n = (size_t)b * S + k0 + j; Vs[j][d] = bf2f(KV[n * 1024 + h * 128 + 64 + d]); }
        __syncthreads();
        for (int j = 0; j < 32; ++j) {
            float s = 0.f;
#pragma unroll
            for (int d = 0; d < 96; ++d) s = fmaf(q[d], Ks[j][d], s);
            const float mn = fmaxf(mx, s), al = exp2f(mx - mn), pp = exp2f(s - mn);
            l = l * al + pp; mx = mn;
#pragma unroll
            for (int d = 0; d < 64; ++d) o[d] = fmaf(pp, Vs[j][d], o[d] * al);
        }
    }
    const float li = 1.f / l;
#pragma unroll
    for (int d = 0; d < 64; ++d) { bf16_t* zp = O1 + m * LD1 + O_ZA + h * 64 + d; *zp = f2bf(o[d] * li * bf2f(*zp)); }
}

__device__ __forceinline__ unsigned f2key(float f) { const unsigned u = __float_as_uint(f); return (u & 0x80000000u) ? ~u : (u | 0x80000000u); }
__device__ __forceinline__ int t5_bucket(int rel) {
    const int n = rel < 0 ? -rel : rel; const int r = rel > 0 ? 16 : 0;
    int v;
    if (n < 8) v = n;
    else { v = 8 + (int)(logf((float)n / 8.f) / 2.772588722239781f * 8.f); if (v > 15) v = 15; }
    return r + v;
}
__global__ void __launch_bounds__(256) k_dsa(Ptrs p) {
    __shared__ float sc[8192];
    __shared__ float lg[8][256];
    __shared__ float qi[8][32];
    __shared__ float qb[512];
    __shared__ float wv[8];
    __shared__ float linv[8];
    __shared__ int sel[256];
    __shared__ int red[8];
    __shared__ int cnt_s;
    bf16_t* O1 = (bf16_t*)(p.ws + WS_OUT1); const bf16_t* KIDX = (const bf16_t*)(p.ws + WS_KIDX);
    const int tid = threadIdx.x, lane = tid & 63, wid = tid >> 6;
    const int m = blockIdx.x, b = m >> 13, qpos = m & (S - 1);
    const size_t mb = (size_t)b * S;
    const bf16_t* prow = O1 + (size_t)m * LD1;
    qi[tid >> 5][tid & 31] = bf2f(prow[O_QIDX + tid]);
    qb[tid] = bf2f(prow[O_QB + tid]); qb[tid + 256] = bf2f(prow[O_QB + tid + 256]);
    if (tid < 8) wv[tid] = bf2f(prow[O_WIDX + tid]) * 0.35355339059327373f;
    if (tid == 0) cnt_s = 0;
    __syncthreads();
    const int nkeys = ((qpos >> 6) + 1) * 64;
    for (int k = tid; k < nkeys; k += 256) {
        const bf16_t* kp = KIDX + (mb + k) * 32;
        float kf[32];
#pragma unroll
        for (int d = 0; d < 32; ++d) kf[d] = bf2f(kp[d]);
        float score = 0.f;
#pragma unroll 1
        for (int h = 0; h < 8; ++h) {
            float s = 0.f;
#pragma unroll
            for (int d = 0; d < 32; ++d) s = fmaf(qi[h][d], kf[d], s);
            s *= 0.17677669529663687f;
            score += fmaxf(s, 0.f) * wv[h];
        }
        sc[k] = score;
    }
    __syncthreads();
    int nsel;
    if (nkeys <= 256) {
        nsel = nkeys;
        if (tid < nkeys) sel[tid] = tid;
    } else {
        unsigned th = 0u;
        for (int bit = 31; bit >= 0; --bit) {
            const unsigned tt = th | (1u << bit);
            int c = 0;
            for (int k = tid; k < nkeys; k += 256) c += (f2key(sc[k]) >= tt) ? 1 : 0;
#pragma unroll
            for (int o = 1; o < 64; o <<= 1) c += __shfl_xor(c, o);
            if (lane == 0) red[wid] = c;
            __syncthreads();
            const int tot = red[0] + red[1] + red[2] + red[3];
            __syncthreads();
            if (tot >= 256) th = tt;
        }
        int cg = 0, ce = 0;
        for (int k = tid; k < nkeys; k += 256) { const unsigned kk = f2key(sc[k]); cg += (kk > th) ? 1 : 0; ce += (kk == th) ? 1 : 0; }
#pragma unroll
        for (int o = 1; o < 64; o <<= 1) { cg += __shfl_xor(cg, o); ce += __shfl_xor(ce, o); }
        if (lane == 0) { red[wid] = cg; red[4 + wid] = ce; }
        __syncthreads();
        const int totg = red[0] + red[1] + red[2] + red[3], tote = red[4] + red[5] + red[6] + red[7];
        const int need = 256 - totg;
        for (int k = tid; k < nkeys; k += 256) {
            const unsigned kk = f2key(sc[k]);
            if (kk > th || (kk == th && tote == need)) { const int pp = atomicAdd(&cnt_s, 1); sel[pp] = k; }
        }
        __syncthreads();
        if (tote != need && tid == 0) {
            int pp = cnt_s, left = need;
            for (int k = 0; k < nkeys && left > 0; ++k) if (f2key(sc[k]) == th) { sel[pp++] = k; --left; }
        }
        nsel = 256;
    }
    __syncthreads();
    if (tid < nsel) {
        const int key = sel[tid];
        const bf16_t* kp = O1 + (mb + key) * LD1 + O_KB;
        const int bk = t5_bucket(key - qpos);
#pragma unroll 1
        for (int h = 0; h < 8; ++h) {
            float s = 0.f;
#pragma unroll 1
            for (int d8 = 0; d8 < 8; ++d8) {
                const uint4 kv = *(const uint4*)(kp + h * 64 + d8 * 8);
                const unsigned w[4] = {kv.x, kv.y, kv.z, kv.w};
#pragma unroll
                for (int e = 0; e < 4; ++e) {
                    s = fmaf(qb[h * 64 + d8 * 8 + 2 * e], bflo(w[e]), s);
                    s = fmaf(qb[h * 64 + d8 * 8 + 2 * e + 1], bfhi(w[e]), s);
                }
            }
            lg[h][tid] = s + p.rel_bias[bk * 8 + h] * LOG2E;
        }
    }
    __syncthreads();
    {
        const int h = tid >> 5, i = tid & 31;
        float mxv = -INFINITY;
        for (int j = i; j < nsel; j += 32) mxv = fmaxf(mxv, lg[h][j]);
#pragma unroll
        for (int o = 1; o < 32; o <<= 1) mxv = fmaxf(mxv, __shfl_xor(mxv, o));
        float sm = 0.f;
        for (int j = i; j < nsel; j += 32) { const float pp = exp2f(lg[h][j] - mxv); lg[h][j] = pp; sm += pp; }
#pragma unroll
        for (int o = 1; o < 32; o <<= 1) sm += __shfl_xor(sm, o);
        if (i == 0) linv[h] = 1.f / sm;
    }
    __syncthreads();
    {
        const int h = tid >> 5, d2 = (tid & 31) * 2;
        float a0 = 0.f, a1 = 0.f;
        for (int j = 0; j < nsel; ++j) {
            const float pp = lg[h][j];
            const unsigned vv = *(const unsigned*)(O1 + (mb + sel[j]) * LD1 + O_VB + h * 64 + d2);
            a0 = fmaf(pp, bflo(vv), a0); a1 = fmaf(pp, bfhi(vv), a1);
        }
        bf16_t* zp = O1 + (size_t)m * LD1 + O_ZB + h * 64 + d2;
        zp[0] = f2bf(a0 * linv[h] * bf2f(zp[0]));
        zp[1] = f2bf(a1 * linv[h] * bf2f(zp[1]));
    }
}

#define PHASE_KERNEL(name, body) \
__global__ void __launch_bounds__(512, 2) name(Ptrs p) { \
    extern __shared__ __attribute__((aligned(16))) unsigned char lds_raw[]; \
    Frame F; F.lds = (LAS unsigned char*)lds_raw; F.tid = threadIdx.x; F.lane = F.tid & 63; F.wave = __builtin_amdgcn_readfirstlane(F.tid >> 6); \
    F.G = gridDim.x; F.bid = blockIdx.x; F.p = p; body(F); }
PHASE_KERNEL(k_p0, phase0)
PHASE_KERNEL(k_p1, phase1)
PHASE_KERNEL(k_p1b, phase1b)
PHASE_KERNEL(k_p4ab, phase4ab)
PHASE_KERNEL(k_p4c, phase4c)
PHASE_KERNEL(k_p5, phase5)

extern "C" void kernel_launch(void* const* d_in, const int* in_sizes, int n_in, void* d_out, int out_size, void* d_ws, size_t ws_size, hipStream_t stream) {
    static int grid = 0;
    if (grid == 0) {
        if (ws_size < WS_END) { fprintf(stderr, "kernel_launch: workspace too small: %zu < %zu\n", ws_size, (size_t)WS_END); grid = -1; return; }
        int dev = 0, cus = 0;
        if (hipGetDevice(&dev) != hipSuccess || hipDeviceGetAttribute(&cus, hipDeviceAttributeMultiprocessorCount, dev) != hipSuccess) { grid = -1; return; }
        const void* ks[6] = {(const void*)k_p0, (const void*)k_p1, (const void*)k_p1b, (const void*)k_p4ab, (const void*)k_p4c, (const void*)k_p5};
        for (int i = 0; i < 6; ++i) if (hipFuncSetAttribute(ks[i], hipFuncAttributeMaxDynamicSharedMemorySize, LDS_BYTES) != hipSuccess) { fprintf(stderr, "hipFuncSetAttribute failed\n"); grid = -1; return; }
        grid = cus;
    }
    if (grid < 0) return;
    Ptrs p{};
    p.x = (const float*)d_in[0]; p.norm_g = (const float*)d_in[1]; p.w_in = (const float*)d_in[2]; p.g_q = (const float*)d_in[3]; p.w_uq = (const float*)d_in[4];
    p.g_kv = (const float*)d_in[5]; p.w_ukv = (const float*)d_in[6]; p.w_oa = (const float*)d_in[7]; p.w_ob = (const float*)d_in[8]; p.w_out = (const float*)d_in[9];
    p.rel_bias = (const float*)d_in[10]; p.final_g = (const float*)d_in[11]; p.out = (float*)d_out; p.ws = (unsigned char*)d_ws;
    hipLaunchKernelGGL(k_p0, dim3(grid), dim3(512), LDS_BYTES, stream, p);
    hipLaunchKernelGGL(k_p1, dim3(grid), dim3(512), LDS_BYTES, stream, p);
    hipLaunchKernelGGL(k_p1b, dim3(grid), dim3(512), LDS_BYTES, stream, p);
    hipLaunchKernelGGL(k_mla, dim3(S / 64, 8, NB), dim3(64), 0, stream, p);
    hipLaunchKernelGGL(k_dsa, dim3(T), dim3(256), 0, stream, p);
    hipLaunchKernelGGL(k_p4ab, dim3(grid), dim3(512), LDS_BYTES, stream, p);
    hipLaunchKernelGGL(k_p4c, dim3(grid), dim3(512), LDS_BYTES, stream, p);
    hipLaunchKernelGGL(k_p5, dim3(grid), dim3(512), LDS_BYTES, stream, p);
}
```

```cpp
#include <hip/hip_runtime.h>
#include <stdint.h>
#include <stdio.h>

namespace pg8 {
#define PG8_LAS __attribute__((address_space(3)))
typedef unsigned short bf16_t;
typedef short bf16x8 __attribute__((ext_vector_type(8)));
typedef float f32x4 __attribute__((ext_vector_type(4)));
typedef unsigned u32x4 __attribute__((ext_vector_type(4)));
constexpr int BM = 256, BK = 64, HALF = 128, HTB = HALF * BK * 2  , STAGE_BYTES = 8 * HTB, NXCD = 8, WGM = 8;

__host__ __device__ __forceinline__ int lds_byte(int r, int c) { const int st = (r >> 4) * 2 + (c >> 5), rr = r & 15, cc = c & 31, ob = rr * 64 + cc * 2; return st * 1024 + (ob ^ (((ob >> 9) & 1) << 5)); }
__host__ __device__ __forceinline__ void stage_rc(int b, int& R, int& C) { const int st = b / 1024, sb = b % 1024, swz = sb ^ (((sb >> 9) & 1) << 5); R = (st >> 1) * 16 + swz / 64; C = (st & 1) * 32 + (swz % 64) / 2; }
__host__ __device__ __forceinline__ int perm32(int rho) { const int n = rho >> 4, i = rho & 15; return 8 * (i >> 2) + 4 * n + (i & 3); }

struct Unit { int pm, pn; };
struct Gemm { const bf16_t* A; int lda; const bf16_t* Bt; int M, N, K; };

struct StaticOrder {
    int nM, nN, nwg, G, c;
    __host__ __device__ void init(int M, int N, int G_, int c_) { nM = M / BM; nN = N / BM; nwg = nM * nN; G = G_; c = c_; }
    __host__ __device__ bool next(int i, Unit& u) const {
        const long L = (long)i * G + c; if (L >= nwg) return false;
        int wgid = (int)L; { const int q = nwg / NXCD, r = nwg % NXCD, xcd = wgid % NXCD, off = wgid / NXCD; wgid = (xcd < r ? xcd * (q + 1) : r * (q + 1) + (xcd - r) * q) + off; }
        const int nig = WGM * nN, gid = wgid / nig, fm = gid * WGM, gsz = (nM - fm) < WGM ? (nM - fm) : WGM;
        u.pm = fm + ((wgid % nig) % gsz); u.pn = (wgid % nig) / gsz; return true;
    }
    __device__ __forceinline__ void a_ready(const Unit&) const {}
    __device__ __forceinline__ void done(const Unit&) const {}
};

__device__ __forceinline__ unsigned cvt_pk_bf16(float lo, float hi) { unsigned r; asm volatile("v_cvt_pk_bf16_f32 %0, %1, %2" : "=v"(r) : "v"(lo), "v"(hi)); return r; }
template <class Epi, class Sched, bool ALIGN_EPI = false, bool SP2 = false>
__device__ __forceinline__ void gemm_phase(PG8_LAS unsigned char* lds, const Gemm g, const Sched& S, const Epi& E) {
    int tid_ = threadIdx.x; asm volatile("" : "+v"(tid_));
    const int tid = tid_, wid = __builtin_amdgcn_readfirstlane(tid >> 6), lane = tid & 63, wr = wid >> 2, wc = wid & 3, fr = lane & 15, fq = lane >> 4;
    int K_ = g.K; asm volatile("" : "+s"(K_));
    const int K = K_, nt = K / BK;
    unsigned voffA[2], voffB[2];
#pragma unroll
    for (int i = 0; i < 2; ++i) { int R, C; stage_rc(tid * 16 + i * 8192, R, C); const int Rb = Epi::PERM ? ((R & ~31) + perm32(R & 31)) : R;
        voffA[i] = (unsigned)(R * g.lda + C) * 2u; voffB[i] = (unsigned)(Rb * K + C) * 2u; }
    const size_t kstep = (size_t)(BK * 2);
    const size_t hstepA = (size_t)HALF * g.lda * 2, hstepB = (size_t)HALF * K * 2;
    const size_t tstepA = 2 * hstepA, tstepB = 2 * hstepB;
    const unsigned ldsw = (unsigned)wid * 1024u;
    const int aoff = lds_byte(wr * 64 + fr, fq * 8), boff = lds_byte(wc * 32 + fr, fq * 8);
#define PG8_SA(b, h) (((b) * 2 + (h)) * HTB)
#define PG8_SB(b, h) ((4 + (b) * 2 + (h)) * HTB)
#define PG8_STAGE(bufoff, gbase, voff) do { _Pragma("unroll") for (int _i = 0; _i < 2; ++_i) \
        __builtin_amdgcn_global_load_lds((const unsigned*)((const char*)(gbase) + (voff)[_i]), (PG8_LAS unsigned*)(lds + (bufoff) + ldsw + _i * 8192), 16, 0, 0); } while (0)
#define PG8_LDA(dst, b, h) do { _Pragma("unroll") for (int m = 0; m < 4; ++m) _Pragma("unroll") for (int k = 0; k < 2; ++k) dst[m][k] = *(const PG8_LAS bf16x8*)(lds + PG8_SA(b, h) + aoff + m * 2048 + k * 1024); } while (0)
#define PG8_LDB(dst, b, h) do { _Pragma("unroll") for (int n = 0; n < 2; ++n) _Pragma("unroll") for (int k = 0; k < 2; ++k) dst[n][k] = *(const PG8_LAS bf16x8*)(lds + PG8_SB(b, h) + boff + n * 2048 + k * 1024); } while (0)
#define PG8_MMA(ai, bj, At, Bt) do { __builtin_amdgcn_s_setprio(1); _Pragma("unroll") for (int m = 0; m < 4; ++m) _Pragma("unroll") for (int n = 0; n < 2; ++n) _Pragma("unroll") for (int k = 0; k < 2; ++k) \
        acc[ai][bj][m][n] = __builtin_amdgcn_mfma_f32_16x16x32_bf16(Bt[n][k], At[m][k], acc[ai][bj][m][n], 0, 0, 0); __builtin_amdgcn_s_setprio(0); } while (0)
#define PG8_WAIT_V(n) asm volatile("s_waitcnt vmcnt(" #n ")" ::: "memory")
#define PG8_WAIT_L(n) asm volatile("s_waitcnt lgkmcnt(" #n ")" ::: "memory")
#define PG8_BAR __builtin_amdgcn_s_barrier()
#define PG8_SCHED __builtin_amdgcn_sched_barrier(0)
    Unit cur, nxt; int ui = 0;
    if (!S.next(0, cur)) return;
    f32x4 acc[2][2][4][2];
#pragma unroll
    for (int a = 0; a < 2; ++a)
#pragma unroll
        for (int b = 0; b < 2; ++b)
#pragma unroll
            for (int m = 0; m < 4; ++m)
#pragma unroll
                for (int n = 0; n < 2; ++n) acc[a][b][m][n] = (f32x4){0.f, 0.f, 0.f, 0.f};
    bf16x8 At[4][2], B0[2][2], B1[2][2];
    const char* cA = (const char*)g.A + (size_t)cur.pm * tstepA; const char* cB = (const char*)g.Bt + (size_t)cur.pn * tstepB;
    S.a_ready(cur);
    if constexpr (SP2) {
        PG8_STAGE(PG8_SB(0, 0), cB, voffB); PG8_STAGE(PG8_SB(0, 1), cB + hstepB, voffB); PG8_STAGE(PG8_SA(0, 0), cA, voffA); PG8_STAGE(PG8_SA(0, 1), cA + hstepA, voffA);
        if (wr == 1) PG8_BAR;
        PG8_WAIT_V(2); PG8_BAR;
        PG8_STAGE(PG8_SB(1, 0), cB + kstep, voffB); PG8_STAGE(PG8_SA(1, 0), cA + kstep, voffA); PG8_STAGE(PG8_SB(1, 1), cB + hstepB + kstep, voffB);
        PG8_WAIT_V(6); PG8_BAR;
    } else {
        PG8_STAGE(PG8_SB(0, 0), cB, voffB); PG8_STAGE(PG8_SA(0, 0), cA, voffA); PG8_STAGE(PG8_SB(0, 1), cB + hstepB, voffB); PG8_STAGE(PG8_SA(0, 1), cA + hstepA, voffA);
        if (wr == 1) PG8_BAR;
        PG8_WAIT_V(4); PG8_BAR;
        PG8_STAGE(PG8_SB(1, 0), cB + kstep, voffB); PG8_STAGE(PG8_SA(1, 0), cA + kstep, voffA); PG8_STAGE(PG8_SB(1, 1), cB + hstepB + kstep, voffB);
        PG8_WAIT_V(6); PG8_BAR;
    }
    for (;;) {
        const bool has_next = S.next(ui + 1, nxt);
        const char* nA = has_next ? (const char*)g.A + (size_t)nxt.pm * tstepA : cA; const char* nB = has_next ? (const char*)g.Bt + (size_t)nxt.pn * tstepB : cB;
        for (int t = 0; t < nt; t += 2) {
            const bool last = (t == nt - 2);
            const char* a1 = cA + (size_t)(t + 1) * kstep;
            const char* a2 = last ? nA : cA + (size_t)(t + 2) * kstep; const char* b2 = last ? nB : cB + (size_t)(t + 2) * kstep;
            const char* a3 = a2 + kstep; const char* b3 = b2 + kstep;
            if (last && has_next) S.a_ready(nxt);
            if constexpr (SP2) {
            PG8_LDB(B0, 0, 0); PG8_LDB(B1, 0, 1); PG8_SCHED; PG8_LDA(At, 0, 0); PG8_STAGE(PG8_SA(1, 1), a1 + hstepA, voffA);
            PG8_WAIT_V(8); PG8_WAIT_L(0); PG8_BAR; PG8_MMA(0, 0, At, B0); PG8_MMA(0, 1, At, B1); PG8_BAR; PG8_SCHED;
            PG8_LDA(At, 0, 1); PG8_STAGE(PG8_SB(0, 0), b2, voffB); PG8_STAGE(PG8_SB(0, 1), b2 + hstepB, voffB); PG8_STAGE(PG8_SA(0, 0), a2, voffA);
            PG8_WAIT_V(8); PG8_WAIT_L(0); PG8_BAR; PG8_MMA(1, 0, At, B0); PG8_MMA(1, 1, At, B1); PG8_BAR; PG8_SCHED;
            PG8_LDB(B0, 1, 0); PG8_LDB(B1, 1, 1); PG8_SCHED; PG8_LDA(At, 1, 0); PG8_STAGE(PG8_SA(0, 1), a2 + hstepA, voffA);
            PG8_WAIT_V(8); PG8_WAIT_L(0); PG8_BAR; PG8_MMA(0, 0, At, B0); PG8_MMA(0, 1, At, B1); PG8_BAR; PG8_SCHED;
            PG8_LDA(At, 1, 1); PG8_STAGE(PG8_SB(1, 0), b3, voffB); PG8_STAGE(PG8_SB(1, 1), b3 + hstepB, voffB); PG8_STAGE(PG8_SA(1, 0), a3, voffA);
            PG8_WAIT_V(8); PG8_WAIT_L(0); PG8_BAR; PG8_MMA(1, 0, At, B0); PG8_MMA(1, 1, At, B1); PG8_BAR; PG8_SCHED;
            } else {
            PG8_LDB(B0, 0, 0); PG8_SCHED; PG8_LDA(At, 0, 0); PG8_STAGE(PG8_SA(1, 1), a1 + hstepA, voffA);
            PG8_WAIT_L(8); PG8_BAR; PG8_WAIT_L(0); PG8_MMA(0, 0, At, B0); PG8_BAR; PG8_SCHED;
            PG8_LDB(B1, 0, 1); PG8_STAGE(PG8_SB(0, 0), b2, voffB);
            PG8_BAR; PG8_WAIT_L(0); PG8_MMA(0, 1, At, B1); PG8_BAR;
            PG8_LDA(At, 0, 1); PG8_STAGE(PG8_SA(0, 0), a2, voffA);
            PG8_BAR; PG8_WAIT_L(0); PG8_MMA(1, 0, At, B0); PG8_BAR; PG8_SCHED;
            PG8_STAGE(PG8_SB(0, 1), b2 + hstepB, voffB);
            PG8_WAIT_V(6); PG8_BAR; PG8_MMA(1, 1, At, B1); PG8_BAR;
            PG8_LDB(B0, 1, 0); PG8_SCHED; PG8_LDA(At, 1, 0); PG8_STAGE(PG8_SA(0, 1), a2 + hstepA, voffA);
            PG8_WAIT_L(8); PG8_BAR; PG8_WAIT_L(0); PG8_MMA(0, 0, At, B0); PG8_BAR; PG8_SCHED;
            PG8_LDB(B1, 1, 1); PG8_STAGE(PG8_SB(1, 0), b3, voffB);
            PG8_BAR; PG8_WAIT_L(0); PG8_MMA(0, 1, At, B1); PG8_BAR;
            PG8_LDA(At, 1, 1); PG8_STAGE(PG8_SA(1, 0), a3, voffA);
            PG8_BAR; PG8_WAIT_L(0); PG8_MMA(1, 0, At, B0); PG8_BAR; PG8_SCHED;
            PG8_STAGE(PG8_SB(1, 1), b3 + hstepB, voffB);
            PG8_WAIT_V(6); PG8_BAR; PG8_MMA(1, 1, At, B1); PG8_BAR;
            }
        }
        if constexpr (ALIGN_EPI) { if (wr == 0) PG8_BAR; }
        if constexpr (!Epi::AFTER_DRAIN) { E(acc, cur, wr, wc, fr, fq); S.done(cur); }
        if (!has_next) break;
#pragma unroll
        for (int a = 0; a < 2; ++a)
#pragma unroll
            for (int b = 0; b < 2; ++b)
#pragma unroll
                for (int m = 0; m < 4; ++m)
#pragma unroll
                    for (int n = 0; n < 2; ++n) acc[a][b][m][n] = (f32x4){0.f, 0.f, 0.f, 0.f};
        cur = nxt; cA = nA; cB = nB; ++ui;
        if constexpr (ALIGN_EPI) { if (wr == 1) PG8_BAR; }
    }
    PG8_WAIT_V(0);
    if constexpr (!ALIGN_EPI) { if (wr == 0) PG8_BAR; }
    PG8_BAR;
    if constexpr (Epi::AFTER_DRAIN) { E.fused(acc, cur, wr, wc, fr, fq, lds, wid, lane); S.done(cur); }
#undef PG8_SA
#undef PG8_SB
#undef PG8_STAGE
#undef PG8_LDA
#undef PG8_LDB
#undef PG8_MMA
#undef PG8_WAIT_V
#undef PG8_WAIT_L
#undef PG8_BAR
#undef PG8_SCHED
}
}

typedef unsigned short bf16_t;
typedef float f32x4 __attribute__((ext_vector_type(4)));
typedef unsigned u32x4 __attribute__((ext_vector_type(4)));
#define LAS __attribute__((address_space(3)))
constexpr int NB = 4, S = 8192, DM = 1024, T = NB * S;
constexpr int NIN = 5576;
constexpr int LD1 = 5632;
constexpr int O_QLAT = 0, O_CKV = 384, O_KROPE = 640, O_KIDX = 672, O_WIDX = 704, O_ZA = 768, O_QB = 1280, O_KB = 1792, O_VB = 2304, O_ZB = 2816,
              O_QIDX = 3328, O_GA = 3584, O_GB = 4608;
constexpr size_t MiB = 1u << 20;
constexpr size_t WS_CTL = 0, WS_WUQT = 1 * MiB, WS_WUKVT = 2 * MiB, WS_WOAT = 3 * MiB, WS_WOBT = 4 * MiB, WS_WOUTT = 5 * MiB, WS_ROPE = 7 * MiB,
                 WS_WINT = 8 * MiB, WS_SSQO = 8 * MiB  , WS_SSQLAT = 19 * MiB, WS_KPE = 22 * MiB, WS_KIDX = 24 * MiB, WS_MASK = 26 * MiB,
                 WS_H = 44 * MiB  , WS_Q = 108 * MiB, WS_OUT1 = 156 * MiB, WS_END = 508 * MiB;
constexpr float LOG2E = 1.4426950408889634f;
constexpr float QSCALE_A = 0.10206207261596577f * LOG2E;
constexpr float QSCALE_B = 0.125f * LOG2E;
constexpr int GEMM_LDS = 131072;
constexpr int LDS_BYTES = 147456;

__device__ __forceinline__ float bf2f(bf16_t v) { return __uint_as_float(((unsigned)v) << 16); }
__device__ __forceinline__ bf16_t f2bf(float f) { unsigned u = __float_as_uint(f); return (bf16_t)((u + 0x7fffu + ((u >> 16) & 1u)) >> 16); }
__device__ __forceinline__ unsigned pk2(float lo, float hi) { return (unsigned)f2bf(lo) | ((unsigned)f2bf(hi) << 16); }
__device__ __forceinline__ float bflo(unsigned w) { return __uint_as_float(w << 16); }
__device__ __forceinline__ float bfhi(unsigned w) { return __uint_as_float(w & 0xffff0000u); }
__device__ __forceinline__ float wave_sum(float v) {
#pragma unroll
    for (int o = 1; o < 64; o <<= 1) v += __shfl_xor(v, o);
    return v;
}
__device__ __forceinline__ float sigmoidf_(float x) { return 1.f / (1.f + __expf(-x)); }

struct Ptrs {
    const float *x, *norm_g, *w_in, *g_q, *w_uq, *g_kv, *w_ukv, *w_oa, *w_ob, *w_out, *rel_bias, *final_g;
    float* out; unsigned char* ws;
};

namespace pg8 {
struct EpiIn {
    static constexpr bool PERM = true, AFTER_DRAIN = false;
    bf16_t* O; float* ssq;
    __device__ __forceinline__ void operator()(const f32x4 (&acc)[2][2][4][2], const Unit& u, int wr, int wc, int, int) const {
        int t_ = threadIdx.x; asm volatile("" : "+v"(t_));
        const int fr = t_ & 15, fq = (t_ >> 4) & 3;
        const int row0 = u.pm * BM + wr * 64 + fr;
#pragma unroll
        for (int bj = 0; bj < 2; ++bj) {
            const int g = u.pn * 2 + bj;
            const int col0 = g * 128 + wc * 32 + 8 * fq;
            int op = 0;
            if ((g >= 6 && g <= 9) || (g >= 22 && g <= 25)) op = 1; else if (g >= 28) op = 2; else if (g >= 10 && g <= 13) op = 3; else if (g <= 4) op = 4;
#pragma unroll
            for (int ai = 0; ai < 2; ++ai)
#pragma unroll
                for (int m = 0; m < 4; ++m) {
                    const int row = row0 + ai * HALF + m * 16;
                    f32x4 v0 = acc[ai][bj][m][0], v1 = acc[ai][bj][m][1];
                    if (op == 1) {
#pragma unroll
                        for (int e = 0; e < 4; ++e) { v0[e] = v0[e] * sigmoidf_(v0[e]); v1[e] = v1[e] * sigmoidf_(v1[e]); }
                    } else if (op == 2) {
#pragma unroll
                        for (int e = 0; e < 4; ++e) { v0[e] = sigmoidf_(v0[e]); v1[e] = sigmoidf_(v1[e]); }
                    } else if (op == 3) { v0 = v0 * QSCALE_B; v1 = v1 * QSCALE_B; }
                    else if (op == 4) {
                        float s = (v0[0] * v0[0] + v0[1] * v0[1]) + (v0[2] * v0[2] + v0[3] * v0[3]) + (v1[0] * v1[0] + v1[1] * v1[1]) + (v1[2] * v1[2] + v1[3] * v1[3]);
                        s += __shfl_xor(s, 16); s += __shfl_xor(s, 32);
                        if (fq == 0) ssq[(size_t)row * 20 + g * 4 + wc] = s;
                    }
                    u32x4 w; w.x = cvt_pk_bf16(v0[0], v0[1]); w.y = cvt_pk_bf16(v0[2], v0[3]); w.z = cvt_pk_bf16(v1[0], v1[1]); w.w = cvt_pk_bf16(v1[2], v1[3]);
                    *(u32x4*)(O + (size_t)row * LD1 + col0) = w;
                }
        }
    }
};
struct EpiQ {
    static constexpr bool PERM = true, AFTER_DRAIN = false;
    bf16_t* Q; const float* ssq; const float2* rope;
    __device__ __forceinline__ static f32x4 rope4(f32x4 v, const f32x4 ca, const f32x4 cb, bool first) {
        const float cs[4] = {ca[0], ca[2], cb[0], cb[2]}, sn[4] = {ca[1], ca[3], cb[1], cb[3]};
#pragma unroll
        for (int e = 0; e < 4; ++e) { const float pv = __shfl_xor(v[e], 32); v[e] = first ? (v[e] * cs[e] - pv * sn[e]) : (pv * sn[e] + v[e] * cs[e]); }
        return v;
    }
    __device__ __forceinline__ void operator()(const f32x4 (&acc)[2][2][4][2], const Unit& u, int wr, int wc, int, int) const {
        int t_ = threadIdx.x; asm volatile("" : "+v"(t_));
        const int fr = t_ & 15, fq = (t_ >> 4) & 3;
        const int row0 = u.pm * BM + wr * 64 + fr;
#pragma unroll
        for (int ai = 0; ai < 2; ++ai)
#pragma unroll
            for (int m = 0; m < 4; ++m) {
                const int row = row0 + ai * HALF + m * 16;
                const f32x4* sp = (const f32x4*)(ssq + (size_t)row * 20);
                float tot;
                { const f32x4 s0 = sp[0]; tot = (s0[0] + s0[1]) + (s0[2] + s0[3]); }
                { const f32x4 s1 = sp[1]; tot += (s1[0] + s1[1]) + (s1[2] + s1[3]); }
                { const f32x4 s2 = sp[2]; tot += (s2[0] + s2[1]) + (s2[2] + s2[3]); }
                const float rs = rsqrtf(tot * (1.f / 384.f) + 1e-6f) * QSCALE_A;
                const f32x4* rp = (const f32x4*)(rope + (size_t)(row & (S - 1)) * 16 + 8 * (fq & 1));
#pragma unroll
                for (int bj = 0; bj < 2; ++bj) {
                    const int sl = u.pn * 8 + bj * 4 + wc;
                    f32x4 v0 = acc[ai][bj][m][0] * rs, v1 = acc[ai][bj][m][1] * rs;
                    if (sl % 3 == 2) {
                        v0 = rope4(v0, rp[0], rp[1], fq < 2);
                        v1 = rope4(v1, rp[2], rp[3], fq < 2);
                    }
                    u32x4 w; w.x = cvt_pk_bf16(v0[0], v0[1]); w.y = cvt_pk_bf16(v0[2], v0[3]); w.z = cvt_pk_bf16(v1[0], v1[1]); w.w = cvt_pk_bf16(v1[2], v1[3]);
                    *(u32x4*)(Q + (size_t)row * 768 + sl * 32 + 8 * fq) = w;
                    asm volatile("" ::: "memory");
                }
            }
    }
};
struct EpiKV {
    static constexpr bool PERM = true, AFTER_DRAIN = false;
    bf16_t* KV; const float* ssq;
    __device__ __forceinline__ void operator()(const f32x4 (&acc)[2][2][4][2], const Unit& u, int wr, int wc, int, int) const {
        int t_ = threadIdx.x; asm volatile("" : "+v"(t_));
        const int fr = t_ & 15, fq = (t_ >> 4) & 3;
        const int row0 = u.pm * BM + wr * 64 + fr;
#pragma unroll
        for (int ai = 0; ai < 2; ++ai)
#pragma unroll
            for (int m = 0; m < 4; ++m) {
                const int row = row0 + ai * HALF + m * 16;
                const f32x4* sp = (const f32x4*)(ssq + (size_t)row * 20 + 12);
                const f32x4 s0 = sp[0], s1 = sp[1];
                const float tot = ((s0[0] + s0[1]) + (s0[2] + s0[3])) + ((s1[0] + s1[1]) + (s1[2] + s1[3]));
                const float rs = rsqrtf(tot * (1.f / 256.f) + 1e-6f);
#pragma unroll
                for (int bj = 0; bj < 2; ++bj) {
                    const int col0 = u.pn * BM + bj * HALF + wc * 32 + 8 * fq;
                    const f32x4 v0 = acc[ai][bj][m][0] * rs, v1 = acc[ai][bj][m][1] * rs;
                    u32x4 w; w.x = cvt_pk_bf16(v0[0], v0[1]); w.y = cvt_pk_bf16(v0[2], v0[3]); w.z = cvt_pk_bf16(v1[0], v1[1]); w.w = cvt_pk_bf16(v1[2], v1[3]);
                    *(u32x4*)(KV + (size_t)row * 1024 + col0) = w;
                }
                asm volatile("" ::: "memory");
            }
    }
};
template <bool ADD> struct EpiGate {
    static constexpr bool PERM = true, AFTER_DRAIN = false;
    bf16_t* MG; const bf16_t* O1; int gcol;
    __device__ __forceinline__ void operator()(const f32x4 (&acc)[2][2][4][2], const Unit& u, int wr, int wc, int, int) const {
        int t_ = threadIdx.x; asm volatile("" : "+v"(t_));
        const int fr = t_ & 15, fq = (t_ >> 4) & 3;
        const int row0 = u.pm * BM + wr * 64 + fr;
#pragma unroll
        for (int ai = 0; ai < 2; ++ai)
#pragma unroll
            for (int m = 0; m < 4; ++m) {
                const int row = row0 + ai * HALF + m * 16;
#pragma unroll
                for (int bj = 0; bj < 2; ++bj) {
                    const int col0 = u.pn * BM + bj * HALF + wc * 32 + 8 * fq;
                    const u32x4 gw = *(const u32x4*)(O1 + (size_t)row * LD1 + gcol + col0);
                    f32x4 v0 = acc[ai][bj][m][0], v1 = acc[ai][bj][m][1];
                    v0[0] *= bflo(gw.x); v0[1] *= bfhi(gw.x); v0[2] *= bflo(gw.y); v0[3] *= bfhi(gw.y);
                    v1[0] *= bflo(gw.z); v1[1] *= bfhi(gw.z); v1[2] *= bflo(gw.w); v1[3] *= bfhi(gw.w);
                    u32x4* dst = (u32x4*)(MG + (size_t)row * DM + col0);
                    if (ADD) { const u32x4 pw = *dst;
                        v0[0] += bflo(pw.x); v0[1] += bfhi(pw.x); v0[2] += bflo(pw.y); v0[3] += bfhi(pw.y);
                        v1[0] += bflo(pw.z); v1[1] += bfhi(pw.z); v1[2] += bflo(pw.w); v1[3] += bfhi(pw.w); }
                    u32x4 w; w.x = cvt_pk_bf16(v0[0], v0[1]); w.y = cvt_pk_bf16(v0[2], v0[3]); w.z = cvt_pk_bf16(v1[0], v1[1]); w.w = cvt_pk_bf16(v1[2], v1[3]);
                    *dst = w;
                }
                asm volatile("" ::: "memory");
            }
    }
};
struct EpiOut {
    static constexpr bool PERM = true, AFTER_DRAIN = false;
    const float* x; float* out; float* ssqo;
    __device__ __forceinline__ void operator()(const f32x4 (&acc)[2][2][4][2], const Unit& u, int wr, int wc, int, int) const {
        int t_ = threadIdx.x; asm volatile("" : "+v"(t_));
        const int fr = t_ & 15, fq = (t_ >> 4) & 3;
        const int row0 = u.pm * BM + wr * 64 + fr;
#pragma unroll
        for (int ai = 0; ai < 2; ++ai)
#pragma unroll
            for (int m = 0; m < 4; ++m) {
                const int row = row0 + ai * HALF + m * 16;
#pragma unroll
                for (int bj = 0; bj < 2; ++bj) {
                    const int col0 = u.pn * BM + bj * HALF + wc * 32 + 8 * fq;
                    const f32x4* xp = (const f32x4*)(x + (size_t)row * DM + col0);
                    const f32x4 v0 = acc[ai][bj][m][0] + xp[0], v1 = acc[ai][bj][m][1] + xp[1];
                    f32x4* op = (f32x4*)(out + (size_t)row * DM + col0);
                    op[0] = v0; op[1] = v1;
                    float s = (v0[0] * v0[0] + v0[1] * v0[1]) + (v0[2] * v0[2] + v0[3] * v0[3]) + (v1[0] * v1[0] + v1[1] * v1[1]) + (v1[2] * v1[2] + v1[3] * v1[3]);
                    s += __shfl_xor(s, 16); s += __shfl_xor(s, 32);
                    if (fq == 0) ssqo[(size_t)row * 32 + u.pn * 8 + bj * 4 + wc] = s;
                }
                asm volatile("" ::: "memory");
            }
    }
};
}


namespace att {
typedef short bf16x8 __attribute__((ext_vector_type(8)));
typedef short s16x4 __attribute__((ext_vector_type(4)));
typedef float f32x16 __attribute__((ext_vector_type(16)));
typedef unsigned u32x4 __attribute__((ext_vector_type(4)));
typedef const LAS char* lds_cptr;
constexpr int SLOT_K = 12288, SLOT_V = 8192;
constexpr int L_K = 0, L_V = 2 * SLOT_K, L_WS = L_V + 2 * SLOT_V, L_OST = L_WS + 2048, L_BIAS = L_OST + 8 * 4096, L_END = L_BIAS + 2048;
constexpr float THR = 8.f;
#define MFMA32(a, b, c) __builtin_amdgcn_mfma_f32_32x32x16_bf16(a, b, c, 0, 0, 0)
__device__ __forceinline__ int crow(int r, int hi) { return (r & 3) + 8 * (r >> 2) + 4 * hi; }
__device__ __forceinline__ unsigned cvtpk(float lo, float hi) { unsigned r; asm("v_cvt_pk_bf16_f32 %0, %1, %2" : "=v"(r) : "v"(lo), "v"(hi)); return r; }
__device__ __forceinline__ s16x4 vtr(lds_cptr p) { typedef short v4i16_t __attribute__((ext_vector_type(4))); return __builtin_bit_cast(s16x4, __builtin_amdgcn_ds_read_tr16_b64_v4i16((LAS v4i16_t*)p)); }
#define MX3(a, b, c) __builtin_fmaxf(__builtin_fmaxf((a), (b)), (c))
__device__ __forceinline__ float rowmax(const f32x16& p0, const f32x16& p1) {
    float a = MX3(p0[0], p0[1], p1[0]), b = MX3(p0[2], p0[3], p1[1]); a = MX3(a, p1[2], p1[3]);
#pragma unroll
    for (int r = 4; r < 16; r += 4) { a = MX3(a, p0[r], p0[r + 1]); b = MX3(b, p0[r + 2], p0[r + 3]); a = MX3(a, p1[r], p1[r + 1]); b = MX3(b, p1[r + 2], p1[r + 3]); }
    const float m = __builtin_fmaxf(a, b); auto rr = __builtin_amdgcn_permlane32_swap(__float_as_uint(m), __float_as_uint(m), false, false);
    return __builtin_fmaxf(__uint_as_float(rr[0]), __uint_as_float(rr[1])); }
__device__ __forceinline__ float maskp(float p, unsigned lo, unsigned hi) {
    const unsigned long long mk = ((unsigned long long)hi << 32) | lo; float o;
    asm("v_cndmask_b32_e64 %0, 0, %1, %2" : "=v"(o) : "v"(p), "s"(mk)); return o; }
__host__ __device__ __forceinline__ size_t mask_tile_off(int qt32) { const int J = qt32 >> 1; return (size_t)2 * J * (J + 1) + ((qt32 & 1) ? 2 * (J + 1) : 0); }
constexpr size_t MASK_TILES_PER_BATCH = (size_t)2 * 128 * 129;

struct Tensors {
    const bf16_t* Q; int ldq;
    const bf16_t* K0; int ldk;
    const bf16_t* K1;
    const bf16_t* V; int ldv;
    bf16_t* O; int ldo;
    const unsigned long long* mask;
    const float* rel_bias;
    int hq, hk, hv;
};

template <bool DSA>
__device__ __forceinline__ void unit(int b, int h, int qb, const Tensors& X, LAS unsigned char* lds) {
    constexpr int NDQ = DSA ? 4 : 6;
    int tid_ = threadIdx.x; asm volatile("" : "+v"(tid_));
    const int tid = tid_, lane = tid & 63, r32 = lane & 31, hi = lane >> 5; const int wid = __builtin_amdgcn_readfirstlane(tid >> 6);
    const size_t rowbase = (size_t)b * S; const int q0 = qb * 256, NT = 4 * qb + 4, NTw = 4 * qb + (wid >> 1) + 1;
    LAS float* wsf = (LAS float*)(lds + L_WS) + wid * 64;
    const bf16_t* ksrc = X.K0 + (rowbase + lane) * X.ldk + h * X.hk + wid * 8;
    const bf16_t* ksrc1 = DSA ? nullptr : X.K1 + (rowbase + lane) * 32 + (wid & 3) * 8;
    const bf16_t* vsrc = X.V + (rowbase + 16 * (wid & 3) + (lane >> 2)) * X.ldv + h * X.hv + (wid >> 2) * 32 + (lane & 3) * 8;
    const size_t kstride = (size_t)64 * X.ldk, vstride = (size_t)64 * X.ldv;
    LAS unsigned char* kdst = lds + L_K + wid * 1024; LAS unsigned char* kdst1 = lds + L_K + (8 + (wid & 3)) * 1024; LAS unsigned char* vdst = lds + L_V + wid * 1024;
    u32x4 sk0, sk1 = {}, sv;
#define ATT_LOAD(t) do { sk0 = *(const u32x4*)(ksrc + (size_t)(t) * kstride); if (!DSA && wid < 4) sk1 = *(const u32x4*)(ksrc1 + (size_t)(t) * 64 * 32); \
                         sv = *(const u32x4*)(vsrc + (size_t)(t) * vstride); } while (0)
#define ATT_WRITE(slot) do { *(LAS u32x4*)(kdst + (slot) * SLOT_K + lane * 16) = sk0; if (!DSA && wid < 4) *(LAS u32x4*)(kdst1 + (slot) * SLOT_K + lane * 16) = sk1; \
                             *(LAS u32x4*)(vdst + (slot) * SLOT_V + lane * 16) = sv; } while (0)
    const lds_cptr vp0 = (lds_cptr)lds + L_V + ((lane >> 4) & 1) * 32 + (lane & 3) * 8 + (4 * hi + ((lane & 15) >> 2)) * 64;
    const lds_cptr kp0 = (lds_cptr)lds + L_K + hi * 1024 + r32 * 16;
    ATT_LOAD(0); ATT_WRITE(0);
    bf16x8 qr[NDQ];
    { const bf16_t* Qw = X.Q + (rowbase + q0 + wid * 32 + r32) * X.ldq + h * X.hq + hi * 8;
#pragma unroll
      for (int d0 = 0; d0 < NDQ; ++d0) qr[d0] = *(const bf16x8*)(Qw + d0 * 16); }
    if (DSA) {
        LAS float* tab = (LAS float*)(lds + L_BIAS);
        const float c15 = X.rel_bias[15 * 8 + h];
        for (int e = tid; e < 320; e += 512) {
            const int rel = e - 255, n = rel < 0 ? -rel : rel; int v;
            if (n < 8) v = n; else if (n < 12) v = 8; else if (n < 16) v = 9; else if (n < 23) v = 10; else if (n < 32) v = 11; else if (n < 46) v = 12; else if (n < 64) v = 13; else if (n < 91) v = 14; else v = 15;
            tab[e] = (X.rel_bias[((rel > 0 ? 16 : 0) + v) * 8 + h] - c15) * LOG2E;
        }
    }
    float mhat = 0.f, l_reg = 0.f; f32x16 o0 = {}, o1 = {};
    const int qpos = q0 + wid * 32 + r32;
    for (int t = 0; t < NT; ++t) {
        asm volatile("s_waitcnt vmcnt(0) lgkmcnt(0)\n\ts_barrier" ::: "memory");
        if (t + 1 < NT) ATT_LOAD(t + 1);
        if (t < NTw) {
            const int so_k = (t & 1) * SLOT_K, so_v = (t & 1) * SLOT_V;
            f32x16 c0 = {}, c1 = {};
#pragma unroll
            for (int d0 = 0; d0 < NDQ; ++d0) {
                const bf16x8 k0 = *(const LAS bf16x8*)(kp0 + so_k + d0 * 2048), k1 = *(const LAS bf16x8*)(kp0 + so_k + d0 * 2048 + 512);
                c0 = MFMA32(k0, qr[d0], c0); c1 = MFMA32(k1, qr[d0], c1);
            }
            if (DSA) {
                if (64 * t + 63 - (q0 + wid * 32) > -128) {
                    const LAS float* tab = (const LAS float*)(lds + L_BIAS);
                    const int base = 64 * t + 4 * hi - qpos + 255;
#pragma unroll
                    for (int r = 0; r < 16; ++r) { const int kr = (r & 3) + 8 * (r >> 2); int i0 = base + kr, i1 = base + kr + 32; i0 = i0 < 0 ? 0 : i0; i1 = i1 < 0 ? 0 : i1;
                        c0[r] += tab[i0]; c1[r] += tab[i1]; }
                }
            }
            const float rm = rowmax(c0, c1);
            if (t == 0) mhat = rm;
            else {
                const float grow = rm - mhat;
                if (__any(grow > THR)) {
                    const float dl = __builtin_fmaxf(grow, 0.f); mhat += dl;
                    const float f = __builtin_amdgcn_exp2f(-dl); l_reg *= f;
                    if (hi == 0) wsf[r32] = f;
                    asm volatile("s_waitcnt lgkmcnt(0)" ::: "memory");
#pragma unroll
                    for (int r = 0; r < 16; ++r) { const float fr = wsf[crow(r, hi)]; o0[r] *= fr; o1[r] *= fr; }
                }
            }
            const float nm = -mhat;
#pragma unroll
            for (int r = 0; r < 16; ++r) { c0[r] = __builtin_amdgcn_exp2f(c0[r] + nm); c1[r] = __builtin_amdgcn_exp2f(c1[r] + nm); }
            if (DSA) {
                const int qt32 = qb * 8 + wid;
                const unsigned* mt = (const unsigned*)((const unsigned short*)X.mask + ((size_t)b * MASK_TILES_PER_BATCH + mask_tile_off(qt32)) * 64) + (size_t)t * 64;
                const unsigned mw = mt[lane];
#pragma unroll
                for (int r = 0; r < 16; ++r) { c0[r] = ((mw >> r) & 1u) ? c0[r] : 0.f; c1[r] = ((mw >> (16 + r)) & 1u) ? c1[r] : 0.f; }
            }
            float sacc = 0.f;
#pragma unroll
            for (int r = 0; r < 16; ++r) sacc += c0[r] + c1[r];
            l_reg += sacc;
            u32x4 pw0 = {cvtpk(c0[0], c0[1]), cvtpk(c0[2], c0[3]), cvtpk(c0[4], c0[5]), cvtpk(c0[6], c0[7])};
            u32x4 pw1 = {cvtpk(c0[8], c0[9]), cvtpk(c0[10], c0[11]), cvtpk(c0[12], c0[13]), cvtpk(c0[14], c0[15])};
            u32x4 pw2 = {cvtpk(c1[0], c1[1]), cvtpk(c1[2], c1[3]), cvtpk(c1[4], c1[5]), cvtpk(c1[6], c1[7])};
            u32x4 pw3 = {cvtpk(c1[8], c1[9]), cvtpk(c1[10], c1[11]), cvtpk(c1[12], c1[13]), cvtpk(c1[14], c1[15])};
            const lds_cptr vp = vp0 + so_v;
#define ATT_VFR(i) ({ const s16x4 lo_ = vtr(vp + (((i) >> 2) * 4096 + ((i) & 3) * 1024)), hi_ = vtr(vp + (((i) >> 2) * 4096 + ((i) & 3) * 1024 + 512)); \
                      (bf16x8){lo_[0], lo_[1], lo_[2], lo_[3], hi_[0], hi_[1], hi_[2], hi_[3]}; })
            o0 = MFMA32(__builtin_bit_cast(bf16x8, pw0), ATT_VFR(0), o0); o1 = MFMA32(__builtin_bit_cast(bf16x8, pw0), ATT_VFR(4), o1);
            o0 = MFMA32(__builtin_bit_cast(bf16x8, pw1), ATT_VFR(1), o0); o1 = MFMA32(__builtin_bit_cast(bf16x8, pw1), ATT_VFR(5), o1);
            o0 = MFMA32(__builtin_bit_cast(bf16x8, pw2), ATT_VFR(2), o0); o1 = MFMA32(__builtin_bit_cast(bf16x8, pw2), ATT_VFR(6), o1);
            o0 = MFMA32(__builtin_bit_cast(bf16x8, pw3), ATT_VFR(3), o0); o1 = MFMA32(__builtin_bit_cast(bf16x8, pw3), ATT_VFR(7), o1);
        }
        if (t + 1 < NT) ATT_WRITE((t + 1) & 1);
    }
    { auto rr = __builtin_amdgcn_permlane32_swap(__float_as_uint(l_reg), __float_as_uint(l_reg), false, false); l_reg = __uint_as_float(rr[0]) + __uint_as_float(rr[1]); }
    if (hi == 0) wsf[32 + r32] = l_reg;
    asm volatile("s_waitcnt lgkmcnt(0)" ::: "memory");
    LAS bf16_t* stg = (LAS bf16_t*)(lds + L_OST) + wid * 2048;
#pragma unroll
    for (int r = 0; r < 16; ++r) { const int orow = crow(r, hi); const float rli = __builtin_amdgcn_rcpf(wsf[32 + orow]);
        stg[orow * 64 + r32] = f2bf(o0[r] * rli); stg[orow * 64 + 32 + r32] = f2bf(o1[r] * rli); }
    asm volatile("s_waitcnt lgkmcnt(0)" ::: "memory");
    bf16_t* Ow = X.O + (rowbase + q0 + wid * 32) * X.ldo + h * 64;
#pragma unroll
    for (int i = 0; i < 4; ++i) { const int row = i * 8 + (lane >> 3), ch = lane & 7;
        const u32x4 ov = *(const LAS u32x4*)(stg + row * 64 + ch * 8); u32x4* gp = (u32x4*)(Ow + (size_t)row * X.ldo + ch * 8); const u32x4 gv = *gp;
        u32x4 res; res.x = pk2(bflo(ov.x) * bflo(gv.x), bfhi(ov.x) * bfhi(gv.x)); res.y = pk2(bflo(ov.y) * bflo(gv.y), bfhi(ov.y) * bfhi(gv.y));
        res.z = pk2(bflo(ov.z) * bflo(gv.z), bfhi(ov.z) * bfhi(gv.z)); res.w = pk2(bflo(ov.w) * bflo(gv.w), bfhi(ov.w) * bfhi(gv.w)); *gp = res; }
    asm volatile("s_waitcnt vmcnt(0) lgkmcnt(0)\n\ts_barrier" ::: "memory");
#undef ATT_LOAD
#undef ATT_WRITE
#undef ATT_VFR
}

template <bool DSA>
__device__ __forceinline__ void phase(const Tensors& X, LAS unsigned char* lds, int G, int bid) {
    for (int p = bid; p < 512; p += G) {
        const int x = p & 7, kk = p >> 3, bh = x + 8 * (kk >> 4), j = kk & 15;
#pragma unroll 1
        for (int u2 = 0; u2 < 2; ++u2) unit<DSA>(bh >> 3, bh & 7, u2 ? 31 - j : j, X, lds);
    }
}
}

namespace idx {
typedef short bf16x8 __attribute__((ext_vector_type(8)));
typedef float f32x16 __attribute__((ext_vector_type(16)));
constexpr int HROW = 257;
constexpr int L_HIST = 0, L_PFX = 32 * HROW * 4, L_NEED = L_PFX + 128, L_END = L_NEED + 128;
__device__ __forceinline__ unsigned f2key(float f) { const unsigned u = __float_as_uint(f); return (u & 0x80000000u) ? ~u : (u | 0x80000000u); }

__device__ __forceinline__ void score_tile(float (&acc)[16], const bf16_t* __restrict__ kidx_tile, int r32, int hi, const bf16x8 (&qf)[8][2], const float (&wv)[8]) {
    const bf16x8 k0 = *(const bf16x8*)(kidx_tile + r32 * 32 + hi * 8), k1 = *(const bf16x8*)(kidx_tile + r32 * 32 + 16 + hi * 8);
#pragma unroll
    for (int r = 0; r < 16; ++r) acc[r] = 0.f;
#pragma unroll
    for (int h = 0; h < 8; ++h) {
        f32x16 c = __builtin_amdgcn_mfma_f32_32x32x16_bf16(k0, qf[h][0], (f32x16){}, 0, 0, 0);
        c = __builtin_amdgcn_mfma_f32_32x32x16_bf16(k1, qf[h][1], c, 0, 0, 0);
#pragma unroll
        for (int r = 0; r < 16; ++r) { acc[r] = __builtin_fmaf(__builtin_fmaxf(c[r], 0.f), wv[h], acc[r]); asm volatile("" : "+v"(acc[r])); }
        if (h & 1) __builtin_amdgcn_sched_barrier(0);
    }
}

__device__ __forceinline__ void unit(int b, int qt, const bf16_t* __restrict__ O1, const bf16_t* __restrict__ KIDX, unsigned* __restrict__ MASK, LAS unsigned char* lds) {
    int tid_ = threadIdx.x; asm volatile("" : "+v"(tid_));
    const int tid = tid_, lane = tid & 63, r32 = lane & 31, hi = lane >> 5; const int wid = __builtin_amdgcn_readfirstlane(tid >> 6);
    const size_t rowbase = (size_t)b * S; const int nkt = 2 * ((qt >> 1) + 1);
    LAS unsigned* hist = (LAS unsigned*)(lds + L_HIST); LAS unsigned* spfx = (LAS unsigned*)(lds + L_PFX); LAS int* sneed = (LAS int*)(lds + L_NEED);
    bf16x8 qf[8][2]; float wv[8];
    { const bf16_t* qrow = O1 + (rowbase + qt * 32 + r32) * LD1;
#pragma unroll
      for (int h = 0; h < 8; ++h) { qf[h][0] = *(const bf16x8*)(qrow + O_QIDX + 32 * h + hi * 8); qf[h][1] = *(const bf16x8*)(qrow + O_QIDX + 32 * h + 16 + hi * 8); }
      const u32x4 ww = *(const u32x4*)(qrow + O_WIDX);
      const float sc = 0.35355339059327373f * 0.17677669529663687f;
      wv[0] = bflo(ww.x) * sc; wv[1] = bfhi(ww.x) * sc; wv[2] = bflo(ww.y) * sc; wv[3] = bfhi(ww.y) * sc; wv[4] = bflo(ww.z) * sc; wv[5] = bfhi(ww.z) * sc; wv[6] = bflo(ww.w) * sc; wv[7] = bfhi(ww.w) * sc; }
    const bf16_t* kbase = KIDX + rowbase * 32;
    unsigned tau = 0u;
    if (nkt * 32 > 256) {
        if (tid < 32) { spfx[tid] = 0u; sneed[tid] = 256; }
        for (int pass = 0; pass < 4; ++pass) {
            for (int e = tid; e < 32 * HROW; e += 512) hist[e] = 0u;
            asm volatile("s_waitcnt lgkmcnt(0)\n\ts_barrier" ::: "memory");
            const unsigned pfx = spfx[r32]; const int sh_bin = 24 - 8 * pass;
            for (int kt = wid; kt < nkt; kt += 8) {
                float acc[16]; score_tile(acc, kbase + (size_t)kt * 32 * 32, r32, hi, qf, wv);
#pragma unroll
                for (int r = 0; r < 16; ++r) {
                    const unsigned key = f2key(acc[r]);
                    const bool match = (pass == 0) || ((key >> (sh_bin + 8)) == pfx);
                    if (match) __hip_atomic_fetch_add(hist + r32 * HROW + ((key >> sh_bin) & 255u), 1u, __ATOMIC_RELAXED, __HIP_MEMORY_SCOPE_WORKGROUP);
                }
            }
            asm volatile("s_waitcnt lgkmcnt(0)\n\ts_barrier" ::: "memory");
#pragma unroll 1
            for (int qi = 0; qi < 4; ++qi) {
                const int q = wid * 4 + qi; const LAS unsigned* hr = hist + q * HROW + 4 * lane;
                const int c0 = (int)hr[0], c1 = (int)hr[1], c2 = (int)hr[2], c3 = (int)hr[3];
                const int c = (c0 + c1) + (c2 + c3);
                int sfx = c;
#pragma unroll
                for (int d = 1; d < 64; d <<= 1) { const int o = __shfl_down(sfx, d); sfx += (lane + d < 64) ? o : 0; }
                const int above = sfx - c, need = sneed[q];
                if (sfx >= need && above < need) {
                    int run = above, bstar, nn;
                    if (run + c3 >= need) { bstar = 3; nn = need - run; }
                    else { run += c3; if (run + c2 >= need) { bstar = 2; nn = need - run; }
                    else { run += c2; if (run + c1 >= need) { bstar = 1; nn = need - run; }
                    else { run += c1; bstar = 0; nn = need - run; } } }
                    spfx[q] = (spfx[q] << 8) | (unsigned)(4 * lane + bstar); sneed[q] = nn;
                }
            }
            asm volatile("s_waitcnt lgkmcnt(0)\n\ts_barrier" ::: "memory");
        }
        tau = spfx[r32];
    }
    unsigned short* mbase = (unsigned short*)MASK + ((size_t)b * att::MASK_TILES_PER_BATCH + att::mask_tile_off(qt)) * 64;
    for (int kt = wid; kt < nkt; kt += 8) {
        float acc[16]; score_tile(acc, kbase + (size_t)kt * 32 * 32, r32, hi, qf, wv);
        unsigned bits = 0u;
#pragma unroll
        for (int r = 0; r < 16; ++r) bits |= (f2key(acc[r]) >= tau) ? (1u << r) : 0u;
        mbase[(size_t)(kt >> 1) * 128 + lane * 2 + (kt & 1)] = (unsigned short)bits;
    }
    asm volatile("s_waitcnt lgkmcnt(0)\n\ts_barrier" ::: "memory");
}

__device__ __forceinline__ void phase(const bf16_t* O1, const bf16_t* KIDX, unsigned* MASK, LAS unsigned char* lds, int G, int bid) {
    for (int p = bid; p < 512; p += G) {
        const int b = p & 3, j = p >> 2;
#pragma unroll 1
        for (int u2 = 0; u2 < 2; ++u2) unit(b, u2 ? 255 - j : j, O1, KIDX, MASK, lds);
    }
}
}
struct Frame { LAS unsigned char* lds; int tid, lane, wave, G, bid; Ptrs p; };

__device__ __forceinline__ int win_dest_row(int n) {
    if (n < 672) return n;
    if (n < 3488) return n + 96;
    if (n < 3528) return n - 3488 + 672;
    return n + 56;
}
template <bool MAP>
__device__ __forceinline__ void transpose_item(const float* __restrict__ W, int K, int N, bf16_t* __restrict__ WT, const float* __restrict__ gk, LAS float* scr, int item, int lane) {
    const int nblk = (N + 31) / 32, kb = item / nblk, nb = item % nblk, k0 = 64 * kb, n0 = 32 * nb;
    const int nn = n0 + (lane & 31);
#pragma unroll 8
    for (int i = 0; i < 32; ++i) { const int kk = 2 * i + (lane >> 5); float v = 0.f; if (nn < N) v = W[(size_t)(k0 + kk) * N + nn]; if (gk) v *= gk[k0 + kk]; scr[kk * 33 + (lane & 31)] = v; }
    asm volatile("s_waitcnt lgkmcnt(0)" ::: "memory");
    const int c = lane & 7;
#pragma unroll
    for (int j = 0; j < 4; ++j) { const int n = (lane >> 3) + 8 * j; const LAS float* s = scr + (8 * c) * 33 + n;
        u32x4 o; o.x = pk2(s[0 * 33], s[1 * 33]); o.y = pk2(s[2 * 33], s[3 * 33]); o.z = pk2(s[4 * 33], s[5 * 33]); o.w = pk2(s[6 * 33], s[7 * 33]);
        if (n0 + n < N) { const int dr = MAP ? win_dest_row(n0 + n) : (n0 + n); *(u32x4*)(WT + (size_t)dr * K + k0 + 8 * c) = o; } }
    asm volatile("s_waitcnt lgkmcnt(0)" ::: "memory");
}

__device__ __forceinline__ void phase0(Frame& F) {
    unsigned char* ws = F.p.ws;
    LAS float* scr = (LAS float*)(F.lds + F.wave * 16384);
    const int gw = F.bid * 8 + F.wave, NGW = F.G * 8;
    constexpr int I_IN = 16 * 175, I_UQ = 6 * 24, I_UKV = 4 * 32, I_OA = 8 * 32, I_OB = 8 * 32, I_OUT = 16 * 32;
    constexpr int NITEMS = I_IN + I_UQ + I_UKV + I_OA + I_OB + I_OUT;
    for (int it = gw; it < NITEMS; it += NGW) {
        int r = it;
        if (r < I_IN) { transpose_item<true>(F.p.w_in, 1024, NIN, (bf16_t*)(ws + WS_WINT), nullptr, scr, r, F.lane); continue; } r -= I_IN;
        if (r < I_UQ) { transpose_item<false>(F.p.w_uq, 384, 768, (bf16_t*)(ws + WS_WUQT), F.p.g_q, scr, r, F.lane); continue; } r -= I_UQ;
        if (r < I_UKV) { transpose_item<false>(F.p.w_ukv, 256, 1024, (bf16_t*)(ws + WS_WUKVT), F.p.g_kv, scr, r, F.lane); continue; } r -= I_UKV;
        if (r < I_OA) { transpose_item<false>(F.p.w_oa, 512, 1024, (bf16_t*)(ws + WS_WOAT), nullptr, scr, r, F.lane); continue; } r -= I_OA;
        if (r < I_OB) { transpose_item<false>(F.p.w_ob, 512, 1024, (bf16_t*)(ws + WS_WOBT), nullptr, scr, r, F.lane); continue; } r -= I_OB;
        transpose_item<false>(F.p.w_out, 1024, 1024, (bf16_t*)(ws + WS_WOUTT), nullptr, scr, r, F.lane);
    }
    { const int gt = F.bid * 512 + F.tid; if (gt < 7168) ((u32x4*)(ws + WS_WINT + (size_t)712 * 1024 * 2))[gt] = (u32x4){0u, 0u, 0u, 0u}; }
    for (int e = F.bid * 512 + F.tid; e < S * 16; e += F.G * 512) {
        const int pos = e >> 4, i = e & 15;
        const float freq = powf(10000.f, -(float)i / 16.f); const float ang = (float)pos * freq;
        ((float2*)(ws + WS_ROPE))[e] = make_float2(cosf(ang), sinf(ang));
    }
    bf16_t* H = (bf16_t*)(ws + WS_H);
    for (int row = gw; row < T; row += NGW) {
        const f32x4* xr = (const f32x4*)(F.p.x + (size_t)row * DM);
        f32x4 v[4]; float s = 0.f;
#pragma unroll
        for (int j = 0; j < 4; ++j) { v[j] = xr[F.lane + 64 * j]; s += (v[j][0] * v[j][0] + v[j][1] * v[j][1]) + (v[j][2] * v[j][2] + v[j][3] * v[j][3]); }
        s = wave_sum(s);
        const float r = rsqrtf(s * (1.f / DM) + 1e-6f);
#pragma unroll
        for (int j = 0; j < 4; ++j) {
            const f32x4 gg = ((const f32x4*)F.p.norm_g)[F.lane + 64 * j];
            uint2 o; o.x = pk2(v[j][0] * r * gg[0], v[j][1] * r * gg[1]); o.y = pk2(v[j][2] * r * gg[2], v[j][3] * r * gg[3]);
            ((uint2*)(H + (size_t)row * DM))[F.lane + 64 * j] = o;
        }
    }
}

__device__ __forceinline__ void phase1(Frame& F) {
    unsigned char* ws = F.p.ws;
    pg8::Gemm g{(const bf16_t*)(ws + WS_H), DM, (const bf16_t*)(ws + WS_WINT), T, LD1, DM};
    pg8::StaticOrder So; So.init(T, LD1, F.G, F.bid);
    pg8::EpiIn E{(bf16_t*)(ws + WS_OUT1), (float*)(ws + WS_SSQLAT)};
    pg8::gemm_phase<pg8::EpiIn, pg8::StaticOrder, true, true>(F.lds, g, So, E);
}

__device__ __forceinline__ void phase1b(Frame& F) {
    unsigned char* ws = F.p.ws;
    const bf16_t* O1 = (const bf16_t*)(ws + WS_OUT1);
    {
        bf16_t* KPE = (bf16_t*)(ws + WS_KPE); bf16_t* KIDX = (bf16_t*)(ws + WS_KIDX); const float2* rope = (const float2*)(ws + WS_ROPE);
        for (int e = F.bid * 512 + F.tid; e < T * 16; e += F.G * 512) {
            const int m = e >> 4, i = e & 15; const bf16_t* src = O1 + (size_t)m * LD1;
            const float2 cs = rope[(size_t)(m & (S - 1)) * 16 + i];
            const float x1 = bf2f(src[O_KROPE + i]), x2 = bf2f(src[O_KROPE + 16 + i]);
            KPE[(size_t)m * 32 + i] = f2bf(x1 * cs.x - x2 * cs.y); KPE[(size_t)m * 32 + 16 + i] = f2bf(x1 * cs.y + x2 * cs.x);
            KIDX[(size_t)m * 32 + i] = src[O_KIDX + i]; KIDX[(size_t)m * 32 + 16 + i] = src[O_KIDX + 16 + i];
        }
    }
    {
        pg8::Gemm g{O1 + O_QLAT, LD1, (const bf16_t*)(ws + WS_WUQT), T, 768, 384};
        pg8::StaticOrder So; So.init(T, 768, F.G, F.bid);
        pg8::EpiQ E{(bf16_t*)(ws + WS_Q), (const float*)(ws + WS_SSQLAT), (const float2*)(ws + WS_ROPE)};
        pg8::gemm_phase<pg8::EpiQ, pg8::StaticOrder, true, true>(F.lds, g, So, E);
    }
    {
        pg8::Gemm g{O1 + O_CKV, LD1, (const bf16_t*)(ws + WS_WUKVT), T, 1024, 256};
        pg8::StaticOrder So; So.init(T, 1024, F.G, F.bid);
        pg8::EpiKV E{(bf16_t*)(ws + WS_H), (const float*)(ws + WS_SSQLAT)};
        pg8::gemm_phase<pg8::EpiKV, pg8::StaticOrder, true, true>(F.lds, g, So, E);
    }
}

__device__ __forceinline__ void phase4ab(Frame& F) {
    unsigned char* ws = F.p.ws;
    const bf16_t* O1 = (const bf16_t*)(ws + WS_OUT1); bf16_t* MG = (bf16_t*)(ws + WS_H);
    {
        pg8::Gemm g{O1 + O_ZA, LD1, (const bf16_t*)(ws + WS_WOAT), T, 1024, 512};
        pg8::StaticOrder So; So.init(T, 1024, F.G, F.bid);
        pg8::EpiGate<false> E{MG, O1, O_GA};
        pg8::gemm_phase<pg8::EpiGate<false>, pg8::StaticOrder, true, true>(F.lds, g, So, E);
    }
    {
        pg8::Gemm g{O1 + O_ZB, LD1, (const bf16_t*)(ws + WS_WOBT), T, 1024, 512};
        pg8::StaticOrder So; So.init(T, 1024, F.G, F.bid);
        pg8::EpiGate<true> E{MG, O1, O_GB};
        pg8::gemm_phase<pg8::EpiGate<true>, pg8::StaticOrder, true, true>(F.lds, g, So, E);
    }
}

__device__ __forceinline__ void phase4c(Frame& F) {
    unsigned char* ws = F.p.ws;
    pg8::Gemm g{(const bf16_t*)(ws + WS_H), DM, (const bf16_t*)(ws + WS_WOUTT), T, 1024, 1024};
    pg8::StaticOrder So; So.init(T, 1024, F.G, F.bid);
    pg8::EpiOut E{F.p.x, F.p.out, (float*)(ws + WS_SSQO)};
    pg8::gemm_phase<pg8::EpiOut, pg8::StaticOrder, true, true>(F.lds, g, So, E);
}

__device__ __forceinline__ void phase5(Frame& F) {
    const float* ssqo = (const float*)(F.p.ws + WS_SSQO);
    const int gw = F.bid * 8 + F.wave, NGW = F.G * 8;
    for (int row = gw; row < T; row += NGW) {
        float s = (F.lane < 32) ? ssqo[(size_t)row * 32 + F.lane] : 0.f;
        s = wave_sum(s);
        const float r = rsqrtf(s * (1.f / DM) + 1e-6f);
        f32x4* xr = (f32x4*)(F.p.out + (size_t)row * DM);
#pragma unroll
        for (int j = 0; j < 4; ++j) { const f32x4 gg = ((const f32x4*)F.p.final_g)[F.lane + 64 * j]; xr[F.lane + 64 * j] = xr[F.lane + 64 * j] * r * gg; }
    }
}

__device__ __forceinline__ void phase_mla(Frame& F) {
    unsigned char* ws = F.p.ws;
    att::Tensors X{};
    X.Q = (const bf16_t*)(ws + WS_Q); X.ldq = 768; X.hq = 96;
    X.K0 = (const bf16_t*)(ws + WS_H); X.ldk = 1024; X.hk = 128; X.K1 = (const bf16_t*)(ws + WS_KPE);
    X.V = (const bf16_t*)(ws + WS_H) + 64; X.ldv = 1024; X.hv = 128;
    X.O = (bf16_t*)(ws + WS_OUT1) + O_ZA; X.ldo = LD1; X.mask = nullptr; X.rel_bias = nullptr;
    att::phase<false>(X, F.lds, F.G, F.bid);
}
__device__ __forceinline__ void phase_dsa(Frame& F) {
    unsigned char* ws = F.p.ws; bf16_t* O1 = (bf16_t*)(ws + WS_OUT1);
    att::Tensors X{};
    X.Q = O1 + O_QB; X.ldq = LD1; X.hq = 64;
    X.K0 = O1 + O_KB; X.ldk = LD1; X.hk = 64; X.K1 = nullptr;
    X.V = O1 + O_VB; X.ldv = LD1; X.hv = 64;
    X.O = O1 + O_ZB; X.ldo = LD1; X.mask = (const unsigned long long*)(ws + WS_MASK); X.rel_bias = F.p.rel_bias;
    att::phase<true>(X, F.lds, F.G, F.bid);
}

__device__ __forceinline__ void phase_idx(Frame& F) {
    unsigned char* ws = F.p.ws;
    idx::phase((const bf16_t*)(ws + WS_OUT1), (const bf16_t*)(ws + WS_KIDX), (unsigned*)(ws + WS_MASK), F.lds, F.G, F.bid);
}

__global__ void __launch_bounds__(64) k_mla(Ptrs p) {
    __shared__ float Ks[32][96];
    __shared__ float Vs[32][64];
    const bf16_t* Q = (const bf16_t*)(p.ws + WS_Q); const bf16_t* KV = (const bf16_t*)(p.ws + WS_H); const bf16_t* KPE = (const bf16_t*)(p.ws + WS_KPE);
    bf16_t* O1 = (bf16_t*)(p.ws + WS_OUT1);
    const int c = blockIdx.x, h = blockIdx.y, b = blockIdx.z, t = threadIdx.x;
    const size_t m = (size_t)b * S + c * 64 + t;
    float q[96], o[64];
#pragma unroll
    for (int d = 0; d < 96; ++d) q[d] = bf2f(Q[m * 768 + h * 96 + d]);
#pragma unroll
    for (int d = 0; d < 64; ++d) o[d] = 0.f;
    float mx = -INFINITY, l = 0.f;
    const int nkeys = (c + 1) * 64;
    for (int k0 = 0; k0 < nkeys; k0 += 32) {
        __syncthreads();
        for (int e = t; e < 32 * 96; e += 64) {
            const int j = e / 96, d = e % 96; const size_t n = (size_t)b * S + k0 + j;
            Ks[j][d] = (d < 64) ? bf2f(KV[n * 1024 + h * 128 + d]) : bf2f(KPE[n * 32 + (d - 64)]);
        }
        for (int e = t; e < 32 * 64; e += 64) { const int j = e >> 6, d = e & 63; const size_t n = (size_t)b * S + k0 + j; Vs[j][d] = bf2f(KV[n * 1024 + h * 128 + 64 + d]); }
        __syncthreads();
        for (int j = 0; j < 32; ++j) {
            float s = 0.f;
#pragma unroll
            for (int d = 0; d < 96; ++d) s = fmaf(q[d], Ks[j][d], s);
            const float mn = fmaxf(mx, s), al = exp2f(mx - mn), pp = exp2f(s - mn);
            l = l * al + pp; mx = mn;
#pragma unroll
            for (int d = 0; d < 64; ++d) o[d] = fmaf(pp, Vs[j][d], o[d] * al);
        }
    }
    const float li = 1.f / l;
#pragma unroll
    for (int d = 0; d < 64; ++d) { bf16_t* zp = O1 + m * LD1 + O_ZA + h * 64 + d; *zp = f2bf(o[d] * li * bf2f(*zp)); }
}

__device__ __forceinline__ unsigned f2key(float f) { const unsigned u = __float_as_uint(f); return (u & 0x80000000u) ? ~u : (u | 0x80000000u); }
__device__ __forceinline__ int t5_bucket(int rel) {
    const int n = rel < 0 ? -rel : rel; const int r = rel > 0 ? 16 : 0;
    int v;
    if (n < 8) v = n;
    else { v = 8 + (int)(logf((float)n / 8.f) / 2.772588722239781f * 8.f); if (v > 15) v = 15; }
    return r + v;
}
__global__ void __launch_bounds__(256) k_dsa(Ptrs p) {
    __shared__ float sc[8192];
    __shared__ float lg[8][256];
    __shared__ float qi[8][32];
    __shared__ float qb[512];
    __shared__ float wv[8];
    __shared__ float linv[8];
    __shared__ int sel[256];
    __shared__ int red[8];
    __shared__ int cnt_s;
    bf16_t* O1 = (bf16_t*)(p.ws + WS_OUT1); const bf16_t* KIDX = (const bf16_t*)(p.ws + WS_KIDX);
    const int tid = threadIdx.x, lane = tid & 63, wid = tid >> 6;
    const int m = blockIdx.x, b = m >> 13, qpos = m & (S - 1);
    const size_t mb = (size_t)b * S;
    const bf16_t* prow = O1 + (size_t)m * LD1;
    qi[tid >> 5][tid & 31] = bf2f(prow[O_QIDX + tid]);
    qb[tid] = bf2f(prow[O_QB + tid]); qb[tid + 256] = bf2f(prow[O_QB + tid + 256]);
    if (tid < 8) wv[tid] = bf2f(prow[O_WIDX + tid]) * 0.35355339059327373f;
    if (tid == 0) cnt_s = 0;
    __syncthreads();
    const int nkeys = ((qpos >> 6) + 1) * 64;
    for (int k = tid; k < nkeys; k += 256) {
        const bf16_t* kp = KIDX + (mb + k) * 32;
        float kf[32];
#pragma unroll
        for (int d = 0; d < 32; ++d) kf[d] = bf2f(kp[d]);
        float score = 0.f;
#pragma unroll 1
        for (int h = 0; h < 8; ++h) {
            float s = 0.f;
#pragma unroll
            for (int d = 0; d < 32; ++d) s = fmaf(qi[h][d], kf[d], s);
            s *= 0.17677669529663687f;
            score += fmaxf(s, 0.f) * wv[h];
        }
        sc[k] = score;
    }
    __syncthreads();
    int nsel;
    if (nkeys <= 256) {
        nsel = nkeys;
        if (tid < nkeys) sel[tid] = tid;
    } else {
        unsigned th = 0u;
        for (int bit = 31; bit >= 0; --bit) {
            const unsigned tt = th | (1u << bit);
            int c = 0;
            for (int k = tid; k < nkeys; k += 256) c += (f2key(sc[k]) >= tt) ? 1 : 0;
#pragma unroll
            for (int o = 1; o < 64; o <<= 1) c += __shfl_xor(c, o);
            if (lane == 0) red[wid] = c;
            __syncthreads();
            const int tot = red[0] + red[1] + red[2] + red[3];
            __syncthreads();
            if (tot >= 256) th = tt;
        }
        int cg = 0, ce = 0;
        for (int k = tid; k < nkeys; k += 256) { const unsigned kk = f2key(sc[k]); cg += (kk > th) ? 1 : 0; ce += (kk == th) ? 1 : 0; }
#pragma unroll
        for (int o = 1; o < 64; o <<= 1) { cg += __shfl_xor(cg, o); ce += __shfl_xor(ce, o); }
        if (lane == 0) { red[wid] = cg; red[4 + wid] = ce; }
        __syncthreads();
        const int totg = red[0] + red[1] + red[2] + red[3], tote = red[4] + red[5] + red[6] + red[7];
        const int need = 256 - totg;
        for (int k = tid; k < nkeys; k += 256) {
            const unsigned kk = f2key(sc[k]);
            if (kk > th || (kk == th && tote == need)) { const int pp = atomicAdd(&cnt_s, 1); sel[pp] = k; }
        }
        __syncthreads();
        if (tote != need && tid == 0) {
            int pp = cnt_s, left = need;
            for (int k = 0; k < nkeys && left > 0; ++k) if (f2key(sc[k]) == th) { sel[pp++] = k; --left; }
        }
        nsel = 256;
    }
    __syncthreads();
    if (tid < nsel) {
        const int key = sel[tid];
        const bf16_t* kp = O1 + (mb + key) * LD1 + O_KB;
        const int bk = t5_bucket(key - qpos);
#pragma unroll 1
        for (int h = 0; h < 8; ++h) {
            float s = 0.f;
#pragma unroll 1
            for (int d8 = 0; d8 < 8; ++d8) {
                const uint4 kv = *(const uint4*)(kp + h * 64 + d8 * 8);
                const unsigned w[4] = {kv.x, kv.y, kv.z, kv.w};
#pragma unroll
                for (int e = 0; e < 4; ++e) {
                    s = fmaf(qb[h * 64 + d8 * 8 + 2 * e], bflo(w[e]), s);
                    s = fmaf(qb[h * 64 + d8 * 8 + 2 * e + 1], bfhi(w[e]), s);
                }
            }
            lg[h][tid] = s + p.rel_bias[bk * 8 + h] * LOG2E;
        }
    }
    __syncthreads();
    {
        const int h = tid >> 5, i = tid & 31;
        float mxv = -INFINITY;
        for (int j = i; j < nsel; j += 32) mxv = fmaxf(mxv, lg[h][j]);
#pragma unroll
        for (int o = 1; o < 32; o <<= 1) mxv = fmaxf(mxv, __shfl_xor(mxv, o));
        float sm = 0.f;
        for (int j = i; j < nsel; j += 32) { const float pp = exp2f(lg[h][j] - mxv); lg[h][j] = pp; sm += pp; }
#pragma unroll
        for (int o = 1; o < 32; o <<= 1) sm += __shfl_xor(sm, o);
        if (i == 0) linv[h] = 1.f / sm;
    }
    __syncthreads();
    {
        const int h = tid >> 5, d2 = (tid & 31) * 2;
        float a0 = 0.f, a1 = 0.f;
        for (int j = 0; j < nsel; ++j) {
            const float pp = lg[h][j];
            const unsigned vv = *(const unsigned*)(O1 + (mb + sel[j]) * LD1 + O_VB + h * 64 + d2);
            a0 = fmaf(pp, bflo(vv), a0); a1 = fmaf(pp, bfhi(vv), a1);
        }
        bf16_t* zp = O1 + (size_t)m * LD1 + O_ZB + h * 64 + d2;
        zp[0] = f2bf(a0 * linv[h] * bf2f(zp[0]));
        zp[1] = f2bf(a1 * linv[h] * bf2f(zp[1]));
    }
}

#define PHASE_KERNEL(name, body) \
__global__ void __launch_bounds__(512, 2) name(Ptrs p) { \
    extern __shared__ __attribute__((aligned(16))) unsigned char lds_raw[]; \
    Frame F; F.lds = (LAS unsigned char*)lds_raw; F.tid = threadIdx.x; F.lane = F.tid & 63; F.wave = __builtin_amdgcn_readfirstlane(F.tid >> 6); \
    F.G = gridDim.x; F.bid = blockIdx.x; F.p = p; body(F); }
PHASE_KERNEL(k_p0, phase0)
PHASE_KERNEL(k_p1, phase1)
PHASE_KERNEL(k_p1b, phase1b)
PHASE_KERNEL(k_p4ab, phase4ab)
PHASE_KERNEL(k_p4c, phase4c)
PHASE_KERNEL(k_p5, phase5)
PHASE_KERNEL(k_mla2, phase_mla)
PHASE_KERNEL(k_idx, phase_idx)
PHASE_KERNEL(k_dsa2, phase_dsa)

extern "C" void kernel_launch(void* const* d_in, const int* in_sizes, int n_in, void* d_out, int out_size, void* d_ws, size_t ws_size, hipStream_t stream) {
    static int grid = 0;
    if (grid == 0) {
        if (ws_size < WS_END) { fprintf(stderr, "kernel_launch: workspace too small: %zu < %zu\n", ws_size, (size_t)WS_END); grid = -1; return; }
        int dev = 0, cus = 0;
        if (hipGetDevice(&dev) != hipSuccess || hipDeviceGetAttribute(&cus, hipDeviceAttributeMultiprocessorCount, dev) != hipSuccess) { grid = -1; return; }
        const void* ks[9] = {(const void*)k_p0, (const void*)k_p1, (const void*)k_p1b, (const void*)k_p4ab, (const void*)k_p4c, (const void*)k_p5, (const void*)k_mla2, (const void*)k_idx, (const void*)k_dsa2};
        for (int i = 0; i < 9; ++i) if (hipFuncSetAttribute(ks[i], hipFuncAttributeMaxDynamicSharedMemorySize, LDS_BYTES) != hipSuccess) { fprintf(stderr, "hipFuncSetAttribute failed\n"); grid = -1; return; }
        grid = cus;
    }
    if (grid < 0) return;
    Ptrs p{};
    p.x = (const float*)d_in[0]; p.norm_g = (const float*)d_in[1]; p.w_in = (const float*)d_in[2]; p.g_q = (const float*)d_in[3]; p.w_uq = (const float*)d_in[4];
    p.g_kv = (const float*)d_in[5]; p.w_ukv = (const float*)d_in[6]; p.w_oa = (const float*)d_in[7]; p.w_ob = (const float*)d_in[8]; p.w_out = (const float*)d_in[9];
    p.rel_bias = (const float*)d_in[10]; p.final_g = (const float*)d_in[11]; p.out = (float*)d_out; p.ws = (unsigned char*)d_ws;
    hipLaunchKernelGGL(k_p0, dim3(grid), dim3(512), LDS_BYTES, stream, p);
    hipLaunchKernelGGL(k_p1, dim3(grid), dim3(512), LDS_BYTES, stream, p);
    hipLaunchKernelGGL(k_p1b, dim3(grid), dim3(512), LDS_BYTES, stream, p);
    hipLaunchKernelGGL(k_mla2, dim3(grid), dim3(512), LDS_BYTES, stream, p);
    hipLaunchKernelGGL(k_idx, dim3(grid), dim3(512), LDS_BYTES, stream, p);
    hipLaunchKernelGGL(k_dsa2, dim3(grid), dim3(512), LDS_BYTES, stream, p);
    hipLaunchKernelGGL(k_p4ab, dim3(grid), dim3(512), LDS_BYTES, stream, p);
    hipLaunchKernelGGL(k_p4c, dim3(grid), dim3(512), LDS_BYTES, stream, p);
    hipLaunchKernelGGL(k_p5, dim3(grid), dim3(512), LDS_BYTES, stream, p);
}
```

```cpp
#include <hip/hip_runtime.h>
#include <hip/hip_cooperative_groups.h>
#include <stdint.h>
#include <stdio.h>

#ifndef PROBE_DUP
#define PROBE_DUP -1
#endif
namespace pg8 {
#define PG8_LAS __attribute__((address_space(3)))
typedef unsigned short bf16_t;
typedef short bf16x8 __attribute__((ext_vector_type(8)));
typedef float f32x4 __attribute__((ext_vector_type(4)));
typedef unsigned u32x4 __attribute__((ext_vector_type(4)));
constexpr int BM = 256, BK = 64, HALF = 128, HTB = HALF * BK * 2  , STAGE_BYTES = 8 * HTB, NXCD = 8, WGM = 8;

__host__ __device__ __forceinline__ int lds_byte(int r, int c) { const int st = (r >> 4) * 2 + (c >> 5), rr = r & 15, cc = c & 31, ob = rr * 64 + cc * 2; return st * 1024 + (ob ^ (((ob >> 9) & 1) << 5)); }
__host__ __device__ __forceinline__ void stage_rc(int b, int& R, int& C) { const int st = b / 1024, sb = b % 1024, swz = sb ^ (((sb >> 9) & 1) << 5); R = (st >> 1) * 16 + swz / 64; C = (st & 1) * 32 + (swz % 64) / 2; }
__host__ __device__ __forceinline__ int perm32(int rho) { const int n = rho >> 4, i = rho & 15; return 8 * (i >> 2) + 4 * n + (i & 3); }

struct Unit { int pm, pn; };
struct Gemm { const bf16_t* A; int lda; const bf16_t* Bt; int M, N, K; };

struct StaticOrder {
    int nM, nN, nwg, G, c;
    __host__ __device__ void init(int M, int N, int G_, int c_) { nM = M / BM; nN = N / BM; nwg = nM * nN; G = G_; c = c_; }
    __host__ __device__ bool next(int i, Unit& u) const {
        const long L = (long)i * G + c; if (L >= nwg) return false;
        int wgid = (int)L; { const int q = nwg / NXCD, r = nwg % NXCD, xcd = wgid % NXCD, off = wgid / NXCD; wgid = (xcd < r ? xcd * (q + 1) : r * (q + 1) + (xcd - r) * q) + off; }
        const int nig = WGM * nN, gid = wgid / nig, fm = gid * WGM, gsz = (nM - fm) < WGM ? (nM - fm) : WGM;
        u.pm = fm + ((wgid % nig) % gsz); u.pn = (wgid % nig) / gsz; return true;
    }
    __device__ __forceinline__ void a_ready(const Unit&) const {}
    __device__ __forceinline__ void done(const Unit&) const {}
};

typedef __bf16 bf16x2_t __attribute__((ext_vector_type(2)));
typedef float f32x2_t __attribute__((ext_vector_type(2)));
__device__ __forceinline__ unsigned cvt_pk_bf16(float lo, float hi) { const f32x2_t v = {lo, hi}; return __builtin_bit_cast(unsigned, __builtin_convertvector(v, bf16x2_t)); }
template <class Epi, class Sched, bool ALIGN_EPI = false, bool SP2 = false>
__device__ __forceinline__ void gemm_phase(PG8_LAS unsigned char* lds, const Gemm g, const Sched& S, const Epi& E) {
    int tid_ = threadIdx.x; asm volatile("" : "+v"(tid_));
    const int tid = tid_, wid = __builtin_amdgcn_readfirstlane(tid >> 6), lane = tid & 63, wr = wid >> 2, wc = wid & 3, fr = lane & 15, fq = lane >> 4;
    int K_ = g.K; asm volatile("" : "+s"(K_));
    const int K = K_, nt = K / BK;
    unsigned voffA[2], voffB[2];
#pragma unroll
    for (int i = 0; i < 2; ++i) { int R, C; stage_rc(tid * 16 + i * 8192, R, C); const int Rb = Epi::PERM ? ((R & ~31) + perm32(R & 31)) : R;
        voffA[i] = (unsigned)(R * g.lda + C) * 2u; voffB[i] = (unsigned)(Rb * K + C) * 2u; }
    const size_t kstep = (size_t)(BK * 2);
    const size_t hstepA = (size_t)HALF * g.lda * 2, hstepB = (size_t)HALF * K * 2;
    const size_t tstepA = 2 * hstepA, tstepB = 2 * hstepB;
    const unsigned ldsw = (unsigned)wid * 1024u;
    const int aoff = lds_byte(wr * 64 + fr, fq * 8), boff = lds_byte(wc * 32 + fr, fq * 8);
#define PG8_SA(b, h) (((b) * 2 + (h)) * HTB)
#define PG8_SB(b, h) ((4 + (b) * 2 + (h)) * HTB)
#define PG8_STAGE(bufoff, gbase, voff) do { _Pragma("unroll") for (int _i = 0; _i < 2; ++_i) \
        __builtin_amdgcn_global_load_lds((const unsigned*)((const char*)(gbase) + (voff)[_i]), (PG8_LAS unsigned*)(lds + (bufoff) + ldsw + _i * 8192), 16, 0, 0); } while (0)
#define PG8_LDA(dst, b, h) do { _Pragma("unroll") for (int m = 0; m < 4; ++m) _Pragma("unroll") for (int k = 0; k < 2; ++k) dst[m][k] = *(const PG8_LAS bf16x8*)(lds + PG8_SA(b, h) + aoff + m * 2048 + k * 1024); } while (0)
#define PG8_LDB(dst, b, h) do { _Pragma("unroll") for (int n = 0; n < 2; ++n) _Pragma("unroll") for (int k = 0; k < 2; ++k) dst[n][k] = *(const PG8_LAS bf16x8*)(lds + PG8_SB(b, h) + boff + n * 2048 + k * 1024); } while (0)
#define PG8_MMA(ai, bj, At, Bt) do { __builtin_amdgcn_s_setprio(1); _Pragma("unroll") for (int m = 0; m < 4; ++m) _Pragma("unroll") for (int n = 0; n < 2; ++n) _Pragma("unroll") for (int k = 0; k < 2; ++k) \
        acc[ai][bj][m][n] = __builtin_amdgcn_mfma_f32_16x16x32_bf16(Bt[n][k], At[m][k], acc[ai][bj][m][n], 0, 0, 0); __builtin_amdgcn_s_setprio(0); } while (0)
#define PG8_WAIT_V(n) asm volatile("s_waitcnt vmcnt(" #n ")" ::: "memory")
#define PG8_WAIT_L(n) asm volatile("s_waitcnt lgkmcnt(" #n ")" ::: "memory")
#define PG8_BAR __builtin_amdgcn_s_barrier()
#define PG8_SCHED __builtin_amdgcn_sched_barrier(0)
    Unit cur, nxt; int ui = 0;
    if (!S.next(0, cur)) return;
    f32x4 acc[2][2][4][2];
#pragma unroll
    for (int a = 0; a < 2; ++a)
#pragma unroll
        for (int b = 0; b < 2; ++b)
#pragma unroll
            for (int m = 0; m < 4; ++m)
#pragma unroll
                for (int n = 0; n < 2; ++n) acc[a][b][m][n] = (f32x4){0.f, 0.f, 0.f, 0.f};
    bf16x8 At[4][2], B0[2][2], B1[2][2];
    const char* cA = (const char*)g.A + (size_t)cur.pm * tstepA; const char* cB = (const char*)g.Bt + (size_t)cur.pn * tstepB;
    S.a_ready(cur);
    if constexpr (SP2) {
        PG8_STAGE(PG8_SB(0, 0), cB, voffB); PG8_STAGE(PG8_SB(0, 1), cB + hstepB, voffB); PG8_STAGE(PG8_SA(0, 0), cA, voffA); PG8_STAGE(PG8_SA(0, 1), cA + hstepA, voffA);
        if (wr == 1) PG8_BAR;
        PG8_WAIT_V(2); PG8_BAR;
        PG8_STAGE(PG8_SB(1, 0), cB + kstep, voffB); PG8_STAGE(PG8_SA(1, 0), cA + kstep, voffA); PG8_STAGE(PG8_SB(1, 1), cB + hstepB + kstep, voffB);
        PG8_WAIT_V(6); PG8_BAR;
    } else {
        PG8_STAGE(PG8_SB(0, 0), cB, voffB); PG8_STAGE(PG8_SA(0, 0), cA, voffA); PG8_STAGE(PG8_SB(0, 1), cB + hstepB, voffB); PG8_STAGE(PG8_SA(0, 1), cA + hstepA, voffA);
        if (wr == 1) PG8_BAR;
        PG8_WAIT_V(4); PG8_BAR;
        PG8_STAGE(PG8_SB(1, 0), cB + kstep, voffB); PG8_STAGE(PG8_SA(1, 0), cA + kstep, voffA); PG8_STAGE(PG8_SB(1, 1), cB + hstepB + kstep, voffB);
        PG8_WAIT_V(6); PG8_BAR;
    }
    for (;;) {
        const bool has_next = S.next(ui + 1, nxt);
        const char* nA = has_next ? (const char*)g.A + (size_t)nxt.pm * tstepA : cA; const char* nB = has_next ? (const char*)g.Bt + (size_t)nxt.pn * tstepB : cB;
        for (int t = 0; t < nt; t += 2) {
            const bool last = (t == nt - 2);
            const char* a1 = cA + (size_t)(t + 1) * kstep;
            const char* a2 = last ? nA : cA + (size_t)(t + 2) * kstep; const char* b2 = last ? nB : cB + (size_t)(t + 2) * kstep;
            const char* a3 = a2 + kstep; const char* b3 = b2 + kstep;
            if (last && has_next) S.a_ready(nxt);
            if constexpr (SP2) {
            PG8_LDB(B0, 0, 0); PG8_LDB(B1, 0, 1); PG8_SCHED; PG8_LDA(At, 0, 0); PG8_STAGE(PG8_SA(1, 1), a1 + hstepA, voffA);
            PG8_WAIT_V(8); PG8_WAIT_L(0); PG8_BAR; PG8_MMA(0, 0, At, B0); PG8_MMA(0, 1, At, B1); PG8_BAR; PG8_SCHED;
            PG8_LDA(At, 0, 1); PG8_STAGE(PG8_SB(0, 0), b2, voffB); PG8_STAGE(PG8_SB(0, 1), b2 + hstepB, voffB); PG8_STAGE(PG8_SA(0, 0), a2, voffA);
            PG8_WAIT_V(8); PG8_WAIT_L(0); PG8_BAR; PG8_MMA(1, 0, At, B0); PG8_MMA(1, 1, At, B1); PG8_BAR; PG8_SCHED;
            PG8_LDB(B0, 1, 0); PG8_LDB(B1, 1, 1); PG8_SCHED; PG8_LDA(At, 1, 0); PG8_STAGE(PG8_SA(0, 1), a2 + hstepA, voffA);
            PG8_WAIT_V(8); PG8_WAIT_L(0); PG8_BAR; PG8_MMA(0, 0, At, B0); PG8_MMA(0, 1, At, B1); PG8_BAR; PG8_SCHED;
            PG8_LDA(At, 1, 1); PG8_STAGE(PG8_SB(1, 0), b3, voffB); PG8_STAGE(PG8_SB(1, 1), b3 + hstepB, voffB); PG8_STAGE(PG8_SA(1, 0), a3, voffA);
            PG8_WAIT_V(8); PG8_WAIT_L(0); PG8_BAR; PG8_MMA(1, 0, At, B0); PG8_MMA(1, 1, At, B1); PG8_BAR; PG8_SCHED;
            } else {
            PG8_LDB(B0, 0, 0); PG8_SCHED; PG8_LDA(At, 0, 0); PG8_STAGE(PG8_SA(1, 1), a1 + hstepA, voffA);
            PG8_WAIT_L(8); PG8_BAR; PG8_WAIT_L(0); PG8_MMA(0, 0, At, B0); PG8_BAR; PG8_SCHED;
            PG8_LDB(B1, 0, 1); PG8_STAGE(PG8_SB(0, 0), b2, voffB);
            PG8_BAR; PG8_WAIT_L(0); PG8_MMA(0, 1, At, B1); PG8_BAR;
            PG8_LDA(At, 0, 1); PG8_STAGE(PG8_SA(0, 0), a2, voffA);
            PG8_BAR; PG8_WAIT_L(0); PG8_MMA(1, 0, At, B0); PG8_BAR; PG8_SCHED;
            PG8_STAGE(PG8_SB(0, 1), b2 + hstepB, voffB);
            PG8_WAIT_V(6); PG8_BAR; PG8_MMA(1, 1, At, B1); PG8_BAR;
            PG8_LDB(B0, 1, 0); PG8_SCHED; PG8_LDA(At, 1, 0); PG8_STAGE(PG8_SA(0, 1), a2 + hstepA, voffA);
            PG8_WAIT_L(8); PG8_BAR; PG8_WAIT_L(0); PG8_MMA(0, 0, At, B0); PG8_BAR; PG8_SCHED;
            PG8_LDB(B1, 1, 1); PG8_STAGE(PG8_SB(1, 0), b3, voffB);
            PG8_BAR; PG8_WAIT_L(0); PG8_MMA(0, 1, At, B1); PG8_BAR;
            PG8_LDA(At, 1, 1); PG8_STAGE(PG8_SA(1, 0), a3, voffA);
            PG8_BAR; PG8_WAIT_L(0); PG8_MMA(1, 0, At, B0); PG8_BAR; PG8_SCHED;
            PG8_STAGE(PG8_SB(1, 1), b3 + hstepB, voffB);
            PG8_WAIT_V(6); PG8_BAR; PG8_MMA(1, 1, At, B1); PG8_BAR;
            }
        }
        if constexpr (ALIGN_EPI) { if (wr == 0) PG8_BAR; }
        if constexpr (!Epi::AFTER_DRAIN) { E(acc, cur, wr, wc, fr, fq); S.done(cur); }
        if (!has_next) break;
#pragma unroll
        for (int a = 0; a < 2; ++a)
#pragma unroll
            for (int b = 0; b < 2; ++b)
#pragma unroll
                for (int m = 0; m < 4; ++m)
#pragma unroll
                    for (int n = 0; n < 2; ++n) acc[a][b][m][n] = (f32x4){0.f, 0.f, 0.f, 0.f};
        cur = nxt; cA = nA; cB = nB; ++ui;
        if constexpr (ALIGN_EPI) { if (wr == 1) PG8_BAR; }
    }
    PG8_WAIT_V(0);
    if constexpr (!ALIGN_EPI) { if (wr == 0) PG8_BAR; }
    PG8_BAR;
    if constexpr (Epi::AFTER_DRAIN) { E.fused(acc, cur, wr, wc, fr, fq, lds, wid, lane); S.done(cur); }
#undef PG8_SA
#undef PG8_SB
#undef PG8_STAGE
#undef PG8_LDA
#undef PG8_LDB
#undef PG8_MMA
#undef PG8_WAIT_V
#undef PG8_WAIT_L
#undef PG8_BAR
#undef PG8_SCHED
}
}

typedef unsigned short bf16_t;
typedef float f32x4 __attribute__((ext_vector_type(4)));
typedef unsigned u32x4 __attribute__((ext_vector_type(4)));
#define LAS __attribute__((address_space(3)))
constexpr int NB = 4, S = 8192, DM = 1024, T = NB * S;
constexpr int NIN = 5576;
constexpr int LD1 = 5632;
constexpr int O_QLAT = 0, O_CKV = 384, O_KROPE = 640, O_KIDX = 672, O_WIDX = 704, O_ZA = 768, O_QB = 1280, O_KB = 1792, O_VB = 2304, O_ZB = 2816,
              O_QIDX = 3328, O_GA = 3584, O_GB = 4608;
constexpr size_t MiB = 1u << 20;
constexpr size_t WS_CTL = 0, WS_WUQT = 1 * MiB, WS_WUKVT = 2 * MiB, WS_WOAT = 3 * MiB, WS_WOBT = 4 * MiB, WS_WOUTT = 5 * MiB, WS_ROPE = 7 * MiB,
                 WS_WINT = 8 * MiB, WS_SSQO = 8 * MiB  , WS_SSQLAT = 19 * MiB, WS_KPE = 22 * MiB, WS_KIDX = 24 * MiB, WS_MASK = 26 * MiB,
                 WS_H = 44 * MiB  , WS_Q = 108 * MiB, WS_OUT1 = 156 * MiB, WS_END = 508 * MiB;
constexpr float LOG2E = 1.4426950408889634f;
constexpr float QSCALE_A = 0.10206207261596577f * LOG2E;
constexpr float QSCALE_B = 0.125f * LOG2E;
constexpr int GEMM_LDS = 131072;
constexpr int LDS_BYTES = 147456;

__device__ __forceinline__ float bf2f(bf16_t v) { return __uint_as_float(((unsigned)v) << 16); }
__device__ __forceinline__ bf16_t f2bf(float f) { unsigned u = __float_as_uint(f); return (bf16_t)((u + 0x7fffu + ((u >> 16) & 1u)) >> 16); }
__device__ __forceinline__ unsigned pk2(float lo, float hi) { return (unsigned)f2bf(lo) | ((unsigned)f2bf(hi) << 16); }
__device__ __forceinline__ float bflo(unsigned w) { return __uint_as_float(w << 16); }
__device__ __forceinline__ float bfhi(unsigned w) { return __uint_as_float(w & 0xffff0000u); }
__device__ __forceinline__ float wave_sum(float v) {
#pragma unroll
    for (int o = 1; o < 64; o <<= 1) v += __shfl_xor(v, o);
    return v;
}
__device__ __forceinline__ float sigmoidf_(float x) { return __builtin_amdgcn_rcpf(1.f + __builtin_amdgcn_exp2f(-LOG2E * x)); }

struct Ptrs {
    const float *x, *norm_g, *w_in, *g_q, *w_uq, *g_kv, *w_ukv, *w_oa, *w_ob, *w_out, *rel_bias, *final_g;
    float* out; unsigned char* ws;
};

namespace pg8 {
struct EpiIn {
    static constexpr bool PERM = true, AFTER_DRAIN = false;
    bf16_t* O; float* ssq;
    __device__ __forceinline__ void operator()(const f32x4 (&acc)[2][2][4][2], const Unit& u, int wr, int wc, int, int) const {
        int t_ = threadIdx.x; asm volatile("" : "+v"(t_));
        const int fr = t_ & 15, fq = (t_ >> 4) & 3;
        const int row0 = u.pm * BM + wr * 64 + fr;
#pragma unroll
        for (int bj = 0; bj < 2; ++bj) {
            const int g = u.pn * 2 + bj;
            const int col0 = g * 128 + wc * 32 + 8 * fq;
            int op = 0;
            if ((g >= 6 && g <= 9) || (g >= 22 && g <= 25)) op = 1; else if (g >= 28) op = 2; else if (g >= 10 && g <= 13) op = 3; else if (g <= 4) op = 4;
#pragma unroll
            for (int ai = 0; ai < 2; ++ai)
#pragma unroll
                for (int m = 0; m < 4; ++m) {
                    const int row = row0 + ai * HALF + m * 16;
                    f32x4 v0 = acc[ai][bj][m][0], v1 = acc[ai][bj][m][1];
                    if (op == 1) {
#pragma unroll
                        for (int e = 0; e < 4; ++e) { v0[e] = v0[e] * sigmoidf_(v0[e]); v1[e] = v1[e] * sigmoidf_(v1[e]); }
                    } else if (op == 2) {
#pragma unroll
                        for (int e = 0; e < 4; ++e) { v0[e] = sigmoidf_(v0[e]); v1[e] = sigmoidf_(v1[e]); }
                    } else if (op == 3) { v0 = v0 * QSCALE_B; v1 = v1 * QSCALE_B; }
                    else if (op == 4) {
                        float s = (v0[0] * v0[0] + v0[1] * v0[1]) + (v0[2] * v0[2] + v0[3] * v0[3]) + (v1[0] * v1[0] + v1[1] * v1[1]) + (v1[2] * v1[2] + v1[3] * v1[3]);
                        s += __shfl_xor(s, 16); s += __shfl_xor(s, 32);
                        if (fq == 0) ssq[(size_t)row * 20 + g * 4 + wc] = s;
                    }
                    u32x4 w; w.x = cvt_pk_bf16(v0[0], v0[1]); w.y = cvt_pk_bf16(v0[2], v0[3]); w.z = cvt_pk_bf16(v1[0], v1[1]); w.w = cvt_pk_bf16(v1[2], v1[3]);
                    *(u32x4*)(O + (size_t)row * LD1 + col0) = w;
                }
        }
    }
};
struct EpiQ {
    static constexpr bool PERM = true, AFTER_DRAIN = false;
    bf16_t* Q; const float* ssq; const float2* rope;
    __device__ __forceinline__ static f32x4 rope4(f32x4 v, const f32x4 ca, const f32x4 cb, bool first) {
        const float cs[4] = {ca[0], ca[2], cb[0], cb[2]}, sn[4] = {ca[1], ca[3], cb[1], cb[3]};
#pragma unroll
        for (int e = 0; e < 4; ++e) { const float pv = __shfl_xor(v[e], 32); v[e] = first ? (v[e] * cs[e] - pv * sn[e]) : (pv * sn[e] + v[e] * cs[e]); }
        return v;
    }
    __device__ __forceinline__ void operator()(const f32x4 (&acc)[2][2][4][2], const Unit& u, int wr, int wc, int, int) const {
        int t_ = threadIdx.x; asm volatile("" : "+v"(t_));
        const int fr = t_ & 15, fq = (t_ >> 4) & 3;
        const int row0 = u.pm * BM + wr * 64 + fr;
#pragma unroll
        for (int ai = 0; ai < 2; ++ai)
#pragma unroll
            for (int m = 0; m < 4; ++m) {
                const int row = row0 + ai * HALF + m * 16;
                const f32x4* sp = (const f32x4*)(ssq + (size_t)row * 20);
                float tot;
                { const f32x4 s0 = sp[0]; tot = (s0[0] + s0[1]) + (s0[2] + s0[3]); }
                { const f32x4 s1 = sp[1]; tot += (s1[0] + s1[1]) + (s1[2] + s1[3]); }
                { const f32x4 s2 = sp[2]; tot += (s2[0] + s2[1]) + (s2[2] + s2[3]); }
                const float rs = rsqrtf(tot * (1.f / 384.f) + 1e-6f) * QSCALE_A;
                const f32x4* rp = (const f32x4*)(rope + (size_t)(row & (S - 1)) * 16 + 8 * (fq & 1));
#pragma unroll
                for (int bj = 0; bj < 2; ++bj) {
                    const int sl = u.pn * 8 + bj * 4 + wc;
                    f32x4 v0 = acc[ai][bj][m][0] * rs, v1 = acc[ai][bj][m][1] * rs;
                    if (sl % 3 == 2) {
                        v0 = rope4(v0, rp[0], rp[1], fq < 2);
                        v1 = rope4(v1, rp[2], rp[3], fq < 2);
                    }
                    u32x4 w; w.x = cvt_pk_bf16(v0[0], v0[1]); w.y = cvt_pk_bf16(v0[2], v0[3]); w.z = cvt_pk_bf16(v1[0], v1[1]); w.w = cvt_pk_bf16(v1[2], v1[3]);
                    *(u32x4*)(Q + (size_t)row * 768 + sl * 32 + 8 * fq) = w;
                    asm volatile("" ::: "memory");
                }
            }
    }
};
struct EpiKV {
    static constexpr bool PERM = true, AFTER_DRAIN = false;
    bf16_t* KV; const float* ssq;
    __device__ __forceinline__ void operator()(const f32x4 (&acc)[2][2][4][2], const Unit& u, int wr, int wc, int, int) const {
        int t_ = threadIdx.x; asm volatile("" : "+v"(t_));
        const int fr = t_ & 15, fq = (t_ >> 4) & 3;
        const int row0 = u.pm * BM + wr * 64 + fr;
#pragma unroll
        for (int ai = 0; ai < 2; ++ai)
#pragma unroll
            for (int m = 0; m < 4; ++m) {
                const int row = row0 + ai * HALF + m * 16;
                const f32x4* sp = (const f32x4*)(ssq + (size_t)row * 20 + 12);
                const f32x4 s0 = sp[0], s1 = sp[1];
                const float tot = ((s0[0] + s0[1]) + (s0[2] + s0[3])) + ((s1[0] + s1[1]) + (s1[2] + s1[3]));
                const float rs = rsqrtf(tot * (1.f / 256.f) + 1e-6f);
#pragma unroll
                for (int bj = 0; bj < 2; ++bj) {
                    const int col0 = u.pn * BM + bj * HALF + wc * 32 + 8 * fq;
                    const f32x4 v0 = acc[ai][bj][m][0] * rs, v1 = acc[ai][bj][m][1] * rs;
                    u32x4 w; w.x = cvt_pk_bf16(v0[0], v0[1]); w.y = cvt_pk_bf16(v0[2], v0[3]); w.z = cvt_pk_bf16(v1[0], v1[1]); w.w = cvt_pk_bf16(v1[2], v1[3]);
                    *(u32x4*)(KV + (size_t)row * 1024 + col0) = w;
                }
                asm volatile("" ::: "memory");
            }
    }
};
template <bool ADD> struct EpiGate {
    static constexpr bool PERM = true, AFTER_DRAIN = false;
    bf16_t* MG; const bf16_t* O1; int gcol;
    __device__ __forceinline__ void operator()(const f32x4 (&acc)[2][2][4][2], const Unit& u, int wr, int wc, int, int) const {
        int t_ = threadIdx.x; asm volatile("" : "+v"(t_));
        const int fr = t_ & 15, fq = (t_ >> 4) & 3;
        const int row0 = u.pm * BM + wr * 64 + fr;
#pragma unroll
        for (int ai = 0; ai < 2; ++ai)
#pragma unroll
            for (int m = 0; m < 4; ++m) {
                const int row = row0 + ai * HALF + m * 16;
#pragma unroll
                for (int bj = 0; bj < 2; ++bj) {
                    const int col0 = u.pn * BM + bj * HALF + wc * 32 + 8 * fq;
                    const u32x4 gw = *(const u32x4*)(O1 + (size_t)row * LD1 + gcol + col0);
                    f32x4 v0 = acc[ai][bj][m][0], v1 = acc[ai][bj][m][1];
                    v0[0] *= bflo(gw.x); v0[1] *= bfhi(gw.x); v0[2] *= bflo(gw.y); v0[3] *= bfhi(gw.y);
                    v1[0] *= bflo(gw.z); v1[1] *= bfhi(gw.z); v1[2] *= bflo(gw.w); v1[3] *= bfhi(gw.w);
                    u32x4* dst = (u32x4*)(MG + (size_t)row * DM + col0);
                    if (ADD) { const u32x4 pw = *dst;
                        v0[0] += bflo(pw.x); v0[1] += bfhi(pw.x); v0[2] += bflo(pw.y); v0[3] += bfhi(pw.y);
                        v1[0] += bflo(pw.z); v1[1] += bfhi(pw.z); v1[2] += bflo(pw.w); v1[3] += bfhi(pw.w); }
                    u32x4 w; w.x = cvt_pk_bf16(v0[0], v0[1]); w.y = cvt_pk_bf16(v0[2], v0[3]); w.z = cvt_pk_bf16(v1[0], v1[1]); w.w = cvt_pk_bf16(v1[2], v1[3]);
                    *dst = w;
                }
                asm volatile("" ::: "memory");
            }
    }
};
struct EpiOut {
    static constexpr bool PERM = true, AFTER_DRAIN = false;
    const float* x; float* out; float* ssqo;
    __device__ __forceinline__ void operator()(const f32x4 (&acc)[2][2][4][2], const Unit& u, int wr, int wc, int, int) const {
        int t_ = threadIdx.x; asm volatile("" : "+v"(t_));
        const int fr = t_ & 15, fq = (t_ >> 4) & 3;
        const int row0 = u.pm * BM + wr * 64 + fr;
#pragma unroll
        for (int ai = 0; ai < 2; ++ai)
#pragma unroll
            for (int m = 0; m < 4; ++m) {
                const int row = row0 + ai * HALF + m * 16;
#pragma unroll
                for (int bj = 0; bj < 2; ++bj) {
                    const int col0 = u.pn * BM + bj * HALF + wc * 32 + 8 * fq;
                    const f32x4* xp = (const f32x4*)(x + (size_t)row * DM + col0);
                    const f32x4 v0 = acc[ai][bj][m][0] + xp[0], v1 = acc[ai][bj][m][1] + xp[1];
                    f32x4* op = (f32x4*)(out + (size_t)row * DM + col0);
                    op[0] = v0; op[1] = v1;
                    float s = (v0[0] * v0[0] + v0[1] * v0[1]) + (v0[2] * v0[2] + v0[3] * v0[3]) + (v1[0] * v1[0] + v1[1] * v1[1]) + (v1[2] * v1[2] + v1[3] * v1[3]);
                    s += __shfl_xor(s, 16); s += __shfl_xor(s, 32);
                    if (fq == 0) ssqo[(size_t)row * 32 + u.pn * 8 + bj * 4 + wc] = s;
                }
                asm volatile("" ::: "memory");
            }
    }
};
}


namespace att {
typedef short bf16x8 __attribute__((ext_vector_type(8)));
typedef short s16x4 __attribute__((ext_vector_type(4)));
typedef float f32x16 __attribute__((ext_vector_type(16)));
typedef unsigned u32x4 __attribute__((ext_vector_type(4)));
typedef const LAS char* lds_cptr;
constexpr int SLOT_K = 12288, SLOT_V = 8192;
constexpr int L_K = 0, L_V = 2 * SLOT_K, L_WS = L_V + 2 * SLOT_V, L_OST = L_WS + 2048, L_BIAS = L_OST + 8 * 4096, L_END = L_BIAS + 2048;
constexpr float THR = 8.f;
#define MFMA32(a, b, c) __builtin_amdgcn_mfma_f32_32x32x16_bf16(a, b, c, 0, 0, 0)
__device__ __forceinline__ int crow(int r, int hi) { return (r & 3) + 8 * (r >> 2) + 4 * hi; }
typedef __bf16 bf16x2_t __attribute__((ext_vector_type(2)));
typedef float f32x2_t __attribute__((ext_vector_type(2)));
__device__ __forceinline__ unsigned cvtpk(float lo, float hi) { const f32x2_t v = {lo, hi}; return __builtin_bit_cast(unsigned, __builtin_convertvector(v, bf16x2_t)); }
__device__ __forceinline__ s16x4 vtr(lds_cptr p) { typedef short v4i16_t __attribute__((ext_vector_type(4))); return __builtin_bit_cast(s16x4, __builtin_amdgcn_ds_read_tr16_b64_v4i16((LAS v4i16_t*)p)); }
#define MX3(a, b, c) __builtin_fmaxf(__builtin_fmaxf((a), (b)), (c))
__device__ __forceinline__ float rowmax(const f32x16& p0, const f32x16& p1) {
    float a = MX3(p0[0], p0[1], p1[0]), b = MX3(p0[2], p0[3], p1[1]); a = MX3(a, p1[2], p1[3]);
#pragma unroll
    for (int r = 4; r < 16; r += 4) { a = MX3(a, p0[r], p0[r + 1]); b = MX3(b, p0[r + 2], p0[r + 3]); a = MX3(a, p1[r], p1[r + 1]); b = MX3(b, p1[r + 2], p1[r + 3]); }
    const float m = __builtin_fmaxf(a, b); auto rr = __builtin_amdgcn_permlane32_swap(__float_as_uint(m), __float_as_uint(m), false, false);
    return __builtin_fmaxf(__uint_as_float(rr[0]), __uint_as_float(rr[1])); }
__device__ __forceinline__ float maskp(float p, unsigned lo, unsigned hi) {
    const unsigned long long mk = ((unsigned long long)hi << 32) | lo; float o;
    asm("v_cndmask_b32_e64 %0, 0, %1, %2" : "=v"(o) : "v"(p), "s"(mk)); return o; }
__host__ __device__ __forceinline__ size_t mask_tile_off(int qt32) { const int J = qt32 >> 1; return (size_t)2 * J * (J + 1) + ((qt32 & 1) ? 2 * (J + 1) : 0); }
constexpr size_t MASK_TILES_PER_BATCH = (size_t)2 * 128 * 129;

struct Tensors {
    const bf16_t* Q; int ldq;
    const bf16_t* K0; int ldk;
    const bf16_t* K1;
    const bf16_t* V; int ldv;
    bf16_t* O; int ldo;
    const unsigned long long* mask;
    const float* rel_bias;
    int hq, hk, hv;
};

template <bool DSA>
__device__ __forceinline__ void unit(int b, int h, int qb, const Tensors& X, LAS unsigned char* lds, bool dry) {
    constexpr int NDQ = DSA ? 4 : 6;
    int tid_ = threadIdx.x; asm volatile("" : "+v"(tid_));
    const int tid = tid_, lane = tid & 63, r32 = lane & 31, hi = lane >> 5; const int wid = __builtin_amdgcn_readfirstlane(tid >> 6);
    const size_t rowbase = (size_t)b * S; const int q0 = qb * 256, NT = 4 * qb + 4, NTw = 4 * qb + (wid >> 1) + 1;
    LAS float* wsf = (LAS float*)(lds + L_WS) + wid * 64;
    const bf16_t* ksrc = X.K0 + (rowbase + lane) * X.ldk + h * X.hk + wid * 8;
    const bf16_t* ksrc1 = DSA ? nullptr : X.K1 + (rowbase + lane) * 32 + (wid & 3) * 8;
    const bf16_t* vsrc = X.V + (rowbase + 16 * (wid & 3) + (lane >> 2)) * X.ldv + h * X.hv + (wid >> 2) * 32 + (lane & 3) * 8;
    const size_t kstride = (size_t)64 * X.ldk, vstride = (size_t)64 * X.ldv;
    LAS unsigned char* kdst = lds + L_K + wid * 1024; LAS unsigned char* kdst1 = lds + L_K + (8 + (wid & 3)) * 1024; LAS unsigned char* vdst = lds + L_V + wid * 1024;
    u32x4 sk0, sk1 = {}, sv;
#define ATT_LOAD(t) do { sk0 = *(const u32x4*)(ksrc + (size_t)(t) * kstride); if (!DSA && wid < 4) sk1 = *(const u32x4*)(ksrc1 + (size_t)(t) * 64 * 32); \
                         sv = *(const u32x4*)(vsrc + (size_t)(t) * vstride); } while (0)
#define ATT_WRITE(slot) do { *(LAS u32x4*)(kdst + (slot) * SLOT_K + lane * 16) = sk0; if (!DSA && wid < 4) *(LAS u32x4*)(kdst1 + (slot) * SLOT_K + lane * 16) = sk1; \
                             *(LAS u32x4*)(vdst + (slot) * SLOT_V + lane * 16) = sv; } while (0)
    const lds_cptr vp0 = (lds_cptr)lds + L_V + ((lane >> 4) & 1) * 32 + (lane & 3) * 8 + (4 * hi + ((lane & 15) >> 2)) * 64;
    const lds_cptr kp0 = (lds_cptr)lds + L_K + hi * 1024 + r32 * 16;
    ATT_LOAD(0); ATT_WRITE(0);
    bf16x8 qr[NDQ];
    { const bf16_t* Qw = X.Q + (rowbase + q0 + wid * 32 + r32) * X.ldq + h * X.hq + hi * 8;
#pragma unroll
      for (int d0 = 0; d0 < NDQ; ++d0) qr[d0] = *(const bf16x8*)(Qw + d0 * 16); }
    if (DSA) {
        LAS float* tab = (LAS float*)(lds + L_BIAS);
        const float c15 = X.rel_bias[15 * 8 + h];
        for (int e = tid; e < 320; e += 512) {
            const int rel = e - 255, n = rel < 0 ? -rel : rel; int v;
            if (n < 8) v = n; else if (n < 12) v = 8; else if (n < 16) v = 9; else if (n < 23) v = 10; else if (n < 32) v = 11; else if (n < 46) v = 12; else if (n < 64) v = 13; else if (n < 91) v = 14; else v = 15;
            tab[e] = (X.rel_bias[((rel > 0 ? 16 : 0) + v) * 8 + h] - c15) * LOG2E;
        }
    }
    float mhat = 0.f, l_reg = 0.f; f32x16 o0 = {}, o1 = {};
    if (wid >= 4) __builtin_amdgcn_s_setprio(1);
    const int qpos = q0 + wid * 32 + r32;
    for (int t = 0; t < NT; ++t) {
        asm volatile("s_waitcnt vmcnt(0) lgkmcnt(0)\n\ts_barrier" ::: "memory");
        if (t + 1 < NT) ATT_LOAD(t + 1);
        if (t < NTw) {
            const int so_k = (t & 1) * SLOT_K, so_v = (t & 1) * SLOT_V;
            f32x16 c0 = {}, c1 = {};
            bf16x8 kf[2 * NDQ];
#pragma unroll
            for (int d0 = 0; d0 < NDQ; ++d0) { kf[2 * d0] = *(const LAS bf16x8*)(kp0 + so_k + d0 * 2048); kf[2 * d0 + 1] = *(const LAS bf16x8*)(kp0 + so_k + d0 * 2048 + 512); }
#pragma unroll
            for (int d0 = 0; d0 < NDQ; ++d0) { c0 = MFMA32(kf[2 * d0], qr[d0], c0); c1 = MFMA32(kf[2 * d0 + 1], qr[d0], c1); }
            const lds_cptr vp = vp0 + so_v;
            bf16x8 vf[8];
#pragma unroll
            for (int i = 0; i < 8; ++i) { const s16x4 lo_ = vtr(vp + ((i >> 2) * 4096 + (i & 3) * 1024)), hi_ = vtr(vp + ((i >> 2) * 4096 + (i & 3) * 1024 + 512));
                vf[i] = (bf16x8){lo_[0], lo_[1], lo_[2], lo_[3], hi_[0], hi_[1], hi_[2], hi_[3]}; }
            if (DSA) {
                if (64 * t + 63 - (q0 + wid * 32) > -128) {
                    const LAS float* tab = (const LAS float*)(lds + L_BIAS);
                    const int base = 64 * t + 4 * hi - qpos + 255;
#pragma unroll
                    for (int r = 0; r < 16; ++r) { const int kr = (r & 3) + 8 * (r >> 2); int i0 = base + kr, i1 = base + kr + 32; i0 = i0 < 0 ? 0 : i0; i1 = i1 < 0 ? 0 : i1;
                        c0[r] += tab[i0]; c1[r] += tab[i1]; }
                }
            }
            const float rm = rowmax(c0, c1);
            if (t == 0) mhat = rm;
            else {
                const float grow = rm - mhat;
                if (__any(grow > THR)) {
                    const float dl = __builtin_fmaxf(grow, 0.f); mhat += dl;
                    const float f = __builtin_amdgcn_exp2f(-dl); l_reg *= f;
                    if (hi == 0) wsf[r32] = f;
                    asm volatile("s_waitcnt lgkmcnt(0)" ::: "memory");
#pragma unroll
                    for (int r = 0; r < 16; ++r) { const float fr = wsf[crow(r, hi)]; o0[r] *= fr; o1[r] *= fr; }
                }
            }
            const float nm = -mhat;
#pragma unroll
            for (int r = 0; r < 16; ++r) { c0[r] = __builtin_amdgcn_exp2f(c0[r] + nm); c1[r] = __builtin_amdgcn_exp2f(c1[r] + nm); }
            if (DSA) {
                const int qt32 = qb * 8 + wid;
                const unsigned* mt = (const unsigned*)((const unsigned short*)X.mask + ((size_t)b * MASK_TILES_PER_BATCH + mask_tile_off(qt32)) * 64) + (size_t)t * 64;
                const unsigned mw = mt[lane];
#pragma unroll
                for (int r = 0; r < 16; ++r) { c0[r] = ((mw >> r) & 1u) ? c0[r] : 0.f; c1[r] = ((mw >> (16 + r)) & 1u) ? c1[r] : 0.f; }
            }
            float sacc = 0.f;
#pragma unroll
            for (int r = 0; r < 16; ++r) sacc += c0[r] + c1[r];
            l_reg += sacc;
            u32x4 pw0 = {cvtpk(c0[0], c0[1]), cvtpk(c0[2], c0[3]), cvtpk(c0[4], c0[5]), cvtpk(c0[6], c0[7])};
            u32x4 pw1 = {cvtpk(c0[8], c0[9]), cvtpk(c0[10], c0[11]), cvtpk(c0[12], c0[13]), cvtpk(c0[14], c0[15])};
            u32x4 pw2 = {cvtpk(c1[0], c1[1]), cvtpk(c1[2], c1[3]), cvtpk(c1[4], c1[5]), cvtpk(c1[6], c1[7])};
            u32x4 pw3 = {cvtpk(c1[8], c1[9]), cvtpk(c1[10], c1[11]), cvtpk(c1[12], c1[13]), cvtpk(c1[14], c1[15])};
            o0 = MFMA32(__builtin_bit_cast(bf16x8, pw0), vf[0], o0); o1 = MFMA32(__builtin_bit_cast(bf16x8, pw0), vf[4], o1);
            o0 = MFMA32(__builtin_bit_cast(bf16x8, pw1), vf[1], o0); o1 = MFMA32(__builtin_bit_cast(bf16x8, pw1), vf[5], o1);
            o0 = MFMA32(__builtin_bit_cast(bf16x8, pw2), vf[2], o0); o1 = MFMA32(__builtin_bit_cast(bf16x8, pw2), vf[6], o1);
            o0 = MFMA32(__builtin_bit_cast(bf16x8, pw3), vf[3], o0); o1 = MFMA32(__builtin_bit_cast(bf16x8, pw3), vf[7], o1);
        }
        if (t + 1 < NT) ATT_WRITE((t + 1) & 1);
    }
    __builtin_amdgcn_s_setprio(0);
    { auto rr = __builtin_amdgcn_permlane32_swap(__float_as_uint(l_reg), __float_as_uint(l_reg), false, false); l_reg = __uint_as_float(rr[0]) + __uint_as_float(rr[1]); }
    if (hi == 0) wsf[32 + r32] = l_reg;
    asm volatile("s_waitcnt lgkmcnt(0)" ::: "memory");
    LAS bf16_t* stg = (LAS bf16_t*)(lds + L_OST) + wid * 2048;
#pragma unroll
    for (int r = 0; r < 16; ++r) { const int orow = crow(r, hi); const float rli = __builtin_amdgcn_rcpf(wsf[32 + orow]);
        stg[orow * 64 + r32] = f2bf(o0[r] * rli); stg[orow * 64 + 32 + r32] = f2bf(o1[r] * rli); }
    asm volatile("s_waitcnt lgkmcnt(0)" ::: "memory");
    bf16_t* Ow = X.O + (rowbase + q0 + wid * 32) * X.ldo + h * 64;
#pragma unroll
    for (int i = 0; i < 4; ++i) { const int row = i * 8 + (lane >> 3), ch = lane & 7;
        const u32x4 ov = *(const LAS u32x4*)(stg + row * 64 + ch * 8); u32x4* gp = (u32x4*)(Ow + (size_t)row * X.ldo + ch * 8); const u32x4 gv = *gp;
        u32x4 res; res.x = pk2(bflo(ov.x) * bflo(gv.x), bfhi(ov.x) * bfhi(gv.x)); res.y = pk2(bflo(ov.y) * bflo(gv.y), bfhi(ov.y) * bfhi(gv.y));
        res.z = pk2(bflo(ov.z) * bflo(gv.z), bfhi(ov.z) * bfhi(gv.z)); res.w = pk2(bflo(ov.w) * bflo(gv.w), bfhi(ov.w) * bfhi(gv.w)); if (!dry) *gp = res; }
    asm volatile("s_waitcnt vmcnt(0) lgkmcnt(0)\n\ts_barrier" ::: "memory");
#undef ATT_LOAD
#undef ATT_WRITE
}

template <bool DSA>
__device__ __forceinline__ void phase(const Tensors& X, LAS unsigned char* lds, int G, int bid, bool dry = false) {
    for (int p = bid; p < 512; p += G) {
        const int x = p & 7, kk = p >> 3, bh = x + 8 * (kk >> 4), j = kk & 15;
#pragma unroll 1
        for (int u2 = 0; u2 < 2; ++u2) unit<DSA>(bh >> 3, bh & 7, u2 ? 31 - j : j, X, lds, dry);
    }
}
}


namespace idx {
typedef short bf16x8 __attribute__((ext_vector_type(8)));
typedef float f32x16 __attribute__((ext_vector_type(16)));
constexpr int HROW = 1025;
constexpr int LCAP = 32;
constexpr int L_HIST = 0, L_PFX = 32 * HROW * 4, L_NEED = L_PFX + 128, L_LCNT = L_NEED + 128, L_LIST = L_LCNT + 128, L_END = L_LIST + 32 * LCAP * 4;
__device__ __forceinline__ unsigned f2key(float f) { const unsigned u = __float_as_uint(f); return (u & 0x80000000u) ? ~u : (u | 0x80000000u); }

struct QOps { bf16x8 qf[8][2]; bf16x8 qb[2][2]; float wv[8]; };
__device__ __forceinline__ void score_tile(float (&acc)[16], const bf16x8 k0, const bf16x8 k1, const QOps& Q) {
#define IDX_HEAD(h) ({ f32x16 c_ = __builtin_amdgcn_mfma_f32_32x32x16_bf16(k0, Q.qf[h][0], (f32x16){}, 0, 0, 0); __builtin_amdgcn_mfma_f32_32x32x16_bf16(k1, Q.qf[h][1], c_, 0, 0, 0); })
#define IDX_ACC(h, c) do { _Pragma("unroll") for (int r = 0; r < 16; ++r) { acc[r] = __builtin_fmaf(Q.wv[h], __builtin_fabsf(c[r]), acc[r]); asm volatile("" : "+v"(acc[r])); } } while (0)
    f32x16 cA = IDX_HEAD(0);
    f32x16 lin = __builtin_amdgcn_mfma_f32_32x32x16_bf16(k0, Q.qb[0][0], (f32x16){}, 0, 0, 0);
    lin = __builtin_amdgcn_mfma_f32_32x32x16_bf16(k1, Q.qb[0][1], lin, 0, 0, 0);
    lin = __builtin_amdgcn_mfma_f32_32x32x16_bf16(k0, Q.qb[1][0], lin, 0, 0, 0);
    lin = __builtin_amdgcn_mfma_f32_32x32x16_bf16(k1, Q.qb[1][1], lin, 0, 0, 0);
    f32x16 cB = IDX_HEAD(1);
#pragma unroll
    for (int r = 0; r < 16; ++r) acc[r] = lin[r];
    __builtin_amdgcn_sched_barrier(0);
#pragma unroll
    for (int hp = 0; hp < 4; ++hp) {
        f32x16 nA, nB;
        if (hp < 3) nA = IDX_HEAD(2 * hp + 2);
        IDX_ACC(2 * hp, cA);
        __builtin_amdgcn_sched_barrier(0);
        if (hp < 3) nB = IDX_HEAD(2 * hp + 3);
        IDX_ACC(2 * hp + 1, cB);
        __builtin_amdgcn_sched_barrier(0);
        if (hp < 3) { cA = nA; cB = nB; }
    }
#undef IDX_HEAD
#undef IDX_ACC
}
#define IDX_KLOAD(k0, k1, kt) do { const bf16_t* kp_ = kbase + (size_t)(kt) * 1024 + r32 * 32 + hi * 8; k0 = *(const bf16x8*)kp_; k1 = *(const bf16x8*)(kp_ + 16); } while (0)

struct PassCtx { const bf16_t* kbase; LAS unsigned* hrow; LAS unsigned* lcnt_q; LAS unsigned* blist_q; unsigned short* mbase; unsigned pfx; int lane, r32, hi, ktb, kte; };
template <int PASS>
__device__ __forceinline__ void pass_tile(const PassCtx& C, const bf16x8 k0, const bf16x8 k1, const QOps& Q, int kt) {
    constexpr int SH_BIN = (PASS == 0) ? 21 : ((PASS == 1) ? 10 : 0), SH_PFX = (PASS == 1) ? 21 : 10; constexpr unsigned BMASK = (PASS == 2) ? 1023u : 2047u;
    float acc[16]; score_tile(acc, k0, k1, Q);
    unsigned bits = 0u, anym = 0u; unsigned keys[16];
#pragma unroll
    for (int r = 0; r < 16; ++r) {
        const unsigned key = f2key(acc[r]), up = key >> SH_PFX, bin = (key >> SH_BIN) & BMASK; keys[r] = key;
        const bool match = (PASS == 0) || (up == C.pfx);
        if (match) __hip_atomic_fetch_add(C.hrow + (bin >> 1), 1u << ((bin & 1u) * 16u), __ATOMIC_RELAXED, __HIP_MEMORY_SCOPE_WORKGROUP);
        if (PASS == 2) { bits |= (up > C.pfx) ? (1u << r) : 0u; anym |= match ? 1u : 0u; }
    }
    if (PASS == 2) {
        C.mbase[(size_t)(kt >> 1) * 128 + C.lane * 2 + (kt & 1)] = (unsigned short)bits;
        if (__any(anym)) {
#pragma unroll
            for (int r = 0; r < 16; ++r) if ((keys[r] >> 10) == C.pfx) {
                const unsigned sl = __hip_atomic_fetch_add(C.lcnt_q, 1u, __ATOMIC_RELAXED, __HIP_MEMORY_SCOPE_WORKGROUP);
                if (sl < (unsigned)LCAP) C.blist_q[sl] = (keys[r] & 1023u) | ((unsigned)r << 10) | ((unsigned)C.lane << 14) | ((unsigned)kt << 20);
            }
        }
    }
}
#define IDX_KLOADC(k0, k1, kt) do { const bf16_t* kp_ = C.kbase + (size_t)(kt) * 1024 + C.r32 * 32 + C.hi * 8; k0 = *(const bf16x8*)kp_; k1 = *(const bf16x8*)(kp_ + 16); } while (0)
template <int PASS>
__device__ __forceinline__ void pass_loop(const PassCtx& C, const QOps& Q) {
    bf16x8 a0, a1, b0, b1, c0, c1; const int ktb = C.ktb, kte = C.kte;
    if (ktb < kte) IDX_KLOADC(a0, a1, ktb); if (ktb + 1 < kte) IDX_KLOADC(b0, b1, ktb + 1); if (ktb + 2 < kte) IDX_KLOADC(c0, c1, ktb + 2);
    for (int kt = ktb; kt < kte; kt += 3) {
        pass_tile<PASS>(C, a0, a1, Q, kt); if (kt + 3 < kte) IDX_KLOADC(a0, a1, kt + 3);
        if (kt + 1 < kte) { pass_tile<PASS>(C, b0, b1, Q, kt + 1); if (kt + 4 < kte) IDX_KLOADC(b0, b1, kt + 4); }
        if (kt + 2 < kte) { pass_tile<PASS>(C, c0, c1, Q, kt + 2); if (kt + 5 < kte) IDX_KLOADC(c0, c1, kt + 5); }
    }
}
#undef IDX_KLOADC

__device__ __forceinline__ void unit(int b, int qt, const bf16_t* __restrict__ O1, const bf16_t* __restrict__ KIDX, unsigned* __restrict__ MASK, LAS unsigned char* lds) {
    int tid_ = threadIdx.x; asm volatile("" : "+v"(tid_));
    const int tid = tid_, lane = tid & 63, r32 = lane & 31, hi = lane >> 5; const int wid = __builtin_amdgcn_readfirstlane(tid >> 6);
    const size_t rowbase = (size_t)b * S; const int nkt = 2 * ((qt >> 1) + 1);
    const int kper = (nkt + 7) >> 3, ktb = wid * kper, kte = (ktb + kper < nkt) ? ktb + kper : nkt;
    LAS unsigned* hist = (LAS unsigned*)(lds + L_HIST); LAS unsigned* spfx = (LAS unsigned*)(lds + L_PFX); LAS int* sneed = (LAS int*)(lds + L_NEED);
    QOps Q;
    { const bf16_t* qrow = O1 + (rowbase + qt * 32 + r32) * LD1;
      const u32x4 ww = *(const u32x4*)(qrow + O_WIDX);
      Q.wv[0] = bflo(ww.x); Q.wv[1] = bfhi(ww.x); Q.wv[2] = bflo(ww.y); Q.wv[3] = bfhi(ww.y); Q.wv[4] = bflo(ww.z); Q.wv[5] = bfhi(ww.z); Q.wv[6] = bflo(ww.w); Q.wv[7] = bfhi(ww.w);
      float qs[2][8];
#pragma unroll
      for (int s2 = 0; s2 < 2; ++s2)
#pragma unroll
          for (int j = 0; j < 8; ++j) qs[s2][j] = 0.f;
#pragma unroll
      for (int h = 0; h < 8; ++h)
#pragma unroll
          for (int s2 = 0; s2 < 2; ++s2) {
              const u32x4 qv = *(const u32x4*)(qrow + O_QIDX + 32 * h + 16 * s2 + hi * 8);
              Q.qf[h][s2] = __builtin_bit_cast(bf16x8, qv);
              qs[s2][0] = __builtin_fmaf(Q.wv[h], bflo(qv.x), qs[s2][0]); qs[s2][1] = __builtin_fmaf(Q.wv[h], bfhi(qv.x), qs[s2][1]);
              qs[s2][2] = __builtin_fmaf(Q.wv[h], bflo(qv.y), qs[s2][2]); qs[s2][3] = __builtin_fmaf(Q.wv[h], bfhi(qv.y), qs[s2][3]);
              qs[s2][4] = __builtin_fmaf(Q.wv[h], bflo(qv.z), qs[s2][4]); qs[s2][5] = __builtin_fmaf(Q.wv[h], bfhi(qv.z), qs[s2][5]);
              qs[s2][6] = __builtin_fmaf(Q.wv[h], bflo(qv.w), qs[s2][6]); qs[s2][7] = __builtin_fmaf(Q.wv[h], bfhi(qv.w), qs[s2][7]);
          }
#pragma unroll
      for (int s2 = 0; s2 < 2; ++s2) {
          u32x4 hv, lv; unsigned* hp = (unsigned*)&hv; unsigned* lp = (unsigned*)&lv;
#pragma unroll
          for (int j = 0; j < 4; ++j) {
              const unsigned hw = pk2(qs[s2][2 * j], qs[s2][2 * j + 1]);
              hp[j] = hw; lp[j] = pk2(qs[s2][2 * j] - bflo(hw), qs[s2][2 * j + 1] - bfhi(hw));
          }
          Q.qb[0][s2] = __builtin_bit_cast(bf16x8, hv); Q.qb[1][s2] = __builtin_bit_cast(bf16x8, lv);
      } }
    const bf16_t* kbase = KIDX + rowbase * 32;
    LAS unsigned* lcnt = (LAS unsigned*)(lds + L_LCNT); LAS unsigned* blist = (LAS unsigned*)(lds + L_LIST);
    unsigned short* mbase = (unsigned short*)MASK + ((size_t)b * att::MASK_TILES_PER_BATCH + att::mask_tile_off(qt)) * 64;
    unsigned tau = 0u;
    bool need_mask_pass = true;
    if (nkt * 32 > 256) {
        if (tid < 32) { spfx[tid] = 0u; sneed[tid] = 256; lcnt[tid] = 0u; }
        for (int pass = 0; pass < 3; ++pass) {
            for (int e = tid; e < 32 * HROW; e += 512) hist[e] = 0u;
            asm volatile("s_waitcnt lgkmcnt(0)\n\ts_barrier" ::: "memory");
            { PassCtx C; C.kbase = kbase; C.hrow = hist + r32 * HROW; C.lcnt_q = lcnt + r32; C.blist_q = blist + r32 * LCAP; C.mbase = mbase; C.pfx = spfx[r32];
              C.lane = lane; C.r32 = r32; C.hi = hi; C.ktb = ktb; C.kte = kte;
              if (pass == 0) pass_loop<0>(C, Q); else if (pass == 1) pass_loop<1>(C, Q); else pass_loop<2>(C, Q); }
            asm volatile("s_waitcnt vmcnt(0) lgkmcnt(0)\n\ts_barrier" ::: "memory");
            const int nbits = (pass == 2) ? 10 : 11;
#pragma unroll 1
            for (int qi = 0; qi < 4; ++qi) {
                const int q = wid * 4 + qi; const LAS unsigned* hr = hist + q * HROW + 16 * lane;
                unsigned wv_[16]; int c = 0;
#pragma unroll
                for (int i = 0; i < 16; ++i) { wv_[i] = hr[i]; c += (int)(wv_[i] & 0xffffu) + (int)(wv_[i] >> 16); }
                int sfx = c;
#pragma unroll
                for (int d = 1; d < 64; d <<= 1) { const int o = __shfl_down(sfx, d); sfx += (lane + d < 64) ? o : 0; }
                const int above = sfx - c, need = sneed[q];
                if (sfx >= need && above < need) {
                    int run = above, bstar = 0, nn = need; bool done = false;
#pragma unroll
                    for (int i = 15; i >= 0; --i) {
                        const int chi = (int)(wv_[i] >> 16), clo = (int)(wv_[i] & 0xffffu);
                        if (!done) { if (run + chi >= need) { bstar = 2 * i + 1; nn = need - run; done = true; } else run += chi; }
                        if (!done) { if (run + clo >= need) { bstar = 2 * i; nn = need - run; done = true; } else run += clo; }
                    }
                    spfx[q] = (spfx[q] << nbits) | (unsigned)(32 * lane + bstar); sneed[q] = nn;
                }
            }
            asm volatile("s_waitcnt lgkmcnt(0)\n\ts_barrier" ::: "memory");
        }
        tau = spfx[r32];
        const bool overflow = __any(lcnt[r32] > (unsigned)LCAP) != 0;
        if (!overflow) {
            need_mask_pass = false;
            const unsigned n = lcnt[r32], tq = tau & 1023u;
            for (unsigned i = 0; i < n; ++i) {
                const unsigned e = blist[r32 * LCAP + i]; const int ekt = (int)(e >> 20);
                if (((e >> 14) & 63u) == (unsigned)lane && ekt >= ktb && ekt < kte && (e & 1023u) >= tq) {
                    unsigned short* wp = mbase + (size_t)(ekt >> 1) * 128 + lane * 2 + (ekt & 1);
                    *wp = (unsigned short)(*wp | (1u << ((e >> 10) & 15u)));
                }
            }
        }
    }
#define IDX_MASK_BODY(K0, K1, KT) do { float acc[16]; score_tile(acc, K0, K1, Q); unsigned bits = 0u; \
        _Pragma("unroll") for (int r = 0; r < 16; ++r) bits |= (f2key(acc[r]) >= tau) ? (1u << r) : 0u; \
        mbase[(size_t)((KT) >> 1) * 128 + lane * 2 + ((KT) & 1)] = (unsigned short)bits; } while (0)
    if (need_mask_pass)
    { bf16x8 a0, a1, b0, b1, c0, c1;
      if (ktb < kte) IDX_KLOAD(a0, a1, ktb); if (ktb + 1 < kte) IDX_KLOAD(b0, b1, ktb + 1); if (ktb + 2 < kte) IDX_KLOAD(c0, c1, ktb + 2);
      for (int kt = ktb; kt < kte; kt += 3) {
          IDX_MASK_BODY(a0, a1, kt); if (kt + 3 < kte) IDX_KLOAD(a0, a1, kt + 3);
          if (kt + 1 < kte) { IDX_MASK_BODY(b0, b1, kt + 1); if (kt + 4 < kte) IDX_KLOAD(b0, b1, kt + 4); }
          if (kt + 2 < kte) { IDX_MASK_BODY(c0, c1, kt + 2); if (kt + 5 < kte) IDX_KLOAD(c0, c1, kt + 5); }
      } }
#undef IDX_MASK_BODY
    asm volatile("s_waitcnt lgkmcnt(0)\n\ts_barrier" ::: "memory");
}
#undef IDX_KLOAD

__device__ __forceinline__ void phase(const bf16_t* O1, const bf16_t* KIDX, unsigned* MASK, LAS unsigned char* lds, int G, int bid) {
    for (int p = bid; p < 512; p += G) {
        const int b = p & 3, j = p >> 2;
#pragma unroll 1
        for (int u2 = 0; u2 < 2; ++u2) unit(b, u2 ? 255 - j : j, O1, KIDX, MASK, lds);
    }
}
}
struct Frame { LAS unsigned char* lds; int tid, lane, wave, G, bid; Ptrs p; };

__device__ __forceinline__ int win_dest_row(int n) {
    if (n < 672) return n;
    if (n < 3488) return n + 96;
    if (n < 3528) return n - 3488 + 672;
    return n + 56;
}
template <bool MAP>
__device__ __forceinline__ void transpose_item(const float* __restrict__ W, int K, int N, bf16_t* __restrict__ WT, const float* __restrict__ gk, LAS float* scr, int item, int lane) {
    const int nblk = (N + 31) / 32, kb = item / nblk, nb = item % nblk, k0 = 64 * kb, n0 = 32 * nb;
    const int nn = n0 + (lane & 31);
#pragma unroll 8
    for (int i = 0; i < 32; ++i) { const int kk = 2 * i + (lane >> 5); float v = 0.f; if (nn < N) v = W[(size_t)(k0 + kk) * N + nn]; if (gk) v *= gk[k0 + kk]; scr[kk * 33 + (lane & 31)] = v; }
    asm volatile("s_waitcnt lgkmcnt(0)" ::: "memory");
    const int c = lane & 7;
#pragma unroll
    for (int j = 0; j < 4; ++j) { const int n = (lane >> 3) + 8 * j; const LAS float* s = scr + (8 * c) * 33 + n;
        u32x4 o; o.x = pk2(s[0 * 33], s[1 * 33]); o.y = pk2(s[2 * 33], s[3 * 33]); o.z = pk2(s[4 * 33], s[5 * 33]); o.w = pk2(s[6 * 33], s[7 * 33]);
        if (n0 + n < N) { const int dr = MAP ? win_dest_row(n0 + n) : (n0 + n); *(u32x4*)(WT + (size_t)dr * K + k0 + 8 * c) = o; } }
    asm volatile("s_waitcnt lgkmcnt(0)" ::: "memory");
}

__device__ __forceinline__ void phase0(Frame& F) {
    unsigned char* ws = F.p.ws;
    LAS float* scr = (LAS float*)(F.lds + F.wave * 16384);
    const int gw = F.bid * 8 + F.wave, NGW = F.G * 8;
    constexpr int I_IN = 16 * 175, I_UQ = 6 * 24, I_UKV = 4 * 32, I_OA = 8 * 32, I_OB = 8 * 32, I_OUT = 16 * 32;
    constexpr int NITEMS = I_IN + I_UQ + I_UKV + I_OA + I_OB + I_OUT;
    for (int it = gw; it < NITEMS; it += NGW) {
        int r = it;
        if (r < I_IN) { transpose_item<true>(F.p.w_in, 1024, NIN, (bf16_t*)(ws + WS_WINT), nullptr, scr, r, F.lane); continue; } r -= I_IN;
        if (r < I_UQ) { transpose_item<false>(F.p.w_uq, 384, 768, (bf16_t*)(ws + WS_WUQT), F.p.g_q, scr, r, F.lane); continue; } r -= I_UQ;
        if (r < I_UKV) { transpose_item<false>(F.p.w_ukv, 256, 1024, (bf16_t*)(ws + WS_WUKVT), F.p.g_kv, scr, r, F.lane); continue; } r -= I_UKV;
        if (r < I_OA) { transpose_item<false>(F.p.w_oa, 512, 1024, (bf16_t*)(ws + WS_WOAT), nullptr, scr, r, F.lane); continue; } r -= I_OA;
        if (r < I_OB) { transpose_item<false>(F.p.w_ob, 512, 1024, (bf16_t*)(ws + WS_WOBT), nullptr, scr, r, F.lane); continue; } r -= I_OB;
        transpose_item<false>(F.p.w_out, 1024, 1024, (bf16_t*)(ws + WS_WOUTT), nullptr, scr, r, F.lane);
    }
    { const int gt = F.bid * 512 + F.tid; if (gt < 7168) ((u32x4*)(ws + WS_WINT + (size_t)712 * 1024 * 2))[gt] = (u32x4){0u, 0u, 0u, 0u}; }
    for (int e = F.bid * 512 + F.tid; e < S * 16; e += F.G * 512) {
        const int pos = e >> 4, i = e & 15;
        const float freq = powf(10000.f, -(float)i / 16.f); const float ang = (float)pos * freq;
        ((float2*)(ws + WS_ROPE))[e] = make_float2(cosf(ang), sinf(ang));
    }
    bf16_t* H = (bf16_t*)(ws + WS_H);
    for (int row = gw; row < T; row += NGW) {
        const f32x4* xr = (const f32x4*)(F.p.x + (size_t)row * DM);
        f32x4 v[4]; float s = 0.f;
#pragma unroll
        for (int j = 0; j < 4; ++j) { v[j] = xr[F.lane + 64 * j]; s += (v[j][0] * v[j][0] + v[j][1] * v[j][1]) + (v[j][2] * v[j][2] + v[j][3] * v[j][3]); }
        s = wave_sum(s);
        const float r = rsqrtf(s * (1.f / DM) + 1e-6f);
#pragma unroll
        for (int j = 0; j < 4; ++j) {
            const f32x4 gg = ((const f32x4*)F.p.norm_g)[F.lane + 64 * j];
            uint2 o; o.x = pk2(v[j][0] * r * gg[0], v[j][1] * r * gg[1]); o.y = pk2(v[j][2] * r * gg[2], v[j][3] * r * gg[3]);
            ((uint2*)(H + (size_t)row * DM))[F.lane + 64 * j] = o;
        }
    }
}

__device__ __forceinline__ void phase1(Frame& F) {
    unsigned char* ws = F.p.ws;
    pg8::Gemm g{(const bf16_t*)(ws + WS_H), DM, (const bf16_t*)(ws + WS_WINT), T, LD1, DM};
    pg8::StaticOrder So; So.init(T, LD1, F.G, F.bid);
    pg8::EpiIn E{(bf16_t*)(ws + WS_OUT1), (float*)(ws + WS_SSQLAT)};
    pg8::gemm_phase<pg8::EpiIn, pg8::StaticOrder, true, true>(F.lds, g, So, E);
}

__device__ __forceinline__ void phase1b(Frame& F) {
    unsigned char* ws = F.p.ws;
    const bf16_t* O1 = (const bf16_t*)(ws + WS_OUT1);
    {
        bf16_t* KPE = (bf16_t*)(ws + WS_KPE); bf16_t* KIDX = (bf16_t*)(ws + WS_KIDX); const float2* rope = (const float2*)(ws + WS_ROPE);
        for (int e = F.bid * 512 + F.tid; e < T * 16; e += F.G * 512) {
            const int m = e >> 4, i = e & 15; const bf16_t* src = O1 + (size_t)m * LD1;
            const float2 cs = rope[(size_t)(m & (S - 1)) * 16 + i];
            const float x1 = bf2f(src[O_KROPE + i]), x2 = bf2f(src[O_KROPE + 16 + i]);
            KPE[(size_t)m * 32 + i] = f2bf(x1 * cs.x - x2 * cs.y); KPE[(size_t)m * 32 + 16 + i] = f2bf(x1 * cs.y + x2 * cs.x);
            KIDX[(size_t)m * 32 + i] = src[O_KIDX + i]; KIDX[(size_t)m * 32 + 16 + i] = src[O_KIDX + 16 + i];
        }
    }
    {
        pg8::Gemm g{O1 + O_QLAT, LD1, (const bf16_t*)(ws + WS_WUQT), T, 768, 384};
        pg8::StaticOrder So; So.init(T, 768, F.G, F.bid);
        pg8::EpiQ E{(bf16_t*)(ws + WS_Q), (const float*)(ws + WS_SSQLAT), (const float2*)(ws + WS_ROPE)};
        pg8::gemm_phase<pg8::EpiQ, pg8::StaticOrder, true, true>(F.lds, g, So, E);
    }
    {
        pg8::Gemm g{O1 + O_CKV, LD1, (const bf16_t*)(ws + WS_WUKVT), T, 1024, 256};
        pg8::StaticOrder So; So.init(T, 1024, F.G, F.bid);
        pg8::EpiKV E{(bf16_t*)(ws + WS_H), (const float*)(ws + WS_SSQLAT)};
        pg8::gemm_phase<pg8::EpiKV, pg8::StaticOrder, true, true>(F.lds, g, So, E);
    }
}

__device__ __forceinline__ void phase4ab(Frame& F) {
    unsigned char* ws = F.p.ws;
    const bf16_t* O1 = (const bf16_t*)(ws + WS_OUT1); bf16_t* MG = (bf16_t*)(ws + WS_H);
    {
        pg8::Gemm g{O1 + O_ZA, LD1, (const bf16_t*)(ws + WS_WOAT), T, 1024, 512};
        pg8::StaticOrder So; So.init(T, 1024, F.G, F.bid);
        pg8::EpiGate<false> E{MG, O1, O_GA};
        pg8::gemm_phase<pg8::EpiGate<false>, pg8::StaticOrder, true, true>(F.lds, g, So, E);
    }
    {
        pg8::Gemm g{O1 + O_ZB, LD1, (const bf16_t*)(ws + WS_WOBT), T, 1024, 512};
        pg8::StaticOrder So; So.init(T, 1024, F.G, F.bid);
        pg8::EpiGate<true> E{MG, O1, O_GB};
        pg8::gemm_phase<pg8::EpiGate<true>, pg8::StaticOrder, true, true>(F.lds, g, So, E);
    }
}

__device__ __forceinline__ void phase4c(Frame& F) {
    unsigned char* ws = F.p.ws;
    pg8::Gemm g{(const bf16_t*)(ws + WS_H), DM, (const bf16_t*)(ws + WS_WOUTT), T, 1024, 1024};
    pg8::StaticOrder So; So.init(T, 1024, F.G, F.bid);
    pg8::EpiOut E{F.p.x, F.p.out, (float*)(ws + WS_SSQO)};
    pg8::gemm_phase<pg8::EpiOut, pg8::StaticOrder, true, true>(F.lds, g, So, E);
}

__device__ __forceinline__ void phase5(Frame& F) {
    const float* ssqo = (const float*)(F.p.ws + WS_SSQO);
    const int gw = F.bid * 8 + F.wave, NGW = F.G * 8;
    for (int row = gw; row < T; row += NGW) {
        float s = (F.lane < 32) ? ssqo[(size_t)row * 32 + F.lane] : 0.f;
        s = wave_sum(s);
        const float r = rsqrtf(s * (1.f / DM) + 1e-6f);
        f32x4* xr = (f32x4*)(F.p.out + (size_t)row * DM);
#pragma unroll
        for (int j = 0; j < 4; ++j) { const f32x4 gg = ((const f32x4*)F.p.final_g)[F.lane + 64 * j]; xr[F.lane + 64 * j] = xr[F.lane + 64 * j] * r * gg; }
    }
}

__device__ __forceinline__ void phase_mla(Frame& F, bool dry = false) {
    unsigned char* ws = F.p.ws;
    att::Tensors X{};
    X.Q = (const bf16_t*)(ws + WS_Q); X.ldq = 768; X.hq = 96;
    X.K0 = (const bf16_t*)(ws + WS_H); X.ldk = 1024; X.hk = 128; X.K1 = (const bf16_t*)(ws + WS_KPE);
    X.V = (const bf16_t*)(ws + WS_H) + 64; X.ldv = 1024; X.hv = 128;
    X.O = (bf16_t*)(ws + WS_OUT1) + O_ZA; X.ldo = LD1; X.mask = nullptr; X.rel_bias = nullptr;
    att::phase<false>(X, F.lds, F.G, F.bid, dry);
}
__device__ __forceinline__ void phase_dsa(Frame& F, bool dry = false) {
    unsigned char* ws = F.p.ws; bf16_t* O1 = (bf16_t*)(ws + WS_OUT1);
    att::Tensors X{};
    X.Q = O1 + O_QB; X.ldq = LD1; X.hq = 64;
    X.K0 = O1 + O_KB; X.ldk = LD1; X.hk = 64; X.K1 = nullptr;
    X.V = O1 + O_VB; X.ldv = LD1; X.hv = 64;
    X.O = O1 + O_ZB; X.ldo = LD1; X.mask = (const unsigned long long*)(ws + WS_MASK); X.rel_bias = F.p.rel_bias;
    att::phase<true>(X, F.lds, F.G, F.bid, dry);
}

__device__ __forceinline__ void phase_idx(Frame& F) {
    unsigned char* ws = F.p.ws;
    idx::phase((const bf16_t*)(ws + WS_OUT1), (const bf16_t*)(ws + WS_KIDX), (unsigned*)(ws + WS_MASK), F.lds, F.G, F.bid);
}

typedef unsigned long long u64_t;
#define XB_TMO      128
#define XB_XCNT(j)  (256  + 64 * (j))
#define XB_XSUB(j)  (1280 + 64 * (j))
#define XB_XGEN(j)  (2304 + 64 * (j))
#define XB_TOP      3328
#define XB_TOPGEN   3392
#define XCD_BAR_WORDS 3456
#define XB_SPIN_CAP (1u << 18)

__device__ __forceinline__ unsigned xb_ld(unsigned* p)              { return __hip_atomic_load(p, __ATOMIC_RELAXED, __HIP_MEMORY_SCOPE_AGENT); }
__device__ __forceinline__ unsigned xb_add(unsigned* p, unsigned v) { return __hip_atomic_fetch_add(p, v, __ATOMIC_RELAXED, __HIP_MEMORY_SCOPE_AGENT); }
__device__ __forceinline__ unsigned xb_xcc_id() { return (unsigned)__builtin_amdgcn_s_getreg((3 << 11) | 20) & 0xFu; }
#define XB_SPIN(cond, bar) do { unsigned _sp = 0; while (cond) { __builtin_amdgcn_s_sleep(1); \
    if ((++_sp & 255u) == 0u) { if (xb_ld(&(bar)[XB_TMO])) break; if (_sp > XB_SPIN_CAP) { atomicAdd(&(bar)[XB_TMO], 1u); break; } } } } while (0)

struct XcdBarrier {
    unsigned* bar; unsigned x;
    volatile LAS unsigned* st;
};

__device__ __forceinline__ XcdBarrier xcd_barrier_post(unsigned* bar, volatile LAS unsigned* st) {
    XcdBarrier b; b.bar = bar; b.x = xb_xcc_id(); b.st = st;
    if (threadIdx.x == 0) (void)xb_add(&bar[XB_XCNT(b.x)], 1u);
    return b;
}
__device__ __forceinline__ void xcd_barrier_complete(unsigned* bar, unsigned x, unsigned& nloc, unsigned& nx) {
    const unsigned G = gridDim.x * gridDim.y * gridDim.z;
    unsigned sum, cnt, mine, sp = 0u;
    for (;;) {
        sum = 0u; cnt = 0u; mine = 0u;
#pragma unroll
        for (unsigned j = 0; j < 16; ++j) { const unsigned c = xb_ld(&bar[XB_XCNT(j)]); sum += c; cnt += (c > 0u) ? 1u : 0u; mine = (j == x) ? c : mine; }
        if (sum == G) break;
        __builtin_amdgcn_s_sleep(1);
        if ((++sp & 255u) == 0u) { if (xb_ld(&bar[XB_TMO])) break; if (sp > XB_SPIN_CAP) { atomicAdd(&bar[XB_TMO], 1u); break; } }
    }
    nloc = mine > 0u ? mine : 1u; nx = cnt > 0u ? cnt : 1u;
}

__device__ __forceinline__ void xcd_barrier(const XcdBarrier& b) {
    asm volatile("s_waitcnt vmcnt(0)" ::: "memory");
    __syncthreads();
    if (threadIdx.x == 0) {
        unsigned* bar = b.bar;
        __builtin_amdgcn_s_waitcnt(0);
        unsigned nloc = b.st[0], nx = b.st[1];
        if (nloc == 0u) { xcd_barrier_complete(bar, b.x, nloc, nx); b.st[0] = nloc; b.st[1] = nx; }
        const unsigned old = xb_add(&bar[XB_XSUB(b.x)], 1u);
        const unsigned gen = old / nloc;
        if (old + 1u == (gen + 1u) * nloc) {
            __builtin_amdgcn_fence(__ATOMIC_RELEASE, "agent");
            asm volatile("s_waitcnt vmcnt(0)" ::: "memory");
            const unsigned og = xb_add(&bar[XB_TOP], 1u);
            const unsigned tg = og / nx;
            if (og + 1u == (tg + 1u) * nx) xb_add(&bar[XB_TOPGEN], 1u);
            else XB_SPIN(xb_ld(&bar[XB_TOPGEN]) == tg, bar);
            __builtin_amdgcn_fence(__ATOMIC_ACQUIRE, "agent");
            xb_add(&bar[XB_XGEN(b.x)], 1u);
            asm volatile("s_waitcnt vmcnt(0)" ::: "memory");
        } else {
            XB_SPIN(xb_ld(&bar[XB_XGEN(b.x)]) == gen, bar);
            __builtin_amdgcn_fence(__ATOMIC_ACQUIRE, "agent");
            asm volatile("s_waitcnt vmcnt(0)" ::: "memory");
        }
    }
    __syncthreads();
}

constexpr int CW_BAR = 4096;
constexpr size_t CTL_ZERO_BYTES = 65536;
constexpr int LDS_MISC = 135680;
struct Args { Ptrs p; int ph_lo, ph_hi; };
__global__ void __launch_bounds__(512, 2) mega_fwd(Args a) {
    extern __shared__ __attribute__((aligned(16))) unsigned char lds_raw[];
    Frame F; F.lds = (LAS unsigned char*)lds_raw; F.tid = threadIdx.x; F.lane = F.tid & 63; F.wave = __builtin_amdgcn_readfirstlane(F.tid >> 6);
    F.G = gridDim.x; F.bid = blockIdx.x; F.p = a.p;
    cooperative_groups::grid_group grid = cooperative_groups::this_grid();
    volatile LAS unsigned* st = (volatile LAS unsigned*)(F.lds + LDS_MISC);
    if (F.tid < 4) st[F.tid] = 0u;
    __syncthreads();
    const XcdBarrier bar = xcd_barrier_post((unsigned*)(a.p.ws + WS_CTL) + CW_BAR, st);
    const int lo = a.ph_lo, hi = a.ph_hi;
#define RUN(k, body, CG) do { if (lo <= (k) && (k) < hi) { body; if ((k) + 1 < hi) { if (CG) grid.sync(); else xcd_barrier(bar); } } } while (0)
    const bool dryrun = (a.ph_hi > 0);
    RUN(0, { phase0(F); if (PROBE_DUP == 0) phase0(F); }, true);
    RUN(1, { phase1(F); if (PROBE_DUP == 1) phase1(F); }, false);
    RUN(2, { phase1b(F); if (PROBE_DUP == 2) phase1b(F); }, false);
    RUN(3, { phase_mla(F); if (PROBE_DUP == 3) phase_mla(F, dryrun); phase_idx(F); if (PROBE_DUP == 8) phase_idx(F); }, false);
    RUN(4, { phase_dsa(F); if (PROBE_DUP == 4) phase_dsa(F, dryrun); }, false);
    RUN(5, { phase4ab(F); if (PROBE_DUP == 5) phase4ab(F); }, false);
    RUN(6, { phase4c(F); if (PROBE_DUP == 6) phase4c(F); }, false);
    RUN(7, phase5(F), false);
#undef RUN
}

extern "C" void kernel_launch(void* const* d_in, const int* in_sizes, int n_in, void* d_out, int out_size, void* d_ws, size_t ws_size, hipStream_t stream) {
    static int grid = 0;
    if (grid == 0) {
        if (ws_size < WS_END) { fprintf(stderr, "kernel_launch: workspace too small: %zu < %zu\n", ws_size, (size_t)WS_END); grid = -1; return; }
        int dev = 0, cus = 0, per_cu = 0;
        if (hipGetDevice(&dev) != hipSuccess || hipDeviceGetAttribute(&cus, hipDeviceAttributeMultiprocessorCount, dev) != hipSuccess) { grid = -1; return; }
        if (hipFuncSetAttribute((const void*)mega_fwd, hipFuncAttributeMaxDynamicSharedMemorySize, LDS_BYTES) != hipSuccess) { fprintf(stderr, "kernel_launch: hipFuncSetAttribute failed\n"); grid = -1; return; }
        if (hipOccupancyMaxActiveBlocksPerMultiprocessor(&per_cu, (const void*)mega_fwd, 512, LDS_BYTES) != hipSuccess || per_cu < 1) { fprintf(stderr, "kernel_launch: occupancy query failed (%d)\n", per_cu); (void)hipGetLastError(); grid = -1; return; }
        grid = cus;
    }
    if (grid < 0) return;
    if (hipMemsetAsync((char*)d_ws + WS_CTL, 0, CTL_ZERO_BYTES, stream) != hipSuccess) { fprintf(stderr, "kernel_launch: hipMemsetAsync failed\n"); return; }
    Args a{};
    a.p.x = (const float*)d_in[0]; a.p.norm_g = (const float*)d_in[1]; a.p.w_in = (const float*)d_in[2]; a.p.g_q = (const float*)d_in[3]; a.p.w_uq = (const float*)d_in[4];
    a.p.g_kv = (const float*)d_in[5]; a.p.w_ukv = (const float*)d_in[6]; a.p.w_oa = (const float*)d_in[7]; a.p.w_ob = (const float*)d_in[8]; a.p.w_out = (const float*)d_in[9];
    a.p.rel_bias = (const float*)d_in[10]; a.p.final_g = (const float*)d_in[11]; a.p.out = (float*)d_out; a.p.ws = (unsigned char*)d_ws;
    a.ph_lo = 0; a.ph_hi = 8;
    void* args[] = {&a};
    const hipError_t e = hipLaunchCooperativeKernel((const void*)mega_fwd, dim3(grid), dim3(512), args, LDS_BYTES, stream);
    if (e != hipSuccess) fprintf(stderr, "kernel_launch: cooperative launch failed: %s (grid %d)\n", hipGetErrorString(e), grid);
}
```

```cpp
#include <hip/hip_runtime.h>
#include <hip/hip_cooperative_groups.h>
#include <stdint.h>
#include <stdio.h>
#ifndef PROBE_DUP
#define PROBE_DUP -1
#endif

namespace pg8 {
#define PG8_LAS __attribute__((address_space(3)))
typedef unsigned short bf16_t;
typedef short bf16x8 __attribute__((ext_vector_type(8)));
typedef float f32x4 __attribute__((ext_vector_type(4)));
typedef unsigned u32x4 __attribute__((ext_vector_type(4)));
constexpr int BM = 256, BK = 64, HALF = 128, HTB = HALF * BK * 2  , STAGE_BYTES = 8 * HTB, NXCD = 8, WGM = 8;

__host__ __device__ __forceinline__ int lds_byte(int r, int c) { const int st = (r >> 4) * 2 + (c >> 5), rr = r & 15, cc = c & 31, ob = rr * 64 + cc * 2; return st * 1024 + (ob ^ (((ob >> 9) & 1) << 5)); }
__host__ __device__ __forceinline__ void stage_rc(int b, int& R, int& C) { const int st = b / 1024, sb = b % 1024, swz = sb ^ (((sb >> 9) & 1) << 5); R = (st >> 1) * 16 + swz / 64; C = (st & 1) * 32 + (swz % 64) / 2; }
__host__ __device__ __forceinline__ int perm32(int rho) { const int n = rho >> 4, i = rho & 15; return 8 * (i >> 2) + 4 * n + (i & 3); }

struct Unit { int pm, pn; };
struct Gemm { const bf16_t* A; int lda; const bf16_t* Bt; int M, N, K; };

struct StaticOrder {
    int nM, nN, nwg, G, c;
    __host__ __device__ void init(int M, int N, int G_, int c_) { nM = M / BM; nN = N / BM; nwg = nM * nN; G = G_; c = c_; }
    __host__ __device__ bool next(int i, Unit& u) const {
        const long L = (long)i * G + c; if (L >= nwg) return false;
        int wgid = (int)L; { const int q = nwg / NXCD, r = nwg % NXCD, xcd = wgid % NXCD, off = wgid / NXCD; wgid = (xcd < r ? xcd * (q + 1) : r * (q + 1) + (xcd - r) * q) + off; }
        const int nig = WGM * nN, gid = wgid / nig, fm = gid * WGM, gsz = (nM - fm) < WGM ? (nM - fm) : WGM;
        u.pm = fm + ((wgid % nig) % gsz); u.pn = (wgid % nig) / gsz; return true;
    }
    __device__ __forceinline__ void a_ready(const Unit&) const {}
    __device__ __forceinline__ void done(const Unit&) const {}
};

typedef __bf16 bf16x2_t __attribute__((ext_vector_type(2)));
typedef float f32x2_t __attribute__((ext_vector_type(2)));
__device__ __forceinline__ unsigned cvt_pk_bf16(float lo, float hi) { const f32x2_t v = {lo, hi}; return __builtin_bit_cast(unsigned, __builtin_convertvector(v, bf16x2_t)); }
template <class Epi, class Sched, bool ALIGN_EPI = false, bool SP2 = false>
__device__ __forceinline__ void gemm_phase(PG8_LAS unsigned char* lds, const Gemm g, const Sched& S, const Epi& E) {
    int tid_ = threadIdx.x; asm volatile("" : "+v"(tid_));
    const int tid = tid_, wid = __builtin_amdgcn_readfirstlane(tid >> 6), lane = tid & 63, wr = wid >> 2, wc = wid & 3, fr = lane & 15, fq = lane >> 4;
    int K_ = g.K; if (g.K < 1024) asm volatile("" : "+s"(K_));
    const int K = K_, nt = K / BK;
    unsigned voffA[2], voffB[2];
#pragma unroll
    for (int i = 0; i < 2; ++i) { int R, C; stage_rc(tid * 16 + i * 8192, R, C); const int Rb = Epi::PERM ? ((R & ~31) + perm32(R & 31)) : R;
        voffA[i] = (unsigned)(R * g.lda + C) * 2u; voffB[i] = (unsigned)(Rb * K + C) * 2u; }
    const size_t kstep = (size_t)(BK * 2);
    const size_t hstepA = (size_t)HALF * g.lda * 2, hstepB = (size_t)HALF * K * 2;
    const size_t tstepA = 2 * hstepA, tstepB = 2 * hstepB;
    const unsigned ldsw = (unsigned)wid * 1024u;
    const int aoff = lds_byte(wr * 64 + fr, fq * 8), boff = lds_byte(wc * 32 + fr, fq * 8);
#define PG8_SA(b, h) (((b) * 2 + (h)) * HTB)
#define PG8_SB(b, h) ((4 + (b) * 2 + (h)) * HTB)
#define PG8_STAGE(bufoff, gbase, voff) do { _Pragma("unroll") for (int _i = 0; _i < 2; ++_i) \
        __builtin_amdgcn_global_load_lds((const unsigned*)((const char*)(gbase) + (voff)[_i]), (PG8_LAS unsigned*)(lds + (bufoff) + ldsw + _i * 8192), 16, 0, 0); } while (0)
#define PG8_LDA(dst, b, h) do { _Pragma("unroll") for (int m = 0; m < 4; ++m) _Pragma("unroll") for (int k = 0; k < 2; ++k) dst[m][k] = *(const PG8_LAS bf16x8*)(lds + PG8_SA(b, h) + aoff + m * 2048 + k * 1024); } while (0)
#define PG8_LDB(dst, b, h) do { _Pragma("unroll") for (int n = 0; n < 2; ++n) _Pragma("unroll") for (int k = 0; k < 2; ++k) dst[n][k] = *(const PG8_LAS bf16x8*)(lds + PG8_SB(b, h) + boff + n * 2048 + k * 1024); } while (0)
#define PG8_MMA(ai, bj, At, Bt) do { __builtin_amdgcn_s_setprio(1); _Pragma("unroll") for (int m = 0; m < 4; ++m) _Pragma("unroll") for (int n = 0; n < 2; ++n) _Pragma("unroll") for (int k = 0; k < 2; ++k) \
        acc[ai][bj][m][n] = __builtin_amdgcn_mfma_f32_16x16x32_bf16(Bt[n][k], At[m][k], acc[ai][bj][m][n], 0, 0, 0); __builtin_amdgcn_s_setprio(0); } while (0)
#define PG8_WAIT_V(n) asm volatile("s_waitcnt vmcnt(" #n ")" ::: "memory")
#define PG8_WAIT_L(n) asm volatile("s_waitcnt lgkmcnt(" #n ")" ::: "memory")
#define PG8_BAR __builtin_amdgcn_s_barrier()
#define PG8_SCHED __builtin_amdgcn_sched_barrier(0)
    Unit cur, nxt; int ui = 0;
    if (!S.next(0, cur)) return;
    f32x4 acc[2][2][4][2];
#pragma unroll
    for (int a = 0; a < 2; ++a)
#pragma unroll
        for (int b = 0; b < 2; ++b)
#pragma unroll
            for (int m = 0; m < 4; ++m)
#pragma unroll
                for (int n = 0; n < 2; ++n) acc[a][b][m][n] = (f32x4){0.f, 0.f, 0.f, 0.f};
    bf16x8 At[4][2], B0[2][2], B1[2][2];
    const char* cA = (const char*)g.A + (size_t)cur.pm * tstepA; const char* cB = (const char*)g.Bt + (size_t)cur.pn * tstepB;
    S.a_ready(cur);
    if constexpr (SP2) {
        PG8_STAGE(PG8_SB(0, 0), cB, voffB); PG8_STAGE(PG8_SB(0, 1), cB + hstepB, voffB); PG8_STAGE(PG8_SA(0, 0), cA, voffA); PG8_STAGE(PG8_SA(0, 1), cA + hstepA, voffA);
        if (wr == 1) PG8_BAR;
        PG8_WAIT_V(2); PG8_BAR;
        PG8_STAGE(PG8_SB(1, 0), cB + kstep, voffB); PG8_STAGE(PG8_SA(1, 0), cA + kstep, voffA); PG8_STAGE(PG8_SB(1, 1), cB + hstepB + kstep, voffB);
        PG8_WAIT_V(6); PG8_BAR;
    } else {
        PG8_STAGE(PG8_SB(0, 0), cB, voffB); PG8_STAGE(PG8_SA(0, 0), cA, voffA); PG8_STAGE(PG8_SB(0, 1), cB + hstepB, voffB); PG8_STAGE(PG8_SA(0, 1), cA + hstepA, voffA);
        if (wr == 1) PG8_BAR;
        PG8_WAIT_V(4); PG8_BAR;
        PG8_STAGE(PG8_SB(1, 0), cB + kstep, voffB); PG8_STAGE(PG8_SA(1, 0), cA + kstep, voffA); PG8_STAGE(PG8_SB(1, 1), cB + hstepB + kstep, voffB);
        PG8_WAIT_V(6); PG8_BAR;
    }
    for (;;) {
        const bool has_next = S.next(ui + 1, nxt);
        const char* nA = has_next ? (const char*)g.A + (size_t)nxt.pm * tstepA : cA; const char* nB = has_next ? (const char*)g.Bt + (size_t)nxt.pn * tstepB : cB;
        for (int t = 0; t < nt; t += 2) {
            const bool last = (t == nt - 2);
            const char* a1 = cA + (size_t)(t + 1) * kstep;
            const char* a2 = last ? nA : cA + (size_t)(t + 2) * kstep; const char* b2 = last ? nB : cB + (size_t)(t + 2) * kstep;
            const char* a3 = a2 + kstep; const char* b3 = b2 + kstep;
            if (last && has_next) S.a_ready(nxt);
            if constexpr (SP2) {
            PG8_LDB(B0, 0, 0); PG8_LDB(B1, 0, 1); PG8_SCHED; PG8_LDA(At, 0, 0); PG8_STAGE(PG8_SA(1, 1), a1 + hstepA, voffA);
            PG8_WAIT_V(8); PG8_WAIT_L(0); PG8_BAR; PG8_MMA(0, 0, At, B0); PG8_MMA(0, 1, At, B1); PG8_BAR; PG8_SCHED;
            PG8_LDA(At, 0, 1); PG8_STAGE(PG8_SB(0, 0), b2, voffB); PG8_STAGE(PG8_SB(0, 1), b2 + hstepB, voffB); PG8_STAGE(PG8_SA(0, 0), a2, voffA);
            PG8_WAIT_V(8); PG8_WAIT_L(0); PG8_BAR; PG8_MMA(1, 0, At, B0); PG8_MMA(1, 1, At, B1); PG8_BAR; PG8_SCHED;
            PG8_LDB(B0, 1, 0); PG8_LDB(B1, 1, 1); PG8_SCHED; PG8_LDA(At, 1, 0); PG8_STAGE(PG8_SA(0, 1), a2 + hstepA, voffA);
            PG8_WAIT_V(8); PG8_WAIT_L(0); PG8_BAR; PG8_MMA(0, 0, At, B0); PG8_MMA(0, 1, At, B1); PG8_BAR; PG8_SCHED;
            PG8_LDA(At, 1, 1); PG8_STAGE(PG8_SB(1, 0), b3, voffB); PG8_STAGE(PG8_SB(1, 1), b3 + hstepB, voffB); PG8_STAGE(PG8_SA(1, 0), a3, voffA);
            PG8_WAIT_V(8); PG8_WAIT_L(0); PG8_BAR; PG8_MMA(1, 0, At, B0); PG8_MMA(1, 1, At, B1); PG8_BAR; PG8_SCHED;
            } else {
            PG8_LDB(B0, 0, 0); PG8_SCHED; PG8_LDA(At, 0, 0); PG8_STAGE(PG8_SA(1, 1), a1 + hstepA, voffA);
            PG8_WAIT_L(8); PG8_BAR; PG8_WAIT_L(0); PG8_MMA(0, 0, At, B0); PG8_BAR; PG8_SCHED;
            PG8_LDB(B1, 0, 1); PG8_STAGE(PG8_SB(0, 0), b2, voffB);
            PG8_BAR; PG8_WAIT_L(0); PG8_MMA(0, 1, At, B1); PG8_BAR;
            PG8_LDA(At, 0, 1); PG8_STAGE(PG8_SA(0, 0), a2, voffA);
            PG8_BAR; PG8_WAIT_L(0); PG8_MMA(1, 0, At, B0); PG8_BAR; PG8_SCHED;
            PG8_STAGE(PG8_SB(0, 1), b2 + hstepB, voffB);
            PG8_WAIT_V(6); PG8_BAR; PG8_MMA(1, 1, At, B1); PG8_BAR;
            PG8_LDB(B0, 1, 0); PG8_SCHED; PG8_LDA(At, 1, 0); PG8_STAGE(PG8_SA(0, 1), a2 + hstepA, voffA);
            PG8_WAIT_L(8); PG8_BAR; PG8_WAIT_L(0); PG8_MMA(0, 0, At, B0); PG8_BAR; PG8_SCHED;
            PG8_LDB(B1, 1, 1); PG8_STAGE(PG8_SB(1, 0), b3, voffB);
            PG8_BAR; PG8_WAIT_L(0); PG8_MMA(0, 1, At, B1); PG8_BAR;
            PG8_LDA(At, 1, 1); PG8_STAGE(PG8_SA(1, 0), a3, voffA);
            PG8_BAR; PG8_WAIT_L(0); PG8_MMA(1, 0, At, B0); PG8_BAR; PG8_SCHED;
            PG8_STAGE(PG8_SB(1, 1), b3 + hstepB, voffB);
            PG8_WAIT_V(6); PG8_BAR; PG8_MMA(1, 1, At, B1); PG8_BAR;
            }
        }
        if constexpr (ALIGN_EPI) { if (wr == 0) PG8_BAR; }
        if constexpr (!Epi::AFTER_DRAIN) { E(acc, cur, wr, wc, fr, fq); S.done(cur); }
        if (!has_next) break;
#pragma unroll
        for (int a = 0; a < 2; ++a)
#pragma unroll
            for (int b = 0; b < 2; ++b)
#pragma unroll
                for (int m = 0; m < 4; ++m)
#pragma unroll
                    for (int n = 0; n < 2; ++n) acc[a][b][m][n] = (f32x4){0.f, 0.f, 0.f, 0.f};
        cur = nxt; cA = nA; cB = nB; ++ui;
        if constexpr (ALIGN_EPI) { if (wr == 1) PG8_BAR; }
    }
    PG8_WAIT_V(0);
    if constexpr (!ALIGN_EPI) { if (wr == 0) PG8_BAR; }
    PG8_BAR;
    if constexpr (Epi::AFTER_DRAIN) { E.fused(acc, cur, wr, wc, fr, fq, lds, wid, lane); S.done(cur); }
#undef PG8_SA
#undef PG8_SB
#undef PG8_STAGE
#undef PG8_LDA
#undef PG8_LDB
#undef PG8_MMA
#undef PG8_WAIT_V
#undef PG8_WAIT_L
#undef PG8_BAR
#undef PG8_SCHED
}
}

typedef unsigned short bf16_t;
typedef float f32x4 __attribute__((ext_vector_type(4)));
typedef unsigned u32x4 __attribute__((ext_vector_type(4)));
#define LAS __attribute__((address_space(3)))
constexpr int NB = 4, S = 8192, DM = 1024, T = NB * S;
constexpr int NIN = 5576;
constexpr int LD1 = 5632;
constexpr int O_QLAT = 0, O_CKV = 384, O_KROPE = 640, O_KIDX = 672, O_WIDX = 704, O_ZA = 768, O_QB = 1280, O_KB = 1792, O_VB = 2304, O_ZB = 2816,
              O_QIDX = 3328, O_GA = 3584, O_GB = 4608;
constexpr size_t MiB = 1u << 20;
constexpr size_t WS_CTL = 0, WS_WUQT = 1 * MiB, WS_WUKVT = 2 * MiB, WS_WOAT = 3 * MiB, WS_WOBT = 4 * MiB, WS_WOUTT = 5 * MiB, WS_ROPE = 7 * MiB,
                 WS_WINT = 8 * MiB, WS_SSQO = 8 * MiB  , WS_SSQLAT = 19 * MiB, WS_KPE = 22 * MiB, WS_KIDX = 24 * MiB, WS_MASK = 26 * MiB,
                 WS_H = 44 * MiB  , WS_Q = 108 * MiB, WS_OUT1 = 156 * MiB, WS_END = 508 * MiB;
constexpr float LOG2E = 1.4426950408889634f;
constexpr float QSCALE_A = 0.10206207261596577f * LOG2E;
constexpr float QSCALE_B = 0.125f * LOG2E;
constexpr int GEMM_LDS = 131072;
constexpr int LDS_BYTES = 147456;

__device__ __forceinline__ float bf2f(bf16_t v) { return __uint_as_float(((unsigned)v) << 16); }
__device__ __forceinline__ bf16_t f2bf(float f) { unsigned u = __float_as_uint(f); return (bf16_t)((u + 0x7fffu + ((u >> 16) & 1u)) >> 16); }
__device__ __forceinline__ unsigned pk2(float lo, float hi) { return (unsigned)f2bf(lo) | ((unsigned)f2bf(hi) << 16); }
__device__ __forceinline__ float bflo(unsigned w) { return __uint_as_float(w << 16); }
__device__ __forceinline__ float bfhi(unsigned w) { return __uint_as_float(w & 0xffff0000u); }
__device__ __forceinline__ float wave_sum(float v) {
#pragma unroll
    for (int o = 1; o < 64; o <<= 1) v += __shfl_xor(v, o);
    return v;
}
__device__ __forceinline__ float sigmoidf_(float x) { return __builtin_amdgcn_rcpf(1.f + __builtin_amdgcn_exp2f(-LOG2E * x)); }

struct Ptrs {
    const float *x, *norm_g, *w_in, *g_q, *w_uq, *g_kv, *w_ukv, *w_oa, *w_ob, *w_out, *rel_bias, *final_g;
    float* out; unsigned char* ws;
};

namespace pg8 {
struct EpiIn {
    static constexpr bool PERM = true, AFTER_DRAIN = false;
    bf16_t* O; float* ssq;
    __device__ __forceinline__ void operator()(const f32x4 (&acc)[2][2][4][2], const Unit& u, int wr, int wc, int, int) const {
        int t_ = threadIdx.x; asm volatile("" : "+v"(t_));
        const int fr = t_ & 15, fq = (t_ >> 4) & 3;
        const int row0 = u.pm * BM + wr * 64 + fr;
#pragma unroll
        for (int bj = 0; bj < 2; ++bj) {
            const int g = u.pn * 2 + bj;
            const int col0 = g * 128 + wc * 32 + 8 * fq;
            int op = 0;
            if ((g >= 6 && g <= 9) || (g >= 22 && g <= 25)) op = 1; else if (g >= 28) op = 2; else if (g >= 10 && g <= 13) op = 3; else if (g <= 4) op = 4;
#pragma unroll
            for (int ai = 0; ai < 2; ++ai)
#pragma unroll
                for (int m = 0; m < 4; ++m) {
                    const int row = row0 + ai * HALF + m * 16;
                    f32x4 v0 = acc[ai][bj][m][0], v1 = acc[ai][bj][m][1];
                    if (op == 1) {
#pragma unroll
                        for (int e = 0; e < 4; ++e) { v0[e] = v0[e] * sigmoidf_(v0[e]); v1[e] = v1[e] * sigmoidf_(v1[e]); }
                    } else if (op == 2) {
#pragma unroll
                        for (int e = 0; e < 4; ++e) { v0[e] = sigmoidf_(v0[e]); v1[e] = sigmoidf_(v1[e]); }
                    } else if (op == 3) { v0 = v0 * QSCALE_B; v1 = v1 * QSCALE_B; }
                    else if (op == 4) {
                        float s = (v0[0] * v0[0] + v0[1] * v0[1]) + (v0[2] * v0[2] + v0[3] * v0[3]) + (v1[0] * v1[0] + v1[1] * v1[1]) + (v1[2] * v1[2] + v1[3] * v1[3]);
                        s += __shfl_xor(s, 16); s += __shfl_xor(s, 32);
                        if (fq == 0) ssq[(size_t)row * 20 + g * 4 + wc] = s;
                    }
                    u32x4 w; w.x = cvt_pk_bf16(v0[0], v0[1]); w.y = cvt_pk_bf16(v0[2], v0[3]); w.z = cvt_pk_bf16(v1[0], v1[1]); w.w = cvt_pk_bf16(v1[2], v1[3]);
                    *(u32x4*)(O + (size_t)row * LD1 + col0) = w;
                }
        }
    }
};
struct EpiQ {
    static constexpr bool PERM = true, AFTER_DRAIN = false;
    bf16_t* Q; const float* ssq; const float2* rope;
    __device__ __forceinline__ static f32x4 rope4(f32x4 v, const f32x4 ca, const f32x4 cb, bool first) {
        const float cs[4] = {ca[0], ca[2], cb[0], cb[2]}, sn[4] = {ca[1], ca[3], cb[1], cb[3]};
#pragma unroll
        for (int e = 0; e < 4; ++e) { const float pv = __shfl_xor(v[e], 32); v[e] = first ? (v[e] * cs[e] - pv * sn[e]) : (pv * sn[e] + v[e] * cs[e]); }
        return v;
    }
    __device__ __forceinline__ void operator()(const f32x4 (&acc)[2][2][4][2], const Unit& u, int wr, int wc, int, int) const {
        int t_ = threadIdx.x; asm volatile("" : "+v"(t_));
        const int fr = t_ & 15, fq = (t_ >> 4) & 3;
        const int row0 = u.pm * BM + wr * 64 + fr;
#pragma unroll
        for (int ai = 0; ai < 2; ++ai)
#pragma unroll
            for (int m = 0; m < 4; ++m) {
                const int row = row0 + ai * HALF + m * 16;
                const f32x4* sp = (const f32x4*)(ssq + (size_t)row * 20);
                float tot;
                { const f32x4 s0 = sp[0]; tot = (s0[0] + s0[1]) + (s0[2] + s0[3]); }
                { const f32x4 s1 = sp[1]; tot += (s1[0] + s1[1]) + (s1[2] + s1[3]); }
                { const f32x4 s2 = sp[2]; tot += (s2[0] + s2[1]) + (s2[2] + s2[3]); }
                const float rs = rsqrtf(tot * (1.f / 384.f) + 1e-6f) * QSCALE_A;
                const f32x4* rp = (const f32x4*)(rope + (size_t)(row & (S - 1)) * 16 + 8 * (fq & 1));
#pragma unroll
                for (int bj = 0; bj < 2; ++bj) {
                    const int sl = u.pn * 8 + bj * 4 + wc;
                    f32x4 v0 = acc[ai][bj][m][0] * rs, v1 = acc[ai][bj][m][1] * rs;
                    if (sl % 3 == 2) {
                        v0 = rope4(v0, rp[0], rp[1], fq < 2);
                        v1 = rope4(v1, rp[2], rp[3], fq < 2);
                    }
                    u32x4 w; w.x = cvt_pk_bf16(v0[0], v0[1]); w.y = cvt_pk_bf16(v0[2], v0[3]); w.z = cvt_pk_bf16(v1[0], v1[1]); w.w = cvt_pk_bf16(v1[2], v1[3]);
                    *(u32x4*)(Q + (size_t)row * 768 + sl * 32 + 8 * fq) = w;
                    asm volatile("" ::: "memory");
                }
            }
    }
};
struct EpiKV {
    static constexpr bool PERM = true, AFTER_DRAIN = false;
    bf16_t* KV; const float* ssq;
    __device__ __forceinline__ void operator()(const f32x4 (&acc)[2][2][4][2], const Unit& u, int wr, int wc, int, int) const {
        int t_ = threadIdx.x; asm volatile("" : "+v"(t_));
        const int fr = t_ & 15, fq = (t_ >> 4) & 3;
        const int row0 = u.pm * BM + wr * 64 + fr;
#pragma unroll
        for (int ai = 0; ai < 2; ++ai)
#pragma unroll
            for (int m = 0; m < 4; ++m) {
                const int row = row0 + ai * HALF + m * 16;
                const f32x4* sp = (const f32x4*)(ssq + (size_t)row * 20 + 12);
                const f32x4 s0 = sp[0], s1 = sp[1];
                const float tot = ((s0[0] + s0[1]) + (s0[2] + s0[3])) + ((s1[0] + s1[1]) + (s1[2] + s1[3]));
                const float rs = rsqrtf(tot * (1.f / 256.f) + 1e-6f);
#pragma unroll
                for (int bj = 0; bj < 2; ++bj) {
                    const int col0 = u.pn * BM + bj * HALF + wc * 32 + 8 * fq;
                    const f32x4 v0 = acc[ai][bj][m][0] * rs, v1 = acc[ai][bj][m][1] * rs;
                    u32x4 w; w.x = cvt_pk_bf16(v0[0], v0[1]); w.y = cvt_pk_bf16(v0[2], v0[3]); w.z = cvt_pk_bf16(v1[0], v1[1]); w.w = cvt_pk_bf16(v1[2], v1[3]);
                    *(u32x4*)(KV + (size_t)row * 1024 + col0) = w;
                }
                asm volatile("" ::: "memory");
            }
    }
};
template <bool ADD> struct EpiGate {
    static constexpr bool PERM = true, AFTER_DRAIN = false;
    bf16_t* MG; const bf16_t* O1; int gcol;
    __device__ __forceinline__ void operator()(const f32x4 (&acc)[2][2][4][2], const Unit& u, int wr, int wc, int, int) const {
        int t_ = threadIdx.x; asm volatile("" : "+v"(t_));
        const int fr = t_ & 15, fq = (t_ >> 4) & 3;
        const int row0 = u.pm * BM + wr * 64 + fr;
#pragma unroll
        for (int ai = 0; ai < 2; ++ai)
#pragma unroll
            for (int m = 0; m < 4; ++m) {
                const int row = row0 + ai * HALF + m * 16;
#pragma unroll
                for (int bj = 0; bj < 2; ++bj) {
                    const int col0 = u.pn * BM + bj * HALF + wc * 32 + 8 * fq;
                    const u32x4 gw = *(const u32x4*)(O1 + (size_t)row * LD1 + gcol + col0);
                    f32x4 v0 = acc[ai][bj][m][0], v1 = acc[ai][bj][m][1];
                    v0[0] *= bflo(gw.x); v0[1] *= bfhi(gw.x); v0[2] *= bflo(gw.y); v0[3] *= bfhi(gw.y);
                    v1[0] *= bflo(gw.z); v1[1] *= bfhi(gw.z); v1[2] *= bflo(gw.w); v1[3] *= bfhi(gw.w);
                    u32x4* dst = (u32x4*)(MG + (size_t)row * DM + col0);
                    if (ADD) { const u32x4 pw = *dst;
                        v0[0] += bflo(pw.x); v0[1] += bfhi(pw.x); v0[2] += bflo(pw.y); v0[3] += bfhi(pw.y);
                        v1[0] += bflo(pw.z); v1[1] += bfhi(pw.z); v1[2] += bflo(pw.w); v1[3] += bfhi(pw.w); }
                    u32x4 w; w.x = cvt_pk_bf16(v0[0], v0[1]); w.y = cvt_pk_bf16(v0[2], v0[3]); w.z = cvt_pk_bf16(v1[0], v1[1]); w.w = cvt_pk_bf16(v1[2], v1[3]);
                    *dst = w;
                }
                asm volatile("" ::: "memory");
            }
    }
};
struct EpiOut {
    static constexpr bool PERM = true, AFTER_DRAIN = false;
    const float* x; float* out; float* ssqo;
    __device__ __forceinline__ void operator()(const f32x4 (&acc)[2][2][4][2], const Unit& u, int wr, int wc, int, int) const {
        int t_ = threadIdx.x; asm volatile("" : "+v"(t_));
        const int fr = t_ & 15, fq = (t_ >> 4) & 3;
        const int row0 = u.pm * BM + wr * 64 + fr;
#pragma unroll
        for (int ai = 0; ai < 2; ++ai)
#pragma unroll
            for (int m = 0; m < 4; ++m) {
                const int row = row0 + ai * HALF + m * 16;
#pragma unroll
                for (int bj = 0; bj < 2; ++bj) {
                    const int col0 = u.pn * BM + bj * HALF + wc * 32 + 8 * fq;
                    const f32x4* xp = (const f32x4*)(x + (size_t)row * DM + col0);
                    const f32x4 v0 = acc[ai][bj][m][0] + xp[0], v1 = acc[ai][bj][m][1] + xp[1];
                    f32x4* op = (f32x4*)(out + (size_t)row * DM + col0);
                    op[0] = v0; op[1] = v1;
                    float s = (v0[0] * v0[0] + v0[1] * v0[1]) + (v0[2] * v0[2] + v0[3] * v0[3]) + (v1[0] * v1[0] + v1[1] * v1[1]) + (v1[2] * v1[2] + v1[3] * v1[3]);
                    s += __shfl_xor(s, 16); s += __shfl_xor(s, 32);
                    if (fq == 0) ssqo[(size_t)row * 32 + u.pn * 8 + bj * 4 + wc] = s;
                }
                asm volatile("" ::: "memory");
            }
    }
};
}


namespace att {
typedef short bf16x8 __attribute__((ext_vector_type(8)));
typedef short s16x4 __attribute__((ext_vector_type(4)));
typedef float f32x16 __attribute__((ext_vector_type(16)));
typedef unsigned u32x4 __attribute__((ext_vector_type(4)));
typedef const LAS char* lds_cptr;
constexpr int SLOT_K = 12288, SLOT_V = 8192;
constexpr int L_K = 0, L_V = 2 * SLOT_K, L_WS = L_V + 2 * SLOT_V, L_OST = L_WS + 2048, L_BIAS = L_OST + 8 * 4096, L_END = L_BIAS + 2048;
constexpr float THR = 8.f;
#define MFMA32(a, b, c) __builtin_amdgcn_mfma_f32_32x32x16_bf16(a, b, c, 0, 0, 0)
__device__ __forceinline__ int crow(int r, int hi) { return (r & 3) + 8 * (r >> 2) + 4 * hi; }
typedef __bf16 bf16x2_t __attribute__((ext_vector_type(2)));
typedef float f32x2_t __attribute__((ext_vector_type(2)));
__device__ __forceinline__ unsigned cvtpk(float lo, float hi) { const f32x2_t v = {lo, hi}; return __builtin_bit_cast(unsigned, __builtin_convertvector(v, bf16x2_t)); }
__device__ __forceinline__ s16x4 vtr(lds_cptr p) { typedef short v4i16_t __attribute__((ext_vector_type(4))); return __builtin_bit_cast(s16x4, __builtin_amdgcn_ds_read_tr16_b64_v4i16((LAS v4i16_t*)p)); }
#define MX3(a, b, c) __builtin_fmaxf(__builtin_fmaxf((a), (b)), (c))
__device__ __forceinline__ float rowmax(const f32x16& p0, const f32x16& p1) {
    float a = MX3(p0[0], p0[1], p1[0]), b = MX3(p0[2], p0[3], p1[1]); a = MX3(a, p1[2], p1[3]);
#pragma unroll
    for (int r = 4; r < 16; r += 4) { a = MX3(a, p0[r], p0[r + 1]); b = MX3(b, p0[r + 2], p0[r + 3]); a = MX3(a, p1[r], p1[r + 1]); b = MX3(b, p1[r + 2], p1[r + 3]); }
    const float m = __builtin_fmaxf(a, b); auto rr = __builtin_amdgcn_permlane32_swap(__float_as_uint(m), __float_as_uint(m), false, false);
    return __builtin_fmaxf(__uint_as_float(rr[0]), __uint_as_float(rr[1])); }
__device__ __forceinline__ float maskp(float p, unsigned lo, unsigned hi) {
    const unsigned long long mk = ((unsigned long long)hi << 32) | lo; float o;
    asm("v_cndmask_b32_e64 %0, 0, %1, %2" : "=v"(o) : "v"(p), "s"(mk)); return o; }
__host__ __device__ __forceinline__ size_t mask_tile_off(int qt32) { const int J = qt32 >> 1; return (size_t)2 * J * (J + 1) + ((qt32 & 1) ? 2 * (J + 1) : 0); }
constexpr size_t MASK_TILES_PER_BATCH = (size_t)2 * 128 * 129;

struct Tensors {
    const bf16_t* Q; int ldq;
    const bf16_t* K0; int ldk;
    const bf16_t* K1;
    const bf16_t* V; int ldv;
    bf16_t* O; int ldo;
    const unsigned long long* mask;
    const float* rel_bias;
    int hq, hk, hv;
};

template <bool DSA>
__device__ __forceinline__ void unit(int b, int h, int qb, const Tensors& X, LAS unsigned char* lds, bool dry) {
    constexpr int NDQ = DSA ? 4 : 6;
    int tid_ = threadIdx.x; asm volatile("" : "+v"(tid_));
    const int tid = tid_, lane = tid & 63, r32 = lane & 31, hi = lane >> 5; const int wid = __builtin_amdgcn_readfirstlane(tid >> 6);
    const size_t rowbase = (size_t)b * S; const int q0 = qb * 256, NT = 4 * qb + 4, NTw = 4 * qb + (wid >> 1) + 1;
    LAS float* wsf = (LAS float*)(lds + L_WS) + wid * 64;
    const bf16_t* ksrc = X.K0 + (rowbase + lane) * X.ldk + h * X.hk + wid * 8;
    const bf16_t* ksrc1 = DSA ? nullptr : X.K1 + (rowbase + lane) * 32 + (wid & 3) * 8;
    const bf16_t* vsrc = X.V + (rowbase + 16 * (wid & 3) + (lane >> 2)) * X.ldv + h * X.hv + (wid >> 2) * 32 + (lane & 3) * 8;
    const size_t kstride = (size_t)64 * X.ldk, vstride = (size_t)64 * X.ldv;
    LAS unsigned char* kdst = lds + L_K + wid * 1024; LAS unsigned char* kdst1 = lds + L_K + (8 + (wid & 3)) * 1024; LAS unsigned char* vdst = lds + L_V + wid * 1024;
    u32x4 sk0, sk1 = {}, sv;
#define ATT_LOAD(t) do { sk0 = *(const u32x4*)(ksrc + (size_t)(t) * kstride); if (!DSA && wid < 4) sk1 = *(const u32x4*)(ksrc1 + (size_t)(t) * 64 * 32); \
                         sv = *(const u32x4*)(vsrc + (size_t)(t) * vstride); } while (0)
#define ATT_WRITE(slot) do { *(LAS u32x4*)(kdst + (slot) * SLOT_K + lane * 16) = sk0; if (!DSA && wid < 4) *(LAS u32x4*)(kdst1 + (slot) * SLOT_K + lane * 16) = sk1; \
                             *(LAS u32x4*)(vdst + (slot) * SLOT_V + lane * 16) = sv; } while (0)
    const lds_cptr vp0 = (lds_cptr)lds + L_V + ((lane >> 4) & 1) * 32 + (lane & 3) * 8 + (4 * hi + ((lane & 15) >> 2)) * 64;
    const lds_cptr kp0 = (lds_cptr)lds + L_K + hi * 1024 + r32 * 16;
    ATT_LOAD(0); ATT_WRITE(0);
    bf16x8 qr[NDQ];
    { const bf16_t* Qw = X.Q + (rowbase + q0 + wid * 32 + r32) * X.ldq + h * X.hq + hi * 8;
#pragma unroll
      for (int d0 = 0; d0 < NDQ; ++d0) qr[d0] = *(const bf16x8*)(Qw + d0 * 16); }
    if (DSA) {
        LAS float* tab = (LAS float*)(lds + L_BIAS);
        const float c15 = X.rel_bias[15 * 8 + h];
        for (int e = tid; e < 320; e += 512) {
            const int rel = e - 255, n = rel < 0 ? -rel : rel; int v;
            if (n < 8) v = n; else if (n < 12) v = 8; else if (n < 16) v = 9; else if (n < 23) v = 10; else if (n < 32) v = 11; else if (n < 46) v = 12; else if (n < 64) v = 13; else if (n < 91) v = 14; else v = 15;
            tab[e] = (X.rel_bias[((rel > 0 ? 16 : 0) + v) * 8 + h] - c15) * LOG2E;
        }
    }
    float mhat = 0.f, l_reg = 0.f; f32x16 o0 = {}, o1 = {};
    if (wid >= 4) __builtin_amdgcn_s_setprio(1);
    const int qpos = q0 + wid * 32 + r32;
    for (int t = 0; t < NT; ++t) {
        asm volatile("s_waitcnt vmcnt(0) lgkmcnt(0)\n\ts_barrier" ::: "memory");
        if (t + 1 < NT) ATT_LOAD(t + 1);
        unsigned mw = 0u;
        if (DSA && t < NTw) { const int qt32 = qb * 8 + wid;
            const unsigned* mt = (const unsigned*)((const unsigned short*)X.mask + ((size_t)b * MASK_TILES_PER_BATCH + mask_tile_off(qt32)) * 64) + (size_t)t * 64;
            mw = mt[lane]; }
        if (t < NTw) {
            const int so_k = (t & 1) * SLOT_K, so_v = (t & 1) * SLOT_V;
            f32x16 c0 = {}, c1 = {};
            bf16x8 kf[2 * NDQ];
#pragma unroll
            for (int d0 = 0; d0 < NDQ; ++d0) { kf[2 * d0] = *(const LAS bf16x8*)(kp0 + so_k + d0 * 2048); kf[2 * d0 + 1] = *(const LAS bf16x8*)(kp0 + so_k + d0 * 2048 + 512); }
#pragma unroll
            for (int d0 = 0; d0 < NDQ; ++d0) { c0 = MFMA32(kf[2 * d0], qr[d0], c0); c1 = MFMA32(kf[2 * d0 + 1], qr[d0], c1); }
            const lds_cptr vp = vp0 + so_v;
            bf16x8 vf[8];
#pragma unroll
            for (int i = 0; i < 8; ++i) { const s16x4 lo_ = vtr(vp + ((i >> 2) * 4096 + (i & 3) * 1024)), hi_ = vtr(vp + ((i >> 2) * 4096 + (i & 3) * 1024 + 512));
                vf[i] = (bf16x8){lo_[0], lo_[1], lo_[2], lo_[3], hi_[0], hi_[1], hi_[2], hi_[3]}; }
            if (DSA) {
                if (64 * t + 63 - (q0 + wid * 32) > -128) {
                    const LAS float* tab = (const LAS float*)(lds + L_BIAS);
                    const int base = 64 * t + 4 * hi - qpos + 255;
#pragma unroll
                    for (int r = 0; r < 16; ++r) { const int kr = (r & 3) + 8 * (r >> 2); int i0 = base + kr, i1 = base + kr + 32; i0 = i0 < 0 ? 0 : i0; i1 = i1 < 0 ? 0 : i1;
                        c0[r] += tab[i0]; c1[r] += tab[i1]; }
                }
            }
            const float rm = rowmax(c0, c1);
            if (t == 0) mhat = rm;
            else {
                const float grow = rm - mhat;
                if (__any(grow > THR)) {
                    const float dl = __builtin_fmaxf(grow, 0.f); mhat += dl;
                    const float f = __builtin_amdgcn_exp2f(-dl); l_reg *= f;
                    if (hi == 0) wsf[r32] = f;
                    asm volatile("s_waitcnt lgkmcnt(0)" ::: "memory");
#pragma unroll
                    for (int r = 0; r < 16; ++r) { const float fr = wsf[crow(r, hi)]; o0[r] *= fr; o1[r] *= fr; }
                }
            }
            const float nm = -mhat;
#pragma unroll
            for (int r = 0; r < 16; ++r) { c0[r] = __builtin_amdgcn_exp2f(c0[r] + nm); c1[r] = __builtin_amdgcn_exp2f(c1[r] + nm); }
            if (DSA) {
#pragma unroll
                for (int r = 0; r < 16; ++r) { c0[r] = ((mw >> r) & 1u) ? c0[r] : 0.f; c1[r] = ((mw >> (16 + r)) & 1u) ? c1[r] : 0.f; }
            }
            float sacc = 0.f;
#pragma unroll
            for (int r = 0; r < 16; ++r) sacc += c0[r] + c1[r];
            l_reg += sacc;
            u32x4 pw0 = {cvtpk(c0[0], c0[1]), cvtpk(c0[2], c0[3]), cvtpk(c0[4], c0[5]), cvtpk(c0[6], c0[7])};
            u32x4 pw1 = {cvtpk(c0[8], c0[9]), cvtpk(c0[10], c0[11]), cvtpk(c0[12], c0[13]), cvtpk(c0[14], c0[15])};
            u32x4 pw2 = {cvtpk(c1[0], c1[1]), cvtpk(c1[2], c1[3]), cvtpk(c1[4], c1[5]), cvtpk(c1[6], c1[7])};
            u32x4 pw3 = {cvtpk(c1[8], c1[9]), cvtpk(c1[10], c1[11]), cvtpk(c1[12], c1[13]), cvtpk(c1[14], c1[15])};
            o0 = MFMA32(__builtin_bit_cast(bf16x8, pw0), vf[0], o0); o1 = MFMA32(__builtin_bit_cast(bf16x8, pw0), vf[4], o1);
            o0 = MFMA32(__builtin_bit_cast(bf16x8, pw1), vf[1], o0); o1 = MFMA32(__builtin_bit_cast(bf16x8, pw1), vf[5], o1);
            o0 = MFMA32(__builtin_bit_cast(bf16x8, pw2), vf[2], o0); o1 = MFMA32(__builtin_bit_cast(bf16x8, pw2), vf[6], o1);
            o0 = MFMA32(__builtin_bit_cast(bf16x8, pw3), vf[3], o0); o1 = MFMA32(__builtin_bit_cast(bf16x8, pw3), vf[7], o1);
        }
        if (t + 1 < NT) ATT_WRITE((t + 1) & 1);
    }
    __builtin_amdgcn_s_setprio(0);
    { auto rr = __builtin_amdgcn_permlane32_swap(__float_as_uint(l_reg), __float_as_uint(l_reg), false, false); l_reg = __uint_as_float(rr[0]) + __uint_as_float(rr[1]); }
    if (hi == 0) wsf[32 + r32] = l_reg;
    asm volatile("s_waitcnt lgkmcnt(0)" ::: "memory");
    LAS bf16_t* stg = (LAS bf16_t*)(lds + L_OST) + wid * 2048;
#pragma unroll
    for (int r = 0; r < 16; ++r) { const int orow = crow(r, hi); const float rli = __builtin_amdgcn_rcpf(wsf[32 + orow]);
        stg[orow * 64 + r32] = f2bf(o0[r] * rli); stg[orow * 64 + 32 + r32] = f2bf(o1[r] * rli); }
    asm volatile("s_waitcnt lgkmcnt(0)" ::: "memory");
    bf16_t* Ow = X.O + (rowbase + q0 + wid * 32) * X.ldo + h * 64;
#pragma unroll
    for (int i = 0; i < 4; ++i) { const int row = i * 8 + (lane >> 3), ch = lane & 7;
        const u32x4 ov = *(const LAS u32x4*)(stg + row * 64 + ch * 8); u32x4* gp = (u32x4*)(Ow + (size_t)row * X.ldo + ch * 8); const u32x4 gv = *gp;
        u32x4 res; res.x = pk2(bflo(ov.x) * bflo(gv.x), bfhi(ov.x) * bfhi(gv.x)); res.y = pk2(bflo(ov.y) * bflo(gv.y), bfhi(ov.y) * bfhi(gv.y));
        res.z = pk2(bflo(ov.z) * bflo(gv.z), bfhi(ov.z) * bfhi(gv.z)); res.w = pk2(bflo(ov.w) * bflo(gv.w), bfhi(ov.w) * bfhi(gv.w)); if (!dry) *gp = res; }
    asm volatile("s_waitcnt vmcnt(0) lgkmcnt(0)\n\ts_barrier" ::: "memory");
#undef ATT_LOAD
#undef ATT_WRITE
}

template <bool DSA>
__device__ __forceinline__ void phase(const Tensors& X, LAS unsigned char* lds, int G, int bid, bool dry = false) {
    for (int p = bid; p < 512; p += G) {
        const int x = p & 7, kk = p >> 3, bh = x + 8 * (kk >> 4), j = kk & 15;
#pragma unroll 1
        for (int u2 = 0; u2 < 2; ++u2) unit<DSA>(bh >> 3, bh & 7, u2 ? 31 - j : j, X, lds, dry);
    }
}
}


namespace idx {
typedef short bf16x8 __attribute__((ext_vector_type(8)));
typedef float f32x16 __attribute__((ext_vector_type(16)));
constexpr int HROW = 1025;
constexpr int LCAP = 32;
constexpr int L_HIST = 0, L_PFX = 32 * HROW * 4, L_NEED = L_PFX + 128, L_LCNT = L_NEED + 128, L_LIST = L_LCNT + 128, L_END = L_LIST + 32 * LCAP * 4;
__device__ __forceinline__ unsigned f2key(float f) { const unsigned u = __float_as_uint(f); return (u & 0x80000000u) ? ~u : (u | 0x80000000u); }

struct QOps { bf16x8 qf[8][2]; bf16x8 qb[2][2]; float wv[8]; };
__device__ __forceinline__ void score_tile(float (&acc)[16], const bf16x8 k0, const bf16x8 k1, const QOps& Q) {
#define IDX_HEAD(h) ({ f32x16 c_ = __builtin_amdgcn_mfma_f32_32x32x16_bf16(k0, Q.qf[h][0], (f32x16){}, 0, 0, 0); __builtin_amdgcn_mfma_f32_32x32x16_bf16(k1, Q.qf[h][1], c_, 0, 0, 0); })
#define IDX_ACC(h, c) do { _Pragma("unroll") for (int r = 0; r < 16; ++r) { acc[r] = __builtin_fmaf(Q.wv[h], __builtin_fabsf(c[r]), acc[r]); asm volatile("" : "+v"(acc[r])); } } while (0)
    f32x16 cA = IDX_HEAD(0);
    f32x16 lin = __builtin_amdgcn_mfma_f32_32x32x16_bf16(k0, Q.qb[0][0], (f32x16){}, 0, 0, 0);
    lin = __builtin_amdgcn_mfma_f32_32x32x16_bf16(k1, Q.qb[0][1], lin, 0, 0, 0);
    lin = __builtin_amdgcn_mfma_f32_32x32x16_bf16(k0, Q.qb[1][0], lin, 0, 0, 0);
    lin = __builtin_amdgcn_mfma_f32_32x32x16_bf16(k1, Q.qb[1][1], lin, 0, 0, 0);
    f32x16 cB = IDX_HEAD(1);
#pragma unroll
    for (int r = 0; r < 16; ++r) acc[r] = lin[r];
    __builtin_amdgcn_sched_barrier(0);
#pragma unroll
    for (int hp = 0; hp < 4; ++hp) {
        f32x16 nA, nB;
        if (hp < 3) nA = IDX_HEAD(2 * hp + 2);
        IDX_ACC(2 * hp, cA);
        __builtin_amdgcn_sched_barrier(0);
        if (hp < 3) nB = IDX_HEAD(2 * hp + 3);
        IDX_ACC(2 * hp + 1, cB);
        __builtin_amdgcn_sched_barrier(0);
        if (hp < 3) { cA = nA; cB = nB; }
    }
#undef IDX_HEAD
#undef IDX_ACC
}
#define IDX_KLOAD(k0, k1, kt) do { const bf16_t* kp_ = kbase + (size_t)(kt) * 1024 + r32 * 32 + hi * 8; k0 = *(const bf16x8*)kp_; k1 = *(const bf16x8*)(kp_ + 16); } while (0)

struct PassCtx { const bf16_t* kbase; LAS unsigned* hrow; LAS unsigned* lcnt_q; LAS unsigned* blist_q; unsigned short* mbase; unsigned pfx; int lane, r32, hi, ktb, kte; };
template <int PASS>
__device__ __forceinline__ void pass_tile(const PassCtx& C, const bf16x8 k0, const bf16x8 k1, const QOps& Q, int kt) {
    constexpr int SH_BIN = (PASS == 0) ? 21 : ((PASS == 1) ? 10 : 0), SH_PFX = (PASS == 1) ? 21 : 10; constexpr unsigned BMASK = (PASS == 2) ? 1023u : 2047u;
    float acc[16]; score_tile(acc, k0, k1, Q);
    unsigned bits = 0u, anym = 0u; unsigned keys[16];
#pragma unroll
    for (int r = 0; r < 16; ++r) {
        const unsigned key = f2key(acc[r]), up = key >> SH_PFX, bin = (key >> SH_BIN) & BMASK; keys[r] = key;
        const bool match = (PASS == 0) || (up == C.pfx);
        if (match) __hip_atomic_fetch_add(C.hrow + (bin >> 1), 1u << ((bin & 1u) * 16u), __ATOMIC_RELAXED, __HIP_MEMORY_SCOPE_WORKGROUP);
        if (PASS == 2) { bits |= (up > C.pfx) ? (1u << r) : 0u; anym |= match ? 1u : 0u; }
    }
    if (PASS == 2) {
        C.mbase[(size_t)(kt >> 1) * 128 + C.lane * 2 + (kt & 1)] = (unsigned short)bits;
        if (__any(anym)) {
#pragma unroll
            for (int r = 0; r < 16; ++r) if ((keys[r] >> 10) == C.pfx) {
                const unsigned sl = __hip_atomic_fetch_add(C.lcnt_q, 1u, __ATOMIC_RELAXED, __HIP_MEMORY_SCOPE_WORKGROUP);
                if (sl < (unsigned)LCAP) C.blist_q[sl] = (keys[r] & 1023u) | ((unsigned)r << 10) | ((unsigned)C.lane << 14) | ((unsigned)kt << 20);
            }
        }
    }
}
#define IDX_KLOADC(k0, k1, kt) do { const bf16_t* kp_ = C.kbase + (size_t)(kt) * 1024 + C.r32 * 32 + C.hi * 8; k0 = *(const bf16x8*)kp_; k1 = *(const bf16x8*)(kp_ + 16); } while (0)
template <int PASS>
__device__ __forceinline__ void pass_loop(const PassCtx& C, const QOps& Q) {
    bf16x8 a0, a1, b0, b1, c0, c1; const int ktb = C.ktb, kte = C.kte;
    if (ktb < kte) IDX_KLOADC(a0, a1, ktb); if (ktb + 1 < kte) IDX_KLOADC(b0, b1, ktb + 1); if (ktb + 2 < kte) IDX_KLOADC(c0, c1, ktb + 2);
    for (int kt = ktb; kt < kte; kt += 3) {
        pass_tile<PASS>(C, a0, a1, Q, kt); if (kt + 3 < kte) IDX_KLOADC(a0, a1, kt + 3);
        if (kt + 1 < kte) { pass_tile<PASS>(C, b0, b1, Q, kt + 1); if (kt + 4 < kte) IDX_KLOADC(b0, b1, kt + 4); }
        if (kt + 2 < kte) { pass_tile<PASS>(C, c0, c1, Q, kt + 2); if (kt + 5 < kte) IDX_KLOADC(c0, c1, kt + 5); }
    }
}
#undef IDX_KLOADC

__device__ __forceinline__ void unit(int b, int qt, const bf16_t* __restrict__ O1, const bf16_t* __restrict__ KIDX, unsigned* __restrict__ MASK, LAS unsigned char* lds) {
    int tid_ = threadIdx.x; asm volatile("" : "+v"(tid_));
    const int tid = tid_, lane = tid & 63, r32 = lane & 31, hi = lane >> 5; const int wid = __builtin_amdgcn_readfirstlane(tid >> 6);
    const size_t rowbase = (size_t)b * S; const int nkt = 2 * ((qt >> 1) + 1);
    const int kper = (nkt + 7) >> 3, ktb = wid * kper, kte = (ktb + kper < nkt) ? ktb + kper : nkt;
    LAS unsigned* hist = (LAS unsigned*)(lds + L_HIST); LAS unsigned* spfx = (LAS unsigned*)(lds + L_PFX); LAS int* sneed = (LAS int*)(lds + L_NEED);
    QOps Q;
    { const bf16_t* qrow = O1 + (rowbase + qt * 32 + r32) * LD1;
      const u32x4 ww = *(const u32x4*)(qrow + O_WIDX);
      Q.wv[0] = bflo(ww.x); Q.wv[1] = bfhi(ww.x); Q.wv[2] = bflo(ww.y); Q.wv[3] = bfhi(ww.y); Q.wv[4] = bflo(ww.z); Q.wv[5] = bfhi(ww.z); Q.wv[6] = bflo(ww.w); Q.wv[7] = bfhi(ww.w);
      float qs[2][8];
#pragma unroll
      for (int s2 = 0; s2 < 2; ++s2)
#pragma unroll
          for (int j = 0; j < 8; ++j) qs[s2][j] = 0.f;
#pragma unroll
      for (int h = 0; h < 8; ++h)
#pragma unroll
          for (int s2 = 0; s2 < 2; ++s2) {
              const u32x4 qv = *(const u32x4*)(qrow + O_QIDX + 32 * h + 16 * s2 + hi * 8);
              Q.qf[h][s2] = __builtin_bit_cast(bf16x8, qv);
              qs[s2][0] = __builtin_fmaf(Q.wv[h], bflo(qv.x), qs[s2][0]); qs[s2][1] = __builtin_fmaf(Q.wv[h], bfhi(qv.x), qs[s2][1]);
              qs[s2][2] = __builtin_fmaf(Q.wv[h], bflo(qv.y), qs[s2][2]); qs[s2][3] = __builtin_fmaf(Q.wv[h], bfhi(qv.y), qs[s2][3]);
              qs[s2][4] = __builtin_fmaf(Q.wv[h], bflo(qv.z), qs[s2][4]); qs[s2][5] = __builtin_fmaf(Q.wv[h], bfhi(qv.z), qs[s2][5]);
              qs[s2][6] = __builtin_fmaf(Q.wv[h], bflo(qv.w), qs[s2][6]); qs[s2][7] = __builtin_fmaf(Q.wv[h], bfhi(qv.w), qs[s2][7]);
          }
#pragma unroll
      for (int s2 = 0; s2 < 2; ++s2) {
          u32x4 hv, lv; unsigned* hp = (unsigned*)&hv; unsigned* lp = (unsigned*)&lv;
#pragma unroll
          for (int j = 0; j < 4; ++j) {
              const unsigned hw = pk2(qs[s2][2 * j], qs[s2][2 * j + 1]);
              hp[j] = hw; lp[j] = pk2(qs[s2][2 * j] - bflo(hw), qs[s2][2 * j + 1] - bfhi(hw));
          }
          Q.qb[0][s2] = __builtin_bit_cast(bf16x8, hv); Q.qb[1][s2] = __builtin_bit_cast(bf16x8, lv);
      } }
    const bf16_t* kbase = KIDX + rowbase * 32;
    LAS unsigned* lcnt = (LAS unsigned*)(lds + L_LCNT); LAS unsigned* blist = (LAS unsigned*)(lds + L_LIST);
    unsigned short* mbase = (unsigned short*)MASK + ((size_t)b * att::MASK_TILES_PER_BATCH + att::mask_tile_off(qt)) * 64;
    unsigned tau = 0u;
    bool need_mask_pass = true;
    if (nkt * 32 > 256) {
        if (tid < 32) { spfx[tid] = 0u; sneed[tid] = 256; lcnt[tid] = 0u; }
        for (int pass = 0; pass < 3; ++pass) {
            { LAS u32x4* h4 = (LAS u32x4*)hist; for (int e = tid; e < 32 * HROW / 4; e += 512) h4[e] = (u32x4){0u, 0u, 0u, 0u}; }
            asm volatile("s_waitcnt lgkmcnt(0)\n\ts_barrier" ::: "memory");
            { PassCtx C; C.kbase = kbase; C.hrow = hist + r32 * HROW; C.lcnt_q = lcnt + r32; C.blist_q = blist + r32 * LCAP; C.mbase = mbase; C.pfx = spfx[r32];
              C.lane = lane; C.r32 = r32; C.hi = hi; C.ktb = ktb; C.kte = kte;
              if (pass == 0) pass_loop<0>(C, Q); else if (pass == 1) pass_loop<1>(C, Q); else pass_loop<2>(C, Q); }
            asm volatile("s_waitcnt vmcnt(0) lgkmcnt(0)\n\ts_barrier" ::: "memory");
            const int nbits = (pass == 2) ? 10 : 11;
#pragma unroll
            for (int qi = 0; qi < 4; ++qi) {
                const int q = wid * 4 + qi; const LAS unsigned* hr = hist + q * HROW + 16 * lane;
                unsigned wv_[16]; int c = 0;
#pragma unroll
                for (int i = 0; i < 16; ++i) { wv_[i] = hr[i]; c += (int)(wv_[i] & 0xffffu) + (int)(wv_[i] >> 16); }
                int sfx = c;
#pragma unroll
                for (int d = 1; d < 64; d <<= 1) { const int o = __shfl_down(sfx, d); sfx += (lane + d < 64) ? o : 0; }
                const int above = sfx - c, need = sneed[q];
                if (sfx >= need && above < need) {
                    int run = above, bstar = 0, nn = need; bool done = false;
#pragma unroll
                    for (int i = 15; i >= 0; --i) {
                        const int chi = (int)(wv_[i] >> 16), clo = (int)(wv_[i] & 0xffffu);
                        if (!done) { if (run + chi >= need) { bstar = 2 * i + 1; nn = need - run; done = true; } else run += chi; }
                        if (!done) { if (run + clo >= need) { bstar = 2 * i; nn = need - run; done = true; } else run += clo; }
                    }
                    spfx[q] = (spfx[q] << nbits) | (unsigned)(32 * lane + bstar); sneed[q] = nn;
                }
            }
            asm volatile("s_waitcnt lgkmcnt(0)\n\ts_barrier" ::: "memory");
        }
        tau = spfx[r32];
        const bool overflow = __any(lcnt[r32] > (unsigned)LCAP) != 0;
        if (!overflow) {
            need_mask_pass = false;
            const unsigned n = lcnt[r32], tq = tau & 1023u;
            for (unsigned i = 0; i < n; ++i) {
                const unsigned e = blist[r32 * LCAP + i]; const int ekt = (int)(e >> 20);
                if (((e >> 14) & 63u) == (unsigned)lane && ekt >= ktb && ekt < kte && (e & 1023u) >= tq) {
                    unsigned short* wp = mbase + (size_t)(ekt >> 1) * 128 + lane * 2 + (ekt & 1);
                    *wp = (unsigned short)(*wp | (1u << ((e >> 10) & 15u)));
                }
            }
        }
    }
#define IDX_MASK_BODY(K0, K1, KT) do { float acc[16]; score_tile(acc, K0, K1, Q); unsigned bits = 0u; \
        _Pragma("unroll") for (int r = 0; r < 16; ++r) bits |= (f2key(acc[r]) >= tau) ? (1u << r) : 0u; \
        mbase[(size_t)((KT) >> 1) * 128 + lane * 2 + ((KT) & 1)] = (unsigned short)bits; } while (0)
    if (need_mask_pass)
    { bf16x8 a0, a1, b0, b1, c0, c1;
      if (ktb < kte) IDX_KLOAD(a0, a1, ktb); if (ktb + 1 < kte) IDX_KLOAD(b0, b1, ktb + 1); if (ktb + 2 < kte) IDX_KLOAD(c0, c1, ktb + 2);
      for (int kt = ktb; kt < kte; kt += 3) {
          IDX_MASK_BODY(a0, a1, kt); if (kt + 3 < kte) IDX_KLOAD(a0, a1, kt + 3);
          if (kt + 1 < kte) { IDX_MASK_BODY(b0, b1, kt + 1); if (kt + 4 < kte) IDX_KLOAD(b0, b1, kt + 4); }
          if (kt + 2 < kte) { IDX_MASK_BODY(c0, c1, kt + 2); if (kt + 5 < kte) IDX_KLOAD(c0, c1, kt + 5); }
      } }
#undef IDX_MASK_BODY
    asm volatile("s_waitcnt lgkmcnt(0)\n\ts_barrier" ::: "memory");
}
#undef IDX_KLOAD

__device__ __forceinline__ void phase(const bf16_t* O1, const bf16_t* KIDX, unsigned* MASK, LAS unsigned char* lds, int G, int bid) {
    for (int p = bid; p < 512; p += G) {
        const int b = p & 3, j = p >> 2;
#pragma unroll 1
        for (int u2 = 0; u2 < 2; ++u2) unit(b, u2 ? 255 - j : j, O1, KIDX, MASK, lds);
    }
}
}
struct Frame { LAS unsigned char* lds; int tid, lane, wave, G, bid; Ptrs p; };

__device__ __forceinline__ int win_dest_row(int n) {
    if (n < 672) return n;
    if (n < 3488) return n + 96;
    if (n < 3528) return n - 3488 + 672;
    return n + 56;
}
template <bool MAP>
__device__ __forceinline__ void transpose_item(const float* __restrict__ W, int K, int N, bf16_t* __restrict__ WT, const float* __restrict__ gk, LAS float* scr, int item, int lane) {
    const int nblk = (N + 31) / 32, kb = item / nblk, nb = item % nblk, k0 = 64 * kb, n0 = 32 * nb;
    const int nn = n0 + (lane & 31);
#pragma unroll 8
    for (int i = 0; i < 32; ++i) { const int kk = 2 * i + (lane >> 5); float v = 0.f; if (nn < N) v = W[(size_t)(k0 + kk) * N + nn]; if (gk) v *= gk[k0 + kk]; scr[kk * 33 + (lane & 31)] = v; }
    asm volatile("s_waitcnt lgkmcnt(0)" ::: "memory");
    const int c = lane & 7;
#pragma unroll
    for (int j = 0; j < 4; ++j) { const int n = (lane >> 3) + 8 * j; const LAS float* s = scr + (8 * c) * 33 + n;
        u32x4 o; o.x = pk2(s[0 * 33], s[1 * 33]); o.y = pk2(s[2 * 33], s[3 * 33]); o.z = pk2(s[4 * 33], s[5 * 33]); o.w = pk2(s[6 * 33], s[7 * 33]);
        if (n0 + n < N) { const int dr = MAP ? win_dest_row(n0 + n) : (n0 + n); *(u32x4*)(WT + (size_t)dr * K + k0 + 8 * c) = o; } }
    asm volatile("s_waitcnt lgkmcnt(0)" ::: "memory");
}

__device__ __forceinline__ void phase0(Frame& F) {
    unsigned char* ws = F.p.ws;
    LAS float* scr = (LAS float*)(F.lds + F.wave * 16384);
    const int gw = F.bid * 8 + F.wave, NGW = F.G * 8;
    constexpr int I_IN = 16 * 175, I_UQ = 6 * 24, I_UKV = 4 * 32, I_OA = 8 * 32, I_OB = 8 * 32, I_OUT = 16 * 32;
    constexpr int NITEMS = I_IN + I_UQ + I_UKV + I_OA + I_OB + I_OUT;
    for (int it = gw; it < NITEMS; it += NGW) {
        int r = it;
        if (r < I_IN) { transpose_item<true>(F.p.w_in, 1024, NIN, (bf16_t*)(ws + WS_WINT), nullptr, scr, r, F.lane); continue; } r -= I_IN;
        if (r < I_UQ) { transpose_item<false>(F.p.w_uq, 384, 768, (bf16_t*)(ws + WS_WUQT), F.p.g_q, scr, r, F.lane); continue; } r -= I_UQ;
        if (r < I_UKV) { transpose_item<false>(F.p.w_ukv, 256, 1024, (bf16_t*)(ws + WS_WUKVT), F.p.g_kv, scr, r, F.lane); continue; } r -= I_UKV;
        if (r < I_OA) { transpose_item<false>(F.p.w_oa, 512, 1024, (bf16_t*)(ws + WS_WOAT), nullptr, scr, r, F.lane); continue; } r -= I_OA;
        if (r < I_OB) { transpose_item<false>(F.p.w_ob, 512, 1024, (bf16_t*)(ws + WS_WOBT), nullptr, scr, r, F.lane); continue; } r -= I_OB;
        transpose_item<false>(F.p.w_out, 1024, 1024, (bf16_t*)(ws + WS_WOUTT), nullptr, scr, r, F.lane);
    }
    { const int gt = F.bid * 512 + F.tid; if (gt < 7168) ((u32x4*)(ws + WS_WINT + (size_t)712 * 1024 * 2))[gt] = (u32x4){0u, 0u, 0u, 0u}; }
    for (int e = F.bid * 512 + F.tid; e < S * 16; e += F.G * 512) {
        const int pos = e >> 4, i = e & 15;
        const float freq = powf(10000.f, -(float)i / 16.f); const float ang = (float)pos * freq;
        ((float2*)(ws + WS_ROPE))[e] = make_float2(cosf(ang), sinf(ang));
    }
    bf16_t* H = (bf16_t*)(ws + WS_H);
    for (int row = gw; row < T; row += NGW) {
        const f32x4* xr = (const f32x4*)(F.p.x + (size_t)row * DM);
        f32x4 v[4]; float s = 0.f;
#pragma unroll
        for (int j = 0; j < 4; ++j) { v[j] = xr[F.lane + 64 * j]; s += (v[j][0] * v[j][0] + v[j][1] * v[j][1]) + (v[j][2] * v[j][2] + v[j][3] * v[j][3]); }
        s = wave_sum(s);
        const float r = rsqrtf(s * (1.f / DM) + 1e-6f);
#pragma unroll
        for (int j = 0; j < 4; ++j) {
            const f32x4 gg = ((const f32x4*)F.p.norm_g)[F.lane + 64 * j];
            uint2 o; o.x = pk2(v[j][0] * r * gg[0], v[j][1] * r * gg[1]); o.y = pk2(v[j][2] * r * gg[2], v[j][3] * r * gg[3]);
            ((uint2*)(H + (size_t)row * DM))[F.lane + 64 * j] = o;
        }
    }
}

__device__ __forceinline__ void phase1(Frame& F) {
    unsigned char* ws = F.p.ws;
    pg8::Gemm g{(const bf16_t*)(ws + WS_H), DM, (const bf16_t*)(ws + WS_WINT), T, LD1, DM};
    pg8::StaticOrder So; So.init(T, LD1, F.G, F.bid);
    pg8::EpiIn E{(bf16_t*)(ws + WS_OUT1), (float*)(ws + WS_SSQLAT)};
    pg8::gemm_phase<pg8::EpiIn, pg8::StaticOrder, true, true>(F.lds, g, So, E);
}

__device__ __forceinline__ void phase1b(Frame& F) {
    unsigned char* ws = F.p.ws;
    const bf16_t* O1 = (const bf16_t*)(ws + WS_OUT1);
    {
        bf16_t* KPE = (bf16_t*)(ws + WS_KPE); bf16_t* KIDX = (bf16_t*)(ws + WS_KIDX); const float2* rope = (const float2*)(ws + WS_ROPE);
        for (int e = F.bid * 512 + F.tid; e < T * 16; e += F.G * 512) {
            const int m = e >> 4, i = e & 15; const bf16_t* src = O1 + (size_t)m * LD1;
            const float2 cs = rope[(size_t)(m & (S - 1)) * 16 + i];
            const float x1 = bf2f(src[O_KROPE + i]), x2 = bf2f(src[O_KROPE + 16 + i]);
            KPE[(size_t)m * 32 + i] = f2bf(x1 * cs.x - x2 * cs.y); KPE[(size_t)m * 32 + 16 + i] = f2bf(x1 * cs.y + x2 * cs.x);
            KIDX[(size_t)m * 32 + i] = src[O_KIDX + i]; KIDX[(size_t)m * 32 + 16 + i] = src[O_KIDX + 16 + i];
        }
    }
    {
        pg8::Gemm g{O1 + O_QLAT, LD1, (const bf16_t*)(ws + WS_WUQT), T, 768, 384};
        pg8::StaticOrder So; So.init(T, 768, F.G, F.bid);
        pg8::EpiQ E{(bf16_t*)(ws + WS_Q), (const float*)(ws + WS_SSQLAT), (const float2*)(ws + WS_ROPE)};
        pg8::gemm_phase<pg8::EpiQ, pg8::StaticOrder, true, true>(F.lds, g, So, E);
    }
    {
        pg8::Gemm g{O1 + O_CKV, LD1, (const bf16_t*)(ws + WS_WUKVT), T, 1024, 256};
        pg8::StaticOrder So; So.init(T, 1024, F.G, F.bid);
        pg8::EpiKV E{(bf16_t*)(ws + WS_H), (const float*)(ws + WS_SSQLAT)};
        pg8::gemm_phase<pg8::EpiKV, pg8::StaticOrder, true, true>(F.lds, g, So, E);
    }
}

__device__ __forceinline__ void phase4ab(Frame& F) {
    unsigned char* ws = F.p.ws;
    const bf16_t* O1 = (const bf16_t*)(ws + WS_OUT1); bf16_t* MG = (bf16_t*)(ws + WS_H);
    {
        pg8::Gemm g{O1 + O_ZA, LD1, (const bf16_t*)(ws + WS_WOAT), T, 1024, 512};
        pg8::StaticOrder So; So.init(T, 1024, F.G, F.bid);
        pg8::EpiGate<false> E{MG, O1, O_GA};
        pg8::gemm_phase<pg8::EpiGate<false>, pg8::StaticOrder, true, true>(F.lds, g, So, E);
    }
    {
        pg8::Gemm g{O1 + O_ZB, LD1, (const bf16_t*)(ws + WS_WOBT), T, 1024, 512};
        pg8::StaticOrder So; So.init(T, 1024, F.G, F.bid);
        pg8::EpiGate<true> E{MG, O1, O_GB};
        pg8::gemm_phase<pg8::EpiGate<true>, pg8::StaticOrder, true, true>(F.lds, g, So, E);
    }
}

__device__ __forceinline__ void phase4c(Frame& F) {
    unsigned char* ws = F.p.ws;
    pg8::Gemm g{(const bf16_t*)(ws + WS_H), DM, (const bf16_t*)(ws + WS_WOUTT), T, 1024, 1024};
    pg8::StaticOrder So; So.init(T, 1024, F.G, F.bid);
    pg8::EpiOut E{F.p.x, F.p.out, (float*)(ws + WS_SSQO)};
    pg8::gemm_phase<pg8::EpiOut, pg8::StaticOrder, true, true>(F.lds, g, So, E);
}

__device__ __forceinline__ void phase5(Frame& F) {
    const float* ssqo = (const float*)(F.p.ws + WS_SSQO);
    const int gw = F.bid * 8 + F.wave, NGW = F.G * 8;
    for (int row = gw; row < T; row += NGW) {
        float s = (F.lane < 32) ? ssqo[(size_t)row * 32 + F.lane] : 0.f;
        s = wave_sum(s);
        const float r = rsqrtf(s * (1.f / DM) + 1e-6f);
        f32x4* xr = (f32x4*)(F.p.out + (size_t)row * DM);
#pragma unroll
        for (int j = 0; j < 4; ++j) { const f32x4 gg = ((const f32x4*)F.p.final_g)[F.lane + 64 * j]; xr[F.lane + 64 * j] = xr[F.lane + 64 * j] * r * gg; }
    }
}

__device__ __forceinline__ void phase_mla(Frame& F, bool dry = false) {
    unsigned char* ws = F.p.ws;
    att::Tensors X{};
    X.Q = (const bf16_t*)(ws + WS_Q); X.ldq = 768; X.hq = 96;
    X.K0 = (const bf16_t*)(ws + WS_H); X.ldk = 1024; X.hk = 128; X.K1 = (const bf16_t*)(ws + WS_KPE);
    X.V = (const bf16_t*)(ws + WS_H) + 64; X.ldv = 1024; X.hv = 128;
    X.O = (bf16_t*)(ws + WS_OUT1) + O_ZA; X.ldo = LD1; X.mask = nullptr; X.rel_bias = nullptr;
    att::phase<false>(X, F.lds, F.G, F.bid, dry);
}
__device__ __forceinline__ void phase_dsa(Frame& F, bool dry = false) {
    unsigned char* ws = F.p.ws; bf16_t* O1 = (bf16_t*)(ws + WS_OUT1);
    att::Tensors X{};
    X.Q = O1 + O_QB; X.ldq = LD1; X.hq = 64;
    X.K0 = O1 + O_KB; X.ldk = LD1; X.hk = 64; X.K1 = nullptr;
    X.V = O1 + O_VB; X.ldv = LD1; X.hv = 64;
    X.O = O1 + O_ZB; X.ldo = LD1; X.mask = (const unsigned long long*)(ws + WS_MASK); X.rel_bias = F.p.rel_bias;
    att::phase<true>(X, F.lds, F.G, F.bid, dry);
}

__device__ __forceinline__ void phase_idx(Frame& F) {
    unsigned char* ws = F.p.ws;
    idx::phase((const bf16_t*)(ws + WS_OUT1), (const bf16_t*)(ws + WS_KIDX), (unsigned*)(ws + WS_MASK), F.lds, F.G, F.bid);
}

typedef unsigned long long u64_t;
#define XB_TMO      128
#define XB_XCNT(j)  (256  + 64 * (j))
#define XB_XSUB(j)  (1280 + 64 * (j))
#define XB_XGEN(j)  (2304 + 64 * (j))
#define XB_TOP      3328
#define XB_TOPGEN   3392
#define XCD_BAR_WORDS 3456
#define XB_SPIN_CAP (1u << 18)

__device__ __forceinline__ unsigned xb_ld(unsigned* p)              { return __hip_atomic_load(p, __ATOMIC_RELAXED, __HIP_MEMORY_SCOPE_AGENT); }
__device__ __forceinline__ unsigned xb_add(unsigned* p, unsigned v) { return __hip_atomic_fetch_add(p, v, __ATOMIC_RELAXED, __HIP_MEMORY_SCOPE_AGENT); }
__device__ __forceinline__ unsigned xb_xcc_id() { return (unsigned)__builtin_amdgcn_s_getreg((3 << 11) | 20) & 0xFu; }
#define XB_SPIN(cond, bar) do { unsigned _sp = 0; while (cond) { __builtin_amdgcn_s_sleep(1); \
    if ((++_sp & 255u) == 0u) { if (xb_ld(&(bar)[XB_TMO])) break; if (_sp > XB_SPIN_CAP) { atomicAdd(&(bar)[XB_TMO], 1u); break; } } } } while (0)

struct XcdBarrier {
    unsigned* bar; unsigned x;
    volatile LAS unsigned* st;
};

__device__ __forceinline__ XcdBarrier xcd_barrier_post(unsigned* bar, volatile LAS unsigned* st) {
    XcdBarrier b; b.bar = bar; b.x = xb_xcc_id(); b.st = st;
    if (threadIdx.x == 0) (void)xb_add(&bar[XB_XCNT(b.x)], 1u);
    return b;
}
__device__ __forceinline__ void xcd_barrier_complete(unsigned* bar, unsigned x, unsigned& nloc, unsigned& nx) {
    const unsigned G = gridDim.x * gridDim.y * gridDim.z;
    unsigned sum, cnt, mine, sp = 0u;
    for (;;) {
        sum = 0u; cnt = 0u; mine = 0u;
#pragma unroll
        for (unsigned j = 0; j < 16; ++j) { const unsigned c = xb_ld(&bar[XB_XCNT(j)]); sum += c; cnt += (c > 0u) ? 1u : 0u; mine = (j == x) ? c : mine; }
        if (sum == G) break;
        __builtin_amdgcn_s_sleep(1);
        if ((++sp & 255u) == 0u) { if (xb_ld(&bar[XB_TMO])) break; if (sp > XB_SPIN_CAP) { atomicAdd(&bar[XB_TMO], 1u); break; } }
    }
    nloc = mine > 0u ? mine : 1u; nx = cnt > 0u ? cnt : 1u;
}

__device__ __forceinline__ void xcd_barrier(const XcdBarrier& b) {
    asm volatile("s_waitcnt vmcnt(0)" ::: "memory");
    __syncthreads();
    if (threadIdx.x == 0) {
        unsigned* bar = b.bar;
        __builtin_amdgcn_s_waitcnt(0);
        unsigned nloc = b.st[0], nx = b.st[1];
        if (nloc == 0u) { xcd_barrier_complete(bar, b.x, nloc, nx); b.st[0] = nloc; b.st[1] = nx; }
        const unsigned old = xb_add(&bar[XB_XSUB(b.x)], 1u);
        const unsigned gen = old / nloc;
        if (old + 1u == (gen + 1u) * nloc) {
            __builtin_amdgcn_fence(__ATOMIC_RELEASE, "agent");
            asm volatile("s_waitcnt vmcnt(0)" ::: "memory");
            const unsigned og = xb_add(&bar[XB_TOP], 1u);
            const unsigned tg = og / nx;
            if (og + 1u == (tg + 1u) * nx) xb_add(&bar[XB_TOPGEN], 1u);
            else XB_SPIN(xb_ld(&bar[XB_TOPGEN]) == tg, bar);
            __builtin_amdgcn_fence(__ATOMIC_ACQUIRE, "agent");
            xb_add(&bar[XB_XGEN(b.x)], 1u);
            asm volatile("s_waitcnt vmcnt(0)" ::: "memory");
        } else {
            XB_SPIN(xb_ld(&bar[XB_XGEN(b.x)]) == gen, bar);
            __builtin_amdgcn_fence(__ATOMIC_ACQUIRE, "agent");
            asm volatile("s_waitcnt vmcnt(0)" ::: "memory");
        }
    }
    __syncthreads();
}

constexpr int CW_BAR = 4096;
constexpr size_t CTL_ZERO_BYTES = 65536;
constexpr int LDS_MISC = 135680;
struct Args { Ptrs p; int ph_lo, ph_hi; };
__global__ void __launch_bounds__(512, 2) mega_fwd(Args a) {
    extern __shared__ __attribute__((aligned(16))) unsigned char lds_raw[];
    Frame F; F.lds = (LAS unsigned char*)lds_raw; F.tid = threadIdx.x; F.lane = F.tid & 63; F.wave = __builtin_amdgcn_readfirstlane(F.tid >> 6);
    F.G = gridDim.x; F.bid = blockIdx.x; F.p = a.p;
    cooperative_groups::grid_group grid = cooperative_groups::this_grid();
    volatile LAS unsigned* st = (volatile LAS unsigned*)(F.lds + LDS_MISC);
    if (F.tid < 4) st[F.tid] = 0u;
    __syncthreads();
    const XcdBarrier bar = xcd_barrier_post((unsigned*)(a.p.ws + WS_CTL) + CW_BAR, st);
    const int lo = a.ph_lo, hi = a.ph_hi;
#define RUN(k, body, CG) do { if (lo <= (k) && (k) < hi) { body; if ((k) + 1 < hi) { if (CG) grid.sync(); else xcd_barrier(bar); } } } while (0)
    const bool dryrun = (a.ph_hi > 0);
    RUN(0, { phase0(F); if (PROBE_DUP == 0) phase0(F); }, true);
    RUN(1, { phase1(F); if (PROBE_DUP == 1) phase1(F); }, false);
    RUN(2, { phase1b(F); if (PROBE_DUP == 2) phase1b(F); }, false);
    RUN(3, { phase_mla(F); if (PROBE_DUP == 3) phase_mla(F, dryrun); phase_idx(F); if (PROBE_DUP == 8) phase_idx(F); }, false);
    RUN(4, { phase_dsa(F); if (PROBE_DUP == 4) phase_dsa(F, dryrun); }, false);
    RUN(5, { phase4ab(F); if (PROBE_DUP == 5) phase4ab(F); }, false);
    RUN(6, { phase4c(F); if (PROBE_DUP == 6) phase4c(F); }, false);
    RUN(7, phase5(F), false);
#undef RUN
}

extern "C" void kernel_launch(void* const* d_in, const int* in_sizes, int n_in, void* d_out, int out_size, void* d_ws, size_t ws_size, hipStream_t stream) {
    static int grid = 0;
    if (grid == 0) {
        if (ws_size < WS_END) { fprintf(stderr, "kernel_launch: workspace too small: %zu < %zu\n", ws_size, (size_t)WS_END); grid = -1; return; }
        int dev = 0, cus = 0, per_cu = 0;
        if (hipGetDevice(&dev) != hipSuccess || hipDeviceGetAttribute(&cus, hipDeviceAttributeMultiprocessorCount, dev) != hipSuccess) { grid = -1; return; }
        if (hipFuncSetAttribute((const void*)mega_fwd, hipFuncAttributeMaxDynamicSharedMemorySize, LDS_BYTES) != hipSuccess) { fprintf(stderr, "kernel_launch: hipFuncSetAttribute failed\n"); grid = -1; return; }
        if (hipOccupancyMaxActiveBlocksPerMultiprocessor(&per_cu, (const void*)mega_fwd, 512, LDS_BYTES) != hipSuccess || per_cu < 1) { fprintf(stderr, "kernel_launch: occupancy query failed (%d)\n", per_cu); (void)hipGetLastError(); grid = -1; return; }
        grid = cus;
    }
    if (grid < 0) return;
    if (hipMemsetAsync((char*)d_ws + WS_CTL, 0, CTL_ZERO_BYTES, stream) != hipSuccess) { fprintf(stderr, "kernel_launch: hipMemsetAsync failed\n"); return; }
    Args a{};
    a.p.x = (const float*)d_in[0]; a.p.norm_g = (const float*)d_in[1]; a.p.w_in = (const float*)d_in[2]; a.p.g_q = (const float*)d_in[3]; a.p.w_uq = (const float*)d_in[4];
    a.p.g_kv = (const float*)d_in[5]; a.p.w_ukv = (const float*)d_in[6]; a.p.w_oa = (const float*)d_in[7]; a.p.w_ob = (const float*)d_in[8]; a.p.w_out = (const float*)d_in[9];
    a.p.rel_bias = (const float*)d_in[10]; a.p.final_g = (const float*)d_in[11]; a.p.out = (float*)d_out; a.p.ws = (unsigned char*)d_ws;
    a.ph_lo = 0; a.ph_hi = 8;
    void* args[] = {&a};
    const hipError_t e = hipLaunchCooperativeKernel((const void*)mega_fwd, dim3(grid), dim3(512), args, LDS_BYTES, stream);
    if (e != hipSuccess) fprintf(stderr, "kernel_launch: cooperative launch failed: %s (grid %d)\n", hipGetErrorString(e), grid);
}
```

```cpp
#include <hip/hip_runtime.h>
#include <hip/hip_cooperative_groups.h>
#include <stdint.h>
#include <stdio.h>
#ifndef PROBE_DUP
#define PROBE_DUP -1
#endif

__device__ __forceinline__ int lane_now() { int l; asm volatile("v_mbcnt_lo_u32_b32 %0, -1, 0\n\tv_mbcnt_hi_u32_b32 %0, -1, %0" : "=v"(l)); return l; }
__device__ __forceinline__ int tid_now(int wv) { return (wv << 6) | lane_now(); }

namespace pg8 {
#define PG8_LAS __attribute__((address_space(3)))
typedef unsigned short bf16_t;
typedef short bf16x8 __attribute__((ext_vector_type(8)));
typedef float f32x4 __attribute__((ext_vector_type(4)));
typedef unsigned u32x4 __attribute__((ext_vector_type(4)));
constexpr int BM = 256, BK = 64, HALF = 128, HTB = HALF * BK * 2  , STAGE_BYTES = 8 * HTB, NXCD = 8, WGM = 8;

__host__ __device__ __forceinline__ int lds_byte(int r, int c) { const int st = (r >> 4) * 2 + (c >> 5), rr = r & 15, cc = c & 31, ob = rr * 64 + cc * 2; return st * 1024 + (ob ^ (((ob >> 9) & 1) << 5)); }
__host__ __device__ __forceinline__ void stage_rc(int b, int& R, int& C) { const int st = b / 1024, sb = b % 1024, swz = sb ^ (((sb >> 9) & 1) << 5); R = (st >> 1) * 16 + swz / 64; C = (st & 1) * 32 + (swz % 64) / 2; }
__host__ __device__ __forceinline__ int perm32(int rho) { const int n = rho >> 4, i = rho & 15; return 8 * (i >> 2) + 4 * n + (i & 3); }

struct Unit { int pm, pn; };
struct Gemm { const bf16_t* A; int lda; const bf16_t* Bt; int M, N, K; int wv; };

struct StaticOrder {
    int nM, nN, nwg, G, c;
    __host__ __device__ void init(int M, int N, int G_, int c_) { nM = M / BM; nN = N / BM; nwg = nM * nN; G = G_; c = c_; }
    __host__ __device__ bool next(int i, Unit& u) const {
        const long L = (long)i * G + c; if (L >= nwg) return false;
        int wgid = (int)L; { const int q = nwg / NXCD, r = nwg % NXCD, xcd = wgid % NXCD, off = wgid / NXCD; wgid = (xcd < r ? xcd * (q + 1) : r * (q + 1) + (xcd - r) * q) + off; }
        const int nig = WGM * nN, gid = wgid / nig, fm = gid * WGM, gsz = (nM - fm) < WGM ? (nM - fm) : WGM;
        u.pm = fm + ((wgid % nig) % gsz); u.pn = (wgid % nig) / gsz; return true;
    }
    __device__ __forceinline__ void a_ready(const Unit&) const {}
    __device__ __forceinline__ void done(const Unit&) const {}
};

typedef __bf16 bf16x2_t __attribute__((ext_vector_type(2)));
typedef float f32x2_t __attribute__((ext_vector_type(2)));
__device__ __forceinline__ unsigned cvt_pk_bf16(float lo, float hi) { const f32x2_t v = {lo, hi}; return __builtin_bit_cast(unsigned, __builtin_convertvector(v, bf16x2_t)); }
template <class Epi, class Sched, bool ALIGN_EPI = false, bool SP2 = false>
__device__ __forceinline__ void gemm_phase(PG8_LAS unsigned char* lds, const Gemm g, const Sched& S, const Epi& E) {
    const int tid_ = tid_now(g.wv);
    const int tid = tid_, wid = g.wv, lane = tid & 63, wr = wid >> 2, wc = wid & 3, fr = lane & 15, fq = lane >> 4;
    int K_ = g.K; if (g.K < 1024) asm volatile("" : "+s"(K_));
    const int K = K_, nt = K / BK;
    unsigned voffA[2], voffB[2];
#pragma unroll
    for (int i = 0; i < 2; ++i) { int R, C; stage_rc(tid * 16 + i * 8192, R, C); const int Rb = Epi::PERM ? ((R & ~31) + perm32(R & 31)) : R;
        voffA[i] = (unsigned)(R * g.lda + C) * 2u; voffB[i] = (unsigned)(Rb * K + C) * 2u; }
    const size_t kstep = (size_t)(BK * 2);
    const size_t hstepA = (size_t)HALF * g.lda * 2, hstepB = (size_t)HALF * K * 2;
    const size_t tstepA = 2 * hstepA, tstepB = 2 * hstepB;
    const unsigned ldsw = (unsigned)wid * 1024u;
    const int aoff = lds_byte(wr * 64 + fr, fq * 8), boff = lds_byte(wc * 32 + fr, fq * 8);
#define PG8_SA(b, h) (((b) * 2 + (h)) * HTB)
#define PG8_SB(b, h) ((4 + (b) * 2 + (h)) * HTB)
#define PG8_STAGE(bufoff, gbase, voff) do { _Pragma("unroll") for (int _i = 0; _i < 2; ++_i) \
        __builtin_amdgcn_global_load_lds((const unsigned*)((const char*)(gbase) + (voff)[_i]), (PG8_LAS unsigned*)(lds + (bufoff) + ldsw + _i * 8192), 16, 0, 0); } while (0)
#define PG8_LDA(dst, b, h) do { _Pragma("unroll") for (int m = 0; m < 4; ++m) _Pragma("unroll") for (int k = 0; k < 2; ++k) dst[m][k] = *(const PG8_LAS bf16x8*)(lds + PG8_SA(b, h) + aoff + m * 2048 + k * 1024); } while (0)
#define PG8_LDB(dst, b, h) do { _Pragma("unroll") for (int n = 0; n < 2; ++n) _Pragma("unroll") for (int k = 0; k < 2; ++k) dst[n][k] = *(const PG8_LAS bf16x8*)(lds + PG8_SB(b, h) + boff + n * 2048 + k * 1024); } while (0)
#define PG8_MMA(ai, bj, At, Bt) do { __builtin_amdgcn_s_setprio(1); _Pragma("unroll") for (int m = 0; m < 4; ++m) _Pragma("unroll") for (int n = 0; n < 2; ++n) _Pragma("unroll") for (int k = 0; k < 2; ++k) \
        acc[ai][bj][m][n] = __builtin_amdgcn_mfma_f32_16x16x32_bf16(Bt[n][k], At[m][k], acc[ai][bj][m][n], 0, 0, 0); __builtin_amdgcn_s_setprio(0); } while (0)
#define PG8_WAIT_V(n) asm volatile("s_waitcnt vmcnt(" #n ")" ::: "memory")
#define PG8_WAIT_L(n) asm volatile("s_waitcnt lgkmcnt(" #n ")" ::: "memory")
#define PG8_BAR __builtin_amdgcn_s_barrier()
#define PG8_SCHED __builtin_amdgcn_sched_barrier(0)
    Unit cur, nxt; int ui = 0;
    if (!S.next(0, cur)) return;
    f32x4 acc[2][2][4][2];
#pragma unroll
    for (int a = 0; a < 2; ++a)
#pragma unroll
        for (int b = 0; b < 2; ++b)
#pragma unroll
            for (int m = 0; m < 4; ++m)
#pragma unroll
                for (int n = 0; n < 2; ++n) acc[a][b][m][n] = (f32x4){0.f, 0.f, 0.f, 0.f};
    bf16x8 At[4][2], B0[2][2], B1[2][2];
    const char* cA = (const char*)g.A + (size_t)cur.pm * tstepA; const char* cB = (const char*)g.Bt + (size_t)cur.pn * tstepB;
    S.a_ready(cur);
    if constexpr (SP2) {
        PG8_STAGE(PG8_SB(0, 0), cB, voffB); PG8_STAGE(PG8_SB(0, 1), cB + hstepB, voffB); PG8_STAGE(PG8_SA(0, 0), cA, voffA); PG8_STAGE(PG8_SA(0, 1), cA + hstepA, voffA);
        if (wr == 1) PG8_BAR;
        PG8_WAIT_V(2); PG8_BAR;
        PG8_STAGE(PG8_SB(1, 0), cB + kstep, voffB); PG8_STAGE(PG8_SA(1, 0), cA + kstep, voffA); PG8_STAGE(PG8_SB(1, 1), cB + hstepB + kstep, voffB);
        PG8_WAIT_V(6); PG8_BAR;
    } else {
        PG8_STAGE(PG8_SB(0, 0), cB, voffB); PG8_STAGE(PG8_SA(0, 0), cA, voffA); PG8_STAGE(PG8_SB(0, 1), cB + hstepB, voffB); PG8_STAGE(PG8_SA(0, 1), cA + hstepA, voffA);
        if (wr == 1) PG8_BAR;
        PG8_WAIT_V(4); PG8_BAR;
        PG8_STAGE(PG8_SB(1, 0), cB + kstep, voffB); PG8_STAGE(PG8_SA(1, 0), cA + kstep, voffA); PG8_STAGE(PG8_SB(1, 1), cB + hstepB + kstep, voffB);
        PG8_WAIT_V(6); PG8_BAR;
    }
    for (;;) {
        const bool has_next = S.next(ui + 1, nxt);
        const char* nA = has_next ? (const char*)g.A + (size_t)nxt.pm * tstepA : cA; const char* nB = has_next ? (const char*)g.Bt + (size_t)nxt.pn * tstepB : cB;
        for (int t = 0; t < nt; t += 2) {
            const bool last = (t == nt - 2);
            const char* a1 = cA + (size_t)(t + 1) * kstep;
            const char* a2 = last ? nA : cA + (size_t)(t + 2) * kstep; const char* b2 = last ? nB : cB + (size_t)(t + 2) * kstep;
            const char* a3 = a2 + kstep; const char* b3 = b2 + kstep;
            if (last && has_next) S.a_ready(nxt);
            if constexpr (SP2) {
            PG8_LDB(B0, 0, 0); PG8_LDB(B1, 0, 1); PG8_SCHED; PG8_LDA(At, 0, 0); PG8_STAGE(PG8_SA(1, 1), a1 + hstepA, voffA);
            PG8_WAIT_V(8); PG8_WAIT_L(0); PG8_BAR; PG8_MMA(0, 0, At, B0); PG8_MMA(0, 1, At, B1); PG8_BAR; PG8_SCHED;
            PG8_LDA(At, 0, 1); PG8_STAGE(PG8_SB(0, 0), b2, voffB); PG8_STAGE(PG8_SB(0, 1), b2 + hstepB, voffB); PG8_STAGE(PG8_SA(0, 0), a2, voffA);
            PG8_WAIT_V(8); PG8_WAIT_L(0); PG8_BAR; PG8_MMA(1, 0, At, B0); PG8_MMA(1, 1, At, B1); PG8_BAR; PG8_SCHED;
            PG8_LDB(B0, 1, 0); PG8_LDB(B1, 1, 1); PG8_SCHED; PG8_LDA(At, 1, 0); PG8_STAGE(PG8_SA(0, 1), a2 + hstepA, voffA);
            PG8_WAIT_V(8); PG8_WAIT_L(0); PG8_BAR; PG8_MMA(0, 0, At, B0); PG8_MMA(0, 1, At, B1); PG8_BAR; PG8_SCHED;
            PG8_LDA(At, 1, 1); PG8_STAGE(PG8_SB(1, 0), b3, voffB); PG8_STAGE(PG8_SB(1, 1), b3 + hstepB, voffB); PG8_STAGE(PG8_SA(1, 0), a3, voffA);
            PG8_WAIT_V(8); PG8_WAIT_L(0); PG8_BAR; PG8_MMA(1, 0, At, B0); PG8_MMA(1, 1, At, B1); PG8_BAR; PG8_SCHED;
            } else {
            PG8_LDB(B0, 0, 0); PG8_SCHED; PG8_LDA(At, 0, 0); PG8_STAGE(PG8_SA(1, 1), a1 + hstepA, voffA);
            PG8_WAIT_L(8); PG8_BAR; PG8_WAIT_L(0); PG8_MMA(0, 0, At, B0); PG8_BAR; PG8_SCHED;
            PG8_LDB(B1, 0, 1); PG8_STAGE(PG8_SB(0, 0), b2, voffB);
            PG8_BAR; PG8_WAIT_L(0); PG8_MMA(0, 1, At, B1); PG8_BAR;
            PG8_LDA(At, 0, 1); PG8_STAGE(PG8_SA(0, 0), a2, voffA);
            PG8_BAR; PG8_WAIT_L(0); PG8_MMA(1, 0, At, B0); PG8_BAR; PG8_SCHED;
            PG8_STAGE(PG8_SB(0, 1), b2 + hstepB, voffB);
            PG8_WAIT_V(6); PG8_BAR; PG8_MMA(1, 1, At, B1); PG8_BAR;
            PG8_LDB(B0, 1, 0); PG8_SCHED; PG8_LDA(At, 1, 0); PG8_STAGE(PG8_SA(0, 1), a2 + hstepA, voffA);
            PG8_WAIT_L(8); PG8_BAR; PG8_WAIT_L(0); PG8_MMA(0, 0, At, B0); PG8_BAR; PG8_SCHED;
            PG8_LDB(B1, 1, 1); PG8_STAGE(PG8_SB(1, 0), b3, voffB);
            PG8_BAR; PG8_WAIT_L(0); PG8_MMA(0, 1, At, B1); PG8_BAR;
            PG8_LDA(At, 1, 1); PG8_STAGE(PG8_SA(1, 0), a3, voffA);
            PG8_BAR; PG8_WAIT_L(0); PG8_MMA(1, 0, At, B0); PG8_BAR; PG8_SCHED;
            PG8_STAGE(PG8_SB(1, 1), b3 + hstepB, voffB);
            PG8_WAIT_V(6); PG8_BAR; PG8_MMA(1, 1, At, B1); PG8_BAR;
            }
        }
        if constexpr (ALIGN_EPI) { if (wr == 0) PG8_BAR; }
        if constexpr (!Epi::AFTER_DRAIN) { E(acc, cur, wr, wc, fr, fq); S.done(cur); }
        if (!has_next) break;
#pragma unroll
        for (int a = 0; a < 2; ++a)
#pragma unroll
            for (int b = 0; b < 2; ++b)
#pragma unroll
                for (int m = 0; m < 4; ++m)
#pragma unroll
                    for (int n = 0; n < 2; ++n) acc[a][b][m][n] = (f32x4){0.f, 0.f, 0.f, 0.f};
        cur = nxt; cA = nA; cB = nB; ++ui;
        if constexpr (ALIGN_EPI) { if (wr == 1) PG8_BAR; }
    }
    PG8_WAIT_V(0);
    if constexpr (!ALIGN_EPI) { if (wr == 0) PG8_BAR; }
    PG8_BAR;
    if constexpr (Epi::AFTER_DRAIN) { E.fused(acc, cur, wr, wc, fr, fq, lds, wid, lane); S.done(cur); }
#undef PG8_SA
#undef PG8_SB
#undef PG8_STAGE
#undef PG8_LDA
#undef PG8_LDB
#undef PG8_MMA
#undef PG8_WAIT_V
#undef PG8_WAIT_L
#undef PG8_BAR
#undef PG8_SCHED
}
}

typedef unsigned short bf16_t;
typedef float f32x4 __attribute__((ext_vector_type(4)));
typedef unsigned u32x4 __attribute__((ext_vector_type(4)));
#define LAS __attribute__((address_space(3)))
constexpr int NB = 4, S = 8192, DM = 1024, T = NB * S;
constexpr int NIN = 5576;
constexpr int LD1 = 5632;
constexpr int O_QLAT = 0, O_CKV = 384, O_KROPE = 640, O_KIDX = 672, O_WIDX = 704, O_ZA = 768, O_QB = 1280, O_KB = 1792, O_VB = 2304, O_ZB = 2816,
              O_QIDX = 3328, O_GA = 3584, O_GB = 4608;
constexpr size_t MiB = 1u << 20;
constexpr size_t WS_CTL = 0, WS_WUQT = 1 * MiB, WS_WUKVT = 2 * MiB, WS_WOAT = 3 * MiB, WS_WOBT = 4 * MiB, WS_WOUTT = 5 * MiB, WS_ROPE = 7 * MiB,
                 WS_WINT = 8 * MiB, WS_SSQO = 8 * MiB  , WS_SSQLAT = 19 * MiB, WS_KPE = 22 * MiB, WS_KIDX = 24 * MiB, WS_MASK = 26 * MiB,
                 WS_H = 44 * MiB  , WS_Q = 108 * MiB, WS_OUT1 = 156 * MiB, WS_END = 508 * MiB;
constexpr float LOG2E = 1.4426950408889634f;
constexpr float QSCALE_A = 0.10206207261596577f * LOG2E;
constexpr float QSCALE_B = 0.125f * LOG2E;
constexpr int GEMM_LDS = 131072;
constexpr int LDS_BYTES = 147456;

__device__ __forceinline__ float bf2f(bf16_t v) { return __uint_as_float(((unsigned)v) << 16); }
__device__ __forceinline__ bf16_t f2bf(float f) { unsigned u = __float_as_uint(f); return (bf16_t)((u + 0x7fffu + ((u >> 16) & 1u)) >> 16); }
__device__ __forceinline__ unsigned pk2(float lo, float hi) { return (unsigned)f2bf(lo) | ((unsigned)f2bf(hi) << 16); }
__device__ __forceinline__ float bflo(unsigned w) { return __uint_as_float(w << 16); }
__device__ __forceinline__ float bfhi(unsigned w) { return __uint_as_float(w & 0xffff0000u); }
__device__ __forceinline__ float wave_sum(float v) {
#pragma unroll
    for (int o = 1; o < 64; o <<= 1) v += __shfl_xor(v, o);
    return v;
}
__device__ __forceinline__ float sigmoidf_(float x) { return __builtin_amdgcn_rcpf(1.f + __builtin_amdgcn_exp2f(-LOG2E * x)); }

struct Ptrs {
    const float *x, *norm_g, *w_in, *g_q, *w_uq, *g_kv, *w_ukv, *w_oa, *w_ob, *w_out, *rel_bias, *final_g;
    float* out; unsigned char* ws;
};

namespace pg8 {
struct EpiIn {
    static constexpr bool PERM = true, AFTER_DRAIN = false;
    bf16_t* O; float* ssq;
    __device__ __forceinline__ void operator()(const f32x4 (&acc)[2][2][4][2], const Unit& u, int wr, int wc, int, int) const {
        const int t_ = lane_now();
        const int fr = t_ & 15, fq = (t_ >> 4) & 3;
        const int row0 = u.pm * BM + wr * 64 + fr;
#pragma unroll
        for (int bj = 0; bj < 2; ++bj) {
            const int g = u.pn * 2 + bj;
            const int col0 = g * 128 + wc * 32 + 8 * fq;
            int op = 0;
            if ((g >= 6 && g <= 9) || (g >= 22 && g <= 25)) op = 1; else if (g >= 28) op = 2; else if (g >= 10 && g <= 13) op = 3; else if (g <= 4) op = 4;
#pragma unroll
            for (int ai = 0; ai < 2; ++ai)
#pragma unroll
                for (int m = 0; m < 4; ++m) {
                    const int row = row0 + ai * HALF + m * 16;
                    f32x4 v0 = acc[ai][bj][m][0], v1 = acc[ai][bj][m][1];
                    if (op == 1) {
#pragma unroll
                        for (int e = 0; e < 4; ++e) { v0[e] = v0[e] * sigmoidf_(v0[e]); v1[e] = v1[e] * sigmoidf_(v1[e]); }
                    } else if (op == 2) {
#pragma unroll
                        for (int e = 0; e < 4; ++e) { v0[e] = sigmoidf_(v0[e]); v1[e] = sigmoidf_(v1[e]); }
                    } else if (op == 3) { v0 = v0 * QSCALE_B; v1 = v1 * QSCALE_B; }
                    else if (op == 4) {
                        float s = (v0[0] * v0[0] + v0[1] * v0[1]) + (v0[2] * v0[2] + v0[3] * v0[3]) + (v1[0] * v1[0] + v1[1] * v1[1]) + (v1[2] * v1[2] + v1[3] * v1[3]);
                        s += __shfl_xor(s, 16); s += __shfl_xor(s, 32);
                        if (fq == 0) ssq[(size_t)row * 20 + g * 4 + wc] = s;
                    }
                    u32x4 w; w.x = cvt_pk_bf16(v0[0], v0[1]); w.y = cvt_pk_bf16(v0[2], v0[3]); w.z = cvt_pk_bf16(v1[0], v1[1]); w.w = cvt_pk_bf16(v1[2], v1[3]);
                    *(u32x4*)(O + (size_t)row * LD1 + col0) = w;
                }
        }
    }
};
struct EpiQ {
    static constexpr bool PERM = true, AFTER_DRAIN = false;
    bf16_t* Q; const float* ssq; const float2* rope;
    __device__ __forceinline__ static f32x4 rope4(f32x4 v, const f32x4 ca, const f32x4 cb, bool first) {
        const float cs[4] = {ca[0], ca[2], cb[0], cb[2]}, sn[4] = {ca[1], ca[3], cb[1], cb[3]};
#pragma unroll
        for (int e = 0; e < 4; ++e) { const float pv = __shfl_xor(v[e], 32); v[e] = first ? (v[e] * cs[e] - pv * sn[e]) : (pv * sn[e] + v[e] * cs[e]); }
        return v;
    }
    __device__ __forceinline__ void operator()(const f32x4 (&acc)[2][2][4][2], const Unit& u, int wr, int wc, int, int) const {
        const int t_ = lane_now();
        const int fr = t_ & 15, fq = (t_ >> 4) & 3;
        const int row0 = u.pm * BM + wr * 64 + fr;
#pragma unroll
        for (int ai = 0; ai < 2; ++ai)
#pragma unroll
            for (int m = 0; m < 4; ++m) {
                const int row = row0 + ai * HALF + m * 16;
                const f32x4* sp = (const f32x4*)(ssq + (size_t)row * 20);
                float tot;
                { const f32x4 s0 = sp[0]; tot = (s0[0] + s0[1]) + (s0[2] + s0[3]); }
                { const f32x4 s1 = sp[1]; tot += (s1[0] + s1[1]) + (s1[2] + s1[3]); }
                { const f32x4 s2 = sp[2]; tot += (s2[0] + s2[1]) + (s2[2] + s2[3]); }
                const float rs = rsqrtf(tot * (1.f / 384.f) + 1e-6f) * QSCALE_A;
                const f32x4* rp = (const f32x4*)(rope + (size_t)(row & (S - 1)) * 16 + 8 * (fq & 1));
#pragma unroll
                for (int bj = 0; bj < 2; ++bj) {
                    const int sl = u.pn * 8 + bj * 4 + wc;
                    f32x4 v0 = acc[ai][bj][m][0] * rs, v1 = acc[ai][bj][m][1] * rs;
                    if (sl % 3 == 2) {
                        v0 = rope4(v0, rp[0], rp[1], fq < 2);
                        v1 = rope4(v1, rp[2], rp[3], fq < 2);
                    }
                    u32x4 w; w.x = cvt_pk_bf16(v0[0], v0[1]); w.y = cvt_pk_bf16(v0[2], v0[3]); w.z = cvt_pk_bf16(v1[0], v1[1]); w.w = cvt_pk_bf16(v1[2], v1[3]);
                    *(u32x4*)(Q + (size_t)row * 768 + sl * 32 + 8 * fq) = w;
                    asm volatile("" ::: "memory");
                }
            }
    }
};
struct EpiKV {
    static constexpr bool PERM = true, AFTER_DRAIN = false;
    bf16_t* KV; const float* ssq;
    __device__ __forceinline__ void operator()(const f32x4 (&acc)[2][2][4][2], const Unit& u, int wr, int wc, int, int) const {
        const int t_ = lane_now();
        const int fr = t_ & 15, fq = (t_ >> 4) & 3;
        const int row0 = u.pm * BM + wr * 64 + fr;
#pragma unroll
        for (int ai = 0; ai < 2; ++ai)
#pragma unroll
            for (int m = 0; m < 4; ++m) {
                const int row = row0 + ai * HALF + m * 16;
                const f32x4* sp = (const f32x4*)(ssq + (size_t)row * 20 + 12);
                const f32x4 s0 = sp[0], s1 = sp[1];
                const float tot = ((s0[0] + s0[1]) + (s0[2] + s0[3])) + ((s1[0] + s1[1]) + (s1[2] + s1[3]));
                const float rs = rsqrtf(tot * (1.f / 256.f) + 1e-6f);
#pragma unroll
                for (int bj = 0; bj < 2; ++bj) {
                    const int col0 = u.pn * BM + bj * HALF + wc * 32 + 8 * fq;
                    const f32x4 v0 = acc[ai][bj][m][0] * rs, v1 = acc[ai][bj][m][1] * rs;
                    u32x4 w; w.x = cvt_pk_bf16(v0[0], v0[1]); w.y = cvt_pk_bf16(v0[2], v0[3]); w.z = cvt_pk_bf16(v1[0], v1[1]); w.w = cvt_pk_bf16(v1[2], v1[3]);
                    *(u32x4*)(KV + (size_t)row * 1024 + col0) = w;
                }
                asm volatile("" ::: "memory");
            }
    }
};
template <bool ADD> struct EpiGate {
    static constexpr bool PERM = true, AFTER_DRAIN = false;
    bf16_t* MG; const bf16_t* O1; int gcol;
    __device__ __forceinline__ void operator()(const f32x4 (&acc)[2][2][4][2], const Unit& u, int wr, int wc, int, int) const {
        const int t_ = lane_now();
        const int fr = t_ & 15, fq = (t_ >> 4) & 3;
        const int row0 = u.pm * BM + wr * 64 + fr;
#pragma unroll
        for (int ai = 0; ai < 2; ++ai)
#pragma unroll
            for (int m = 0; m < 4; ++m) {
                const int row = row0 + ai * HALF + m * 16;
#pragma unroll
                for (int bj = 0; bj < 2; ++bj) {
                    const int col0 = u.pn * BM + bj * HALF + wc * 32 + 8 * fq;
                    const u32x4 gw = *(const u32x4*)(O1 + (size_t)row * LD1 + gcol + col0);
                    f32x4 v0 = acc[ai][bj][m][0], v1 = acc[ai][bj][m][1];
                    v0[0] *= bflo(gw.x); v0[1] *= bfhi(gw.x); v0[2] *= bflo(gw.y); v0[3] *= bfhi(gw.y);
                    v1[0] *= bflo(gw.z); v1[1] *= bfhi(gw.z); v1[2] *= bflo(gw.w); v1[3] *= bfhi(gw.w);
                    u32x4* dst = (u32x4*)(MG + (size_t)row * DM + col0);
                    if (ADD) { const u32x4 pw = *dst;
                        v0[0] += bflo(pw.x); v0[1] += bfhi(pw.x); v0[2] += bflo(pw.y); v0[3] += bfhi(pw.y);
                        v1[0] += bflo(pw.z); v1[1] += bfhi(pw.z); v1[2] += bflo(pw.w); v1[3] += bfhi(pw.w); }
                    u32x4 w; w.x = cvt_pk_bf16(v0[0], v0[1]); w.y = cvt_pk_bf16(v0[2], v0[3]); w.z = cvt_pk_bf16(v1[0], v1[1]); w.w = cvt_pk_bf16(v1[2], v1[3]);
                    *dst = w;
                }
                asm volatile("" ::: "memory");
            }
    }
};
struct EpiOut {
    static constexpr bool PERM = true, AFTER_DRAIN = false;
    const float* x; float* out; float* ssqo;
    __device__ __forceinline__ void operator()(const f32x4 (&acc)[2][2][4][2], const Unit& u, int wr, int wc, int, int) const {
        const int t_ = lane_now();
        const int fr = t_ & 15, fq = (t_ >> 4) & 3;
        const int row0 = u.pm * BM + wr * 64 + fr;
#pragma unroll
        for (int ai = 0; ai < 2; ++ai)
#pragma unroll
            for (int m = 0; m < 4; ++m) {
                const int row = row0 + ai * HALF + m * 16;
#pragma unroll
                for (int bj = 0; bj < 2; ++bj) {
                    const int col0 = u.pn * BM + bj * HALF + wc * 32 + 8 * fq;
                    const f32x4* xp = (const f32x4*)(x + (size_t)row * DM + col0);
                    const f32x4 v0 = acc[ai][bj][m][0] + xp[0], v1 = acc[ai][bj][m][1] + xp[1];
                    f32x4* op = (f32x4*)(out + (size_t)row * DM + col0);
                    op[0] = v0; op[1] = v1;
                    float s = (v0[0] * v0[0] + v0[1] * v0[1]) + (v0[2] * v0[2] + v0[3] * v0[3]) + (v1[0] * v1[0] + v1[1] * v1[1]) + (v1[2] * v1[2] + v1[3] * v1[3]);
                    s += __shfl_xor(s, 16); s += __shfl_xor(s, 32);
                    if (fq == 0) ssqo[(size_t)row * 32 + u.pn * 8 + bj * 4 + wc] = s;
                }
                asm volatile("" ::: "memory");
            }
    }
};
}


namespace att {
typedef short bf16x8 __attribute__((ext_vector_type(8)));
typedef short s16x4 __attribute__((ext_vector_type(4)));
typedef float f32x16 __attribute__((ext_vector_type(16)));
typedef unsigned u32x4 __attribute__((ext_vector_type(4)));
typedef const LAS char* lds_cptr;
constexpr int SLOT_K = 12288, SLOT_V = 8192;
constexpr int L_K = 0, L_V = 2 * SLOT_K, L_WS = L_V + 2 * SLOT_V, L_OST = L_WS + 2048, L_BIAS = L_OST + 8 * 4096, L_END = L_BIAS + 2048;
constexpr float THR = 8.f;
#define MFMA32(a, b, c) __builtin_amdgcn_mfma_f32_32x32x16_bf16(a, b, c, 0, 0, 0)
__device__ __forceinline__ int crow(int r, int hi) { return (r & 3) + 8 * (r >> 2) + 4 * hi; }
typedef __bf16 bf16x2_t __attribute__((ext_vector_type(2)));
typedef float f32x2_t __attribute__((ext_vector_type(2)));
__device__ __forceinline__ unsigned cvtpk(float lo, float hi) { const f32x2_t v = {lo, hi}; return __builtin_bit_cast(unsigned, __builtin_convertvector(v, bf16x2_t)); }
__device__ __forceinline__ s16x4 vtr(lds_cptr p) { typedef short v4i16_t __attribute__((ext_vector_type(4))); return __builtin_bit_cast(s16x4, __builtin_amdgcn_ds_read_tr16_b64_v4i16((LAS v4i16_t*)p)); }
#define MX3(a, b, c) __builtin_fmaxf(__builtin_fmaxf((a), (b)), (c))
__device__ __forceinline__ float rowmax(const f32x16& p0, const f32x16& p1) {
    float a = MX3(p0[0], p0[1], p1[0]), b = MX3(p0[2], p0[3], p1[1]); a = MX3(a, p1[2], p1[3]);
#pragma unroll
    for (int r = 4; r < 16; r += 4) { a = MX3(a, p0[r], p0[r + 1]); b = MX3(b, p0[r + 2], p0[r + 3]); a = MX3(a, p1[r], p1[r + 1]); b = MX3(b, p1[r + 2], p1[r + 3]); }
    const float m = __builtin_fmaxf(a, b); auto rr = __builtin_amdgcn_permlane32_swap(__float_as_uint(m), __float_as_uint(m), false, false);
    return __builtin_fmaxf(__uint_as_float(rr[0]), __uint_as_float(rr[1])); }
__device__ __forceinline__ float maskp(float p, unsigned lo, unsigned hi) {
    const unsigned long long mk = ((unsigned long long)hi << 32) | lo; float o;
    asm("v_cndmask_b32_e64 %0, 0, %1, %2" : "=v"(o) : "v"(p), "s"(mk)); return o; }
__host__ __device__ __forceinline__ size_t mask_tile_off(int qt32) { const int J = qt32 >> 1; return (size_t)2 * J * (J + 1) + ((qt32 & 1) ? 2 * (J + 1) : 0); }
constexpr size_t MASK_TILES_PER_BATCH = (size_t)2 * 128 * 129;

struct Tensors {
    const bf16_t* Q; int ldq;
    const bf16_t* K0; int ldk;
    const bf16_t* K1;
    const bf16_t* V; int ldv;
    bf16_t* O; int ldo;
    const unsigned long long* mask;
    const float* rel_bias;
    int hq, hk, hv;
    int wv;
};

template <bool DSA>
__device__ __forceinline__ void unit(int b, int h, int qb, const Tensors& X, LAS unsigned char* lds, bool dry) {
    constexpr int NDQ = DSA ? 4 : 6;
    const int tid_ = tid_now(X.wv);
    const int tid = tid_, lane = tid & 63, r32 = lane & 31, hi = lane >> 5; const int wid = X.wv;
    const size_t rowbase = (size_t)b * S; const int q0 = qb * 256, NT = 4 * qb + 4, NTw = 4 * qb + (wid >> 1) + 1;
    LAS float* wsf = (LAS float*)(lds + L_WS) + wid * 64;
    const bf16_t* ksrc = X.K0 + (rowbase + lane) * X.ldk + h * X.hk + wid * 8;
    const bf16_t* ksrc1 = DSA ? nullptr : X.K1 + (rowbase + lane) * 32 + (wid & 3) * 8;
    const bf16_t* vsrc = X.V + (rowbase + 16 * (wid & 3) + (lane >> 2)) * X.ldv + h * X.hv + (wid >> 2) * 32 + (lane & 3) * 8;
    const size_t kstride = (size_t)64 * X.ldk, vstride = (size_t)64 * X.ldv;
    LAS unsigned char* kdst = lds + L_K + wid * 1024; LAS unsigned char* kdst1 = lds + L_K + (8 + (wid & 3)) * 1024; LAS unsigned char* vdst = lds + L_V + wid * 1024;
    u32x4 sk0, sk1 = {}, sv;
#define ATT_LOAD(t) do { sk0 = *(const u32x4*)(ksrc + (size_t)(t) * kstride); if (!DSA && wid < 4) sk1 = *(const u32x4*)(ksrc1 + (size_t)(t) * 64 * 32); \
                         sv = *(const u32x4*)(vsrc + (size_t)(t) * vstride); } while (0)
#define ATT_WRITE(slot) do { *(LAS u32x4*)(kdst + (slot) * SLOT_K + lane * 16) = sk0; if (!DSA && wid < 4) *(LAS u32x4*)(kdst1 + (slot) * SLOT_K + lane * 16) = sk1; \
                             *(LAS u32x4*)(vdst + (slot) * SLOT_V + lane * 16) = sv; } while (0)
    const lds_cptr vp0 = (lds_cptr)lds + L_V + ((lane >> 4) & 1) * 32 + (lane & 3) * 8 + (4 * hi + ((lane & 15) >> 2)) * 64;
    const lds_cptr kp0 = (lds_cptr)lds + L_K + hi * 1024 + r32 * 16;
    ATT_LOAD(0); ATT_WRITE(0);
    bf16x8 qr[NDQ];
    { const bf16_t* Qw = X.Q + (rowbase + q0 + wid * 32 + r32) * X.ldq + h * X.hq + hi * 8;
#pragma unroll
      for (int d0 = 0; d0 < NDQ; ++d0) qr[d0] = *(const bf16x8*)(Qw + d0 * 16); }
    if (DSA) {
        LAS float* tab = (LAS float*)(lds + L_BIAS);
        const float c15 = X.rel_bias[15 * 8 + h];
        for (int e = tid; e < 320; e += 512) {
            const int rel = e - 255, n = rel < 0 ? -rel : rel; int v;
            if (n < 8) v = n; else if (n < 12) v = 8; else if (n < 16) v = 9; else if (n < 23) v = 10; else if (n < 32) v = 11; else if (n < 46) v = 12; else if (n < 64) v = 13; else if (n < 91) v = 14; else v = 15;
            tab[e] = (X.rel_bias[((rel > 0 ? 16 : 0) + v) * 8 + h] - c15) * LOG2E;
        }
    }
    float mhat = 0.f, l_reg = 0.f; f32x16 o0 = {}, o1 = {};
    if (wid >= 4) __builtin_amdgcn_s_setprio(1);
    const int qpos = q0 + wid * 32 + r32;
    for (int t = 0; t < NT; ++t) {
        asm volatile("s_waitcnt vmcnt(0) lgkmcnt(0)\n\ts_barrier" ::: "memory");
        if (t + 1 < NT) ATT_LOAD(t + 1);
        unsigned mw = 0u;
        if (DSA && t < NTw) { const int qt32 = qb * 8 + wid;
            const unsigned* mt = (const unsigned*)((const unsigned short*)X.mask + ((size_t)b * MASK_TILES_PER_BATCH + mask_tile_off(qt32)) * 64) + (size_t)t * 64;
            mw = mt[lane]; }
        if (t < NTw) {
            const int so_k = (t & 1) * SLOT_K, so_v = (t & 1) * SLOT_V;
            f32x16 c0 = {}, c1 = {};
            bf16x8 kf[2 * NDQ];
#pragma unroll
            for (int d0 = 0; d0 < NDQ; ++d0) { kf[2 * d0] = *(const LAS bf16x8*)(kp0 + so_k + d0 * 2048); kf[2 * d0 + 1] = *(const LAS bf16x8*)(kp0 + so_k + d0 * 2048 + 512); }
#pragma unroll
            for (int d0 = 0; d0 < NDQ; ++d0) { c0 = MFMA32(kf[2 * d0], qr[d0], c0); c1 = MFMA32(kf[2 * d0 + 1], qr[d0], c1); }
            const lds_cptr vp = vp0 + so_v;
            bf16x8 vf[8];
#pragma unroll
            for (int i = 0; i < 8; ++i) { const s16x4 lo_ = vtr(vp + ((i >> 2) * 4096 + (i & 3) * 1024)), hi_ = vtr(vp + ((i >> 2) * 4096 + (i & 3) * 1024 + 512));
                vf[i] = (bf16x8){lo_[0], lo_[1], lo_[2], lo_[3], hi_[0], hi_[1], hi_[2], hi_[3]}; }
            if (DSA) {
                if (64 * t + 63 - (q0 + wid * 32) > -128) {
                    const LAS float* tab = (const LAS float*)(lds + L_BIAS);
                    const int base = 64 * t + 4 * hi - qpos + 255;
#pragma unroll
                    for (int r = 0; r < 16; ++r) { const int kr = (r & 3) + 8 * (r >> 2); int i0 = base + kr, i1 = base + kr + 32; i0 = i0 < 0 ? 0 : i0; i1 = i1 < 0 ? 0 : i1;
                        c0[r] += tab[i0]; c1[r] += tab[i1]; }
                }
            }
            const float rm = rowmax(c0, c1);
            if (t == 0) mhat = rm;
            else {
                const float grow = rm - mhat;
                if (__any(grow > THR)) {
                    const float dl = __builtin_fmaxf(grow, 0.f); mhat += dl;
                    const float f = __builtin_amdgcn_exp2f(-dl); l_reg *= f;
                    if (hi == 0) wsf[r32] = f;
                    asm volatile("s_waitcnt lgkmcnt(0)" ::: "memory");
#pragma unroll
                    for (int r = 0; r < 16; ++r) { const float fr = wsf[crow(r, hi)]; o0[r] *= fr; o1[r] *= fr; }
                }
            }
            const float nm = -mhat;
#pragma unroll
            for (int r = 0; r < 16; ++r) { c0[r] = __builtin_amdgcn_exp2f(c0[r] + nm); c1[r] = __builtin_amdgcn_exp2f(c1[r] + nm); }
            if (DSA) {
#pragma unroll
                for (int r = 0; r < 16; ++r) { c0[r] = ((mw >> r) & 1u) ? c0[r] : 0.f; c1[r] = ((mw >> (16 + r)) & 1u) ? c1[r] : 0.f; }
            }
            float sacc = 0.f;
#pragma unroll
            for (int r = 0; r < 16; ++r) sacc += c0[r] + c1[r];
            l_reg += sacc;
            u32x4 pw0 = {cvtpk(c0[0], c0[1]), cvtpk(c0[2], c0[3]), cvtpk(c0[4], c0[5]), cvtpk(c0[6], c0[7])};
            u32x4 pw1 = {cvtpk(c0[8], c0[9]), cvtpk(c0[10], c0[11]), cvtpk(c0[12], c0[13]), cvtpk(c0[14], c0[15])};
            u32x4 pw2 = {cvtpk(c1[0], c1[1]), cvtpk(c1[2], c1[3]), cvtpk(c1[4], c1[5]), cvtpk(c1[6], c1[7])};
            u32x4 pw3 = {cvtpk(c1[8], c1[9]), cvtpk(c1[10], c1[11]), cvtpk(c1[12], c1[13]), cvtpk(c1[14], c1[15])};
            o0 = MFMA32(__builtin_bit_cast(bf16x8, pw0), vf[0], o0); o1 = MFMA32(__builtin_bit_cast(bf16x8, pw0), vf[4], o1);
            o0 = MFMA32(__builtin_bit_cast(bf16x8, pw1), vf[1], o0); o1 = MFMA32(__builtin_bit_cast(bf16x8, pw1), vf[5], o1);
            o0 = MFMA32(__builtin_bit_cast(bf16x8, pw2), vf[2], o0); o1 = MFMA32(__builtin_bit_cast(bf16x8, pw2), vf[6], o1);
            o0 = MFMA32(__builtin_bit_cast(bf16x8, pw3), vf[3], o0); o1 = MFMA32(__builtin_bit_cast(bf16x8, pw3), vf[7], o1);
        }
        if (t + 1 < NT) ATT_WRITE((t + 1) & 1);
    }
    __builtin_amdgcn_s_setprio(0);
    { auto rr = __builtin_amdgcn_permlane32_swap(__float_as_uint(l_reg), __float_as_uint(l_reg), false, false); l_reg = __uint_as_float(rr[0]) + __uint_as_float(rr[1]); }
    if (hi == 0) wsf[32 + r32] = l_reg;
    asm volatile("s_waitcnt lgkmcnt(0)" ::: "memory");
    LAS bf16_t* stg = (LAS bf16_t*)(lds + L_OST) + wid * 2048;
#pragma unroll
    for (int r = 0; r < 16; ++r) { const int orow = crow(r, hi); const float rli = __builtin_amdgcn_rcpf(wsf[32 + orow]);
        stg[orow * 64 + r32] = f2bf(o0[r] * rli); stg[orow * 64 + 32 + r32] = f2bf(o1[r] * rli); }
    asm volatile("s_waitcnt lgkmcnt(0)" ::: "memory");
    bf16_t* Ow = X.O + (rowbase + q0 + wid * 32) * X.ldo + h * 64;
#pragma unroll
    for (int i = 0; i < 4; ++i) { const int row = i * 8 + (lane >> 3), ch = lane & 7;
        const u32x4 ov = *(const LAS u32x4*)(stg + row * 64 + ch * 8); u32x4* gp = (u32x4*)(Ow + (size_t)row * X.ldo + ch * 8); const u32x4 gv = *gp;
        u32x4 res; res.x = pk2(bflo(ov.x) * bflo(gv.x), bfhi(ov.x) * bfhi(gv.x)); res.y = pk2(bflo(ov.y) * bflo(gv.y), bfhi(ov.y) * bfhi(gv.y));
        res.z = pk2(bflo(ov.z) * bflo(gv.z), bfhi(ov.z) * bfhi(gv.z)); res.w = pk2(bflo(ov.w) * bflo(gv.w), bfhi(ov.w) * bfhi(gv.w)); if (!dry) *gp = res; }
    asm volatile("s_waitcnt vmcnt(0) lgkmcnt(0)\n\ts_barrier" ::: "memory");
#undef ATT_LOAD
#undef ATT_WRITE
}

template <bool DSA>
__device__ __forceinline__ void phase(const Tensors& X, LAS unsigned char* lds, int G, int bid, bool dry = false) {
    for (int p = bid; p < 512; p += G) {
        const int x = p & 7, kk = p >> 3, bh = x + 8 * (kk >> 4), j = kk & 15;
#pragma unroll 1
        for (int u2 = 0; u2 < 2; ++u2) unit<DSA>(bh >> 3, bh & 7, u2 ? 31 - j : j, X, lds, dry);
    }
}
}


namespace idx {
typedef short bf16x8 __attribute__((ext_vector_type(8)));
typedef float f32x16 __attribute__((ext_vector_type(16)));
constexpr int HROW = 1025;
constexpr int LCAP = 32;
constexpr int L_HIST = 0, L_PFX = 32 * HROW * 4, L_NEED = L_PFX + 128, L_LCNT = L_NEED + 128, L_LIST = L_LCNT + 128, L_END = L_LIST + 32 * LCAP * 4;
__device__ __forceinline__ unsigned f2key(float f) { const unsigned u = __float_as_uint(f); return u ^ ((unsigned)((int)u >> 31) | 0x80000000u); }

struct QOps { bf16x8 qf[8][2]; bf16x8 qb[2][2]; float wv[8]; };
__device__ __forceinline__ void score_tile(float (&acc)[16], const bf16x8 k0, const bf16x8 k1, const QOps& Q) {
#define IDX_HEAD(h) ({ f32x16 c_ = __builtin_amdgcn_mfma_f32_32x32x16_bf16(k0, Q.qf[h][0], (f32x16){}, 0, 0, 0); __builtin_amdgcn_mfma_f32_32x32x16_bf16(k1, Q.qf[h][1], c_, 0, 0, 0); })
#define IDX_ACC(h, c) do { _Pragma("unroll") for (int r = 0; r < 16; ++r) { acc[r] = __builtin_fmaf(Q.wv[h], __builtin_fabsf(c[r]), acc[r]); asm volatile("" : "+v"(acc[r])); } } while (0)
    f32x16 cA = IDX_HEAD(0);
    f32x16 lin = __builtin_amdgcn_mfma_f32_32x32x16_bf16(k0, Q.qb[0][0], (f32x16){}, 0, 0, 0);
    lin = __builtin_amdgcn_mfma_f32_32x32x16_bf16(k1, Q.qb[0][1], lin, 0, 0, 0);
    lin = __builtin_amdgcn_mfma_f32_32x32x16_bf16(k0, Q.qb[1][0], lin, 0, 0, 0);
    lin = __builtin_amdgcn_mfma_f32_32x32x16_bf16(k1, Q.qb[1][1], lin, 0, 0, 0);
    f32x16 cB = IDX_HEAD(1);
#pragma unroll
    for (int r = 0; r < 16; ++r) acc[r] = lin[r];
    __builtin_amdgcn_sched_barrier(0);
#pragma unroll
    for (int hp = 0; hp < 4; ++hp) {
        f32x16 nA, nB;
        if (hp < 3) nA = IDX_HEAD(2 * hp + 2);
        IDX_ACC(2 * hp, cA);
        __builtin_amdgcn_sched_barrier(0);
        if (hp < 3) nB = IDX_HEAD(2 * hp + 3);
        IDX_ACC(2 * hp + 1, cB);
        __builtin_amdgcn_sched_barrier(0);
        if (hp < 3) { cA = nA; cB = nB; }
    }
#undef IDX_HEAD
#undef IDX_ACC
}
#define IDX_KLOAD(k0, k1, kt) do { const bf16_t* kp_ = kbase + (size_t)(kt) * 1024 + r32 * 32 + hi * 8; k0 = *(const bf16x8*)kp_; k1 = *(const bf16x8*)(kp_ + 16); } while (0)

struct PassCtx { const bf16_t* kbase; LAS unsigned* hrow; LAS unsigned* lcnt_q; LAS unsigned* blist_q; unsigned short* mbase; unsigned pfx; int lane, r32, hi, ktb, kte; };
template <int PASS>
__device__ __forceinline__ void pass_tile(const PassCtx& C, const bf16x8 k0, const bf16x8 k1, const QOps& Q, int kt) {
    constexpr int SH_BIN = (PASS == 0) ? 22 : ((PASS == 1) ? 11 : 0), SH_PFX = (PASS == 1) ? 22 : 11;
    __builtin_amdgcn_sched_barrier(0);
    float acc[16]; score_tile(acc, k0, k1, Q);
    unsigned bits = 0u, anym = 0u; unsigned keys[16];
#pragma unroll
    for (int r = 0; r < 16; ++r) {
        const unsigned key = f2key(acc[r]), up = key >> SH_PFX, bin = (PASS == 0) ? (key >> 22) : ((key >> SH_BIN) & 2047u); if (PASS == 2) keys[r] = key;
        const bool match = (PASS == 0) || (up == C.pfx);
        if (PASS == 0) __hip_atomic_fetch_add(C.hrow + bin, 1u, __ATOMIC_RELAXED, __HIP_MEMORY_SCOPE_WORKGROUP);
        else if (match) __hip_atomic_fetch_add(C.hrow + (bin >> 1), 1u << ((bin & 1u) * 16u), __ATOMIC_RELAXED, __HIP_MEMORY_SCOPE_WORKGROUP);
        if (PASS == 2) { bits |= (up > C.pfx) ? (1u << r) : 0u; anym |= match ? 1u : 0u; }
    }
    if (PASS == 2) {
        C.mbase[(size_t)(kt >> 1) * 128 + C.lane * 2 + (kt & 1)] = (unsigned short)bits;
        if (__any(anym)) {
#pragma unroll
            for (int r = 0; r < 16; ++r) if ((keys[r] >> 11) == C.pfx) {
                const unsigned sl = __hip_atomic_fetch_add(C.lcnt_q, 1u, __ATOMIC_RELAXED, __HIP_MEMORY_SCOPE_WORKGROUP);
                if (sl < (unsigned)LCAP) C.blist_q[sl] = (keys[r] & 2047u) | ((unsigned)r << 11) | ((unsigned)C.lane << 15) | ((unsigned)kt << 21);
            }
        }
    }
}
#define IDX_KLOADC(k0, k1, kt) do { const bf16_t* kp_ = C.kbase + (size_t)(kt) * 1024 + C.r32 * 32 + C.hi * 8; k0 = *(const bf16x8*)kp_; k1 = *(const bf16x8*)(kp_ + 16); } while (0)
template <int PASS>
__device__ __forceinline__ void pass_loop(const PassCtx& C, const QOps& Q) {
    bf16x8 a0, a1, b0, b1, c0, c1; const int ktb = C.ktb, kte = C.kte;
    if (ktb < kte) IDX_KLOADC(a0, a1, ktb); if (ktb + 1 < kte) IDX_KLOADC(b0, b1, ktb + 1); if (ktb + 2 < kte) IDX_KLOADC(c0, c1, ktb + 2);
    for (int kt = ktb; kt < kte; kt += 3) {
        pass_tile<PASS>(C, a0, a1, Q, kt); if (kt + 3 < kte) IDX_KLOADC(a0, a1, kt + 3);
        if (kt + 1 < kte) { pass_tile<PASS>(C, b0, b1, Q, kt + 1); if (kt + 4 < kte) IDX_KLOADC(b0, b1, kt + 4); }
        if (kt + 2 < kte) { pass_tile<PASS>(C, c0, c1, Q, kt + 2); if (kt + 5 < kte) IDX_KLOADC(c0, c1, kt + 5); }
    }
}
#undef IDX_KLOADC

__device__ __forceinline__ void unit(int b, int qt, const bf16_t* __restrict__ O1, const bf16_t* __restrict__ KIDX, unsigned* __restrict__ MASK, LAS unsigned char* lds, int wv) {
    const int tid_ = tid_now(wv);
    asm volatile("" : "+s"(O1), "+s"(KIDX), "+s"(MASK));
    const int tid = tid_, lane = tid & 63, r32 = lane & 31, hi = lane >> 5; const int wid = wv;
    const size_t rowbase = (size_t)b * S; const int nkt = 2 * ((qt >> 1) + 1);
    const int kper = (nkt + 7) >> 3, ktb = wid * kper, kte = (ktb + kper < nkt) ? ktb + kper : nkt;
    LAS unsigned* hist = (LAS unsigned*)(lds + L_HIST); LAS unsigned* spfx = (LAS unsigned*)(lds + L_PFX); LAS int* sneed = (LAS int*)(lds + L_NEED);
    QOps Q;
    { const bf16_t* qrow = O1 + (rowbase + qt * 32 + r32) * LD1;
      const u32x4 ww = *(const u32x4*)(qrow + O_WIDX);
      Q.wv[0] = bflo(ww.x); Q.wv[1] = bfhi(ww.x); Q.wv[2] = bflo(ww.y); Q.wv[3] = bfhi(ww.y); Q.wv[4] = bflo(ww.z); Q.wv[5] = bfhi(ww.z); Q.wv[6] = bflo(ww.w); Q.wv[7] = bfhi(ww.w);
      float qs[2][8];
#pragma unroll
      for (int s2 = 0; s2 < 2; ++s2)
#pragma unroll
          for (int j = 0; j < 8; ++j) qs[s2][j] = 0.f;
#pragma unroll
      for (int h = 0; h < 8; ++h)
#pragma unroll
          for (int s2 = 0; s2 < 2; ++s2) {
              const u32x4 qv = *(const u32x4*)(qrow + O_QIDX + 32 * h + 16 * s2 + hi * 8);
              Q.qf[h][s2] = __builtin_bit_cast(bf16x8, qv);
              qs[s2][0] = __builtin_fmaf(Q.wv[h], bflo(qv.x), qs[s2][0]); qs[s2][1] = __builtin_fmaf(Q.wv[h], bfhi(qv.x), qs[s2][1]);
              qs[s2][2] = __builtin_fmaf(Q.wv[h], bflo(qv.y), qs[s2][2]); qs[s2][3] = __builtin_fmaf(Q.wv[h], bfhi(qv.y), qs[s2][3]);
              qs[s2][4] = __builtin_fmaf(Q.wv[h], bflo(qv.z), qs[s2][4]); qs[s2][5] = __builtin_fmaf(Q.wv[h], bfhi(qv.z), qs[s2][5]);
              qs[s2][6] = __builtin_fmaf(Q.wv[h], bflo(qv.w), qs[s2][6]); qs[s2][7] = __builtin_fmaf(Q.wv[h], bfhi(qv.w), qs[s2][7]);
          }
#pragma unroll
      for (int s2 = 0; s2 < 2; ++s2) {
          u32x4 hv, lv; unsigned* hp = (unsigned*)&hv; unsigned* lp = (unsigned*)&lv;
#pragma unroll
          for (int j = 0; j < 4; ++j) {
              const unsigned hw = pk2(qs[s2][2 * j], qs[s2][2 * j + 1]);
              hp[j] = hw; lp[j] = pk2(qs[s2][2 * j] - bflo(hw), qs[s2][2 * j + 1] - bfhi(hw));
          }
          Q.qb[0][s2] = __builtin_bit_cast(bf16x8, hv); Q.qb[1][s2] = __builtin_bit_cast(bf16x8, lv);
      } }
    const bf16_t* kbase = KIDX + rowbase * 32;
    LAS unsigned* lcnt = (LAS unsigned*)(lds + L_LCNT); LAS unsigned* blist = (LAS unsigned*)(lds + L_LIST);
    unsigned short* mbase = (unsigned short*)MASK + ((size_t)b * att::MASK_TILES_PER_BATCH + att::mask_tile_off(qt)) * 64;
    unsigned tau = 0u;
    bool need_mask_pass = true;
    if (nkt * 32 > 256) {
        if (tid < 32) { spfx[tid] = 0u; sneed[tid] = 256; lcnt[tid] = 0u; }
        for (int pass = 0; pass < 3; ++pass) {
            { LAS u32x4* h4 = (LAS u32x4*)hist; for (int e = tid_now(wv); e < 32 * HROW / 4; e += 512) h4[e] = (u32x4){0u, 0u, 0u, 0u}; }
            asm volatile("s_waitcnt lgkmcnt(0)\n\ts_barrier" ::: "memory");
            { const int ln = lane_now(), lr = ln & 31;
              PassCtx C; C.kbase = kbase; C.hrow = hist + lr * HROW; C.lcnt_q = lcnt + lr; C.blist_q = blist + lr * LCAP; C.mbase = mbase; C.pfx = spfx[lr];
              C.lane = ln; C.r32 = lr; C.hi = ln >> 5; C.ktb = ktb; C.kte = kte;
              if (pass == 0) pass_loop<0>(C, Q); else if (pass == 1) pass_loop<1>(C, Q); else pass_loop<2>(C, Q); }
            asm volatile("s_waitcnt vmcnt(0) lgkmcnt(0)\n\ts_barrier" ::: "memory");
            const int nbits = (pass == 0) ? 10 : 11;
#pragma unroll 1
            for (int qi = 0; qi < 4; ++qi) {
                const int lane = lane_now();
                const int q = wid * 4 + qi; const LAS unsigned* hr = hist + q * HROW + 16 * lane;
                unsigned wv_[16]; int c = 0;
#pragma unroll
                for (int i = 0; i < 16; ++i) { wv_[i] = hr[i]; c += (pass == 0) ? (int)wv_[i] : (int)(wv_[i] & 0xffffu) + (int)(wv_[i] >> 16); }
                int sfx = c;
#pragma unroll
                for (int d = 1; d < 64; d <<= 1) { const int o = __shfl_down(sfx, d); sfx += (lane + d < 64) ? o : 0; }
                const int above = sfx - c, need = sneed[q];
                if (sfx >= need && above < need) {
                    int run = above, bstar = 0, nn = need; bool done = false;
                    if (pass == 0) {
#pragma unroll
                        for (int i = 15; i >= 0; --i) { const int ci = (int)wv_[i]; if (!done) { if (run + ci >= need) { bstar = 16 * lane + i; nn = need - run; done = true; } else run += ci; } }
                    } else {
#pragma unroll
                        for (int i = 15; i >= 0; --i) {
                            const int chi = (int)(wv_[i] >> 16), clo = (int)(wv_[i] & 0xffffu);
                            if (!done) { if (run + chi >= need) { bstar = 32 * lane + 2 * i + 1; nn = need - run; done = true; } else run += chi; }
                            if (!done) { if (run + clo >= need) { bstar = 32 * lane + 2 * i; nn = need - run; done = true; } else run += clo; }
                        }
                    }
                    spfx[q] = (spfx[q] << nbits) | (unsigned)bstar; sneed[q] = nn;
                }
            }
            asm volatile("s_waitcnt lgkmcnt(0)\n\ts_barrier" ::: "memory");
        }
        const int lane = lane_now(), r32 = lane & 31;
        tau = spfx[r32];
        const bool overflow = __any(lcnt[r32] > (unsigned)LCAP) != 0;
        if (!overflow) {
            need_mask_pass = false;
            const unsigned n = lcnt[r32], tq = tau & 2047u;
            for (unsigned i = 0; i < n; ++i) {
                const unsigned e = blist[r32 * LCAP + i]; const int ekt = (int)(e >> 21);
                if (((e >> 15) & 63u) == (unsigned)lane && ekt >= ktb && ekt < kte && (e & 2047u) >= tq) {
                    unsigned short* wp = mbase + (size_t)(ekt >> 1) * 128 + lane * 2 + (ekt & 1);
                    *wp = (unsigned short)(*wp | (1u << ((e >> 11) & 15u)));
                }
            }
        }
    }
#define IDX_MASK_BODY(K0, K1, KT) do { float acc[16]; score_tile(acc, K0, K1, Q); unsigned bits = 0u; \
        _Pragma("unroll") for (int r = 0; r < 16; ++r) bits |= (f2key(acc[r]) >= tau) ? (1u << r) : 0u; \
        mbase[(size_t)((KT) >> 1) * 128 + lane * 2 + ((KT) & 1)] = (unsigned short)bits; } while (0)
    if (need_mask_pass)
    { bf16x8 a0, a1, b0, b1, c0, c1;
      if (ktb < kte) IDX_KLOAD(a0, a1, ktb); if (ktb + 1 < kte) IDX_KLOAD(b0, b1, ktb + 1); if (ktb + 2 < kte) IDX_KLOAD(c0, c1, ktb + 2);
      for (int kt = ktb; kt < kte; kt += 3) {
          IDX_MASK_BODY(a0, a1, kt); if (kt + 3 < kte) IDX_KLOAD(a0, a1, kt + 3);
          if (kt + 1 < kte) { IDX_MASK_BODY(b0, b1, kt + 1); if (kt + 4 < kte) IDX_KLOAD(b0, b1, kt + 4); }
          if (kt + 2 < kte) { IDX_MASK_BODY(c0, c1, kt + 2); if (kt + 5 < kte) IDX_KLOAD(c0, c1, kt + 5); }
      } }
#undef IDX_MASK_BODY
    asm volatile("s_waitcnt lgkmcnt(0)\n\ts_barrier" ::: "memory");
}
#undef IDX_KLOAD

__device__ __forceinline__ void phase(const bf16_t* O1, const bf16_t* KIDX, unsigned* MASK, LAS unsigned char* lds, int G, int bid, int wv) {
    for (int p = bid; p < 512; p += G) {
        const int b = p & 3, j = p >> 2;
#pragma unroll 1
        for (int u2 = 0; u2 < 2; ++u2) unit(b, u2 ? 255 - j : j, O1, KIDX, MASK, lds, wv);
    }
}
}
struct Frame { LAS unsigned char* lds; int G, bid, wv; Ptrs p; };

__device__ __forceinline__ int win_dest_row(int n) {
    if (n < 672) return n;
    if (n < 3488) return n + 96;
    if (n < 3528) return n - 3488 + 672;
    return n + 56;
}
template <bool MAP>
__device__ __forceinline__ void transpose_item(const float* __restrict__ W, int K, int N, bf16_t* __restrict__ WT, const float* __restrict__ gk, LAS float* scr, int item, int lane) {
    const int nblk = (N + 31) / 32, kb = item / nblk, nb = item % nblk, k0 = 64 * kb, n0 = 32 * nb;
    const int nn = n0 + (lane & 31);
#pragma unroll 8
    for (int i = 0; i < 32; ++i) { const int kk = 2 * i + (lane >> 5); float v = 0.f; if (nn < N) v = W[(size_t)(k0 + kk) * N + nn]; if (gk) v *= gk[k0 + kk]; scr[kk * 33 + (lane & 31)] = v; }
    asm volatile("s_waitcnt lgkmcnt(0)" ::: "memory");
    const int c = lane & 7;
#pragma unroll
    for (int j = 0; j < 4; ++j) { const int n = (lane >> 3) + 8 * j; const LAS float* s = scr + (8 * c) * 33 + n;
        u32x4 o; o.x = pk2(s[0 * 33], s[1 * 33]); o.y = pk2(s[2 * 33], s[3 * 33]); o.z = pk2(s[4 * 33], s[5 * 33]); o.w = pk2(s[6 * 33], s[7 * 33]);
        if (n0 + n < N) { const int dr = MAP ? win_dest_row(n0 + n) : (n0 + n); *(u32x4*)(WT + (size_t)dr * K + k0 + 8 * c) = o; } }
    asm volatile("s_waitcnt lgkmcnt(0)" ::: "memory");
}

__device__ __forceinline__ void phase0(Frame& F) {
    const int t_ = tid_now(F.wv);
    const int tid = t_, lane = tid & 63; const int wave = F.wv; (void)tid; (void)lane; (void)wave;
    unsigned char* ws = F.p.ws;
    LAS float* scr = (LAS float*)(F.lds + wave * 16384);
    const int gw = F.bid * 8 + wave, NGW = F.G * 8;
    constexpr int I_IN = 16 * 175, I_UQ = 6 * 24, I_UKV = 4 * 32, I_OA = 8 * 32, I_OB = 8 * 32, I_OUT = 16 * 32;
    constexpr int NITEMS = I_IN + I_UQ + I_UKV + I_OA + I_OB + I_OUT;
    for (int it = gw; it < NITEMS; it += NGW) {
        int r = it;
        if (r < I_IN) { transpose_item<true>(F.p.w_in, 1024, NIN, (bf16_t*)(ws + WS_WINT), nullptr, scr, r, lane); continue; } r -= I_IN;
        if (r < I_UQ) { transpose_item<false>(F.p.w_uq, 384, 768, (bf16_t*)(ws + WS_WUQT), F.p.g_q, scr, r, lane); continue; } r -= I_UQ;
        if (r < I_UKV) { transpose_item<false>(F.p.w_ukv, 256, 1024, (bf16_t*)(ws + WS_WUKVT), F.p.g_kv, scr, r, lane); continue; } r -= I_UKV;
        if (r < I_OA) { transpose_item<false>(F.p.w_oa, 512, 1024, (bf16_t*)(ws + WS_WOAT), nullptr, scr, r, lane); continue; } r -= I_OA;
        if (r < I_OB) { transpose_item<false>(F.p.w_ob, 512, 1024, (bf16_t*)(ws + WS_WOBT), nullptr, scr, r, lane); continue; } r -= I_OB;
        transpose_item<false>(F.p.w_out, 1024, 1024, (bf16_t*)(ws + WS_WOUTT), nullptr, scr, r, lane);
    }
    { const int gt = F.bid * 512 + tid; if (gt < 7168) ((u32x4*)(ws + WS_WINT + (size_t)712 * 1024 * 2))[gt] = (u32x4){0u, 0u, 0u, 0u}; }
    for (int e = F.bid * 512 + tid; e < S * 16; e += F.G * 512) {
        const int pos = e >> 4, i = e & 15;
        const float freq = powf(10000.f, -(float)i / 16.f); const float ang = (float)pos * freq;
        ((float2*)(ws + WS_ROPE))[e] = make_float2(cosf(ang), sinf(ang));
    }
    bf16_t* H = (bf16_t*)(ws + WS_H);
    for (int row = gw; row < T; row += NGW) {
        const f32x4* xr = (const f32x4*)(F.p.x + (size_t)row * DM);
        f32x4 v[4]; float s = 0.f;
#pragma unroll
        for (int j = 0; j < 4; ++j) { v[j] = xr[lane + 64 * j]; s += (v[j][0] * v[j][0] + v[j][1] * v[j][1]) + (v[j][2] * v[j][2] + v[j][3] * v[j][3]); }
        s = wave_sum(s);
        const float r = rsqrtf(s * (1.f / DM) + 1e-6f);
#pragma unroll
        for (int j = 0; j < 4; ++j) {
            const f32x4 gg = ((const f32x4*)F.p.norm_g)[lane + 64 * j];
            uint2 o; o.x = pk2(v[j][0] * r * gg[0], v[j][1] * r * gg[1]); o.y = pk2(v[j][2] * r * gg[2], v[j][3] * r * gg[3]);
            ((uint2*)(H + (size_t)row * DM))[lane + 64 * j] = o;
        }
    }
}

__device__ __forceinline__ void phase1(Frame& F) {
    unsigned char* ws = F.p.ws;
    pg8::Gemm g{(const bf16_t*)(ws + WS_H), DM, (const bf16_t*)(ws + WS_WINT), T, LD1, DM, F.wv};
    pg8::StaticOrder So; So.init(T, LD1, F.G, F.bid);
    pg8::EpiIn E{(bf16_t*)(ws + WS_OUT1), (float*)(ws + WS_SSQLAT)};
    pg8::gemm_phase<pg8::EpiIn, pg8::StaticOrder, true, true>(F.lds, g, So, E);
}

__device__ __forceinline__ void phase1b(Frame& F) {
    const int t_ = tid_now(F.wv);
    const int tid = t_, lane = tid & 63; const int wave = F.wv; (void)tid; (void)lane; (void)wave;
    unsigned char* ws = F.p.ws;
    const bf16_t* O1 = (const bf16_t*)(ws + WS_OUT1);
    {
        bf16_t* KPE = (bf16_t*)(ws + WS_KPE); bf16_t* KIDX = (bf16_t*)(ws + WS_KIDX); const float2* rope = (const float2*)(ws + WS_ROPE);
        for (int e = F.bid * 512 + tid; e < T * 16; e += F.G * 512) {
            const int m = e >> 4, i = e & 15; const bf16_t* src = O1 + (size_t)m * LD1;
            const float2 cs = rope[(size_t)(m & (S - 1)) * 16 + i];
            const float x1 = bf2f(src[O_KROPE + i]), x2 = bf2f(src[O_KROPE + 16 + i]);
            KPE[(size_t)m * 32 + i] = f2bf(x1 * cs.x - x2 * cs.y); KPE[(size_t)m * 32 + 16 + i] = f2bf(x1 * cs.y + x2 * cs.x);
            KIDX[(size_t)m * 32 + i] = src[O_KIDX + i]; KIDX[(size_t)m * 32 + 16 + i] = src[O_KIDX + 16 + i];
        }
    }
    {
        pg8::Gemm g{O1 + O_QLAT, LD1, (const bf16_t*)(ws + WS_WUQT), T, 768, 384, F.wv};
        pg8::StaticOrder So; So.init(T, 768, F.G, F.bid);
        pg8::EpiQ E{(bf16_t*)(ws + WS_Q), (const float*)(ws + WS_SSQLAT), (const float2*)(ws + WS_ROPE)};
        pg8::gemm_phase<pg8::EpiQ, pg8::StaticOrder, true, true>(F.lds, g, So, E);
    }
    {
        pg8::Gemm g{O1 + O_CKV, LD1, (const bf16_t*)(ws + WS_WUKVT), T, 1024, 256, F.wv};
        pg8::StaticOrder So; So.init(T, 1024, F.G, F.bid);
        pg8::EpiKV E{(bf16_t*)(ws + WS_H), (const float*)(ws + WS_SSQLAT)};
        pg8::gemm_phase<pg8::EpiKV, pg8::StaticOrder, true, true>(F.lds, g, So, E);
    }
}

__device__ __forceinline__ void phase4ab(Frame& F) {
    unsigned char* ws = F.p.ws;
    const bf16_t* O1 = (const bf16_t*)(ws + WS_OUT1); bf16_t* MG = (bf16_t*)(ws + WS_H);
    {
        pg8::Gemm g{O1 + O_ZA, LD1, (const bf16_t*)(ws + WS_WOAT), T, 1024, 512, F.wv};
        pg8::StaticOrder So; So.init(T, 1024, F.G, F.bid);
        pg8::EpiGate<false> E{MG, O1, O_GA};
        pg8::gemm_phase<pg8::EpiGate<false>, pg8::StaticOrder, true, true>(F.lds, g, So, E);
    }
    {
        pg8::Gemm g{O1 + O_ZB, LD1, (const bf16_t*)(ws + WS_WOBT), T, 1024, 512, F.wv};
        pg8::StaticOrder So; So.init(T, 1024, F.G, F.bid);
        pg8::EpiGate<true> E{MG, O1, O_GB};
        pg8::gemm_phase<pg8::EpiGate<true>, pg8::StaticOrder, true, true>(F.lds, g, So, E);
    }
}

__device__ __forceinline__ void phase4c(Frame& F) {
    unsigned char* ws = F.p.ws;
    pg8::Gemm g{(const bf16_t*)(ws + WS_H), DM, (const bf16_t*)(ws + WS_WOUTT), T, 1024, 1024, F.wv};
    pg8::StaticOrder So; So.init(T, 1024, F.G, F.bid);
    pg8::EpiOut E{F.p.x, F.p.out, (float*)(ws + WS_SSQO)};
    pg8::gemm_phase<pg8::EpiOut, pg8::StaticOrder, true, true>(F.lds, g, So, E);
}

__device__ __forceinline__ void phase5(Frame& F) {
    const int t_ = tid_now(F.wv);
    const int tid = t_, lane = tid & 63; const int wave = F.wv; (void)tid; (void)lane; (void)wave;
    const float* ssqo = (const float*)(F.p.ws + WS_SSQO);
    const int gw = F.bid * 8 + wave, NGW = F.G * 8;
    for (int row = gw; row < T; row += NGW) {
        float s = (lane < 32) ? ssqo[(size_t)row * 32 + lane] : 0.f;
        s = wave_sum(s);
        const float r = rsqrtf(s * (1.f / DM) + 1e-6f);
        f32x4* xr = (f32x4*)(F.p.out + (size_t)row * DM);
#pragma unroll
        for (int j = 0; j < 4; ++j) { const f32x4 gg = ((const f32x4*)F.p.final_g)[lane + 64 * j]; xr[lane + 64 * j] = xr[lane + 64 * j] * r * gg; }
    }
}

__device__ __forceinline__ void phase_mla(Frame& F, bool dry = false) {
    unsigned char* ws = F.p.ws;
    att::Tensors X{};
    X.Q = (const bf16_t*)(ws + WS_Q); X.ldq = 768; X.hq = 96;
    X.K0 = (const bf16_t*)(ws + WS_H); X.ldk = 1024; X.hk = 128; X.K1 = (const bf16_t*)(ws + WS_KPE);
    X.V = (const bf16_t*)(ws + WS_H) + 64; X.ldv = 1024; X.hv = 128;
    X.O = (bf16_t*)(ws + WS_OUT1) + O_ZA; X.ldo = LD1; X.mask = nullptr; X.rel_bias = nullptr;
    X.wv = F.wv;
    att::phase<false>(X, F.lds, F.G, F.bid, dry);
}
__device__ __forceinline__ void phase_dsa(Frame& F, bool dry = false) {
    unsigned char* ws = F.p.ws; bf16_t* O1 = (bf16_t*)(ws + WS_OUT1);
    att::Tensors X{};
    X.Q = O1 + O_QB; X.ldq = LD1; X.hq = 64;
    X.K0 = O1 + O_KB; X.ldk = LD1; X.hk = 64; X.K1 = nullptr;
    X.V = O1 + O_VB; X.ldv = LD1; X.hv = 64;
    X.O = O1 + O_ZB; X.ldo = LD1; X.mask = (const unsigned long long*)(ws + WS_MASK); X.rel_bias = F.p.rel_bias;
    X.wv = F.wv;
    att::phase<true>(X, F.lds, F.G, F.bid, dry);
}

__device__ __forceinline__ void phase_idx(Frame& F) {
    unsigned char* ws = F.p.ws;
    idx::phase((const bf16_t*)(ws + WS_OUT1), (const bf16_t*)(ws + WS_KIDX), (unsigned*)(ws + WS_MASK), F.lds, F.G, F.bid, F.wv);
}

typedef unsigned long long u64_t;
#define XB_TMO      128
#define XB_XCNT(j)  (256  + 64 * (j))
#define XB_XSUB(j)  (1280 + 64 * (j))
#define XB_XGEN(j)  (2304 + 64 * (j))
#define XB_TOP      3328
#define XB_TOPGEN   3392
#define XCD_BAR_WORDS 3456
#define XB_SPIN_CAP (1u << 18)

__device__ __forceinline__ unsigned xb_ld(unsigned* p)              { return __hip_atomic_load(p, __ATOMIC_RELAXED, __HIP_MEMORY_SCOPE_AGENT); }
__device__ __forceinline__ unsigned xb_add(unsigned* p, unsigned v) { return __hip_atomic_fetch_add(p, v, __ATOMIC_RELAXED, __HIP_MEMORY_SCOPE_AGENT); }
__device__ __forceinline__ unsigned xb_xcc_id() { return (unsigned)__builtin_amdgcn_s_getreg((3 << 11) | 20) & 0xFu; }
#define XB_SPIN(cond, bar) do { unsigned _sp = 0; while (cond) { __builtin_amdgcn_s_sleep(1); \
    if ((++_sp & 255u) == 0u) { if (xb_ld(&(bar)[XB_TMO])) break; if (_sp > XB_SPIN_CAP) { atomicAdd(&(bar)[XB_TMO], 1u); break; } } } } while (0)

struct XcdBarrier {
    unsigned* bar; unsigned x; int wv;
    volatile LAS unsigned* st;
};

__device__ __forceinline__ XcdBarrier xcd_barrier_post(unsigned* bar, volatile LAS unsigned* st, int wv) {
    XcdBarrier b; b.bar = bar; b.x = xb_xcc_id(); b.st = st; b.wv = wv;
    if (threadIdx.x == 0) (void)xb_add(&bar[XB_XCNT(b.x)], 1u);
    return b;
}
__device__ __forceinline__ void xcd_barrier_complete(unsigned* bar, unsigned x, unsigned& nloc, unsigned& nx) {
    const unsigned G = gridDim.x * gridDim.y * gridDim.z;
    unsigned sum, cnt, mine, sp = 0u;
    for (;;) {
        sum = 0u; cnt = 0u; mine = 0u;
#pragma unroll
        for (unsigned j = 0; j < 16; ++j) { const unsigned c = xb_ld(&bar[XB_XCNT(j)]); sum += c; cnt += (c > 0u) ? 1u : 0u; mine = (j == x) ? c : mine; }
        if (sum == G) break;
        __builtin_amdgcn_s_sleep(1);
        if ((++sp & 255u) == 0u) { if (xb_ld(&bar[XB_TMO])) break; if (sp > XB_SPIN_CAP) { atomicAdd(&bar[XB_TMO], 1u); break; } }
    }
    nloc = mine > 0u ? mine : 1u; nx = cnt > 0u ? cnt : 1u;
}

__device__ __forceinline__ void xcd_barrier(const XcdBarrier& b) {
    asm volatile("s_waitcnt vmcnt(0)" ::: "memory");
    __syncthreads();
    if (b.wv == 0 && lane_now() == 0) {
        unsigned* bar = b.bar;
        __builtin_amdgcn_s_waitcnt(0);
        unsigned nloc = b.st[0], nx = b.st[1];
        if (nloc == 0u) { xcd_barrier_complete(bar, b.x, nloc, nx); b.st[0] = nloc; b.st[1] = nx; }
        const unsigned old = xb_add(&bar[XB_XSUB(b.x)], 1u);
        const unsigned gen = old / nloc;
        if (old + 1u == (gen + 1u) * nloc) {
            __builtin_amdgcn_fence(__ATOMIC_RELEASE, "agent");
            asm volatile("s_waitcnt vmcnt(0)" ::: "memory");
            const unsigned og = xb_add(&bar[XB_TOP], 1u);
            const unsigned tg = og / nx;
            if (og + 1u == (tg + 1u) * nx) xb_add(&bar[XB_TOPGEN], 1u);
            else XB_SPIN(xb_ld(&bar[XB_TOPGEN]) == tg, bar);
            __builtin_amdgcn_fence(__ATOMIC_ACQUIRE, "agent");
            xb_add(&bar[XB_XGEN(b.x)], 1u);
            asm volatile("s_waitcnt vmcnt(0)" ::: "memory");
        } else {
            XB_SPIN(xb_ld(&bar[XB_XGEN(b.x)]) == gen, bar);
            __builtin_amdgcn_fence(__ATOMIC_ACQUIRE, "agent");
            asm volatile("s_waitcnt vmcnt(0)" ::: "memory");
        }
    }
    __syncthreads();
}

constexpr int CW_BAR = 4096;
constexpr size_t CTL_ZERO_BYTES = 65536;
constexpr int LDS_MISC = 135680;
struct Args { Ptrs p; int ph_lo, ph_hi; };
__global__ void __launch_bounds__(512, 2) mega_fwd(Args a) {
    extern __shared__ __attribute__((aligned(16))) unsigned char lds_raw[];
    Frame F; F.lds = (LAS unsigned char*)lds_raw;
    F.G = gridDim.x; F.bid = blockIdx.x; F.p = a.p;
    cooperative_groups::grid_group grid = cooperative_groups::this_grid();
    volatile LAS unsigned* st = (volatile LAS unsigned*)(F.lds + LDS_MISC);
    if (threadIdx.x < 4) st[threadIdx.x] = 0u;
    F.wv = __builtin_amdgcn_readfirstlane((int)(threadIdx.x >> 6));
    __syncthreads();
    const XcdBarrier bar = xcd_barrier_post((unsigned*)(a.p.ws + WS_CTL) + CW_BAR, st, F.wv);
    const int lo = a.ph_lo, hi = a.ph_hi;
#define RUN(k, body, CG) do { if (lo <= (k) && (k) < hi) { body; if ((k) + 1 < hi) { if (CG) grid.sync(); else xcd_barrier(bar); } } } while (0)
    const bool dryrun = (a.ph_hi > 0);
    RUN(0, { phase0(F); if (PROBE_DUP == 0) phase0(F); }, true);
    RUN(1, { phase1(F); if (PROBE_DUP == 1) phase1(F); }, false);
    RUN(2, { phase1b(F); if (PROBE_DUP == 2) phase1b(F); }, false);
    RUN(3, { phase_mla(F); if (PROBE_DUP == 3) phase_mla(F, dryrun); phase_idx(F); if (PROBE_DUP == 8) phase_idx(F); }, false);
    RUN(4, { phase_dsa(F); if (PROBE_DUP == 4) phase_dsa(F, dryrun); }, false);
    RUN(5, { phase4ab(F); if (PROBE_DUP == 5) phase4ab(F); }, false);
    RUN(6, { phase4c(F); if (PROBE_DUP == 6) phase4c(F); }, false);
    RUN(7, phase5(F), false);
#undef RUN
}

extern "C" void kernel_launch(void* const* d_in, const int* in_sizes, int n_in, void* d_out, int out_size, void* d_ws, size_t ws_size, hipStream_t stream) {
    static int grid = 0;
    if (grid == 0) {
        if (ws_size < WS_END) { fprintf(stderr, "kernel_launch: workspace too small: %zu < %zu\n", ws_size, (size_t)WS_END); grid = -1; return; }
        int dev = 0, cus = 0, per_cu = 0;
        if (hipGetDevice(&dev) != hipSuccess || hipDeviceGetAttribute(&cus, hipDeviceAttributeMultiprocessorCount, dev) != hipSuccess) { grid = -1; return; }
        if (hipFuncSetAttribute((const void*)mega_fwd, hipFuncAttributeMaxDynamicSharedMemorySize, LDS_BYTES) != hipSuccess) { fprintf(stderr, "kernel_launch: hipFuncSetAttribute failed\n"); grid = -1; return; }
        if (hipOccupancyMaxActiveBlocksPerMultiprocessor(&per_cu, (const void*)mega_fwd, 512, LDS_BYTES) != hipSuccess || per_cu < 1) { fprintf(stderr, "kernel_launch: occupancy query failed (%d)\n", per_cu); (void)hipGetLastError(); grid = -1; return; }
        grid = cus;
    }
    if (grid < 0) return;
    if (hipMemsetAsync((char*)d_ws + WS_CTL, 0, CTL_ZERO_BYTES, stream) != hipSuccess) { fprintf(stderr, "kernel_launch: hipMemsetAsync failed\n"); return; }
    Args a{};
    a.p.x = (const float*)d_in[0]; a.p.norm_g = (const float*)d_in[1]; a.p.w_in = (const float*)d_in[2]; a.p.g_q = (const float*)d_in[3]; a.p.w_uq = (const float*)d_in[4];
    a.p.g_kv = (const float*)d_in[5]; a.p.w_ukv = (const float*)d_in[6]; a.p.w_oa = (const float*)d_in[7]; a.p.w_ob = (const float*)d_in[8]; a.p.w_out = (const float*)d_in[9];
    a.p.rel_bias = (const float*)d_in[10]; a.p.final_g = (const float*)d_in[11]; a.p.out = (float*)d_out; a.p.ws = (unsigned char*)d_ws;
    a.ph_lo = 0; a.ph_hi = 8;
    void* args[] = {&a};
    const hipError_t e = hipLaunchCooperativeKernel((const void*)mega_fwd, dim3(grid), dim3(512), args, LDS_BYTES, stream);
    if (e != hipSuccess) fprintf(stderr, "kernel_launch: cooperative launch failed: %s (grid %d)\n", hipGetErrorString(e), grid);
}
```

```cpp
#include <hip/hip_runtime.h>
#include <hip/hip_cooperative_groups.h>
#include <stdint.h>
#include <stdio.h>
#ifndef PROBE_DUP
#define PROBE_DUP -1
#endif

__device__ __forceinline__ int lane_now() { int l; asm volatile("v_mbcnt_lo_u32_b32 %0, -1, 0\n\tv_mbcnt_hi_u32_b32 %0, -1, %0" : "=v"(l)); return l; }
__device__ __forceinline__ int tid_now(int wv) { return (wv << 6) | lane_now(); }

namespace pg8 {
#define PG8_LAS __attribute__((address_space(3)))
typedef unsigned short bf16_t;
typedef short bf16x8 __attribute__((ext_vector_type(8)));
typedef float f32x4 __attribute__((ext_vector_type(4)));
typedef unsigned u32x4 __attribute__((ext_vector_type(4)));
constexpr int BM = 256, BK = 64, HALF = 128, HTB = HALF * BK * 2  , STAGE_BYTES = 8 * HTB, NXCD = 8, WGM = 8;

__host__ __device__ __forceinline__ int lds_byte(int r, int c) { const int st = (r >> 4) * 2 + (c >> 5), rr = r & 15, cc = c & 31, ob = rr * 64 + cc * 2; return st * 1024 + (ob ^ (((ob >> 9) & 1) << 5)); }
__host__ __device__ __forceinline__ void stage_rc(int b, int& R, int& C) { const int st = b / 1024, sb = b % 1024, swz = sb ^ (((sb >> 9) & 1) << 5); R = (st >> 1) * 16 + swz / 64; C = (st & 1) * 32 + (swz % 64) / 2; }
__host__ __device__ __forceinline__ int perm32(int rho) { const int n = rho >> 4, i = rho & 15; return 8 * (i >> 2) + 4 * n + (i & 3); }

struct Unit { int pm, pn; };
struct Gemm { const bf16_t* A; int lda; const bf16_t* Bt; int M, N, K; int wv; };

struct StaticOrder {
    int nM, nN, nwg, G, c;
    __host__ __device__ void init(int M, int N, int G_, int c_) { nM = M / BM; nN = N / BM; nwg = nM * nN; G = G_; c = c_; }
    __host__ __device__ bool next(int i, Unit& u) const {
        const long L = (long)i * G + c; if (L >= nwg) return false;
        int wgid = (int)L; { const int q = nwg / NXCD, r = nwg % NXCD, xcd = wgid % NXCD, off = wgid / NXCD; wgid = (xcd < r ? xcd * (q + 1) : r * (q + 1) + (xcd - r) * q) + off; }
        const int nig = WGM * nN, gid = wgid / nig, fm = gid * WGM, gsz = (nM - fm) < WGM ? (nM - fm) : WGM;
        u.pm = fm + ((wgid % nig) % gsz); u.pn = (wgid % nig) / gsz; return true;
    }
    __device__ __forceinline__ void a_ready(const Unit&) const {}
    __device__ __forceinline__ void done(const Unit&) const {}
};
struct SameTileOrder {
    StaticOrder S;
    __host__ __device__ bool next(int i, Unit& u) const { const bool ok = S.next(i, u); u.pm = 0; u.pn = 0; return ok; }
    __device__ __forceinline__ void a_ready(const Unit&) const {}
    __device__ __forceinline__ void done(const Unit&) const {}
};

typedef __bf16 bf16x2_t __attribute__((ext_vector_type(2)));
typedef float f32x2_t __attribute__((ext_vector_type(2)));
__device__ __forceinline__ unsigned cvt_pk_bf16(float lo, float hi) { const f32x2_t v = {lo, hi}; return __builtin_bit_cast(unsigned, __builtin_convertvector(v, bf16x2_t)); }
template <class Epi, class Sched, bool ALIGN_EPI = false, bool SP2 = false>
__device__ __forceinline__ void gemm_phase(PG8_LAS unsigned char* lds, const Gemm g, const Sched& S, const Epi& E) {
    const int tid_ = tid_now(g.wv);
    const int tid = tid_, wid = g.wv, lane = tid & 63, wr = wid >> 2, wc = wid & 3, fr = lane & 15, fq = lane >> 4;
    int K_ = g.K; if (g.K < 1024) asm volatile("" : "+s"(K_));
    const int K = K_, nt = K / BK;
    unsigned voffA[2], voffB[2];
#pragma unroll
    for (int i = 0; i < 2; ++i) { int R, C; stage_rc(tid * 16 + i * 8192, R, C); const int Rb = Epi::PERM ? ((R & ~31) + perm32(R & 31)) : R;
        voffA[i] = (unsigned)(R * g.lda + C) * 2u; voffB[i] = (unsigned)(Rb * K + C) * 2u; }
    const size_t kstep = (size_t)(BK * 2);
    const size_t hstepA = (size_t)HALF * g.lda * 2, hstepB = (size_t)HALF * K * 2;
    const size_t tstepA = 2 * hstepA, tstepB = 2 * hstepB;
    const unsigned ldsw = (unsigned)wid * 1024u;
    const int aoff = lds_byte(wr * 64 + fr, fq * 8), boff = lds_byte(wc * 32 + fr, fq * 8);
#define PG8_SA(b, h) (((b) * 2 + (h)) * HTB)
#define PG8_SB(b, h) ((4 + (b) * 2 + (h)) * HTB)
#define PG8_STAGE(bufoff, gbase, voff) do { _Pragma("unroll") for (int _i = 0; _i < 2; ++_i) \
        __builtin_amdgcn_global_load_lds((const unsigned*)((const char*)(gbase) + (voff)[_i]), (PG8_LAS unsigned*)(lds + (bufoff) + ldsw + _i * 8192), 16, 0, 0); } while (0)
#define PG8_LDA(dst, b, h) do { _Pragma("unroll") for (int m = 0; m < 4; ++m) _Pragma("unroll") for (int k = 0; k < 2; ++k) dst[m][k] = *(const PG8_LAS bf16x8*)(lds + PG8_SA(b, h) + aoff + m * 2048 + k * 1024); } while (0)
#define PG8_LDB(dst, b, h) do { _Pragma("unroll") for (int n = 0; n < 2; ++n) _Pragma("unroll") for (int k = 0; k < 2; ++k) dst[n][k] = *(const PG8_LAS bf16x8*)(lds + PG8_SB(b, h) + boff + n * 2048 + k * 1024); } while (0)
#define PG8_MMA(ai, bj, At, Bt) do { __builtin_amdgcn_s_setprio(1); _Pragma("unroll") for (int m = 0; m < 4; ++m) _Pragma("unroll") for (int n = 0; n < 2; ++n) _Pragma("unroll") for (int k = 0; k < 2; ++k) \
        acc[ai][bj][m][n] = __builtin_amdgcn_mfma_f32_16x16x32_bf16(Bt[n][k], At[m][k], acc[ai][bj][m][n], 0, 0, 0); __builtin_amdgcn_s_setprio(0); } while (0)
#define PG8_WAIT_V(n) asm volatile("s_waitcnt vmcnt(" #n ")" ::: "memory")
#define PG8_WAIT_L(n) asm volatile("s_waitcnt lgkmcnt(" #n ")" ::: "memory")
#define PG8_BAR __builtin_amdgcn_s_barrier()
#define PG8_SCHED __builtin_amdgcn_sched_barrier(0)
    Unit cur, nxt; int ui = 0;
    if (!S.next(0, cur)) return;
    f32x4 acc[2][2][4][2];
#pragma unroll
    for (int a = 0; a < 2; ++a)
#pragma unroll
        for (int b = 0; b < 2; ++b)
#pragma unroll
            for (int m = 0; m < 4; ++m)
#pragma unroll
                for (int n = 0; n < 2; ++n) acc[a][b][m][n] = (f32x4){0.f, 0.f, 0.f, 0.f};
    bf16x8 At[4][2], B0[2][2], B1[2][2];
    const char* cA = (const char*)g.A + (size_t)cur.pm * tstepA; const char* cB = (const char*)g.Bt + (size_t)cur.pn * tstepB;
    S.a_ready(cur);
    if constexpr (SP2) {
        PG8_STAGE(PG8_SB(0, 0), cB, voffB); PG8_STAGE(PG8_SB(0, 1), cB + hstepB, voffB); PG8_STAGE(PG8_SA(0, 0), cA, voffA); PG8_STAGE(PG8_SA(0, 1), cA + hstepA, voffA);
        if (wr == 1) PG8_BAR;
        PG8_WAIT_V(2); PG8_BAR;
        PG8_STAGE(PG8_SB(1, 0), cB + kstep, voffB); PG8_STAGE(PG8_SA(1, 0), cA + kstep, voffA); PG8_STAGE(PG8_SB(1, 1), cB + hstepB + kstep, voffB);
        PG8_WAIT_V(6); PG8_BAR;
    } else {
        PG8_STAGE(PG8_SB(0, 0), cB, voffB); PG8_STAGE(PG8_SA(0, 0), cA, voffA); PG8_STAGE(PG8_SB(0, 1), cB + hstepB, voffB); PG8_STAGE(PG8_SA(0, 1), cA + hstepA, voffA);
        if (wr == 1) PG8_BAR;
        PG8_WAIT_V(4); PG8_BAR;
        PG8_STAGE(PG8_SB(1, 0), cB + kstep, voffB); PG8_STAGE(PG8_SA(1, 0), cA + kstep, voffA); PG8_STAGE(PG8_SB(1, 1), cB + hstepB + kstep, voffB);
        PG8_WAIT_V(6); PG8_BAR;
    }
    for (;;) {
        const bool has_next = S.next(ui + 1, nxt);
        const char* nA = has_next ? (const char*)g.A + (size_t)nxt.pm * tstepA : cA; const char* nB = has_next ? (const char*)g.Bt + (size_t)nxt.pn * tstepB : cB;
        for (int t = 0; t < nt; t += 2) {
            const bool last = (t == nt - 2);
            const char* a1 = cA + (size_t)(t + 1) * kstep;
            const char* a2 = last ? nA : cA + (size_t)(t + 2) * kstep; const char* b2 = last ? nB : cB + (size_t)(t + 2) * kstep;
            const char* a3 = a2 + kstep; const char* b3 = b2 + kstep;
            if (last && has_next) S.a_ready(nxt);
            if constexpr (SP2) {
            PG8_LDB(B0, 0, 0); PG8_LDB(B1, 0, 1); PG8_SCHED; PG8_LDA(At, 0, 0); PG8_STAGE(PG8_SA(1, 1), a1 + hstepA, voffA);
            PG8_WAIT_V(8); PG8_WAIT_L(0); PG8_BAR; PG8_MMA(0, 0, At, B0); PG8_MMA(0, 1, At, B1); PG8_BAR; PG8_SCHED;
            PG8_LDA(At, 0, 1); PG8_STAGE(PG8_SB(0, 0), b2, voffB); PG8_STAGE(PG8_SB(0, 1), b2 + hstepB, voffB); PG8_STAGE(PG8_SA(0, 0), a2, voffA);
            PG8_WAIT_V(8); PG8_WAIT_L(0); PG8_BAR; PG8_MMA(1, 0, At, B0); PG8_MMA(1, 1, At, B1); PG8_BAR; PG8_SCHED;
            PG8_LDB(B0, 1, 0); PG8_LDB(B1, 1, 1); PG8_SCHED; PG8_LDA(At, 1, 0); PG8_STAGE(PG8_SA(0, 1), a2 + hstepA, voffA);
            PG8_WAIT_V(8); PG8_WAIT_L(0); PG8_BAR; PG8_MMA(0, 0, At, B0); PG8_MMA(0, 1, At, B1); PG8_BAR; PG8_SCHED;
            PG8_LDA(At, 1, 1); PG8_STAGE(PG8_SB(1, 0), b3, voffB); PG8_STAGE(PG8_SB(1, 1), b3 + hstepB, voffB); PG8_STAGE(PG8_SA(1, 0), a3, voffA);
            PG8_WAIT_V(8); PG8_WAIT_L(0); PG8_BAR; PG8_MMA(1, 0, At, B0); PG8_MMA(1, 1, At, B1); PG8_BAR; PG8_SCHED;
            } else {
            PG8_LDB(B0, 0, 0); PG8_SCHED; PG8_LDA(At, 0, 0); PG8_STAGE(PG8_SA(1, 1), a1 + hstepA, voffA);
            PG8_WAIT_L(8); PG8_BAR; PG8_WAIT_L(0); PG8_MMA(0, 0, At, B0); PG8_BAR; PG8_SCHED;
            PG8_LDB(B1, 0, 1); PG8_STAGE(PG8_SB(0, 0), b2, voffB);
            PG8_BAR; PG8_WAIT_L(0); PG8_MMA(0, 1, At, B1); PG8_BAR;
            PG8_LDA(At, 0, 1); PG8_STAGE(PG8_SA(0, 0), a2, voffA);
            PG8_BAR; PG8_WAIT_L(0); PG8_MMA(1, 0, At, B0); PG8_BAR; PG8_SCHED;
            PG8_STAGE(PG8_SB(0, 1), b2 + hstepB, voffB);
            PG8_WAIT_V(6); PG8_BAR; PG8_MMA(1, 1, At, B1); PG8_BAR;
            PG8_LDB(B0, 1, 0); PG8_SCHED; PG8_LDA(At, 1, 0); PG8_STAGE(PG8_SA(0, 1), a2 + hstepA, voffA);
            PG8_WAIT_L(8); PG8_BAR; PG8_WAIT_L(0); PG8_MMA(0, 0, At, B0); PG8_BAR; PG8_SCHED;
            PG8_LDB(B1, 1, 1); PG8_STAGE(PG8_SB(1, 0), b3, voffB);
            PG8_BAR; PG8_WAIT_L(0); PG8_MMA(0, 1, At, B1); PG8_BAR;
            PG8_LDA(At, 1, 1); PG8_STAGE(PG8_SA(1, 0), a3, voffA);
            PG8_BAR; PG8_WAIT_L(0); PG8_MMA(1, 0, At, B0); PG8_BAR; PG8_SCHED;
            PG8_STAGE(PG8_SB(1, 1), b3 + hstepB, voffB);
            PG8_WAIT_V(6); PG8_BAR; PG8_MMA(1, 1, At, B1); PG8_BAR;
            }
        }
        if constexpr (ALIGN_EPI) { if (wr == 0) PG8_BAR; }
        if constexpr (!Epi::AFTER_DRAIN) { E(acc, cur, wr, wc, fr, fq); S.done(cur); }
        if (!has_next) break;
#pragma unroll
        for (int a = 0; a < 2; ++a)
#pragma unroll
            for (int b = 0; b < 2; ++b)
#pragma unroll
                for (int m = 0; m < 4; ++m)
#pragma unroll
                    for (int n = 0; n < 2; ++n) acc[a][b][m][n] = (f32x4){0.f, 0.f, 0.f, 0.f};
        cur = nxt; cA = nA; cB = nB; ++ui;
        if constexpr (ALIGN_EPI) { if (wr == 1) PG8_BAR; }
    }
    PG8_WAIT_V(0);
    if constexpr (!ALIGN_EPI) { if (wr == 0) PG8_BAR; }
    PG8_BAR;
    if constexpr (Epi::AFTER_DRAIN) { E.fused(acc, cur, wr, wc, fr, fq, lds, wid, lane); S.done(cur); }
#undef PG8_SA
#undef PG8_SB
#undef PG8_STAGE
#undef PG8_LDA
#undef PG8_LDB
#undef PG8_MMA
#undef PG8_WAIT_V
#undef PG8_WAIT_L
#undef PG8_BAR
#undef PG8_SCHED
}
}

typedef unsigned short bf16_t;
typedef float f32x4 __attribute__((ext_vector_type(4)));
typedef unsigned u32x4 __attribute__((ext_vector_type(4)));
#define LAS __attribute__((address_space(3)))
constexpr int NB = 4, S = 8192, DM = 1024, T = NB * S;
constexpr int NIN = 5576;
constexpr int LD1 = 5632;
constexpr int O_QLAT = 0, O_CKV = 384, O_KROPE = 640, O_KIDX = 672, O_WIDX = 704, O_ZA = 768, O_QB = 1280, O_KB = 1792, O_VB = 2304, O_ZB = 2816,
              O_QIDX = 3328, O_GA = 3584, O_GB = 4608;
constexpr size_t MiB = 1u << 20;
constexpr size_t WS_CTL = 0, WS_WUQT = 1 * MiB, WS_WUKVT = 2 * MiB, WS_WOAT = 3 * MiB, WS_WOBT = 4 * MiB, WS_WOUTT = 5 * MiB, WS_ROPE = 7 * MiB,
                 WS_WINT = 8 * MiB, WS_SSQO = 8 * MiB  , WS_SSQLAT = 19 * MiB, WS_KPE = 22 * MiB, WS_KIDX = 24 * MiB, WS_MASK = 26 * MiB,
                 WS_H = 44 * MiB  , WS_Q = 108 * MiB, WS_OUT1 = 156 * MiB, WS_END = 508 * MiB;
constexpr float LOG2E = 1.4426950408889634f;
constexpr float QSCALE_A = 0.10206207261596577f * LOG2E;
constexpr float QSCALE_B = 0.125f * LOG2E;
constexpr int GEMM_LDS = 131072;
constexpr int LDS_BYTES = 155648;
#ifndef FUSE_AFTER_DRAIN
#define FUSE_AFTER_DRAIN 0
#endif
#ifndef DEBUG_FUSE
#define DEBUG_FUSE 0
#endif
#ifndef FUSE_FINAL_NORM
#define FUSE_FINAL_NORM 1
#endif
constexpr int CW_PANEL = 8192, CW_TMO = 4096 + 128;
#ifndef MIX_ORDER
#define MIX_ORDER 0
#endif
#ifndef P1_STAGGER_TICKS
#define P1_STAGGER_TICKS 0
#endif

__device__ __forceinline__ float bf2f(bf16_t v) { return __uint_as_float(((unsigned)v) << 16); }
__device__ __forceinline__ bf16_t f2bf(float f) { unsigned u = __float_as_uint(f); return (bf16_t)((u + 0x7fffu + ((u >> 16) & 1u)) >> 16); }
__device__ __forceinline__ unsigned pk2(float lo, float hi) { return (unsigned)f2bf(lo) | ((unsigned)f2bf(hi) << 16); }
__device__ __forceinline__ float bflo(unsigned w) { return __uint_as_float(w << 16); }
__device__ __forceinline__ float bfhi(unsigned w) { return __uint_as_float(w & 0xffff0000u); }
__device__ __forceinline__ float wave_sum(float v) {
#pragma unroll
    for (int o = 1; o < 64; o <<= 1) v += __shfl_xor(v, o);
    return v;
}
__device__ __forceinline__ float sigmoidf_(float x) { return __builtin_amdgcn_rcpf(1.f + __builtin_amdgcn_exp2f(-LOG2E * x)); }

struct Ptrs {
    const float *x, *norm_g, *w_in, *g_q, *w_uq, *g_kv, *w_ukv, *w_oa, *w_ob, *w_out, *rel_bias, *final_g;
    float* out; unsigned char* ws;
};

namespace pg8 {
struct EpiIn {
    static constexpr bool PERM = true, AFTER_DRAIN = false;
    bf16_t* O; float* ssq; int dry;
    __device__ __forceinline__ void operator()(const f32x4 (&acc)[2][2][4][2], const Unit& u, int wr, int wc, int, int) const {
        const int t_ = lane_now();
        const int fr = t_ & 15, fq = (t_ >> 4) & 3;
        if ((PROBE_DUP >= 11 && PROBE_DUP <= 14) && dry) { f32x4 s4 = {0.f, 0.f, 0.f, 0.f};
#pragma unroll
            for (int a = 0; a < 2; ++a)
#pragma unroll
                for (int b = 0; b < 2; ++b)
#pragma unroll
                    for (int m = 0; m < 4; ++m) { s4 += acc[a][b][m][0]; s4 += acc[a][b][m][1]; }
            if (s4[0] + s4[1] + s4[2] + s4[3] == 1.2345e30f) O[0] = 0; return; }
        const int row0 = u.pm * BM + wr * 64 + fr;
#pragma unroll
        for (int bj = 0; bj < 2; ++bj) {
            const int g = u.pn * 2 + bj;
            const int col0 = g * 128 + wc * 32 + 8 * fq;
            int op = 0;
            if ((g >= 6 && g <= 9) || (g >= 22 && g <= 25)) op = 1; else if (g >= 28) op = 2; else if (g >= 10 && g <= 13) op = 3; else if (g <= 4) op = 4;
#pragma unroll
            for (int ai = 0; ai < 2; ++ai)
#pragma unroll
                for (int m = 0; m < 4; ++m) {
                    const int row = row0 + ai * HALF + m * 16;
                    f32x4 v0 = acc[ai][bj][m][0], v1 = acc[ai][bj][m][1];
                    if (op == 1) {
#pragma unroll
                        for (int e = 0; e < 4; ++e) { v0[e] = v0[e] * sigmoidf_(v0[e]); v1[e] = v1[e] * sigmoidf_(v1[e]); }
                    } else if (op == 2) {
#pragma unroll
                        for (int e = 0; e < 4; ++e) { v0[e] = sigmoidf_(v0[e]); v1[e] = sigmoidf_(v1[e]); }
                    } else if (op == 3) { v0 = v0 * QSCALE_B; v1 = v1 * QSCALE_B; }
                    else if (op == 4) {
                        float s = (v0[0] * v0[0] + v0[1] * v0[1]) + (v0[2] * v0[2] + v0[3] * v0[3]) + (v1[0] * v1[0] + v1[1] * v1[1]) + (v1[2] * v1[2] + v1[3] * v1[3]);
                        s += __shfl_xor(s, 16); s += __shfl_xor(s, 32);
                        if (fq == 0) ssq[(size_t)row * 20 + g * 4 + wc] = s;
                    }
                    u32x4 w; w.x = cvt_pk_bf16(v0[0], v0[1]); w.y = cvt_pk_bf16(v0[2], v0[3]); w.z = cvt_pk_bf16(v1[0], v1[1]); w.w = cvt_pk_bf16(v1[2], v1[3]);
                    *(u32x4*)(O + (size_t)row * LD1 + col0) = w;
                }
        }
    }
};
struct EpiQ {
    static constexpr bool PERM = true, AFTER_DRAIN = false;
    bf16_t* Q; const float* ssq; const float2* rope;
    __device__ __forceinline__ static f32x4 rope4(f32x4 v, const f32x4 ca, const f32x4 cb, bool first) {
        const float cs[4] = {ca[0], ca[2], cb[0], cb[2]}, sn[4] = {ca[1], ca[3], cb[1], cb[3]};
#pragma unroll
        for (int e = 0; e < 4; ++e) { const float pv = __shfl_xor(v[e], 32); v[e] = first ? (v[e] * cs[e] - pv * sn[e]) : (pv * sn[e] + v[e] * cs[e]); }
        return v;
    }
    __device__ __forceinline__ void operator()(const f32x4 (&acc)[2][2][4][2], const Unit& u, int wr, int wc, int, int) const {
        const int t_ = lane_now();
        const int fr = t_ & 15, fq = (t_ >> 4) & 3;
        const int row0 = u.pm * BM + wr * 64 + fr;
        float rs8[8];
#pragma unroll
        for (int it = 0; it < 8; ++it) {
            const f32x4* sp = (const f32x4*)(ssq + (size_t)(row0 + (it >> 2) * HALF + (it & 3) * 16) * 20);
            const f32x4 s0 = sp[0], s1 = sp[1], s2 = sp[2];
            const float tot = ((s0[0] + s0[1]) + (s0[2] + s0[3])) + ((s1[0] + s1[1]) + (s1[2] + s1[3])) + ((s2[0] + s2[1]) + (s2[2] + s2[3]));
            rs8[it] = rsqrtf(tot * (1.f / 384.f) + 1e-6f) * QSCALE_A;
        }
        asm volatile("" ::: "memory");
#pragma unroll
        for (int ai = 0; ai < 2; ++ai)
#pragma unroll
            for (int m = 0; m < 4; ++m) {
                const int row = row0 + ai * HALF + m * 16;
                const float rs = rs8[ai * 4 + m];
                const f32x4* rp = (const f32x4*)(rope + (size_t)(row & (S - 1)) * 16 + 8 * (fq & 1));
#pragma unroll
                for (int bj = 0; bj < 2; ++bj) {
                    const int sl = u.pn * 8 + bj * 4 + wc;
                    f32x4 v0 = acc[ai][bj][m][0] * rs, v1 = acc[ai][bj][m][1] * rs;
                    if (sl % 3 == 2) {
                        v0 = rope4(v0, rp[0], rp[1], fq < 2);
                        v1 = rope4(v1, rp[2], rp[3], fq < 2);
                    }
                    u32x4 w; w.x = cvt_pk_bf16(v0[0], v0[1]); w.y = cvt_pk_bf16(v0[2], v0[3]); w.z = cvt_pk_bf16(v1[0], v1[1]); w.w = cvt_pk_bf16(v1[2], v1[3]);
                    *(u32x4*)(Q + (size_t)row * 768 + sl * 32 + 8 * fq) = w;
                    asm volatile("" ::: "memory");
                }
            }
    }
};
struct EpiKV {
    static constexpr bool PERM = true, AFTER_DRAIN = false;
    bf16_t* KV; const float* ssq;
    __device__ __forceinline__ void operator()(const f32x4 (&acc)[2][2][4][2], const Unit& u, int wr, int wc, int, int) const {
        const int t_ = lane_now();
        const int fr = t_ & 15, fq = (t_ >> 4) & 3;
        const int row0 = u.pm * BM + wr * 64 + fr;
        float rs8[8];
#pragma unroll
        for (int it = 0; it < 8; ++it) {
            const f32x4* sp = (const f32x4*)(ssq + (size_t)(row0 + (it >> 2) * HALF + (it & 3) * 16) * 20 + 12);
            const f32x4 s0 = sp[0], s1 = sp[1];
            const float tot = ((s0[0] + s0[1]) + (s0[2] + s0[3])) + ((s1[0] + s1[1]) + (s1[2] + s1[3]));
            rs8[it] = rsqrtf(tot * (1.f / 256.f) + 1e-6f);
        }
        asm volatile("" ::: "memory");
#pragma unroll
        for (int ai = 0; ai < 2; ++ai)
#pragma unroll
            for (int m = 0; m < 4; ++m) {
                const int row = row0 + ai * HALF + m * 16;
                const float rs = rs8[ai * 4 + m];
#pragma unroll
                for (int bj = 0; bj < 2; ++bj) {
                    const int col0 = u.pn * BM + bj * HALF + wc * 32 + 8 * fq;
                    const f32x4 v0 = acc[ai][bj][m][0] * rs, v1 = acc[ai][bj][m][1] * rs;
                    u32x4 w; w.x = cvt_pk_bf16(v0[0], v0[1]); w.y = cvt_pk_bf16(v0[2], v0[3]); w.z = cvt_pk_bf16(v1[0], v1[1]); w.w = cvt_pk_bf16(v1[2], v1[3]);
                    *(u32x4*)(KV + (size_t)row * 1024 + col0) = w;
                }
                asm volatile("" ::: "memory");
            }
    }
};
template <bool ADD> struct EpiGate {
    static constexpr bool PERM = true, AFTER_DRAIN = false;
    bf16_t* MG; const bf16_t* O1; int gcol;
    __device__ __forceinline__ void operator()(const f32x4 (&acc)[2][2][4][2], const Unit& u, int wr, int wc, int, int) const {
        const int t_ = lane_now();
        const int fr = t_ & 15, fq = (t_ >> 4) & 3;
        const int row0 = u.pm * BM + wr * 64 + fr;
        const int colb = u.pn * BM + wc * 32 + 8 * fq;
        u32x4 gn[2], pn_[2];
#define EG_LOAD(it_) do { const int row_ = row0 + ((it_) >> 2) * HALF + ((it_) & 3) * 16; _Pragma("unroll") for (int bj = 0; bj < 2; ++bj) { \
            gn[bj] = *(const u32x4*)(O1 + (size_t)row_ * LD1 + gcol + colb + bj * HALF); if (ADD) pn_[bj] = *(const u32x4*)(MG + (size_t)row_ * DM + colb + bj * HALF); } } while (0)
        EG_LOAD(0);
#pragma unroll
        for (int it = 0; it < 8; ++it) {
            const int ai = it >> 2, m = it & 3, row = row0 + ai * HALF + m * 16;
            u32x4 gc[2], pc[2];
#pragma unroll
            for (int bj = 0; bj < 2; ++bj) { gc[bj] = gn[bj]; if (ADD) pc[bj] = pn_[bj]; }
            if (it < 7) EG_LOAD(it + 1);
            asm volatile("" ::: "memory");
#pragma unroll
            for (int bj = 0; bj < 2; ++bj) {
                const u32x4 gw = gc[bj];
                f32x4 v0 = acc[ai][bj][m][0], v1 = acc[ai][bj][m][1];
                v0[0] *= bflo(gw.x); v0[1] *= bfhi(gw.x); v0[2] *= bflo(gw.y); v0[3] *= bfhi(gw.y);
                v1[0] *= bflo(gw.z); v1[1] *= bfhi(gw.z); v1[2] *= bflo(gw.w); v1[3] *= bfhi(gw.w);
                if (ADD) { const u32x4 pw = pc[bj];
                    v0[0] += bflo(pw.x); v0[1] += bfhi(pw.x); v0[2] += bflo(pw.y); v0[3] += bfhi(pw.y);
                    v1[0] += bflo(pw.z); v1[1] += bfhi(pw.z); v1[2] += bflo(pw.w); v1[3] += bfhi(pw.w); }
                u32x4 w; w.x = cvt_pk_bf16(v0[0], v0[1]); w.y = cvt_pk_bf16(v0[2], v0[3]); w.z = cvt_pk_bf16(v1[0], v1[1]); w.w = cvt_pk_bf16(v1[2], v1[3]);
                *(u32x4*)(MG + (size_t)row * DM + colb + bj * HALF) = w;
            }
        }
#undef EG_LOAD
    }
};
struct EpiOut {
    static constexpr bool PERM = true, AFTER_DRAIN = false;
    const float* x; float* out; float* ssqo;
    __device__ __forceinline__ void operator()(const f32x4 (&acc)[2][2][4][2], const Unit& u, int wr, int wc, int, int) const {
        const int t_ = lane_now();
        const int fr = t_ & 15, fq = (t_ >> 4) & 3;
        const int row0 = u.pm * BM + wr * 64 + fr;
#pragma unroll
        for (int ai = 0; ai < 2; ++ai)
#pragma unroll
            for (int m = 0; m < 4; ++m) {
                const int row = row0 + ai * HALF + m * 16;
#pragma unroll
                for (int bj = 0; bj < 2; ++bj) {
                    const int col0 = u.pn * BM + bj * HALF + wc * 32 + 8 * fq;
                    const f32x4* xp = (const f32x4*)(x + (size_t)row * DM + col0);
                    const f32x4 v0 = acc[ai][bj][m][0] + xp[0], v1 = acc[ai][bj][m][1] + xp[1];
                    f32x4* op = (f32x4*)(out + (size_t)row * DM + col0);
                    op[0] = v0; op[1] = v1;
                    float s = (v0[0] * v0[0] + v0[1] * v0[1]) + (v0[2] * v0[2] + v0[3] * v0[3]) + (v1[0] * v1[0] + v1[1] * v1[1]) + (v1[2] * v1[2] + v1[3] * v1[3]);
                    s += __shfl_xor(s, 16); s += __shfl_xor(s, 32);
                    if (fq == 0) ssqo[(size_t)row * 32 + u.pn * 8 + bj * 4 + wc] = s;
                }
                asm volatile("" ::: "memory");
            }
    }
};
struct EpiOutNorm {
    static constexpr bool PERM = true, AFTER_DRAIN = (FUSE_AFTER_DRAIN != 0);
    const float* x; float* out; float* ssqo; const float* fg; unsigned* cnt; unsigned* tmo; PG8_LAS unsigned char* ldsp;
    __device__ __forceinline__ void operator()(const f32x4 (&acc)[2][2][4][2], const Unit& u, int wr, int wc, int fr, int fq) const { if (!AFTER_DRAIN) fused(acc, u, wr, wc, fr, fq, ldsp, wr * 4 + wc, 0); }
    __device__ __forceinline__ void fused(const f32x4 (&acc)[2][2][4][2], const Unit& u, int wr, int wc, int, int, PG8_LAS unsigned char* lds, int wid, int) const {
        const int ln = lane_now(), fr = ln & 15, fq = (ln >> 4) & 3, tid = wid * 64 + ln;
        PG8_LAS float* part = (PG8_LAS float*)(lds + 135168);
        PG8_LAS float* rinv = part + 1024;
        const int rl0 = wr * 64 + fr;
        f32x4 v[2][2][4][2];
#pragma unroll
        for (int ai = 0; ai < 2; ++ai)
#pragma unroll
            for (int m = 0; m < 4; ++m) {
                const int rl = rl0 + ai * HALF + m * 16; const size_t row = (size_t)u.pm * BM + rl;
                float s = 0.f;
#pragma unroll
                for (int bj = 0; bj < 2; ++bj) {
                    const int col0 = u.pn * BM + bj * HALF + wc * 32 + 8 * fq;
                    const f32x4* xp = (const f32x4*)(x + row * DM + col0);
                    const f32x4 v0 = acc[ai][bj][m][0] + xp[0], v1 = acc[ai][bj][m][1] + xp[1];
                    v[ai][bj][m][0] = v0; v[ai][bj][m][1] = v1;
                    s += (v0[0] * v0[0] + v0[1] * v0[1]) + (v0[2] * v0[2] + v0[3] * v0[3]) + (v1[0] * v1[0] + v1[1] * v1[1]) + (v1[2] * v1[2] + v1[3] * v1[3]);
                }
                s += __shfl_xor(s, 16); s += __shfl_xor(s, 32);
                if (fq == 0) part[rl * 4 + wc] = s;
            }
        __syncthreads();
        if (DEBUG_FUSE) {
            if (tid < 256) { const f32x4 p4 = *(const PG8_LAS f32x4*)(part + tid * 4); float* q = ssqo + ((size_t)u.pm * BM + tid) * 32 + u.pn * 8;
                q[0] = (p4[0] + p4[1]) + (p4[2] + p4[3]); for (int i = 1; i < 8; ++i) q[i] = 0.f; }
#pragma unroll
            for (int bj = 0; bj < 2; ++bj)
#pragma unroll
                for (int ai = 0; ai < 2; ++ai)
#pragma unroll
                    for (int m = 0; m < 4; ++m) { const int rl = rl0 + ai * HALF + m * 16; const int col0 = u.pn * BM + bj * HALF + wc * 32 + 8 * fq;
                        f32x4* op = (f32x4*)(out + ((size_t)u.pm * BM + rl) * DM + col0); op[0] = v[ai][bj][m][0]; op[1] = v[ai][bj][m][1]; }
            return;
        }
        if (tid < 256) { const f32x4 p4 = *(const PG8_LAS f32x4*)(part + tid * 4); ssqo[((size_t)u.pm * BM + tid) * 4 + u.pn] = (p4[0] + p4[1]) + (p4[2] + p4[3]); }
        asm volatile("s_waitcnt vmcnt(0)" ::: "memory");
        __syncthreads();
        if (tid == 0) {
            __builtin_amdgcn_fence(__ATOMIC_RELEASE, "agent");
            (void)__hip_atomic_fetch_add(cnt + 16 * u.pm, 1u, __ATOMIC_RELAXED, __HIP_MEMORY_SCOPE_AGENT);
            unsigned sp = 0u;
            while (__hip_atomic_load(cnt + 16 * u.pm, __ATOMIC_RELAXED, __HIP_MEMORY_SCOPE_AGENT) < 4u) {
                __builtin_amdgcn_s_sleep(1);
                if ((++sp & 255u) == 0u) { if (__hip_atomic_load(tmo, __ATOMIC_RELAXED, __HIP_MEMORY_SCOPE_AGENT)) break; if (sp > (1u << 18)) { atomicAdd(tmo, 1u); break; } }
            }
            __builtin_amdgcn_fence(__ATOMIC_ACQUIRE, "agent");
            asm volatile("s_waitcnt vmcnt(0)" ::: "memory");
        }
        __syncthreads();
        if (tid < 256) {
            float* sp4 = ssqo + ((size_t)u.pm * BM + tid) * 4;
            const float t = (__hip_atomic_load(sp4, __ATOMIC_RELAXED, __HIP_MEMORY_SCOPE_AGENT) + __hip_atomic_load(sp4 + 1, __ATOMIC_RELAXED, __HIP_MEMORY_SCOPE_AGENT))
                          + (__hip_atomic_load(sp4 + 2, __ATOMIC_RELAXED, __HIP_MEMORY_SCOPE_AGENT) + __hip_atomic_load(sp4 + 3, __ATOMIC_RELAXED, __HIP_MEMORY_SCOPE_AGENT));
            rinv[tid] = rsqrtf(t * (1.f / DM) + 1e-6f);
        }
        __syncthreads();
#pragma unroll
        for (int bj = 0; bj < 2; ++bj) {
            const int col0 = u.pn * BM + bj * HALF + wc * 32 + 8 * fq;
            const f32x4 g0 = *(const f32x4*)(fg + col0), g1 = *(const f32x4*)(fg + col0 + 4);
#pragma unroll
            for (int ai = 0; ai < 2; ++ai)
#pragma unroll
                for (int m = 0; m < 4; ++m) {
                    const int rl = rl0 + ai * HALF + m * 16; const float r = rinv[rl];
                    f32x4* op = (f32x4*)(out + ((size_t)u.pm * BM + rl) * DM + col0);
                    op[0] = v[ai][bj][m][0] * r * g0; op[1] = v[ai][bj][m][1] * r * g1;
                }
        }
    }
};
}


namespace att {
typedef short bf16x8 __attribute__((ext_vector_type(8)));
typedef short s16x4 __attribute__((ext_vector_type(4)));
typedef float f32x16 __attribute__((ext_vector_type(16)));
typedef unsigned u32x4 __attribute__((ext_vector_type(4)));
typedef const LAS char* lds_cptr;
constexpr int SLOT_K = 12288, SLOT_V = 8192;
constexpr int L_K = 0, L_V = 2 * SLOT_K, L_WS = L_V + 2 * SLOT_V, L_OST = L_WS + 2048, L_BIAS = L_OST + 8 * 4096, L_END = L_BIAS + 2048;
constexpr float THR = 8.f;
#define MFMA32(a, b, c) __builtin_amdgcn_mfma_f32_32x32x16_bf16(a, b, c, 0, 0, 0)
__device__ __forceinline__ int crow(int r, int hi) { return (r & 3) + 8 * (r >> 2) + 4 * hi; }
typedef __bf16 bf16x2_t __attribute__((ext_vector_type(2)));
typedef float f32x2_t __attribute__((ext_vector_type(2)));
__device__ __forceinline__ unsigned cvtpk(float lo, float hi) { const f32x2_t v = {lo, hi}; return __builtin_bit_cast(unsigned, __builtin_convertvector(v, bf16x2_t)); }
__device__ __forceinline__ s16x4 vtr(lds_cptr p) { typedef short v4i16_t __attribute__((ext_vector_type(4))); return __builtin_bit_cast(s16x4, __builtin_amdgcn_ds_read_tr16_b64_v4i16((LAS v4i16_t*)p)); }
#define MX3(a, b, c) __builtin_fmaxf(__builtin_fmaxf((a), (b)), (c))
__device__ __forceinline__ float rowmax(const f32x16& p0, const f32x16& p1) {
    float a = MX3(p0[0], p0[1], p1[0]), b = MX3(p0[2], p0[3], p1[1]); a = MX3(a, p1[2], p1[3]);
#pragma unroll
    for (int r = 4; r < 16; r += 4) { a = MX3(a, p0[r], p0[r + 1]); b = MX3(b, p0[r + 2], p0[r + 3]); a = MX3(a, p1[r], p1[r + 1]); b = MX3(b, p1[r + 2], p1[r + 3]); }
    const float m = __builtin_fmaxf(a, b); auto rr = __builtin_amdgcn_permlane32_swap(__float_as_uint(m), __float_as_uint(m), false, false);
    return __builtin_fmaxf(__uint_as_float(rr[0]), __uint_as_float(rr[1])); }
__device__ __forceinline__ float maskp(float p, unsigned lo, unsigned hi) {
    const unsigned long long mk = ((unsigned long long)hi << 32) | lo; float o;
    asm("v_cndmask_b32_e64 %0, 0, %1, %2" : "=v"(o) : "v"(p), "s"(mk)); return o; }
__host__ __device__ __forceinline__ size_t mask_tile_off(int qt32) { const int J = qt32 >> 1; return (size_t)2 * J * (J + 1) + ((qt32 & 1) ? 2 * (J + 1) : 0); }
constexpr size_t MASK_TILES_PER_BATCH = (size_t)2 * 128 * 129;

struct Tensors {
    const bf16_t* Q; int ldq;
    const bf16_t* K0; int ldk;
    const bf16_t* K1;
    const bf16_t* V; int ldv;
    bf16_t* O; int ldo;
    const unsigned long long* mask;
    const float* rel_bias;
    int hq, hk, hv;
    int wv;
};

template <bool DSA>
__device__ __forceinline__ void unit(int b, int h, int qb, const Tensors& X, LAS unsigned char* lds, bool dry) {
    constexpr int NDQ = DSA ? 4 : 6;
    const int tid_ = tid_now(X.wv);
    const int tid = tid_, lane = tid & 63, r32 = lane & 31, hi = lane >> 5; const int wid = X.wv;
    const size_t rowbase = (size_t)b * S; const int q0 = qb * 256, NT = 4 * qb + 4, NTw = 4 * qb + (wid >> 1) + 1;
    LAS float* wsf = (LAS float*)(lds + L_WS) + wid * 64;
    const bf16_t* ksrc = X.K0 + (rowbase + lane) * X.ldk + h * X.hk + wid * 8;
    const bf16_t* ksrc1 = DSA ? nullptr : X.K1 + (rowbase + lane) * 32 + (wid & 3) * 8;
    const bf16_t* vsrc = X.V + (rowbase + 16 * (wid & 3) + (lane >> 2)) * X.ldv + h * X.hv + (wid >> 2) * 32 + (lane & 3) * 8;
    const size_t kstride = (size_t)64 * X.ldk, vstride = (size_t)64 * X.ldv;
    LAS unsigned char* kdst = lds + L_K + wid * 1024; LAS unsigned char* kdst1 = lds + L_K + (8 + (wid & 3)) * 1024; LAS unsigned char* vdst = lds + L_V + wid * 1024;
    u32x4 sk0, sk1 = {}, sv;
#define ATT_LOAD(t) do { sk0 = *(const u32x4*)(ksrc + (size_t)(t) * kstride); if (!DSA && wid < 4) sk1 = *(const u32x4*)(ksrc1 + (size_t)(t) * 64 * 32); \
                         sv = *(const u32x4*)(vsrc + (size_t)(t) * vstride); } while (0)
#define ATT_WRITE(slot) do { *(LAS u32x4*)(kdst + (slot) * SLOT_K + lane * 16) = sk0; if (!DSA && wid < 4) *(LAS u32x4*)(kdst1 + (slot) * SLOT_K + lane * 16) = sk1; \
                             *(LAS u32x4*)(vdst + (slot) * SLOT_V + lane * 16) = sv; } while (0)
    const lds_cptr vp0 = (lds_cptr)lds + L_V + ((lane >> 4) & 1) * 32 + (lane & 3) * 8 + (4 * hi + ((lane & 15) >> 2)) * 64;
    const lds_cptr kp0 = (lds_cptr)lds + L_K + hi * 1024 + r32 * 16;
    ATT_LOAD(0);
    bf16x8 qr[NDQ];
    { const bf16_t* Qw = X.Q + (rowbase + q0 + wid * 32 + r32) * X.ldq + h * X.hq + hi * 8;
#pragma unroll
      for (int d0 = 0; d0 < NDQ; ++d0) qr[d0] = *(const bf16x8*)(Qw + d0 * 16); }
    if (DSA) {
        LAS float* tab = (LAS float*)(lds + L_BIAS);
        const float c15 = X.rel_bias[15 * 8 + h];
        for (int e = tid; e < 320; e += 512) {
            const int rel = e - 255, n = rel < 0 ? -rel : rel; int v;
            if (n < 8) v = n; else if (n < 12) v = 8; else if (n < 16) v = 9; else if (n < 23) v = 10; else if (n < 32) v = 11; else if (n < 46) v = 12; else if (n < 64) v = 13; else if (n < 91) v = 14; else v = 15;
            tab[e] = (X.rel_bias[((rel > 0 ? 16 : 0) + v) * 8 + h] - c15) * LOG2E;
        }
    }
    ATT_WRITE(0);
    float mhat = 0.f, l_reg = 0.f; f32x16 o0 = {}, o1 = {};
    f32x16 negm = {};
    if (wid >= 4) __builtin_amdgcn_s_setprio(1);
    const int qpos = q0 + wid * 32 + r32;
    for (int t = 0; t < NT; ++t) {
        asm volatile("s_waitcnt vmcnt(0) lgkmcnt(0)\n\ts_barrier" ::: "memory");
        if (t + 1 < NT) ATT_LOAD(t + 1);
        unsigned mw = 0u;
        if (DSA && t < NTw) { const int qt32 = qb * 8 + wid;
            const unsigned* mt = (const unsigned*)((const unsigned short*)X.mask + ((size_t)b * MASK_TILES_PER_BATCH + mask_tile_off(qt32)) * 64) + (size_t)t * 64;
            mw = mt[lane]; }
        if (t < NTw) {
            const int so_k = (t & 1) * SLOT_K, so_v = (t & 1) * SLOT_V;
            f32x16 c0, c1;
            bf16x8 kf[2 * NDQ];
#pragma unroll
            for (int d0 = 0; d0 < NDQ; ++d0) { kf[2 * d0] = *(const LAS bf16x8*)(kp0 + so_k + d0 * 2048); kf[2 * d0 + 1] = *(const LAS bf16x8*)(kp0 + so_k + d0 * 2048 + 512); }
#pragma unroll
            for (int d0 = 0; d0 < NDQ; ++d0) { c0 = MFMA32(kf[2 * d0], qr[d0], d0 == 0 ? negm : c0); c1 = MFMA32(kf[2 * d0 + 1], qr[d0], d0 == 0 ? negm : c1); }
            const lds_cptr vp = vp0 + so_v;
            bf16x8 vf[8];
#pragma unroll
            for (int i = 0; i < 8; ++i) { const s16x4 lo_ = vtr(vp + ((i >> 2) * 4096 + (i & 3) * 1024)), hi_ = vtr(vp + ((i >> 2) * 4096 + (i & 3) * 1024 + 512));
                vf[i] = (bf16x8){lo_[0], lo_[1], lo_[2], lo_[3], hi_[0], hi_[1], hi_[2], hi_[3]}; }
            if (DSA) {
                if (64 * t + 63 - (q0 + wid * 32) > -128) {
                    const LAS float* tab = (const LAS float*)(lds + L_BIAS);
                    const int base = 64 * t + 4 * hi - qpos + 255;
#pragma unroll
                    for (int r = 0; r < 16; ++r) { const int kr = (r & 3) + 8 * (r >> 2); int i0 = base + kr, i1 = base + kr + 32; i0 = i0 < 0 ? 0 : i0; i1 = i1 < 0 ? 0 : i1;
                        c0[r] += tab[i0]; c1[r] += tab[i1]; }
                }
            }
            const float rm = rowmax(c0, c1);
            if (t == 0 || __any(rm > THR)) {
                const float dl = (t == 0) ? rm : __builtin_fmaxf(rm, 0.f); mhat += dl;
                if (t > 0) {
                    const float f = __builtin_amdgcn_exp2f(-dl); l_reg *= f;
                    if (hi == 0) wsf[r32] = f;
                    asm volatile("s_waitcnt lgkmcnt(0)" ::: "memory");
#pragma unroll
                    for (int r = 0; r < 16; ++r) { const float fr = wsf[crow(r, hi)]; o0[r] *= fr; o1[r] *= fr; }
                }
#pragma unroll
                for (int r = 0; r < 16; ++r) { c0[r] -= dl; c1[r] -= dl; negm[r] -= dl; }
            }
#pragma unroll
            for (int r = 0; r < 16; ++r) { c0[r] = __builtin_amdgcn_exp2f(c0[r]); c1[r] = __builtin_amdgcn_exp2f(c1[r]); }
            if (DSA) {
#pragma unroll
                for (int r = 0; r < 16; ++r) {
                    int m0 = __builtin_amdgcn_sbfe((int)mw, r, 1), m1 = __builtin_amdgcn_sbfe((int)mw, 16 + r, 1); asm("" : "+v"(m0), "+v"(m1));
                    c0[r] = __uint_as_float(__float_as_uint(c0[r]) & (unsigned)m0); c1[r] = __uint_as_float(__float_as_uint(c1[r]) & (unsigned)m1); }
            }
            float sacc = 0.f;
#pragma unroll
            for (int r = 0; r < 16; ++r) sacc += c0[r] + c1[r];
            l_reg += sacc;
            u32x4 pw0 = {cvtpk(c0[0], c0[1]), cvtpk(c0[2], c0[3]), cvtpk(c0[4], c0[5]), cvtpk(c0[6], c0[7])};
            u32x4 pw1 = {cvtpk(c0[8], c0[9]), cvtpk(c0[10], c0[11]), cvtpk(c0[12], c0[13]), cvtpk(c0[14], c0[15])};
            u32x4 pw2 = {cvtpk(c1[0], c1[1]), cvtpk(c1[2], c1[3]), cvtpk(c1[4], c1[5]), cvtpk(c1[6], c1[7])};
            u32x4 pw3 = {cvtpk(c1[8], c1[9]), cvtpk(c1[10], c1[11]), cvtpk(c1[12], c1[13]), cvtpk(c1[14], c1[15])};
            o0 = MFMA32(__builtin_bit_cast(bf16x8, pw0), vf[0], o0); o1 = MFMA32(__builtin_bit_cast(bf16x8, pw0), vf[4], o1);
            o0 = MFMA32(__builtin_bit_cast(bf16x8, pw1), vf[1], o0); o1 = MFMA32(__builtin_bit_cast(bf16x8, pw1), vf[5], o1);
            o0 = MFMA32(__builtin_bit_cast(bf16x8, pw2), vf[2], o0); o1 = MFMA32(__builtin_bit_cast(bf16x8, pw2), vf[6], o1);
            o0 = MFMA32(__builtin_bit_cast(bf16x8, pw3), vf[3], o0); o1 = MFMA32(__builtin_bit_cast(bf16x8, pw3), vf[7], o1);
        }
        if (t + 1 < NT) ATT_WRITE((t + 1) & 1);
    }
    __builtin_amdgcn_s_setprio(0);
    bf16_t* Ow = X.O + (rowbase + q0 + wid * 32) * X.ldo + h * 64;
    u32x4 gv4[4];
#pragma unroll
    for (int i = 0; i < 4; ++i) gv4[i] = *(const u32x4*)(Ow + (size_t)(i * 8 + (lane >> 3)) * X.ldo + (lane & 7) * 8);
    { auto rr = __builtin_amdgcn_permlane32_swap(__float_as_uint(l_reg), __float_as_uint(l_reg), false, false); l_reg = __uint_as_float(rr[0]) + __uint_as_float(rr[1]); }
    if (hi == 0) wsf[32 + r32] = l_reg;
    asm volatile("s_waitcnt lgkmcnt(0)" ::: "memory");
    LAS bf16_t* stg = (LAS bf16_t*)(lds + L_OST) + wid * 2048;
#pragma unroll
    for (int r = 0; r < 16; ++r) { const int orow = crow(r, hi); const float rli = __builtin_amdgcn_rcpf(wsf[32 + orow]);
        stg[orow * 64 + r32] = f2bf(o0[r] * rli); stg[orow * 64 + 32 + r32] = f2bf(o1[r] * rli); }
    asm volatile("s_waitcnt lgkmcnt(0)" ::: "memory");
#pragma unroll
    for (int i = 0; i < 4; ++i) { const int row = i * 8 + (lane >> 3), ch = lane & 7;
        const u32x4 ov = *(const LAS u32x4*)(stg + row * 64 + ch * 8); u32x4* gp = (u32x4*)(Ow + (size_t)row * X.ldo + ch * 8); const u32x4 gv = gv4[i];
        u32x4 res; res.x = pk2(bflo(ov.x) * bflo(gv.x), bfhi(ov.x) * bfhi(gv.x)); res.y = pk2(bflo(ov.y) * bflo(gv.y), bfhi(ov.y) * bfhi(gv.y));
        res.z = pk2(bflo(ov.z) * bflo(gv.z), bfhi(ov.z) * bfhi(gv.z)); res.w = pk2(bflo(ov.w) * bflo(gv.w), bfhi(ov.w) * bfhi(gv.w)); if (!dry) *gp = res; }
    asm volatile("s_waitcnt vmcnt(0) lgkmcnt(0)\n\ts_barrier" ::: "memory");
#undef ATT_LOAD
#undef ATT_WRITE
}

template <bool DSA>
__device__ __forceinline__ void phase(const Tensors& X, LAS unsigned char* lds, int G, int bid, bool dry = false) {
    for (int p = bid; p < 512; p += G) {
        const int x = p & 7, kk = p >> 3, bh = x + 8 * (kk >> 4), j = kk & 15;
#pragma unroll 1
        for (int u2 = 0; u2 < 2; ++u2) unit<DSA>(bh >> 3, bh & 7, u2 ? 31 - j : j, X, lds, dry);
    }
}
}


#ifndef IDX_PRIO
#define IDX_PRIO 0
#endif
#ifndef PASS0_SPLIT
#define PASS0_SPLIT 0
#endif
#ifndef IDX_FORCE_SLOW
#define IDX_FORCE_SLOW 0
#endif
namespace idx {
typedef short bf16x8 __attribute__((ext_vector_type(8)));
typedef float f32x16 __attribute__((ext_vector_type(16)));
constexpr int HROW = 1025;
constexpr int LCAP = 32;
constexpr int LISTN = 64, LSTR = 65;
constexpr int L_HIST = 0, LISTS_END = (511 * LSTR + 513) * 4, L_PFX = LISTS_END, L_NEED = L_PFX + 128, L_LCNT = L_NEED + 128, L_LIST = L_LCNT + 128, L_CNT = L_LIST + 32 * LCAP * 4, L_TAU = L_CNT + 512 * 4,
              L_FLAG = L_TAU + 128, L_LB = L_FLAG + 16, L_WH = L_LB + 128, L_END = L_WH + 8 * 1024;
static_assert(LISTS_END % 16 == 0 && LISTS_END >= 32 * HROW * 4, "indexer LDS layout");
__device__ __forceinline__ unsigned f2key(float f) { const unsigned u = __float_as_uint(f); return u ^ ((unsigned)((int)u >> 31) | 0x80000000u); }

struct QOps { bf16x8 qf[8][2]; bf16x8 qb[2][2]; float wv[8]; };
__device__ __forceinline__ void score_tile(float (&acc)[16], const bf16x8 k0, const bf16x8 k1, const QOps& Q) {
#define IDX_M0(h) __builtin_amdgcn_mfma_f32_32x32x16_bf16(k0, Q.qf[h][0], (f32x16){}, 0, 0, 0)
#define IDX_M1(h, c) __builtin_amdgcn_mfma_f32_32x32x16_bf16(k1, Q.qf[h][1], c, 0, 0, 0)
#define IDX_ACC8(h, c, r0) do { _Pragma("unroll") for (int r = (r0); r < (r0) + 8; ++r) { acc[r] = __builtin_fmaf(Q.wv[h], __builtin_fabsf(c[r]), acc[r]); asm volatile("" : "+v"(acc[r])); } } while (0)
    f32x16 cA = IDX_M0(0); cA = IDX_M1(0, cA);
    f32x16 lin = __builtin_amdgcn_mfma_f32_32x32x16_bf16(k0, Q.qb[0][0], (f32x16){}, 0, 0, 0);
    lin = __builtin_amdgcn_mfma_f32_32x32x16_bf16(k1, Q.qb[0][1], lin, 0, 0, 0);
    lin = __builtin_amdgcn_mfma_f32_32x32x16_bf16(k0, Q.qb[1][0], lin, 0, 0, 0);
    lin = __builtin_amdgcn_mfma_f32_32x32x16_bf16(k1, Q.qb[1][1], lin, 0, 0, 0);
#pragma unroll
    for (int r = 0; r < 16; ++r) acc[r] = lin[r];
    __builtin_amdgcn_sched_barrier(0);
#pragma unroll
    for (int h = 0; h < 8; ++h) {
        f32x16 nC;
        if (h < 7) nC = IDX_M0(h + 1);
        IDX_ACC8(h, cA, 0);
        __builtin_amdgcn_sched_barrier(0);
        if (h < 7) nC = IDX_M1(h + 1, nC);
        IDX_ACC8(h, cA, 8);
        __builtin_amdgcn_sched_barrier(0);
        if (h < 7) cA = nC;
    }
#undef IDX_M0
#undef IDX_M1
#undef IDX_ACC8
}
#define GAS __attribute__((address_space(1)))
#define IDX_KLOAD(k0, k1, kt) do { const GAS bf16_t* kp_ = kbase + (size_t)(kt) * 1024 + r32 * 32 + hi * 8; k0 = *(const GAS bf16x8*)kp_; k1 = *(const GAS bf16x8*)(kp_ + 16); } while (0)

struct PassCtx { const GAS bf16_t* kbase; LAS unsigned* hrow; LAS unsigned* lcnt_q; LAS unsigned* blist_q; LAS unsigned* lown; GAS unsigned short* mbase; unsigned pfx, msk; int lane, r32, hi, ktb, kte; bool hi2; };
template <int PASS>
__device__ __forceinline__ void pass_tile(const PassCtx& C, const bf16x8 k0, const bf16x8 k1, const QOps& Q, int kt, unsigned& ncand) {
    if constexpr (PASS == 3) {
        __builtin_amdgcn_sched_barrier(0);
        float acc[16]; score_tile(acc, k0, k1, Q);
        const unsigned tlo = C.pfx << 22, thim1 = tlo | 0x3fffffu, pos = (unsigned)(kt - C.ktb) << 26;
        unsigned bits = 0u, vmask = 0x3fffffu; asm volatile("" : "+v"(vmask));
#pragma unroll
        for (int r = 15; r >= 0; --r) {
            const unsigned k = __float_as_uint(acc[r]) ^ C.msk;
            const bool sel = k > thim1, ge = k >= tlo;
            bits = bits + bits + (sel ? 1u : 0u);
            unsigned pr = ((unsigned)r << 22) | pos; asm volatile("" : "+s"(pr));
            *(LAS unsigned*)ncand = (k & vmask) | pr;
            ncand += (ge != sel) ? 4u : 0u;
        }
        C.mbase[(size_t)(kt >> 1) * 128 + C.lane * 2 + (kt & 1)] = (unsigned short)bits;
        return;
    }
    constexpr int SH_BIN = (PASS == 0 || PASS == 4) ? 22 : ((PASS == 1) ? 11 : 0), SH_PFX = (PASS == 1) ? 22 : 11;
    __builtin_amdgcn_sched_barrier(0);
    float acc[16]; score_tile(acc, k0, k1, Q);
    unsigned bits = 0u, anym = 0u; unsigned keys[16];
#pragma unroll
    for (int r = 0; r < 16; ++r) {
        const unsigned key = f2key(acc[r]), up = key >> SH_PFX, bin = (PASS == 0 || PASS == 4) ? (key >> 22) : ((key >> SH_BIN) & 2047u); if (PASS == 2) keys[r] = key;
        const bool match = (PASS == 0) || (PASS == 4 ? (bin >= C.pfx) : (up == C.pfx));
        if (PASS == 0) __hip_atomic_fetch_add(C.hrow + bin, 1u, __ATOMIC_RELAXED, __HIP_MEMORY_SCOPE_WORKGROUP);
        else if (PASS == 4) { if (match) __hip_atomic_fetch_add(C.hrow + bin, 1u, __ATOMIC_RELAXED, __HIP_MEMORY_SCOPE_WORKGROUP); }
        else if (match) __hip_atomic_fetch_add(C.hrow + (bin >> 1), 1u << ((bin & 1u) * 16u), __ATOMIC_RELAXED, __HIP_MEMORY_SCOPE_WORKGROUP);
        if (PASS == 2) { bits |= (up > C.pfx) ? (1u << r) : 0u; anym |= match ? 1u : 0u; }
    }
    if (PASS == 2) {
        C.mbase[(size_t)(kt >> 1) * 128 + C.lane * 2 + (kt & 1)] = (unsigned short)bits;
        if (__any(anym)) {
#pragma unroll
            for (int r = 0; r < 16; ++r) if ((keys[r] >> 11) == C.pfx) {
                const unsigned sl = __hip_atomic_fetch_add(C.lcnt_q, 1u, __ATOMIC_RELAXED, __HIP_MEMORY_SCOPE_WORKGROUP);
                if (sl < (unsigned)LCAP) C.blist_q[sl] = (keys[r] & 2047u) | ((unsigned)r << 11) | ((unsigned)C.lane << 15) | ((unsigned)kt << 21);
            }
        }
    }
}
#define IDX_KLOADC(k0, k1, kt) do { const GAS bf16_t* kp_ = C.kbase + (size_t)(kt) * 1024 + C.r32 * 32 + C.hi * 8; k0 = *(const GAS bf16x8*)kp_; k1 = *(const GAS bf16x8*)(kp_ + 16); } while (0)
template <int PASS>
__device__ __forceinline__ void pass_loop(const PassCtx& C, const QOps& Q, unsigned& ncand) {
    bf16x8 a0, a1, b0, b1, c0, c1; const int ktb = C.ktb, kte = C.kte;
    if (IDX_PRIO) { if (C.hi2) __builtin_amdgcn_s_setprio(1); }
    if (ktb < kte) IDX_KLOADC(a0, a1, ktb); if (ktb + 1 < kte) IDX_KLOADC(b0, b1, ktb + 1); if (ktb + 2 < kte) IDX_KLOADC(c0, c1, ktb + 2);
    for (int kt = ktb; kt < kte; kt += 3) {
        pass_tile<PASS>(C, a0, a1, Q, kt, ncand); if (kt + 3 < kte) IDX_KLOADC(a0, a1, kt + 3);
        if (kt + 1 < kte) { pass_tile<PASS>(C, b0, b1, Q, kt + 1, ncand); if (kt + 4 < kte) IDX_KLOADC(b0, b1, kt + 4); }
        if (kt + 2 < kte) { pass_tile<PASS>(C, c0, c1, Q, kt + 2, ncand); if (kt + 5 < kte) IDX_KLOADC(c0, c1, kt + 5); }
    }
    if (IDX_PRIO) __builtin_amdgcn_s_setprio(0);
}
#undef IDX_KLOADC

__device__ __forceinline__ int wave_prefix_sum(int v) {
    v += __builtin_amdgcn_update_dpp(0, v, 0x111, 0xf, 0xf, false);
    v += __builtin_amdgcn_update_dpp(0, v, 0x112, 0xf, 0xf, false);
    v += __builtin_amdgcn_update_dpp(0, v, 0x114, 0xf, 0xf, false);
    v += __builtin_amdgcn_update_dpp(0, v, 0x118, 0xf, 0xf, false);
    v += __builtin_amdgcn_update_dpp(0, v, 0x142, 0xa, 0xf, false);
    v += __builtin_amdgcn_update_dpp(0, v, 0x143, 0xc, 0xf, false);
    return v;
}
__device__ __forceinline__ void scan_hist(const LAS unsigned* hist, LAS unsigned* spfx, LAS int* sneed, LAS unsigned* slb, int wid, int pass, bool partial) {
    const int nbits = (pass == 0) ? 10 : 11;
    const int lane = lane_now();
    unsigned wv_[4][16]; int c[4], need[4];
#pragma unroll
    for (int qi = 0; qi < 4; ++qi) {
        const LAS unsigned* hr = hist + (wid * 4 + qi) * HROW + 16 * lane;
#pragma unroll
        for (int i = 0; i < 16; ++i) wv_[qi][i] = hr[i];
        need[qi] = sneed[wid * 4 + qi];
    }
#pragma unroll
    for (int qi = 0; qi < 4; ++qi) {
        int t = 0;
#pragma unroll
        for (int i = 0; i < 16; ++i) t += (pass == 0) ? (int)wv_[qi][i] : (int)(wv_[qi][i] & 0xffffu) + (int)(wv_[qi][i] >> 16);
        c[qi] = t;
    }
#pragma unroll
    for (int qi = 0; qi < 4; ++qi) {
        const int q = wid * 4 + qi, nd = need[qi];
        const int pre = wave_prefix_sum(c[qi]), total = __builtin_amdgcn_readlane(pre, 63);
        const int sfx = total - pre + c[qi], above = sfx - c[qi];
        int run = above, bstar = 0, nn = nd;
        if (pass == 0) {
#pragma unroll
            for (int i = 15; i >= 0; --i) { const int ci = (int)wv_[qi][i]; const bool hit = (run < nd) && (run + ci >= nd); bstar = hit ? 16 * lane + i : bstar; nn = hit ? nd - run : nn; run += ci; }
        } else {
#pragma unroll
            for (int i = 15; i >= 0; --i) {
                const int chi = (int)(wv_[qi][i] >> 16), clo = (int)(wv_[qi][i] & 0xffffu);
                { const bool hit = (run < nd) && (run + chi >= nd); bstar = hit ? 32 * lane + 2 * i + 1 : bstar; nn = hit ? nd - run : nn; run += chi; }
                { const bool hit = (run < nd) && (run + clo >= nd); bstar = hit ? 32 * lane + 2 * i : bstar; nn = hit ? nd - run : nn; run += clo; }
            }
        }
        if (partial && lane == 0) slb[q] = 0u;
        if (sfx >= nd && above < nd) {
            if (partial) slb[q] = (unsigned)bstar; else { spfx[q] = (spfx[q] << nbits) | (unsigned)bstar; sneed[q] = nn; }
        }
    }
}

template <int NJ>
__device__ __forceinline__ unsigned resolve_query(const LAS unsigned* lbase, int cn, int ln, LAS unsigned* wh, int need) {
    int ev[NJ]; const int sub = ln >> 4;
#pragma unroll
    for (int t = 0; t < NJ; ++t) { const int sl = 4 * t + sub; const unsigned w = lbase[sl]; ev[t] = (sl < cn) ? (int)(w & 0x3fffffu) : -1; }
    unsigned tl = 0u;
#pragma unroll
    for (int step = 0; step < 3; ++step) {
        const int sh = (step == 0) ? 14 : ((step == 1) ? 6 : 0), nb = (step == 2) ? 6 : 8, dm = (1 << nb) - 1;
        ((LAS u32x4*)wh)[ln] = (u32x4){0u, 0u, 0u, 0u};
#pragma unroll
        for (int t = 0; t < NJ; ++t) if (ev[t] >= 0) __hip_atomic_fetch_add(wh + ((ev[t] >> sh) & dm), 1u, __ATOMIC_RELAXED, __HIP_MEMORY_SCOPE_WORKGROUP);
        asm volatile("s_waitcnt lgkmcnt(0)" ::: "memory");
        const u32x4 c4 = ((const LAS u32x4*)wh)[ln];
        const int c = (int)(c4.x + c4.y + c4.z + c4.w);
        const int pre = wave_prefix_sum(c), sfx = __builtin_amdgcn_readlane(pre, 63) - pre + c;
        const int above = sfx - c;
        int run = above, dig = 0, nn = need; bool done = false;
        { const int ci = (int)c4.w; if (run + ci >= need) { dig = 4 * ln + 3; nn = need - run; done = true; } else run += ci; }
        { const int ci = (int)c4.z; if (!done) { if (run + ci >= need) { dig = 4 * ln + 2; nn = need - run; done = true; } else run += ci; } }
        { const int ci = (int)c4.y; if (!done) { if (run + ci >= need) { dig = 4 * ln + 1; nn = need - run; done = true; } else run += ci; } }
        { if (!done) { dig = 4 * ln; nn = need - run; } }
        const unsigned long long hm = __ballot(sfx >= need && above < need);
        const int src = (int)__builtin_ctzll(hm | (1ull << 63));
        dig = __builtin_amdgcn_readlane(dig, src); need = __builtin_amdgcn_readlane(nn, src);
        tl = (tl << nb) | (unsigned)dig;
        if (step < 2) {
#pragma unroll
            for (int t = 0; t < NJ; ++t) ev[t] = (((ev[t] >> sh) & dm) == dig) ? ev[t] : -1;
        }
    }
    return tl;
}

__device__ __forceinline__ void unit(int b, int qt, const bf16_t* __restrict__ O1, const bf16_t* __restrict__ KIDX, unsigned* __restrict__ MASK, LAS unsigned char* lds, int wv) {
    const int tid_ = tid_now(wv);
    long long spin_ = 0; long long tw0_ = 0; (void)tw0_;
#define RT_NOW(t) asm volatile("s_waitcnt vmcnt(0) lgkmcnt(0)\n\ts_memrealtime %0\n\ts_waitcnt lgkmcnt(0)" : "=s"(t) :: "memory")
#define SEC_B(id) do { if (PROBE_DUP == (id)) { unsigned long long t_; RT_NOW(t_); tw0_ = (long long)t_; } } while (0)
#define SEC_E(id) do { if (PROBE_DUP == (id)) { unsigned long long t_; RT_NOW(t_); spin_ += (long long)t_ - tw0_; } } while (0)
    SEC_B(90); SEC_B(91); SEC_B(70);
    asm volatile("" : "+s"(O1), "+s"(KIDX), "+s"(MASK));
    const int tid = tid_, lane = tid & 63, r32 = lane & 31, hi = lane >> 5; const int wid = wv;
    const size_t rowbase = (size_t)b * S; const int nkt = 2 * ((qt >> 1) + 1);
    const int kper = (nkt + 7) >> 3, ktb = wid * kper, kte = (ktb + kper < nkt) ? ktb + kper : nkt;
    LAS unsigned* hist = (LAS unsigned*)(lds + L_HIST); LAS unsigned* spfx = (LAS unsigned*)(lds + L_PFX); LAS int* sneed = (LAS int*)(lds + L_NEED);
    QOps Q;
    for (int rq_ = 0; rq_ < ((PROBE_DUP == 78) ? 9 : 1); ++rq_)
    { const GAS bf16_t* qrow = (const GAS bf16_t*)O1 + (rowbase + qt * 32 + r32 + (rq_ >> 4)) * LD1;
      const u32x4 ww = *(const GAS u32x4*)(qrow + O_WIDX);
      Q.wv[0] = bflo(ww.x); Q.wv[1] = bfhi(ww.x); Q.wv[2] = bflo(ww.y); Q.wv[3] = bfhi(ww.y); Q.wv[4] = bflo(ww.z); Q.wv[5] = bfhi(ww.z); Q.wv[6] = bflo(ww.w); Q.wv[7] = bfhi(ww.w);
      float qs[2][8];
#pragma unroll
      for (int s2 = 0; s2 < 2; ++s2)
#pragma unroll
          for (int j = 0; j < 8; ++j) qs[s2][j] = 0.f;
#pragma unroll
      for (int h = 0; h < 8; ++h)
#pragma unroll
          for (int s2 = 0; s2 < 2; ++s2) {
              const u32x4 qv = *(const GAS u32x4*)(qrow + O_QIDX + 32 * h + 16 * s2 + hi * 8);
              Q.qf[h][s2] = __builtin_bit_cast(bf16x8, qv);
              qs[s2][0] = __builtin_fmaf(Q.wv[h], bflo(qv.x), qs[s2][0]); qs[s2][1] = __builtin_fmaf(Q.wv[h], bfhi(qv.x), qs[s2][1]);
              qs[s2][2] = __builtin_fmaf(Q.wv[h], bflo(qv.y), qs[s2][2]); qs[s2][3] = __builtin_fmaf(Q.wv[h], bfhi(qv.y), qs[s2][3]);
              qs[s2][4] = __builtin_fmaf(Q.wv[h], bflo(qv.z), qs[s2][4]); qs[s2][5] = __builtin_fmaf(Q.wv[h], bfhi(qv.z), qs[s2][5]);
              qs[s2][6] = __builtin_fmaf(Q.wv[h], bflo(qv.w), qs[s2][6]); qs[s2][7] = __builtin_fmaf(Q.wv[h], bfhi(qv.w), qs[s2][7]);
          }
#pragma unroll
      for (int s2 = 0; s2 < 2; ++s2) {
          u32x4 hv, lv; unsigned* hp = (unsigned*)&hv; unsigned* lp = (unsigned*)&lv;
#pragma unroll
          for (int j = 0; j < 4; ++j) {
              const unsigned hw = pk2(qs[s2][2 * j], qs[s2][2 * j + 1]);
              hp[j] = hw; lp[j] = pk2(qs[s2][2 * j] - bflo(hw), qs[s2][2 * j + 1] - bfhi(hw));
          }
          Q.qb[0][s2] = __builtin_bit_cast(bf16x8, hv); Q.qb[1][s2] = __builtin_bit_cast(bf16x8, lv);
      } }
    SEC_E(91); SEC_B(92); SEC_E(70);
    const GAS bf16_t* kbase = (const GAS bf16_t*)KIDX + rowbase * 32;
    LAS unsigned* lcnt = (LAS unsigned*)(lds + L_LCNT); LAS unsigned* blist = (LAS unsigned*)(lds + L_LIST);
    GAS unsigned short* mbase = (GAS unsigned short*)MASK + ((size_t)b * att::MASK_TILES_PER_BATCH + att::mask_tile_off(qt)) * 64;
    unsigned tau = 0u;
    bool need_mask_pass = true;
    if (nkt * 32 > 256) {
        LAS unsigned* lists = (LAS unsigned*)(lds + L_HIST); LAS unsigned* scnt = (LAS unsigned*)(lds + L_CNT); LAS unsigned* stau = (LAS unsigned*)(lds + L_TAU); LAS unsigned* sflag = (LAS unsigned*)(lds + L_FLAG); LAS unsigned* slb = (LAS unsigned*)(lds + L_LB);
        if (tid < 32) { spfx[tid] = 0u; sneed[tid] = 256; lcnt[tid] = 0u; if (tid == 0) sflag[0] = ((IDX_FORCE_SLOW || PROBE_DUP == 77) ? 1u : 0u); }
        bool fast = false;
        for (int pass = 0; pass < 3; ++pass) {
            for (int rp_ = 0; rp_ < (((PROBE_DUP == 83 || PROBE_DUP == 89) && pass == 0) ? 2 : 1); ++rp_) {
            if (PROBE_DUP == 89 && tid < 32) { spfx[tid] = 0u; sneed[tid] = 256; }
            { LAS u32x4* h4 = (LAS u32x4*)hist; for (int e = tid_now(wv); e < 32 * HROW / 4; e += 512) h4[e] = (u32x4){0u, 0u, 0u, 0u}; }
            asm volatile("s_waitcnt lgkmcnt(0)\n\ts_barrier" ::: "memory");
            { const int ln = lane_now(), lr = ln & 31;
              PassCtx C; C.kbase = kbase; C.hrow = hist + lr * HROW; C.lcnt_q = lcnt + lr; C.blist_q = blist + lr * LCAP; C.mbase = mbase; C.pfx = spfx[lr];
              C.lane = ln; C.r32 = lr; C.hi = ln >> 5; C.ktb = ktb; C.kte = kte; C.hi2 = (wid >= 4);
              C.lown = nullptr; unsigned nc_ = 0u;
              if (pass == 0) {
                  if (PASS0_SPLIT && nkt >= 64) {
                      const int kmid = (kte > ktb) ? ktb + ((kte - ktb + 3) >> 2) : ktb;
                      C.kte = kmid; pass_loop<0>(C, Q, nc_);
                      asm volatile("s_waitcnt lgkmcnt(0)\n\ts_barrier" ::: "memory");
                      scan_hist(hist, spfx, sneed, slb, wid, 0, true);
                      asm volatile("s_waitcnt lgkmcnt(0)\n\ts_barrier" ::: "memory");
                      C.ktb = kmid; C.kte = kte; C.pfx = slb[lane_now() & 31]; pass_loop<4>(C, Q, nc_);
                  } else pass_loop<0>(C, Q, nc_);
              } else if (pass == 1) pass_loop<1>(C, Q, nc_); else pass_loop<2>(C, Q, nc_); }
            asm volatile("s_waitcnt vmcnt(0) lgkmcnt(0)\n\ts_barrier" ::: "memory");
            if (PROBE_DUP == 89 && pass == 0 && rp_ == 0) { scan_hist(hist, spfx, sneed, slb, wid, pass, false); asm volatile("s_waitcnt lgkmcnt(0)\n\ts_barrier" ::: "memory"); }
            }
            SEC_E(92); SEC_B(93);
            scan_hist(hist, spfx, sneed, slb, wid, pass, false);
            if (PROBE_DUP == 94 && pass == 0) { for (int rp_ = 0; rp_ < 4; ++rp_) { asm volatile("s_waitcnt lgkmcnt(0)\n\ts_barrier" ::: "memory"); scan_hist(hist, spfx, sneed, slb, wid, 0, true); } }
            asm volatile("s_waitcnt lgkmcnt(0)\n\ts_barrier" ::: "memory");
            SEC_E(93);
            if (pass == 0) {
                for (int rpB_ = 0; rpB_ < ((PROBE_DUP == 79) ? 2 : 1); ++rpB_) {
                SEC_B(95);
                for (int rp_ = 0; rp_ < ((PROBE_DUP == 84) ? 2 : 1); ++rp_)
                { const int ln = lane_now(), lr = ln & 31;
                  const unsigned la0 = (unsigned)(size_t)(lists + (wid * 64 + ln) * LSTR); unsigned la = la0;
                  PassCtx C; C.kbase = kbase; C.hrow = nullptr; C.lcnt_q = nullptr; C.blist_q = nullptr; C.lown = nullptr; C.mbase = mbase; C.pfx = spfx[lr]; C.msk = (C.pfx >= 512u) ? 0x80000000u : 0xffffffffu;
                  C.lane = ln; C.r32 = lr; C.hi = ln >> 5; C.ktb = ktb; C.kte = kte; C.hi2 = (wid >= 4);
                  pass_loop<3>(C, Q, la);
                  const unsigned nc = (la - la0) >> 2;
                  scnt[wid * 64 + ln] = nc < (unsigned)LISTN ? nc : (unsigned)LISTN;
                  if (nc > (unsigned)LISTN) sflag[0] = 1u; }
                asm volatile("s_waitcnt vmcnt(0) lgkmcnt(0)\n\ts_barrier" ::: "memory");
                SEC_E(95);
                if (sflag[0] == 0u) {
                    SEC_B(96);
                    for (int rp_ = 0; rp_ < ((PROBE_DUP == 85) ? 2 : 1); ++rp_)
                    { const int ln = lane_now(), li = ln & 15; LAS unsigned* wh = (LAS unsigned*)(lds + L_WH) + wid * 256;
#pragma unroll 1
                      for (int qi = 0; qi < 4; ++qi) {
                          const int q = wid * 4 + qi, L = (li >> 1) * 64 + q + 32 * (li & 1);
                          const int cn = (int)scnt[L];
                          int mx = cn;
                          { int o;
                            o = __builtin_amdgcn_update_dpp(0, mx, 0x111, 0xf, 0xf, false); mx = o > mx ? o : mx;
                            o = __builtin_amdgcn_update_dpp(0, mx, 0x112, 0xf, 0xf, false); mx = o > mx ? o : mx;
                            o = __builtin_amdgcn_update_dpp(0, mx, 0x114, 0xf, 0xf, false); mx = o > mx ? o : mx;
                            o = __builtin_amdgcn_update_dpp(0, mx, 0x118, 0xf, 0xf, false); mx = o > mx ? o : mx; }
                          const int nj = (__builtin_amdgcn_readlane(mx, 15) + 3) >> 2;
                          const int need = __builtin_amdgcn_readfirstlane(sneed[q]);
                          const LAS unsigned* lbase = lists + L * LSTR;
                          unsigned tl;
                          if (nj <= 4) tl = resolve_query<4>(lbase, cn, ln, wh, need); else if (nj <= 8) tl = resolve_query<8>(lbase, cn, ln, wh, need); else tl = resolve_query<16>(lbase, cn, ln, wh, need);
                          if (ln == 0) stau[q] = tl;
                      } }
                    asm volatile("s_waitcnt lgkmcnt(0)\n\ts_barrier" ::: "memory");
                    SEC_E(96); SEC_B(97);
                    for (int rp_ = 0; rp_ < ((PROBE_DUP == 86) ? 2 : 1); ++rp_)
                    { const int ln = lane_now(); const unsigned tq = stau[ln & 31], n = scnt[wid * 64 + ln]; const LAS unsigned* lown = lists + (wid * 64 + ln) * LSTR;
                      for (unsigned i = 0; i < n; ++i) {
                          const unsigned e = lown[i];
                          if ((e & 0x3fffffu) >= tq) {
                              const int ekt = ktb + (int)(e >> 26);
                              (void)__hip_atomic_fetch_or((GAS unsigned*)mbase + (size_t)(ekt >> 1) * 64 + ln, 1u << (((e >> 22) & 15u) + 16u * (unsigned)(ekt & 1)), __ATOMIC_RELAXED, __HIP_MEMORY_SCOPE_AGENT);
                          }
                      } }
                    SEC_E(97);
                    fast = true; need_mask_pass = false;
                }
                if (PROBE_DUP == 79 && rpB_ == 0) asm volatile("s_waitcnt vmcnt(0) lgkmcnt(0)\n\ts_barrier" ::: "memory");
                }
                if (fast) break;
            }
        }
        SEC_B(71);
        const int lane = lane_now(), r32 = lane & 31;
        tau = spfx[r32];
        const bool overflow = fast ? true : (__any(lcnt[r32] > (unsigned)LCAP) != 0);
        if (!overflow) {
            need_mask_pass = false;
            const unsigned n = lcnt[r32], tq = tau & 2047u;
            for (unsigned i = 0; i < n; ++i) {
                const unsigned e = blist[r32 * LCAP + i]; const int ekt = (int)(e >> 21);
                if (((e >> 15) & 63u) == (unsigned)lane && ekt >= ktb && ekt < kte && (e & 2047u) >= tq) {
                    GAS unsigned short* wp = mbase + (size_t)(ekt >> 1) * 128 + lane * 2 + (ekt & 1);
                    *wp = (unsigned short)(*wp | (1u << ((e >> 11) & 15u)));
                }
            }
        }
    }
#define IDX_MASK_BODY(K0, K1, KT) do { float acc[16]; score_tile(acc, K0, K1, Q); unsigned bits = 0u; \
        _Pragma("unroll") for (int r = 0; r < 16; ++r) bits |= (f2key(acc[r]) >= tau) ? (1u << r) : 0u; \
        if (!dryp) mbase[(size_t)((KT) >> 1) * 128 + lane * 2 + ((KT) & 1)] = (unsigned short)bits; else if (bits == 0xffffu && tau == 0x12345679u) mbase[0] = 0; } while (0)
    const int nreal = need_mask_pass ? 1 : 0, nrep = nreal + ((PROBE_DUP == 81) ? 2 : 0);
    for (int rep_ = 0; rep_ < nrep; ++rep_)
    { const bool dryp = (PROBE_DUP == 81) && (rep_ >= nreal);
      bf16x8 a0, a1, b0, b1, c0, c1;
      if (ktb < kte) IDX_KLOAD(a0, a1, ktb); if (ktb + 1 < kte) IDX_KLOAD(b0, b1, ktb + 1); if (ktb + 2 < kte) IDX_KLOAD(c0, c1, ktb + 2);
      for (int kt = ktb; kt < kte; kt += 3) {
          IDX_MASK_BODY(a0, a1, kt); if (kt + 3 < kte) IDX_KLOAD(a0, a1, kt + 3);
          if (kt + 1 < kte) { IDX_MASK_BODY(b0, b1, kt + 1); if (kt + 4 < kte) IDX_KLOAD(b0, b1, kt + 4); }
          if (kt + 2 < kte) { IDX_MASK_BODY(c0, c1, kt + 2); if (kt + 5 < kte) IDX_KLOAD(c0, c1, kt + 5); }
      } }
#undef IDX_MASK_BODY
    SEC_E(90); if (nkt * 32 > 256) SEC_E(71);
    if (PROBE_DUP >= 90 && PROBE_DUP < 100) { const long long t0_ = wall_clock64(); while (wall_clock64() - t0_ < spin_) __builtin_amdgcn_s_sleep(4); }
    asm volatile("s_waitcnt lgkmcnt(0)\n\ts_barrier" ::: "memory");
#undef SEC_B
#undef SEC_E
}
#undef IDX_KLOAD

__device__ __forceinline__ void phase(const bf16_t* O1, const bf16_t* KIDX, unsigned* MASK, LAS unsigned char* lds, int G, int bid, int wv) {
    for (int p = bid; p < 512; p += G) {
        const int b = p & 3, j = p >> 2;
#pragma unroll 1
        for (int u2 = 0; u2 < 2; ++u2) for (int rp_ = 0; rp_ < ((PROBE_DUP == 87) ? 2 : 1); ++rp_) unit(b, u2 ? 255 - j : j, O1, KIDX, MASK, lds, wv);
    }
}
}
struct Frame { LAS unsigned char* lds; int G, bid, wv; Ptrs p; };

__device__ __forceinline__ int win_dest_row(int n) {
    if (n < 672) return n;
    if (n < 3488) return n + 96;
    if (n < 3528) return n - 3488 + 672;
    return n + 56;
}
template <bool MAP>
__device__ __forceinline__ void transpose_item(const float* __restrict__ W, int K, int N, bf16_t* __restrict__ WT, const float* __restrict__ gk, LAS float* scr, int item, int lane) {
    const int nblk = (N + 31) / 32, kb = item / nblk, nb = item % nblk, k0 = 64 * kb, n0 = 32 * nb;
    const int nn = n0 + (lane & 31);
#pragma unroll 8
    for (int i = 0; i < 32; ++i) { const int kk = 2 * i + (lane >> 5); float v = 0.f; if (nn < N) v = W[(size_t)(k0 + kk) * N + nn]; if (gk) v *= gk[k0 + kk]; scr[kk * 33 + (lane & 31)] = v; }
    asm volatile("s_waitcnt lgkmcnt(0)" ::: "memory");
    const int c = lane & 7;
#pragma unroll
    for (int j = 0; j < 4; ++j) { const int n = (lane >> 3) + 8 * j; const LAS float* s = scr + (8 * c) * 33 + n;
        u32x4 o; o.x = pk2(s[0 * 33], s[1 * 33]); o.y = pk2(s[2 * 33], s[3 * 33]); o.z = pk2(s[4 * 33], s[5 * 33]); o.w = pk2(s[6 * 33], s[7 * 33]);
        if (n0 + n < N) { const int dr = MAP ? win_dest_row(n0 + n) : (n0 + n); *(u32x4*)(WT + (size_t)dr * K + k0 + 8 * c) = o; } }
    asm volatile("s_waitcnt lgkmcnt(0)" ::: "memory");
}

__device__ __forceinline__ void phase0(Frame& F) {
    const int t_ = tid_now(F.wv);
    const int tid = t_, lane = tid & 63; const int wave = F.wv; (void)tid; (void)lane; (void)wave;
    unsigned char* ws = F.p.ws;
    LAS float* scr = (LAS float*)(F.lds + wave * 16384);
    const int gw = F.bid * 8 + wave, NGW = F.G * 8;
    constexpr int I_IN = 16 * 175, I_UQ = 6 * 24, I_UKV = 4 * 32, I_OA = 8 * 32, I_OB = 8 * 32, I_OUT = 16 * 32;
    constexpr int NITEMS = I_IN + I_UQ + I_UKV + I_OA + I_OB + I_OUT;
    for (int it = gw; it < NITEMS; it += NGW) {
        int r = it;
        if (r < I_IN) { transpose_item<true>(F.p.w_in, 1024, NIN, (bf16_t*)(ws + WS_WINT), nullptr, scr, r, lane); continue; } r -= I_IN;
        if (r < I_UQ) { transpose_item<false>(F.p.w_uq, 384, 768, (bf16_t*)(ws + WS_WUQT), F.p.g_q, scr, r, lane); continue; } r -= I_UQ;
        if (r < I_UKV) { transpose_item<false>(F.p.w_ukv, 256, 1024, (bf16_t*)(ws + WS_WUKVT), F.p.g_kv, scr, r, lane); continue; } r -= I_UKV;
        if (r < I_OA) { transpose_item<false>(F.p.w_oa, 512, 1024, (bf16_t*)(ws + WS_WOAT), nullptr, scr, r, lane); continue; } r -= I_OA;
        if (r < I_OB) { transpose_item<false>(F.p.w_ob, 512, 1024, (bf16_t*)(ws + WS_WOBT), nullptr, scr, r, lane); continue; } r -= I_OB;
        transpose_item<false>(F.p.w_out, 1024, 1024, (bf16_t*)(ws + WS_WOUTT), nullptr, scr, r, lane);
    }
    { const int gt = F.bid * 512 + tid; if (gt < 7168) ((u32x4*)(ws + WS_WINT + (size_t)712 * 1024 * 2))[gt] = (u32x4){0u, 0u, 0u, 0u}; }
    for (int e = F.bid * 512 + tid; e < S * 16; e += F.G * 512) {
        const int pos = e >> 4, i = e & 15;
        const float freq = powf(10000.f, -(float)i / 16.f); const float ang = (float)pos * freq;
        ((float2*)(ws + WS_ROPE))[e] = make_float2(cosf(ang), sinf(ang));
    }
    bf16_t* H = (bf16_t*)(ws + WS_H);
    for (int row = gw; row < T; row += NGW) {
        const f32x4* xr = (const f32x4*)(F.p.x + (size_t)row * DM);
        f32x4 v[4]; float s = 0.f;
#pragma unroll
        for (int j = 0; j < 4; ++j) { v[j] = xr[lane + 64 * j]; s += (v[j][0] * v[j][0] + v[j][1] * v[j][1]) + (v[j][2] * v[j][2] + v[j][3] * v[j][3]); }
        s = wave_sum(s);
        const float r = rsqrtf(s * (1.f / DM) + 1e-6f);
#pragma unroll
        for (int j = 0; j < 4; ++j) {
            const f32x4 gg = ((const f32x4*)F.p.norm_g)[lane + 64 * j];
            uint2 o; o.x = pk2(v[j][0] * r * gg[0], v[j][1] * r * gg[1]); o.y = pk2(v[j][2] * r * gg[2], v[j][3] * r * gg[3]);
            ((uint2*)(H + (size_t)row * DM))[lane + 64 * j] = o;
        }
    }
}

__device__ __forceinline__ void phase1(Frame& F, int dry = 0) {
    unsigned char* ws = F.p.ws;
    pg8::Gemm g{(const bf16_t*)(ws + WS_H), DM, (const bf16_t*)(ws + WS_WINT), T, LD1, DM, F.wv};
    pg8::StaticOrder So; So.init(T, LD1, F.G, F.bid);
    pg8::EpiIn E{(bf16_t*)(ws + WS_OUT1), (float*)(ws + WS_SSQLAT), dry};
    if (P1_STAGGER_TICKS > 0 && !dry && 2 * F.bid >= F.G) { const long long t0 = wall_clock64(); while (wall_clock64() - t0 < P1_STAGGER_TICKS) __builtin_amdgcn_s_sleep(8); }
    if (PROBE_DUP == 14 && dry) { pg8::Gemm gz{(const bf16_t*)(ws + WS_CTL), 0, (const bf16_t*)(ws + WS_CTL), T, LD1, DM, F.wv}; pg8::SameTileOrder Ss; Ss.S = So; pg8::gemm_phase<pg8::EpiIn, pg8::SameTileOrder, true, true>(F.lds, gz, Ss, E); return; }
    if (PROBE_DUP == 12 && dry) { pg8::SameTileOrder Ss; Ss.S = So; pg8::gemm_phase<pg8::EpiIn, pg8::SameTileOrder, true, true>(F.lds, g, Ss, E); return; }
    pg8::gemm_phase<pg8::EpiIn, pg8::StaticOrder, true, true>(F.lds, g, So, E);
}

__device__ __forceinline__ void probe13(Frame& F, int dry) {
    const long long c0 = clock64(); const long long w0 = wall_clock64();
    phase1(F, dry);
    const long long c1 = clock64(); const long long w1 = wall_clock64();
    const long long ticks = (c1 - c0) * 1000ll / (w1 - w0 + 1);
    const long long t0 = wall_clock64(); while (wall_clock64() - t0 < ticks) __builtin_amdgcn_s_sleep(8);
}

__device__ __forceinline__ void phase1b(Frame& F) {
    const int t_ = tid_now(F.wv);
    const int tid = t_, lane = tid & 63; const int wave = F.wv; (void)tid; (void)lane; (void)wave;
    unsigned char* ws = F.p.ws;
    const bf16_t* O1 = (const bf16_t*)(ws + WS_OUT1);
    {
        bf16_t* KPE = (bf16_t*)(ws + WS_KPE); bf16_t* KIDX = (bf16_t*)(ws + WS_KIDX); const float2* rope = (const float2*)(ws + WS_ROPE);
        for (int e = F.bid * 512 + tid; e < T * 16; e += F.G * 512) {
            const int m = e >> 4, i = e & 15; const bf16_t* src = O1 + (size_t)m * LD1;
            const float2 cs = rope[(size_t)(m & (S - 1)) * 16 + i];
            const float x1 = bf2f(src[O_KROPE + i]), x2 = bf2f(src[O_KROPE + 16 + i]);
            KPE[(size_t)m * 32 + i] = f2bf(x1 * cs.x - x2 * cs.y); KPE[(size_t)m * 32 + 16 + i] = f2bf(x1 * cs.y + x2 * cs.x);
            KIDX[(size_t)m * 32 + i] = src[O_KIDX + i]; KIDX[(size_t)m * 32 + 16 + i] = src[O_KIDX + 16 + i];
        }
    }
    {
        pg8::Gemm g{O1 + O_QLAT, LD1, (const bf16_t*)(ws + WS_WUQT), T, 768, 384, F.wv};
        pg8::StaticOrder So; So.init(T, 768, F.G, F.bid);
        pg8::EpiQ E{(bf16_t*)(ws + WS_Q), (const float*)(ws + WS_SSQLAT), (const float2*)(ws + WS_ROPE)};
        pg8::gemm_phase<pg8::EpiQ, pg8::StaticOrder, true, true>(F.lds, g, So, E);
    }
    {
        pg8::Gemm g{O1 + O_CKV, LD1, (const bf16_t*)(ws + WS_WUKVT), T, 1024, 256, F.wv};
        pg8::StaticOrder So; So.init(T, 1024, F.G, F.bid);
        pg8::EpiKV E{(bf16_t*)(ws + WS_H), (const float*)(ws + WS_SSQLAT)};
        pg8::gemm_phase<pg8::EpiKV, pg8::StaticOrder, true, true>(F.lds, g, So, E);
    }
}

__device__ __forceinline__ void phase4ab(Frame& F) {
    unsigned char* ws = F.p.ws;
    const bf16_t* O1 = (const bf16_t*)(ws + WS_OUT1); bf16_t* MG = (bf16_t*)(ws + WS_H);
    {
        pg8::Gemm g{O1 + O_ZA, LD1, (const bf16_t*)(ws + WS_WOAT), T, 1024, 512, F.wv};
        pg8::StaticOrder So; So.init(T, 1024, F.G, F.bid);
        pg8::EpiGate<false> E{MG, O1, O_GA};
        pg8::gemm_phase<pg8::EpiGate<false>, pg8::StaticOrder, true, true>(F.lds, g, So, E);
    }
    {
        pg8::Gemm g{O1 + O_ZB, LD1, (const bf16_t*)(ws + WS_WOBT), T, 1024, 512, F.wv};
        pg8::StaticOrder So; So.init(T, 1024, F.G, F.bid);
        pg8::EpiGate<true> E{MG, O1, O_GB};
        pg8::gemm_phase<pg8::EpiGate<true>, pg8::StaticOrder, true, true>(F.lds, g, So, E);
    }
}

__device__ __forceinline__ void phase4c(Frame& F) {
    unsigned char* ws = F.p.ws;
    pg8::Gemm g{(const bf16_t*)(ws + WS_H), DM, (const bf16_t*)(ws + WS_WOUTT), T, 1024, 1024, F.wv};
    pg8::StaticOrder So; So.init(T, 1024, F.G, F.bid);
    if (FUSE_FINAL_NORM && F.G == 256) {
        unsigned* ctl = (unsigned*)(ws + WS_CTL);
        pg8::EpiOutNorm E{F.p.x, F.p.out, (float*)(ws + WS_SSQO), F.p.final_g, ctl + CW_PANEL, ctl + CW_TMO, F.lds};
        pg8::gemm_phase<pg8::EpiOutNorm, pg8::StaticOrder, true, true>(F.lds, g, So, E);
        return;
    }
    pg8::EpiOut E{F.p.x, F.p.out, (float*)(ws + WS_SSQO)};
    pg8::gemm_phase<pg8::EpiOut, pg8::StaticOrder, true, true>(F.lds, g, So, E);
}

__device__ __forceinline__ void phase5(Frame& F) {
    const int t_ = tid_now(F.wv);
    const int tid = t_, lane = tid & 63; const int wave = F.wv; (void)tid; (void)lane; (void)wave;
    const float* ssqo = (const float*)(F.p.ws + WS_SSQO);
    const int gw = F.bid * 8 + wave, NGW = F.G * 8;
    for (int row = gw; row < T; row += NGW) {
        float s = (lane < 32) ? ssqo[(size_t)row * 32 + lane] : 0.f;
        s = wave_sum(s);
        const float r = rsqrtf(s * (1.f / DM) + 1e-6f);
        f32x4* xr = (f32x4*)(F.p.out + (size_t)row * DM);
#pragma unroll
        for (int j = 0; j < 4; ++j) { const f32x4 gg = ((const f32x4*)F.p.final_g)[lane + 64 * j]; xr[lane + 64 * j] = xr[lane + 64 * j] * r * gg; }
    }
}

__device__ __forceinline__ void phase_mla(Frame& F, bool dry = false) {
    unsigned char* ws = F.p.ws;
    att::Tensors X{};
    X.Q = (const bf16_t*)(ws + WS_Q); X.ldq = 768; X.hq = 96;
    X.K0 = (const bf16_t*)(ws + WS_H); X.ldk = 1024; X.hk = 128; X.K1 = (const bf16_t*)(ws + WS_KPE);
    X.V = (const bf16_t*)(ws + WS_H) + 64; X.ldv = 1024; X.hv = 128;
    X.O = (bf16_t*)(ws + WS_OUT1) + O_ZA; X.ldo = LD1; X.mask = nullptr; X.rel_bias = nullptr;
    X.wv = F.wv;
    att::phase<false>(X, F.lds, F.G, F.bid, dry);
}
__device__ __forceinline__ void phase_dsa(Frame& F, bool dry = false) {
    unsigned char* ws = F.p.ws; bf16_t* O1 = (bf16_t*)(ws + WS_OUT1);
    att::Tensors X{};
    X.Q = O1 + O_QB; X.ldq = LD1; X.hq = 64;
    X.K0 = O1 + O_KB; X.ldk = LD1; X.hk = 64; X.K1 = nullptr;
    X.V = O1 + O_VB; X.ldv = LD1; X.hv = 64;
    X.O = O1 + O_ZB; X.ldo = LD1; X.mask = (const unsigned long long*)(ws + WS_MASK); X.rel_bias = F.p.rel_bias;
    X.wv = F.wv;
    att::phase<true>(X, F.lds, F.G, F.bid, dry);
}

__device__ __forceinline__ void phase_idx(Frame& F) {
    unsigned char* ws = F.p.ws;
    idx::phase((const bf16_t*)(ws + WS_OUT1), (const bf16_t*)(ws + WS_KIDX), (unsigned*)(ws + WS_MASK), F.lds, F.G, F.bid, F.wv);
}

typedef unsigned long long u64_t;
#define XB_TMO      128
#define XB_XCNT(j)  (256  + 64 * (j))
#define XB_XSUB(j)  (1280 + 64 * (j))
#define XB_XGEN(j)  (2304 + 64 * (j))
#define XB_TOP      3328
#define XB_TOPGEN   3392
#define XCD_BAR_WORDS 3456
#define XB_SPIN_CAP (1u << 18)

__device__ __forceinline__ unsigned xb_ld(unsigned* p)              { return __hip_atomic_load(p, __ATOMIC_RELAXED, __HIP_MEMORY_SCOPE_AGENT); }
__device__ __forceinline__ unsigned xb_add(unsigned* p, unsigned v) { return __hip_atomic_fetch_add(p, v, __ATOMIC_RELAXED, __HIP_MEMORY_SCOPE_AGENT); }
__device__ __forceinline__ unsigned xb_xcc_id() { return (unsigned)__builtin_amdgcn_s_getreg((3 << 11) | 20) & 0xFu; }
#define XB_SPIN(cond, bar) do { unsigned _sp = 0; while (cond) { __builtin_amdgcn_s_sleep(1); \
    if ((++_sp & 255u) == 0u) { if (xb_ld(&(bar)[XB_TMO])) break; if (_sp > XB_SPIN_CAP) { atomicAdd(&(bar)[XB_TMO], 1u); break; } } } } while (0)

struct XcdBarrier {
    unsigned* bar; unsigned x; int wv;
    volatile LAS unsigned* st;
};

__device__ __forceinline__ XcdBarrier xcd_barrier_post(unsigned* bar, volatile LAS unsigned* st, int wv) {
    XcdBarrier b; b.bar = bar; b.x = xb_xcc_id(); b.st = st; b.wv = wv;
    if (threadIdx.x == 0) (void)xb_add(&bar[XB_XCNT(b.x)], 1u);
    return b;
}
__device__ __forceinline__ void xcd_barrier_complete(unsigned* bar, unsigned x, unsigned& nloc, unsigned& nx) {
    const unsigned G = gridDim.x * gridDim.y * gridDim.z;
    unsigned sum, cnt, mine, sp = 0u;
    for (;;) {
        sum = 0u; cnt = 0u; mine = 0u;
#pragma unroll
        for (unsigned j = 0; j < 16; ++j) { const unsigned c = xb_ld(&bar[XB_XCNT(j)]); sum += c; cnt += (c > 0u) ? 1u : 0u; mine = (j == x) ? c : mine; }
        if (sum == G) break;
        __builtin_amdgcn_s_sleep(1);
        if ((++sp & 255u) == 0u) { if (xb_ld(&bar[XB_TMO])) break; if (sp > XB_SPIN_CAP) { atomicAdd(&bar[XB_TMO], 1u); break; } }
    }
    nloc = mine > 0u ? mine : 1u; nx = cnt > 0u ? cnt : 1u;
}

__device__ __forceinline__ void xcd_barrier(const XcdBarrier& b) {
    asm volatile("s_waitcnt vmcnt(0)" ::: "memory");
    __syncthreads();
    if (b.wv == 0 && lane_now() == 0) {
        unsigned* bar = b.bar;
        __builtin_amdgcn_s_waitcnt(0);
        unsigned nloc = b.st[0], nx = b.st[1];
        if (nloc == 0u) { xcd_barrier_complete(bar, b.x, nloc, nx); b.st[0] = nloc; b.st[1] = nx; }
        const unsigned old = xb_add(&bar[XB_XSUB(b.x)], 1u);
        const unsigned gen = old / nloc;
        if (old + 1u == (gen + 1u) * nloc) {
            __builtin_amdgcn_fence(__ATOMIC_RELEASE, "agent");
            asm volatile("s_waitcnt vmcnt(0)" ::: "memory");
            const unsigned og = xb_add(&bar[XB_TOP], 1u);
            const unsigned tg = og / nx;
            if (og + 1u == (tg + 1u) * nx) xb_add(&bar[XB_TOPGEN], 1u);
            else XB_SPIN(xb_ld(&bar[XB_TOPGEN]) == tg, bar);
            __builtin_amdgcn_fence(__ATOMIC_ACQUIRE, "agent");
            xb_add(&bar[XB_XGEN(b.x)], 1u);
            asm volatile("s_waitcnt vmcnt(0)" ::: "memory");
        } else {
            XB_SPIN(xb_ld(&bar[XB_XGEN(b.x)]) == gen, bar);
            __builtin_amdgcn_fence(__ATOMIC_ACQUIRE, "agent");
            asm volatile("s_waitcnt vmcnt(0)" ::: "memory");
        }
    }
    __syncthreads();
}

constexpr int CW_BAR = 4096;
constexpr size_t CTL_ZERO_BYTES = (PROBE_DUP == 14) ? (1u << 20) : 65536;
constexpr int LDS_MISC = 150016;
struct Args { Ptrs p; int ph_lo, ph_hi; };
__global__ void __launch_bounds__(512, 2) mega_fwd(Args a) {
    extern __shared__ __attribute__((aligned(16))) unsigned char lds_raw[];
    Frame F; F.lds = (LAS unsigned char*)lds_raw;
    F.G = gridDim.x; F.bid = blockIdx.x; F.p = a.p;
    cooperative_groups::grid_group grid = cooperative_groups::this_grid();
    volatile LAS unsigned* st = (volatile LAS unsigned*)(F.lds + LDS_MISC);
    if (threadIdx.x < 4) st[threadIdx.x] = 0u;
    F.wv = __builtin_amdgcn_readfirstlane((int)(threadIdx.x >> 6));
    __syncthreads();
    const XcdBarrier bar = xcd_barrier_post((unsigned*)(a.p.ws + WS_CTL) + CW_BAR, st, F.wv);
    static_assert(CW_TMO == CW_BAR + XB_TMO && CW_PANEL * 4 + 64 * 64 <= (int)CTL_ZERO_BYTES, "control words");
    const int lo = a.ph_lo, hi = (FUSE_FINAL_NORM && !DEBUG_FUSE && F.G == 256 && a.ph_hi > 7) ? 7 : a.ph_hi;
struct ClkProbe {
    long long c0, w0;
    __device__ __forceinline__ void begin() { c0 = clock64(); w0 = wall_clock64(); }
    __device__ __forceinline__ void end() { const long long c1 = clock64(); const long long w1 = wall_clock64(); const long long ticks = (c1 - c0) * 1000ll / (w1 - w0 + 1);
        const long long t0 = wall_clock64(); while (wall_clock64() - t0 < ticks) __builtin_amdgcn_s_sleep(8); }
};
#define CLK(code, body) do { if (PROBE_DUP == (code)) { ClkProbe q_; q_.begin(); body; q_.end(); } else { body; } } while (0)
#define RUN(k, body, CG) do { if (lo <= (k) && (k) < hi) { body; if ((k) + 1 < hi) { if (CG) grid.sync(); else { xcd_barrier(bar); } } } } while (0)
    const bool dryrun = (a.ph_hi > 0);
    RUN(0, { CLK(30, phase0(F)); if (PROBE_DUP == 0) phase0(F); }, true);
    RUN(1, { if (PROBE_DUP == 21) { const long long t0 = clock64(); while (clock64() - t0 < 1000000ll) __builtin_amdgcn_s_sleep(8); } CLK(31, phase1(F)); if (PROBE_DUP == 1) phase1(F); if (PROBE_DUP == 11 || PROBE_DUP == 12 || PROBE_DUP == 14) phase1(F, (int)dryrun); if (PROBE_DUP == 13) probe13(F, (int)dryrun); }, false);
    RUN(2, { CLK(32, phase1b(F)); if (PROBE_DUP == 2) phase1b(F); }, false);
    RUN(3, { const bool idx_first = (MIX_ORDER != 0) && (((F.bid >> 3) & 1) != 0); if (idx_first) phase_idx(F); CLK(33, phase_mla(F)); if (PROBE_DUP == 3) phase_mla(F, dryrun); if (!idx_first) CLK(38, phase_idx(F)); if (PROBE_DUP == 8) phase_idx(F); }, false);
    RUN(4, { CLK(34, phase_dsa(F)); if (PROBE_DUP == 4) phase_dsa(F, dryrun); }, false);
    RUN(5, { CLK(35, phase4ab(F)); if (PROBE_DUP == 5) phase4ab(F); }, false);
    RUN(6, { if (PROBE_DUP == 22) { const long long t0 = clock64(); while (clock64() - t0 < 1000000ll) __builtin_amdgcn_s_sleep(8); } CLK(36, phase4c(F)); if (PROBE_DUP == 6) phase4c(F); }, false);
    if (!(FUSE_FINAL_NORM && !DEBUG_FUSE && F.G == 256)) RUN(7, phase5(F), false);
#undef RUN
}

extern "C" void kernel_launch(void* const* d_in, const int* in_sizes, int n_in, void* d_out, int out_size, void* d_ws, size_t ws_size, hipStream_t stream) {
    static int grid = 0;
    if (grid == 0) {
        if (ws_size < WS_END) { fprintf(stderr, "kernel_launch: workspace too small: %zu < %zu\n", ws_size, (size_t)WS_END); grid = -1; return; }
        int dev = 0, cus = 0, per_cu = 0;
        if (hipGetDevice(&dev) != hipSuccess || hipDeviceGetAttribute(&cus, hipDeviceAttributeMultiprocessorCount, dev) != hipSuccess) { grid = -1; return; }
        if (hipFuncSetAttribute((const void*)mega_fwd, hipFuncAttributeMaxDynamicSharedMemorySize, LDS_BYTES) != hipSuccess) { fprintf(stderr, "kernel_launch: hipFuncSetAttribute failed\n"); grid = -1; return; }
        if (hipOccupancyMaxActiveBlocksPerMultiprocessor(&per_cu, (const void*)mega_fwd, 512, LDS_BYTES) != hipSuccess || per_cu < 1) { fprintf(stderr, "kernel_launch: occupancy query failed (%d)\n", per_cu); (void)hipGetLastError(); grid = -1; return; }
        grid = cus;
    }
    if (grid < 0) return;
    if (hipMemsetAsync((char*)d_ws + WS_CTL, 0, CTL_ZERO_BYTES, stream) != hipSuccess) { fprintf(stderr, "kernel_launch: hipMemsetAsync failed\n"); return; }
    Args a{};
    a.p.x = (const float*)d_in[0]; a.p.norm_g = (const float*)d_in[1]; a.p.w_in = (const float*)d_in[2]; a.p.g_q = (const float*)d_in[3]; a.p.w_uq = (const float*)d_in[4];
    a.p.g_kv = (const float*)d_in[5]; a.p.w_ukv = (const float*)d_in[6]; a.p.w_oa = (const float*)d_in[7]; a.p.w_ob = (const float*)d_in[8]; a.p.w_out = (const float*)d_in[9];
    a.p.rel_bias = (const float*)d_in[10]; a.p.final_g = (const float*)d_in[11]; a.p.out = (float*)d_out; a.p.ws = (unsigned char*)d_ws;
    a.ph_lo = 0; a.ph_hi = 8;
    void* args[] = {&a};
    const hipError_t e = hipLaunchCooperativeKernel((const void*)mega_fwd, dim3(grid), dim3(512), args, LDS_BYTES, stream);
    if (e != hipSuccess) fprintf(stderr, "kernel_launch: cooperative launch failed: %s (grid %d)\n", hipGetErrorString(e), grid);
}
```

```cpp
#include <hip/hip_runtime.h>
#include <hip/hip_cooperative_groups.h>
#include <stdint.h>
#include <stdio.h>
#ifndef PROBE_DUP
#define PROBE_DUP -1
#endif

__device__ __forceinline__ int lane_now() { int l; asm volatile("v_mbcnt_lo_u32_b32 %0, -1, 0\n\tv_mbcnt_hi_u32_b32 %0, -1, %0" : "=v"(l)); return l; }
__device__ __forceinline__ int tid_now(int wv) { return (wv << 6) | lane_now(); }

namespace pg8 {
#define PG8_LAS __attribute__((address_space(3)))
typedef unsigned short bf16_t;
typedef short bf16x8 __attribute__((ext_vector_type(8)));
typedef float f32x4 __attribute__((ext_vector_type(4)));
typedef unsigned u32x4 __attribute__((ext_vector_type(4)));
constexpr int BM = 256, BK = 64, HALF = 128, HTB = HALF * BK * 2  , STAGE_BYTES = 8 * HTB, NXCD = 8, WGM = 8;

__host__ __device__ __forceinline__ int lds_byte(int r, int c) { const int st = (r >> 4) * 2 + (c >> 5), rr = r & 15, cc = c & 31, ob = rr * 64 + cc * 2; return st * 1024 + (ob ^ (((ob >> 9) & 1) << 5)); }
__host__ __device__ __forceinline__ void stage_rc(int b, int& R, int& C) { const int st = b / 1024, sb = b % 1024, swz = sb ^ (((sb >> 9) & 1) << 5); R = (st >> 1) * 16 + swz / 64; C = (st & 1) * 32 + (swz % 64) / 2; }
__host__ __device__ __forceinline__ int perm32(int rho) { const int n = rho >> 4, i = rho & 15; return 8 * (i >> 2) + 4 * n + (i & 3); }

struct Unit { int pm, pn; };
struct Gemm { const bf16_t* A; int lda; const bf16_t* Bt; int M, N, K; int wv; };

struct StaticOrder {
    int nM, nN, nwg, G, c;
    __host__ __device__ void init(int M, int N, int G_, int c_) { nM = M / BM; nN = N / BM; nwg = nM * nN; G = G_; c = c_; }
    __host__ __device__ bool next(int i, Unit& u) const {
        const long L = (long)i * G + c; if (L >= nwg) return false;
        int wgid = (int)L; { const int q = nwg / NXCD, r = nwg % NXCD, xcd = wgid % NXCD, off = wgid / NXCD; wgid = (xcd < r ? xcd * (q + 1) : r * (q + 1) + (xcd - r) * q) + off; }
        const int nig = WGM * nN, gid = wgid / nig, fm = gid * WGM, gsz = (nM - fm) < WGM ? (nM - fm) : WGM;
        u.pm = fm + ((wgid % nig) % gsz); u.pn = (wgid % nig) / gsz; return true;
    }
    __device__ __forceinline__ void a_ready(const Unit&) const {}
    __device__ __forceinline__ void done(const Unit&) const {}
};
struct SameTileOrder {
    StaticOrder S;
    __host__ __device__ bool next(int i, Unit& u) const { const bool ok = S.next(i, u); u.pm = 0; u.pn = 0; return ok; }
    __device__ __forceinline__ void a_ready(const Unit&) const {}
    __device__ __forceinline__ void done(const Unit&) const {}
};

typedef __bf16 bf16x2_t __attribute__((ext_vector_type(2)));
typedef float f32x2_t __attribute__((ext_vector_type(2)));
__device__ __forceinline__ unsigned cvt_pk_bf16(float lo, float hi) { const f32x2_t v = {lo, hi}; return __builtin_bit_cast(unsigned, __builtin_convertvector(v, bf16x2_t)); }
template <class Epi, class Sched, bool ALIGN_EPI = false, bool SP2 = false>
__device__ __forceinline__ void gemm_phase(PG8_LAS unsigned char* lds, const Gemm g, const Sched& S, const Epi& E) {
    const int tid_ = tid_now(g.wv);
    const int tid = tid_, wid = g.wv, lane = tid & 63, wr = wid >> 2, wc = wid & 3, fr = lane & 15, fq = lane >> 4;
    int K_ = g.K; if (g.K < 1024) asm volatile("" : "+s"(K_));
    const int K = K_, nt = K / BK;
    unsigned voffA[2], voffB[2];
#pragma unroll
    for (int i = 0; i < 2; ++i) { int R, C; stage_rc(tid * 16 + i * 8192, R, C); const int Rb = Epi::PERM ? ((R & ~31) + perm32(R & 31)) : R;
        voffA[i] = (unsigned)(R * g.lda + C) * 2u; voffB[i] = (unsigned)(Rb * K + C) * 2u; }
    const size_t kstep = (size_t)(BK * 2);
    const size_t hstepA = (size_t)HALF * g.lda * 2, hstepB = (size_t)HALF * K * 2;
    const size_t tstepA = 2 * hstepA, tstepB = 2 * hstepB;
    const unsigned ldsw = (unsigned)wid * 1024u;
    const int aoff = lds_byte(wr * 64 + fr, fq * 8), boff = lds_byte(wc * 32 + fr, fq * 8);
#define PG8_SA(b, h) (((b) * 2 + (h)) * HTB)
#define PG8_SB(b, h) ((4 + (b) * 2 + (h)) * HTB)
#define PG8_STAGE(bufoff, gbase, voff) do { _Pragma("unroll") for (int _i = 0; _i < 2; ++_i) \
        __builtin_amdgcn_global_load_lds((const unsigned*)((const char*)(gbase) + (voff)[_i]), (PG8_LAS unsigned*)(lds + (bufoff) + ldsw + _i * 8192), 16, 0, 0); } while (0)
#define PG8_LDA(dst, b, h) do { _Pragma("unroll") for (int m = 0; m < 4; ++m) _Pragma("unroll") for (int k = 0; k < 2; ++k) dst[m][k] = *(const PG8_LAS bf16x8*)(lds + PG8_SA(b, h) + aoff + m * 2048 + k * 1024); } while (0)
#define PG8_LDB(dst, b, h) do { _Pragma("unroll") for (int n = 0; n < 2; ++n) _Pragma("unroll") for (int k = 0; k < 2; ++k) dst[n][k] = *(const PG8_LAS bf16x8*)(lds + PG8_SB(b, h) + boff + n * 2048 + k * 1024); } while (0)
#define PG8_MMA(ai, bj, At, Bt) do { __builtin_amdgcn_s_setprio(1); _Pragma("unroll") for (int m = 0; m < 4; ++m) _Pragma("unroll") for (int n = 0; n < 2; ++n) _Pragma("unroll") for (int k = 0; k < 2; ++k) \
        acc[ai][bj][m][n] = __builtin_amdgcn_mfma_f32_16x16x32_bf16(Bt[n][k], At[m][k], acc[ai][bj][m][n], 0, 0, 0); __builtin_amdgcn_s_setprio(0); } while (0)
#define PG8_WAIT_V(n) asm volatile("s_waitcnt vmcnt(" #n ")" ::: "memory")
#define PG8_WAIT_L(n) asm volatile("s_waitcnt lgkmcnt(" #n ")" ::: "memory")
#define PG8_BAR __builtin_amdgcn_s_barrier()
#define PG8_SCHED __builtin_amdgcn_sched_barrier(0)
    Unit cur, nxt; int ui = 0;
    if (!S.next(0, cur)) return;
    f32x4 acc[2][2][4][2];
#pragma unroll
    for (int a = 0; a < 2; ++a)
#pragma unroll
        for (int b = 0; b < 2; ++b)
#pragma unroll
            for (int m = 0; m < 4; ++m)
#pragma unroll
                for (int n = 0; n < 2; ++n) acc[a][b][m][n] = (f32x4){0.f, 0.f, 0.f, 0.f};
    bf16x8 At[4][2], B0[2][2], B1[2][2];
    const char* cA = (const char*)g.A + (size_t)cur.pm * tstepA; const char* cB = (const char*)g.Bt + (size_t)cur.pn * tstepB;
    S.a_ready(cur);
    if constexpr (SP2) {
        PG8_STAGE(PG8_SB(0, 0), cB, voffB); PG8_STAGE(PG8_SB(0, 1), cB + hstepB, voffB); PG8_STAGE(PG8_SA(0, 0), cA, voffA); PG8_STAGE(PG8_SA(0, 1), cA + hstepA, voffA);
        if (wr == 1) PG8_BAR;
        PG8_WAIT_V(2); PG8_BAR;
        PG8_STAGE(PG8_SB(1, 0), cB + kstep, voffB); PG8_STAGE(PG8_SA(1, 0), cA + kstep, voffA); PG8_STAGE(PG8_SB(1, 1), cB + hstepB + kstep, voffB);
        PG8_WAIT_V(6); PG8_BAR;
    } else {
        PG8_STAGE(PG8_SB(0, 0), cB, voffB); PG8_STAGE(PG8_SA(0, 0), cA, voffA); PG8_STAGE(PG8_SB(0, 1), cB + hstepB, voffB); PG8_STAGE(PG8_SA(0, 1), cA + hstepA, voffA);
        if (wr == 1) PG8_BAR;
        PG8_WAIT_V(4); PG8_BAR;
        PG8_STAGE(PG8_SB(1, 0), cB + kstep, voffB); PG8_STAGE(PG8_SA(1, 0), cA + kstep, voffA); PG8_STAGE(PG8_SB(1, 1), cB + hstepB + kstep, voffB);
        PG8_WAIT_V(6); PG8_BAR;
    }
    for (;;) {
        const bool has_next = S.next(ui + 1, nxt);
        const char* nA = has_next ? (const char*)g.A + (size_t)nxt.pm * tstepA : cA; const char* nB = has_next ? (const char*)g.Bt + (size_t)nxt.pn * tstepB : cB;
        for (int t = 0; t < nt; t += 2) {
            const bool last = (t == nt - 2);
            const char* a1 = cA + (size_t)(t + 1) * kstep;
            const char* a2 = last ? nA : cA + (size_t)(t + 2) * kstep; const char* b2 = last ? nB : cB + (size_t)(t + 2) * kstep;
            const char* a3 = a2 + kstep; const char* b3 = b2 + kstep;
            if (last && has_next) S.a_ready(nxt);
            if constexpr (SP2) {
            PG8_LDB(B0, 0, 0); PG8_LDB(B1, 0, 1); PG8_SCHED; PG8_LDA(At, 0, 0); PG8_STAGE(PG8_SA(1, 1), a1 + hstepA, voffA);
            PG8_WAIT_V(8); PG8_WAIT_L(0); PG8_BAR; PG8_MMA(0, 0, At, B0); PG8_MMA(0, 1, At, B1); PG8_BAR; PG8_SCHED;
            PG8_LDA(At, 0, 1); PG8_STAGE(PG8_SB(0, 0), b2, voffB); PG8_STAGE(PG8_SB(0, 1), b2 + hstepB, voffB); PG8_STAGE(PG8_SA(0, 0), a2, voffA);
            PG8_WAIT_V(8); PG8_WAIT_L(0); PG8_BAR; PG8_MMA(1, 0, At, B0); PG8_MMA(1, 1, At, B1); PG8_BAR; PG8_SCHED;
            PG8_LDB(B0, 1, 0); PG8_LDB(B1, 1, 1); PG8_SCHED; PG8_LDA(At, 1, 0); PG8_STAGE(PG8_SA(0, 1), a2 + hstepA, voffA);
            PG8_WAIT_V(8); PG8_WAIT_L(0); PG8_BAR; PG8_MMA(0, 0, At, B0); PG8_MMA(0, 1, At, B1); PG8_BAR; PG8_SCHED;
            PG8_LDA(At, 1, 1); PG8_STAGE(PG8_SB(1, 0), b3, voffB); PG8_STAGE(PG8_SB(1, 1), b3 + hstepB, voffB); PG8_STAGE(PG8_SA(1, 0), a3, voffA);
            PG8_WAIT_V(8); PG8_WAIT_L(0); PG8_BAR; PG8_MMA(1, 0, At, B0); PG8_MMA(1, 1, At, B1); PG8_BAR; PG8_SCHED;
            } else {
            PG8_LDB(B0, 0, 0); PG8_SCHED; PG8_LDA(At, 0, 0); PG8_STAGE(PG8_SA(1, 1), a1 + hstepA, voffA);
            PG8_WAIT_L(8); PG8_BAR; PG8_WAIT_L(0); PG8_MMA(0, 0, At, B0); PG8_BAR; PG8_SCHED;
            PG8_LDB(B1, 0, 1); PG8_STAGE(PG8_SB(0, 0), b2, voffB);
            PG8_BAR; PG8_WAIT_L(0); PG8_MMA(0, 1, At, B1); PG8_BAR;
            PG8_LDA(At, 0, 1); PG8_STAGE(PG8_SA(0, 0), a2, voffA);
            PG8_BAR; PG8_WAIT_L(0); PG8_MMA(1, 0, At, B0); PG8_BAR; PG8_SCHED;
            PG8_STAGE(PG8_SB(0, 1), b2 + hstepB, voffB);
            PG8_WAIT_V(6); PG8_BAR; PG8_MMA(1, 1, At, B1); PG8_BAR;
            PG8_LDB(B0, 1, 0); PG8_SCHED; PG8_LDA(At, 1, 0); PG8_STAGE(PG8_SA(0, 1), a2 + hstepA, voffA);
            PG8_WAIT_L(8); PG8_BAR; PG8_WAIT_L(0); PG8_MMA(0, 0, At, B0); PG8_BAR; PG8_SCHED;
            PG8_LDB(B1, 1, 1); PG8_STAGE(PG8_SB(1, 0), b3, voffB);
            PG8_BAR; PG8_WAIT_L(0); PG8_MMA(0, 1, At, B1); PG8_BAR;
            PG8_LDA(At, 1, 1); PG8_STAGE(PG8_SA(1, 0), a3, voffA);
            PG8_BAR; PG8_WAIT_L(0); PG8_MMA(1, 0, At, B0); PG8_BAR; PG8_SCHED;
            PG8_STAGE(PG8_SB(1, 1), b3 + hstepB, voffB);
            PG8_WAIT_V(6); PG8_BAR; PG8_MMA(1, 1, At, B1); PG8_BAR;
            }
        }
        if constexpr (ALIGN_EPI) { if (wr == 0) PG8_BAR; }
        if constexpr (!Epi::AFTER_DRAIN) { E(acc, cur, wr, wc, fr, fq); S.done(cur); }
        if (!has_next) break;
#pragma unroll
        for (int a = 0; a < 2; ++a)
#pragma unroll
            for (int b = 0; b < 2; ++b)
#pragma unroll
                for (int m = 0; m < 4; ++m)
#pragma unroll
                    for (int n = 0; n < 2; ++n) acc[a][b][m][n] = (f32x4){0.f, 0.f, 0.f, 0.f};
        cur = nxt; cA = nA; cB = nB; ++ui;
        if constexpr (ALIGN_EPI) { if (wr == 1) PG8_BAR; }
    }
    PG8_WAIT_V(0);
    if constexpr (!ALIGN_EPI) { if (wr == 0) PG8_BAR; }
    PG8_BAR;
    if constexpr (Epi::AFTER_DRAIN) { E.fused(acc, cur, wr, wc, fr, fq, lds, wid, lane); S.done(cur); }
#undef PG8_SA
#undef PG8_SB
#undef PG8_STAGE
#undef PG8_LDA
#undef PG8_LDB
#undef PG8_MMA
#undef PG8_WAIT_V
#undef PG8_WAIT_L
#undef PG8_BAR
#undef PG8_SCHED
}
}

typedef unsigned short bf16_t;
typedef float f32x4 __attribute__((ext_vector_type(4)));
typedef unsigned u32x4 __attribute__((ext_vector_type(4)));
#define LAS __attribute__((address_space(3)))
constexpr int NB = 4, S = 8192, DM = 1024, T = NB * S;
constexpr int NIN = 5576;
constexpr int LD1 = 5632;
constexpr int O_QLAT = 0, O_CKV = 384, O_KROPE = 640, O_KIDX = 672, O_WIDX = 704, O_ZA = 768, O_QB = 1280, O_KB = 1792, O_VB = 2304, O_ZB = 2816,
              O_QIDX = 3328, O_GA = 3584, O_GB = 4608;
constexpr size_t MiB = 1u << 20;
constexpr size_t WS_CTL = 0, WS_WUQT = 1 * MiB, WS_WUKVT = 2 * MiB, WS_WOAT = 3 * MiB, WS_WOBT = 4 * MiB, WS_WOUTT = 5 * MiB, WS_ROPE = 7 * MiB,
                 WS_WINT = 8 * MiB, WS_SSQO = 8 * MiB  , WS_SSQLAT = 19 * MiB, WS_KPE = 22 * MiB, WS_KIDX = 24 * MiB, WS_MASK = 26 * MiB,
                 WS_H = 44 * MiB  , WS_Q = 108 * MiB, WS_OUT1 = 156 * MiB, WS_END = 508 * MiB;
constexpr float LOG2E = 1.4426950408889634f;
constexpr float QSCALE_A = 0.10206207261596577f * LOG2E;
constexpr float QSCALE_B = 0.125f * LOG2E;
constexpr int GEMM_LDS = 131072;
constexpr int LDS_BYTES = 155648;
#ifndef FUSE_AFTER_DRAIN
#define FUSE_AFTER_DRAIN 0
#endif
#ifndef DEBUG_FUSE
#define DEBUG_FUSE 0
#endif
#ifndef FUSE_FINAL_NORM
#define FUSE_FINAL_NORM 1
#endif
constexpr int CW_PANEL = 8192, CW_TMO = 4096 + 128;
#ifndef MIX_ORDER
#define MIX_ORDER 0
#endif
#ifndef P1_STAGGER_TICKS
#define P1_STAGGER_TICKS 0
#endif

__device__ __forceinline__ float bf2f(bf16_t v) { return __uint_as_float(((unsigned)v) << 16); }
__device__ __forceinline__ bf16_t f2bf(float f) { unsigned u = __float_as_uint(f); return (bf16_t)((u + 0x7fffu + ((u >> 16) & 1u)) >> 16); }
__device__ __forceinline__ unsigned pk2(float lo, float hi) { return (unsigned)f2bf(lo) | ((unsigned)f2bf(hi) << 16); }
__device__ __forceinline__ float bflo(unsigned w) { return __uint_as_float(w << 16); }
__device__ __forceinline__ float bfhi(unsigned w) { return __uint_as_float(w & 0xffff0000u); }
__device__ __forceinline__ float wave_sum(float v) {
#pragma unroll
    for (int o = 1; o < 64; o <<= 1) v += __shfl_xor(v, o);
    return v;
}
__device__ __forceinline__ float sigmoidf_(float x) { return __builtin_amdgcn_rcpf(1.f + __builtin_amdgcn_exp2f(-LOG2E * x)); }

struct Ptrs {
    const float *x, *norm_g, *w_in, *g_q, *w_uq, *g_kv, *w_ukv, *w_oa, *w_ob, *w_out, *rel_bias, *final_g;
    float* out; unsigned char* ws;
};

namespace pg8 {
struct EpiIn {
    static constexpr bool PERM = true, AFTER_DRAIN = false;
    bf16_t* O; float* ssq; int dry;
    __device__ __forceinline__ void operator()(const f32x4 (&acc)[2][2][4][2], const Unit& u, int wr, int wc, int, int) const {
        const int t_ = lane_now();
        const int fr = t_ & 15, fq = (t_ >> 4) & 3;
        if ((PROBE_DUP >= 11 && PROBE_DUP <= 14) && dry) { f32x4 s4 = {0.f, 0.f, 0.f, 0.f};
#pragma unroll
            for (int a = 0; a < 2; ++a)
#pragma unroll
                for (int b = 0; b < 2; ++b)
#pragma unroll
                    for (int m = 0; m < 4; ++m) { s4 += acc[a][b][m][0]; s4 += acc[a][b][m][1]; }
            if (s4[0] + s4[1] + s4[2] + s4[3] == 1.2345e30f) O[0] = 0; return; }
        const int row0 = u.pm * BM + wr * 64 + fr;
#pragma unroll
        for (int bj = 0; bj < 2; ++bj) {
            const int g = u.pn * 2 + bj;
            const int col0 = g * 128 + wc * 32 + 8 * fq;
            int op = 0;
            if ((g >= 6 && g <= 9) || (g >= 22 && g <= 25)) op = 1; else if (g >= 28) op = 2; else if (g >= 10 && g <= 13) op = 3; else if (g <= 4) op = 4;
#pragma unroll
            for (int ai = 0; ai < 2; ++ai)
#pragma unroll
                for (int m = 0; m < 4; ++m) {
                    const int row = row0 + ai * HALF + m * 16;
                    f32x4 v0 = acc[ai][bj][m][0], v1 = acc[ai][bj][m][1];
                    if (op == 1) {
#pragma unroll
                        for (int e = 0; e < 4; ++e) { v0[e] = v0[e] * sigmoidf_(v0[e]); v1[e] = v1[e] * sigmoidf_(v1[e]); }
                    } else if (op == 2) {
#pragma unroll
                        for (int e = 0; e < 4; ++e) { v0[e] = sigmoidf_(v0[e]); v1[e] = sigmoidf_(v1[e]); }
                    } else if (op == 3) { v0 = v0 * QSCALE_B; v1 = v1 * QSCALE_B; }
                    else if (op == 4) {
                        float s = (v0[0] * v0[0] + v0[1] * v0[1]) + (v0[2] * v0[2] + v0[3] * v0[3]) + (v1[0] * v1[0] + v1[1] * v1[1]) + (v1[2] * v1[2] + v1[3] * v1[3]);
                        s += __shfl_xor(s, 16); s += __shfl_xor(s, 32);
                        if (fq == 0) ssq[(size_t)row * 20 + g * 4 + wc] = s;
                    }
                    u32x4 w; w.x = cvt_pk_bf16(v0[0], v0[1]); w.y = cvt_pk_bf16(v0[2], v0[3]); w.z = cvt_pk_bf16(v1[0], v1[1]); w.w = cvt_pk_bf16(v1[2], v1[3]);
                    *(u32x4*)(O + (size_t)row * LD1 + col0) = w;
                }
        }
    }
};
struct EpiQ {
    static constexpr bool PERM = true, AFTER_DRAIN = false;
    bf16_t* Q; const float* ssq; const float2* rope;
    __device__ __forceinline__ static f32x4 rope4(f32x4 v, const f32x4 ca, const f32x4 cb, bool first) {
        const float cs[4] = {ca[0], ca[2], cb[0], cb[2]}, sn[4] = {ca[1], ca[3], cb[1], cb[3]};
#pragma unroll
        for (int e = 0; e < 4; ++e) { const float pv = __shfl_xor(v[e], 32); v[e] = first ? (v[e] * cs[e] - pv * sn[e]) : (pv * sn[e] + v[e] * cs[e]); }
        return v;
    }
    __device__ __forceinline__ void operator()(const f32x4 (&acc)[2][2][4][2], const Unit& u, int wr, int wc, int, int) const {
        const int t_ = lane_now();
        const int fr = t_ & 15, fq = (t_ >> 4) & 3;
        const int row0 = u.pm * BM + wr * 64 + fr;
#pragma unroll
        for (int ai = 0; ai < 2; ++ai)
#pragma unroll
            for (int m = 0; m < 4; ++m) {
                const int row = row0 + ai * HALF + m * 16;
                const f32x4* sp = (const f32x4*)(ssq + (size_t)row * 20);
                float tot;
                { const f32x4 s0 = sp[0]; tot = (s0[0] + s0[1]) + (s0[2] + s0[3]); }
                { const f32x4 s1 = sp[1]; tot += (s1[0] + s1[1]) + (s1[2] + s1[3]); }
                { const f32x4 s2 = sp[2]; tot += (s2[0] + s2[1]) + (s2[2] + s2[3]); }
                const float rs = rsqrtf(tot * (1.f / 384.f) + 1e-6f) * QSCALE_A;
                const f32x4* rp = (const f32x4*)(rope + (size_t)(row & (S - 1)) * 16 + 8 * (fq & 1));
#pragma unroll
                for (int bj = 0; bj < 2; ++bj) {
                    const int sl = u.pn * 8 + bj * 4 + wc;
                    f32x4 v0 = acc[ai][bj][m][0] * rs, v1 = acc[ai][bj][m][1] * rs;
                    if (sl % 3 == 2) {
                        v0 = rope4(v0, rp[0], rp[1], fq < 2);
                        v1 = rope4(v1, rp[2], rp[3], fq < 2);
                    }
                    u32x4 w; w.x = cvt_pk_bf16(v0[0], v0[1]); w.y = cvt_pk_bf16(v0[2], v0[3]); w.z = cvt_pk_bf16(v1[0], v1[1]); w.w = cvt_pk_bf16(v1[2], v1[3]);
                    *(u32x4*)(Q + (size_t)row * 768 + sl * 32 + 8 * fq) = w;
                    asm volatile("" ::: "memory");
                }
            }
    }
};
struct EpiKV {
    static constexpr bool PERM = true, AFTER_DRAIN = false;
    bf16_t* KV; const float* ssq;
    __device__ __forceinline__ void operator()(const f32x4 (&acc)[2][2][4][2], const Unit& u, int wr, int wc, int, int) const {
        const int t_ = lane_now();
        const int fr = t_ & 15, fq = (t_ >> 4) & 3;
        const int row0 = u.pm * BM + wr * 64 + fr;
#pragma unroll
        for (int ai = 0; ai < 2; ++ai)
#pragma unroll
            for (int m = 0; m < 4; ++m) {
                const int row = row0 + ai * HALF + m * 16;
                const f32x4* sp = (const f32x4*)(ssq + (size_t)row * 20 + 12);
                const f32x4 s0 = sp[0], s1 = sp[1];
                const float tot = ((s0[0] + s0[1]) + (s0[2] + s0[3])) + ((s1[0] + s1[1]) + (s1[2] + s1[3]));
                const float rs = rsqrtf(tot * (1.f / 256.f) + 1e-6f);
#pragma unroll
                for (int bj = 0; bj < 2; ++bj) {
                    const int col0 = u.pn * BM + bj * HALF + wc * 32 + 8 * fq;
                    const f32x4 v0 = acc[ai][bj][m][0] * rs, v1 = acc[ai][bj][m][1] * rs;
                    u32x4 w; w.x = cvt_pk_bf16(v0[0], v0[1]); w.y = cvt_pk_bf16(v0[2], v0[3]); w.z = cvt_pk_bf16(v1[0], v1[1]); w.w = cvt_pk_bf16(v1[2], v1[3]);
                    *(u32x4*)(KV + (size_t)row * 1024 + col0) = w;
                }
                asm volatile("" ::: "memory");
            }
    }
};
template <bool ADD> struct EpiGate {
    static constexpr bool PERM = true, AFTER_DRAIN = false;
    bf16_t* MG; const bf16_t* O1; int gcol;
    __device__ __forceinline__ void operator()(const f32x4 (&acc)[2][2][4][2], const Unit& u, int wr, int wc, int, int) const {
        const int t_ = lane_now();
        const int fr = t_ & 15, fq = (t_ >> 4) & 3;
        const int row0 = u.pm * BM + wr * 64 + fr;
        const int colb = u.pn * BM + wc * 32 + 8 * fq;
        u32x4 gn[2], pn_[2];
#define EG_LOAD(it_) do { const int row_ = row0 + ((it_) >> 2) * HALF + ((it_) & 3) * 16; _Pragma("unroll") for (int bj = 0; bj < 2; ++bj) { \
            gn[bj] = *(const u32x4*)(O1 + (size_t)row_ * LD1 + gcol + colb + bj * HALF); if (ADD) pn_[bj] = *(const u32x4*)(MG + (size_t)row_ * DM + colb + bj * HALF); } } while (0)
        EG_LOAD(0);
#pragma unroll
        for (int it = 0; it < 8; ++it) {
            const int ai = it >> 2, m = it & 3, row = row0 + ai * HALF + m * 16;
            u32x4 gc[2], pc[2];
#pragma unroll
            for (int bj = 0; bj < 2; ++bj) { gc[bj] = gn[bj]; if (ADD) pc[bj] = pn_[bj]; }
            if (it < 7) EG_LOAD(it + 1);
            asm volatile("" ::: "memory");
#pragma unroll
            for (int bj = 0; bj < 2; ++bj) {
                const u32x4 gw = gc[bj];
                f32x4 v0 = acc[ai][bj][m][0], v1 = acc[ai][bj][m][1];
                v0[0] *= bflo(gw.x); v0[1] *= bfhi(gw.x); v0[2] *= bflo(gw.y); v0[3] *= bfhi(gw.y);
                v1[0] *= bflo(gw.z); v1[1] *= bfhi(gw.z); v1[2] *= bflo(gw.w); v1[3] *= bfhi(gw.w);
                if (ADD) { const u32x4 pw = pc[bj];
                    v0[0] += bflo(pw.x); v0[1] += bfhi(pw.x); v0[2] += bflo(pw.y); v0[3] += bfhi(pw.y);
                    v1[0] += bflo(pw.z); v1[1] += bfhi(pw.z); v1[2] += bflo(pw.w); v1[3] += bfhi(pw.w); }
                u32x4 w; w.x = cvt_pk_bf16(v0[0], v0[1]); w.y = cvt_pk_bf16(v0[2], v0[3]); w.z = cvt_pk_bf16(v1[0], v1[1]); w.w = cvt_pk_bf16(v1[2], v1[3]);
                *(u32x4*)(MG + (size_t)row * DM + colb + bj * HALF) = w;
            }
        }
#undef EG_LOAD
    }
};
struct EpiOut {
    static constexpr bool PERM = true, AFTER_DRAIN = false;
    const float* x; float* out; float* ssqo;
    __device__ __forceinline__ void operator()(const f32x4 (&acc)[2][2][4][2], const Unit& u, int wr, int wc, int, int) const {
        const int t_ = lane_now();
        const int fr = t_ & 15, fq = (t_ >> 4) & 3;
        const int row0 = u.pm * BM + wr * 64 + fr;
#pragma unroll
        for (int ai = 0; ai < 2; ++ai)
#pragma unroll
            for (int m = 0; m < 4; ++m) {
                const int row = row0 + ai * HALF + m * 16;
#pragma unroll
                for (int bj = 0; bj < 2; ++bj) {
                    const int col0 = u.pn * BM + bj * HALF + wc * 32 + 8 * fq;
                    const f32x4* xp = (const f32x4*)(x + (size_t)row * DM + col0);
                    const f32x4 v0 = acc[ai][bj][m][0] + xp[0], v1 = acc[ai][bj][m][1] + xp[1];
                    f32x4* op = (f32x4*)(out + (size_t)row * DM + col0);
                    op[0] = v0; op[1] = v1;
                    float s = (v0[0] * v0[0] + v0[1] * v0[1]) + (v0[2] * v0[2] + v0[3] * v0[3]) + (v1[0] * v1[0] + v1[1] * v1[1]) + (v1[2] * v1[2] + v1[3] * v1[3]);
                    s += __shfl_xor(s, 16); s += __shfl_xor(s, 32);
                    if (fq == 0) ssqo[(size_t)row * 32 + u.pn * 8 + bj * 4 + wc] = s;
                }
                asm volatile("" ::: "memory");
            }
    }
};
struct EpiOutNorm {
    static constexpr bool PERM = true, AFTER_DRAIN = (FUSE_AFTER_DRAIN != 0);
    const float* x; float* out; float* ssqo; const float* fg; unsigned* cnt; unsigned* tmo; PG8_LAS unsigned char* ldsp;
    __device__ __forceinline__ void operator()(const f32x4 (&acc)[2][2][4][2], const Unit& u, int wr, int wc, int fr, int fq) const { if (!AFTER_DRAIN) fused(acc, u, wr, wc, fr, fq, ldsp, wr * 4 + wc, 0); }
    __device__ __forceinline__ void fused(const f32x4 (&acc)[2][2][4][2], const Unit& u, int wr, int wc, int, int, PG8_LAS unsigned char* lds, int wid, int) const {
        const int ln = lane_now(), fr = ln & 15, fq = (ln >> 4) & 3, tid = wid * 64 + ln;
        PG8_LAS float* part = (PG8_LAS float*)(lds + 135168);
        PG8_LAS float* rinv = part + 1024;
        const int rl0 = wr * 64 + fr;
        f32x4 v[2][2][4][2];
#pragma unroll
        for (int ai = 0; ai < 2; ++ai)
#pragma unroll
            for (int m = 0; m < 4; ++m) {
                const int rl = rl0 + ai * HALF + m * 16; const size_t row = (size_t)u.pm * BM + rl;
                float s = 0.f;
#pragma unroll
                for (int bj = 0; bj < 2; ++bj) {
                    const int col0 = u.pn * BM + bj * HALF + wc * 32 + 8 * fq;
                    const f32x4* xp = (const f32x4*)(x + row * DM + col0);
                    const f32x4 v0 = acc[ai][bj][m][0] + xp[0], v1 = acc[ai][bj][m][1] + xp[1];
                    v[ai][bj][m][0] = v0; v[ai][bj][m][1] = v1;
                    s += (v0[0] * v0[0] + v0[1] * v0[1]) + (v0[2] * v0[2] + v0[3] * v0[3]) + (v1[0] * v1[0] + v1[1] * v1[1]) + (v1[2] * v1[2] + v1[3] * v1[3]);
                }
                s += __shfl_xor(s, 16); s += __shfl_xor(s, 32);
                if (fq == 0) part[rl * 4 + wc] = s;
            }
        __syncthreads();
        if (DEBUG_FUSE) {
            if (tid < 256) { const f32x4 p4 = *(const PG8_LAS f32x4*)(part + tid * 4); float* q = ssqo + ((size_t)u.pm * BM + tid) * 32 + u.pn * 8;
                q[0] = (p4[0] + p4[1]) + (p4[2] + p4[3]); for (int i = 1; i < 8; ++i) q[i] = 0.f; }
#pragma unroll
            for (int bj = 0; bj < 2; ++bj)
#pragma unroll
                for (int ai = 0; ai < 2; ++ai)
#pragma unroll
                    for (int m = 0; m < 4; ++m) { const int rl = rl0 + ai * HALF + m * 16; const int col0 = u.pn * BM + bj * HALF + wc * 32 + 8 * fq;
                        f32x4* op = (f32x4*)(out + ((size_t)u.pm * BM + rl) * DM + col0); op[0] = v[ai][bj][m][0]; op[1] = v[ai][bj][m][1]; }
            return;
        }
        if (tid < 256) { const f32x4 p4 = *(const PG8_LAS f32x4*)(part + tid * 4); ssqo[((size_t)u.pm * BM + tid) * 4 + u.pn] = (p4[0] + p4[1]) + (p4[2] + p4[3]); }
        asm volatile("s_waitcnt vmcnt(0)" ::: "memory");
        __syncthreads();
        if (tid == 0) {
            __builtin_amdgcn_fence(__ATOMIC_RELEASE, "agent");
            (void)__hip_atomic_fetch_add(cnt + 16 * u.pm, 1u, __ATOMIC_RELAXED, __HIP_MEMORY_SCOPE_AGENT);
            unsigned sp = 0u;
            while (__hip_atomic_load(cnt + 16 * u.pm, __ATOMIC_RELAXED, __HIP_MEMORY_SCOPE_AGENT) < 4u) {
                __builtin_amdgcn_s_sleep(1);
                if ((++sp & 255u) == 0u) { if (__hip_atomic_load(tmo, __ATOMIC_RELAXED, __HIP_MEMORY_SCOPE_AGENT)) break; if (sp > (1u << 18)) { atomicAdd(tmo, 1u); break; } }
            }
            __builtin_amdgcn_fence(__ATOMIC_ACQUIRE, "agent");
            asm volatile("s_waitcnt vmcnt(0)" ::: "memory");
        }
        __syncthreads();
        if (tid < 256) {
            float* sp4 = ssqo + ((size_t)u.pm * BM + tid) * 4;
            const float t = (__hip_atomic_load(sp4, __ATOMIC_RELAXED, __HIP_MEMORY_SCOPE_AGENT) + __hip_atomic_load(sp4 + 1, __ATOMIC_RELAXED, __HIP_MEMORY_SCOPE_AGENT))
                          + (__hip_atomic_load(sp4 + 2, __ATOMIC_RELAXED, __HIP_MEMORY_SCOPE_AGENT) + __hip_atomic_load(sp4 + 3, __ATOMIC_RELAXED, __HIP_MEMORY_SCOPE_AGENT));
            rinv[tid] = rsqrtf(t * (1.f / DM) + 1e-6f);
        }
        __syncthreads();
#pragma unroll
        for (int bj = 0; bj < 2; ++bj) {
            const int col0 = u.pn * BM + bj * HALF + wc * 32 + 8 * fq;
            const f32x4 g0 = *(const f32x4*)(fg + col0), g1 = *(const f32x4*)(fg + col0 + 4);
#pragma unroll
            for (int ai = 0; ai < 2; ++ai)
#pragma unroll
                for (int m = 0; m < 4; ++m) {
                    const int rl = rl0 + ai * HALF + m * 16; const float r = rinv[rl];
                    f32x4* op = (f32x4*)(out + ((size_t)u.pm * BM + rl) * DM + col0);
                    op[0] = v[ai][bj][m][0] * r * g0; op[1] = v[ai][bj][m][1] * r * g1;
                }
        }
    }
};
}


namespace att {
typedef short bf16x8 __attribute__((ext_vector_type(8)));
typedef short s16x4 __attribute__((ext_vector_type(4)));
typedef float f32x16 __attribute__((ext_vector_type(16)));
typedef unsigned u32x4 __attribute__((ext_vector_type(4)));
typedef const LAS char* lds_cptr;
constexpr int SLOT_K = 12288, SLOT_V = 8192;
constexpr int L_K = 0, L_V = 2 * SLOT_K, L_WS = L_V + 2 * SLOT_V, L_OST = L_WS + 2048, L_BIAS = L_OST + 8 * 4096, L_END = L_BIAS + 2048;
constexpr float THR = 8.f;
#define MFMA32(a, b, c) __builtin_amdgcn_mfma_f32_32x32x16_bf16(a, b, c, 0, 0, 0)
__device__ __forceinline__ int crow(int r, int hi) { return (r & 3) + 8 * (r >> 2) + 4 * hi; }
typedef __bf16 bf16x2_t __attribute__((ext_vector_type(2)));
typedef float f32x2_t __attribute__((ext_vector_type(2)));
__device__ __forceinline__ unsigned cvtpk(float lo, float hi) { const f32x2_t v = {lo, hi}; return __builtin_bit_cast(unsigned, __builtin_convertvector(v, bf16x2_t)); }
__device__ __forceinline__ s16x4 vtr(lds_cptr p) { typedef short v4i16_t __attribute__((ext_vector_type(4))); return __builtin_bit_cast(s16x4, __builtin_amdgcn_ds_read_tr16_b64_v4i16((LAS v4i16_t*)p)); }
#define MX3(a, b, c) __builtin_fmaxf(__builtin_fmaxf((a), (b)), (c))
__device__ __forceinline__ float rowmax(const f32x16& p0, const f32x16& p1) {
    float a = MX3(p0[0], p0[1], p1[0]), b = MX3(p0[2], p0[3], p1[1]); a = MX3(a, p1[2], p1[3]);
#pragma unroll
    for (int r = 4; r < 16; r += 4) { a = MX3(a, p0[r], p0[r + 1]); b = MX3(b, p0[r + 2], p0[r + 3]); a = MX3(a, p1[r], p1[r + 1]); b = MX3(b, p1[r + 2], p1[r + 3]); }
    const float m = __builtin_fmaxf(a, b); auto rr = __builtin_amdgcn_permlane32_swap(__float_as_uint(m), __float_as_uint(m), false, false);
    return __builtin_fmaxf(__uint_as_float(rr[0]), __uint_as_float(rr[1])); }
__device__ __forceinline__ float maskp(float p, unsigned lo, unsigned hi) {
    const unsigned long long mk = ((unsigned long long)hi << 32) | lo; float o;
    asm("v_cndmask_b32_e64 %0, 0, %1, %2" : "=v"(o) : "v"(p), "s"(mk)); return o; }
__host__ __device__ __forceinline__ size_t mask_tile_off(int qt32) { const int J = qt32 >> 1; return (size_t)2 * J * (J + 1) + ((qt32 & 1) ? 2 * (J + 1) : 0); }
constexpr size_t MASK_TILES_PER_BATCH = (size_t)2 * 128 * 129;

struct Tensors {
    const bf16_t* Q; int ldq;
    const bf16_t* K0; int ldk;
    const bf16_t* K1;
    const bf16_t* V; int ldv;
    bf16_t* O; int ldo;
    const unsigned long long* mask;
    const float* rel_bias;
    int hq, hk, hv;
    int wv;
};

template <bool DSA>
__device__ __forceinline__ void unit(int b, int h, int qb, const Tensors& X, LAS unsigned char* lds, bool dry) {
    constexpr int NDQ = DSA ? 4 : 6;
    const int tid_ = tid_now(X.wv);
    const int tid = tid_, lane = tid & 63, r32 = lane & 31, hi = lane >> 5; const int wid = X.wv;
    const size_t rowbase = (size_t)b * S; const int q0 = qb * 256, NT = 4 * qb + 4, NTw = 4 * qb + (wid >> 1) + 1;
    LAS float* wsf = (LAS float*)(lds + L_WS) + wid * 64;
    const bf16_t* ksrc = X.K0 + (rowbase + lane) * X.ldk + h * X.hk + wid * 8;
    const bf16_t* ksrc1 = DSA ? nullptr : X.K1 + (rowbase + lane) * 32 + (wid & 3) * 8;
    const bf16_t* vsrc = X.V + (rowbase + 16 * (wid & 3) + (lane >> 2)) * X.ldv + h * X.hv + (wid >> 2) * 32 + (lane & 3) * 8;
    const size_t kstride = (size_t)64 * X.ldk, vstride = (size_t)64 * X.ldv;
    LAS unsigned char* kdst = lds + L_K + wid * 1024; LAS unsigned char* kdst1 = lds + L_K + (8 + (wid & 3)) * 1024; LAS unsigned char* vdst = lds + L_V + wid * 1024;
    u32x4 sk0, sk1 = {}, sv;
#define ATT_LOAD(t) do { sk0 = *(const u32x4*)(ksrc + (size_t)(t) * kstride); if (!DSA && wid < 4) sk1 = *(const u32x4*)(ksrc1 + (size_t)(t) * 64 * 32); \
                         sv = *(const u32x4*)(vsrc + (size_t)(t) * vstride); } while (0)
#define ATT_WRITE(slot) do { *(LAS u32x4*)(kdst + (slot) * SLOT_K + lane * 16) = sk0; if (!DSA && wid < 4) *(LAS u32x4*)(kdst1 + (slot) * SLOT_K + lane * 16) = sk1; \
                             *(LAS u32x4*)(vdst + (slot) * SLOT_V + lane * 16) = sv; } while (0)
    const lds_cptr vp0 = (lds_cptr)lds + L_V + ((lane >> 4) & 1) * 32 + (lane & 3) * 8 + (4 * hi + ((lane & 15) >> 2)) * 64;
    const lds_cptr kp0 = (lds_cptr)lds + L_K + hi * 1024 + r32 * 16;
    ATT_LOAD(0);
    bf16x8 qr[NDQ];
    { const bf16_t* Qw = X.Q + (rowbase + q0 + wid * 32 + r32) * X.ldq + h * X.hq + hi * 8;
#pragma unroll
      for (int d0 = 0; d0 < NDQ; ++d0) qr[d0] = *(const bf16x8*)(Qw + d0 * 16); }
    if (DSA) {
        LAS float* tab = (LAS float*)(lds + L_BIAS);
        const float c15 = X.rel_bias[15 * 8 + h];
        for (int e = tid; e < 320; e += 512) {
            const int rel = e - 255, n = rel < 0 ? -rel : rel; int v;
            if (n < 8) v = n; else if (n < 12) v = 8; else if (n < 16) v = 9; else if (n < 23) v = 10; else if (n < 32) v = 11; else if (n < 46) v = 12; else if (n < 64) v = 13; else if (n < 91) v = 14; else v = 15;
            tab[e] = (X.rel_bias[((rel > 0 ? 16 : 0) + v) * 8 + h] - c15) * LOG2E;
        }
    }
    ATT_WRITE(0);
    float mhat = 0.f, l_reg = 0.f; f32x16 o0 = {}, o1 = {};
    f32x16 negm = {};
    if (wid >= 4) __builtin_amdgcn_s_setprio(1);
    const int qpos = q0 + wid * 32 + r32;
    for (int t = 0; t < NT; ++t) {
        asm volatile("s_waitcnt vmcnt(0) lgkmcnt(0)\n\ts_barrier" ::: "memory");
        if (t + 1 < NT) ATT_LOAD(t + 1);
        unsigned mw = 0u;
        if (DSA && t < NTw) { const int qt32 = qb * 8 + wid;
            const unsigned* mt = (const unsigned*)((const unsigned short*)X.mask + ((size_t)b * MASK_TILES_PER_BATCH + mask_tile_off(qt32)) * 64) + (size_t)t * 64;
            mw = mt[lane]; }
        if (t < NTw) {
            const int so_k = (t & 1) * SLOT_K, so_v = (t & 1) * SLOT_V;
            f32x16 c0, c1;
            bf16x8 kf[2 * NDQ];
#pragma unroll
            for (int d0 = 0; d0 < NDQ; ++d0) { kf[2 * d0] = *(const LAS bf16x8*)(kp0 + so_k + d0 * 2048); kf[2 * d0 + 1] = *(const LAS bf16x8*)(kp0 + so_k + d0 * 2048 + 512); }
#pragma unroll
            for (int d0 = 0; d0 < NDQ; ++d0) { c0 = MFMA32(kf[2 * d0], qr[d0], d0 == 0 ? negm : c0); c1 = MFMA32(kf[2 * d0 + 1], qr[d0], d0 == 0 ? negm : c1); }
            const lds_cptr vp = vp0 + so_v;
            bf16x8 vf[8];
#pragma unroll
            for (int i = 0; i < 8; ++i) { const s16x4 lo_ = vtr(vp + ((i >> 2) * 4096 + (i & 3) * 1024)), hi_ = vtr(vp + ((i >> 2) * 4096 + (i & 3) * 1024 + 512));
                vf[i] = (bf16x8){lo_[0], lo_[1], lo_[2], lo_[3], hi_[0], hi_[1], hi_[2], hi_[3]}; }
            if (DSA) {
                if (64 * t + 63 - (q0 + wid * 32) > -128) {
                    const LAS float* tab = (const LAS float*)(lds + L_BIAS);
                    const int base = 64 * t + 4 * hi - qpos + 255;
#pragma unroll
                    for (int r = 0; r < 16; ++r) { const int kr = (r & 3) + 8 * (r >> 2); int i0 = base + kr, i1 = base + kr + 32; i0 = i0 < 0 ? 0 : i0; i1 = i1 < 0 ? 0 : i1;
                        c0[r] += tab[i0]; c1[r] += tab[i1]; }
                }
            }
            const float rm = rowmax(c0, c1);
            if (t == 0 || __any(rm > THR)) {
                const float dl = (t == 0) ? rm : __builtin_fmaxf(rm, 0.f); mhat += dl;
                if (t > 0) {
                    const float f = __builtin_amdgcn_exp2f(-dl); l_reg *= f;
                    if (hi == 0) wsf[r32] = f;
                    asm volatile("s_waitcnt lgkmcnt(0)" ::: "memory");
#pragma unroll
                    for (int r = 0; r < 16; ++r) { const float fr = wsf[crow(r, hi)]; o0[r] *= fr; o1[r] *= fr; }
                }
#pragma unroll
                for (int r = 0; r < 16; ++r) { c0[r] -= dl; c1[r] -= dl; negm[r] -= dl; }
            }
#pragma unroll
            for (int r = 0; r < 16; ++r) { c0[r] = __builtin_amdgcn_exp2f(c0[r]); c1[r] = __builtin_amdgcn_exp2f(c1[r]); }
            if (DSA) {
#pragma unroll
                for (int r = 0; r < 16; ++r) {
                    int m0 = __builtin_amdgcn_sbfe((int)mw, r, 1), m1 = __builtin_amdgcn_sbfe((int)mw, 16 + r, 1); asm("" : "+v"(m0), "+v"(m1));
                    c0[r] = __uint_as_float(__float_as_uint(c0[r]) & (unsigned)m0); c1[r] = __uint_as_float(__float_as_uint(c1[r]) & (unsigned)m1); }
            }
            float sacc = 0.f;
#pragma unroll
            for (int r = 0; r < 16; ++r) sacc += c0[r] + c1[r];
            l_reg += sacc;
            u32x4 pw0 = {cvtpk(c0[0], c0[1]), cvtpk(c0[2], c0[3]), cvtpk(c0[4], c0[5]), cvtpk(c0[6], c0[7])};
            u32x4 pw1 = {cvtpk(c0[8], c0[9]), cvtpk(c0[10], c0[11]), cvtpk(c0[12], c0[13]), cvtpk(c0[14], c0[15])};
            u32x4 pw2 = {cvtpk(c1[0], c1[1]), cvtpk(c1[2], c1[3]), cvtpk(c1[4], c1[5]), cvtpk(c1[6], c1[7])};
            u32x4 pw3 = {cvtpk(c1[8], c1[9]), cvtpk(c1[10], c1[11]), cvtpk(c1[12], c1[13]), cvtpk(c1[14], c1[15])};
            o0 = MFMA32(__builtin_bit_cast(bf16x8, pw0), vf[0], o0); o1 = MFMA32(__builtin_bit_cast(bf16x8, pw0), vf[4], o1);
            o0 = MFMA32(__builtin_bit_cast(bf16x8, pw1), vf[1], o0); o1 = MFMA32(__builtin_bit_cast(bf16x8, pw1), vf[5], o1);
            o0 = MFMA32(__builtin_bit_cast(bf16x8, pw2), vf[2], o0); o1 = MFMA32(__builtin_bit_cast(bf16x8, pw2), vf[6], o1);
            o0 = MFMA32(__builtin_bit_cast(bf16x8, pw3), vf[3], o0); o1 = MFMA32(__builtin_bit_cast(bf16x8, pw3), vf[7], o1);
        }
        if (t + 1 < NT) ATT_WRITE((t + 1) & 1);
    }
    __builtin_amdgcn_s_setprio(0);
    bf16_t* Ow = X.O + (rowbase + q0 + wid * 32) * X.ldo + h * 64;
    u32x4 gv4[4];
#pragma unroll
    for (int i = 0; i < 4; ++i) gv4[i] = *(const u32x4*)(Ow + (size_t)(i * 8 + (lane >> 3)) * X.ldo + (lane & 7) * 8);
    { auto rr = __builtin_amdgcn_permlane32_swap(__float_as_uint(l_reg), __float_as_uint(l_reg), false, false); l_reg = __uint_as_float(rr[0]) + __uint_as_float(rr[1]); }
    if (hi == 0) wsf[32 + r32] = l_reg;
    asm volatile("s_waitcnt lgkmcnt(0)" ::: "memory");
    LAS bf16_t* stg = (LAS bf16_t*)(lds + L_OST) + wid * 2048;
#pragma unroll
    for (int r = 0; r < 16; ++r) { const int orow = crow(r, hi); const float rli = __builtin_amdgcn_rcpf(wsf[32 + orow]);
        stg[orow * 64 + r32] = f2bf(o0[r] * rli); stg[orow * 64 + 32 + r32] = f2bf(o1[r] * rli); }
    asm volatile("s_waitcnt lgkmcnt(0)" ::: "memory");
#pragma unroll
    for (int i = 0; i < 4; ++i) { const int row = i * 8 + (lane >> 3), ch = lane & 7;
        const u32x4 ov = *(const LAS u32x4*)(stg + row * 64 + ch * 8); u32x4* gp = (u32x4*)(Ow + (size_t)row * X.ldo + ch * 8); const u32x4 gv = gv4[i];
        u32x4 res; res.x = pk2(bflo(ov.x) * bflo(gv.x), bfhi(ov.x) * bfhi(gv.x)); res.y = pk2(bflo(ov.y) * bflo(gv.y), bfhi(ov.y) * bfhi(gv.y));
        res.z = pk2(bflo(ov.z) * bflo(gv.z), bfhi(ov.z) * bfhi(gv.z)); res.w = pk2(bflo(ov.w) * bflo(gv.w), bfhi(ov.w) * bfhi(gv.w)); if (!dry) *gp = res; }
    asm volatile("s_waitcnt vmcnt(0) lgkmcnt(0)\n\ts_barrier" ::: "memory");
#undef ATT_LOAD
#undef ATT_WRITE
}

template <bool DSA>
__device__ __forceinline__ void phase(const Tensors& X, LAS unsigned char* lds, int G, int bid, bool dry = false) {
    for (int p = bid; p < 512; p += G) {
        const int x = p & 7, kk = p >> 3, bh = x + 8 * (kk >> 4), j = kk & 15;
#pragma unroll 1
        for (int u2 = 0; u2 < 2; ++u2) unit<DSA>(bh >> 3, bh & 7, u2 ? 31 - j : j, X, lds, dry);
    }
}
}


#ifndef IDX_PRIO
#define IDX_PRIO 0
#endif
#ifndef PASS0_SPLIT
#define PASS0_SPLIT 0
#endif
#ifndef IDX_FORCE_SLOW
#define IDX_FORCE_SLOW 0
#endif
namespace idx {
typedef short bf16x8 __attribute__((ext_vector_type(8)));
typedef float f32x16 __attribute__((ext_vector_type(16)));
constexpr int HROW = 1025;
constexpr int LCAP = 32;
constexpr int LISTN = 64, LSTR = 65;
constexpr int L_HIST = 0, LISTS_END = (511 * LSTR + 513) * 4, L_PFX = LISTS_END, L_NEED = L_PFX + 128, L_LCNT = L_NEED + 128, L_LIST = L_LCNT + 128, L_CNT = L_LIST + 32 * LCAP * 4, L_TAU = L_CNT + 512 * 4,
              L_FLAG = L_TAU + 128, L_LB = L_FLAG + 16, L_WH = L_LB + 128, L_END = L_WH + 8 * 1024;
static_assert(LISTS_END % 16 == 0 && LISTS_END >= 32 * HROW * 4, "indexer LDS layout");
__device__ __forceinline__ unsigned f2key(float f) { const unsigned u = __float_as_uint(f); return u ^ ((unsigned)((int)u >> 31) | 0x80000000u); }

struct QOps { bf16x8 qf[8][2]; bf16x8 qb[2][2]; float wv[8]; };
__device__ __forceinline__ void score_tile(float (&acc)[16], const bf16x8 k0, const bf16x8 k1, const QOps& Q) {
#define IDX_M0(h) __builtin_amdgcn_mfma_f32_32x32x16_bf16(k0, Q.qf[h][0], (f32x16){}, 0, 0, 0)
#define IDX_M1(h, c) __builtin_amdgcn_mfma_f32_32x32x16_bf16(k1, Q.qf[h][1], c, 0, 0, 0)
#define IDX_ACC8(h, c, r0) do { _Pragma("unroll") for (int r = (r0); r < (r0) + 8; ++r) { acc[r] = __builtin_fmaf(Q.wv[h], __builtin_fabsf(c[r]), acc[r]); asm volatile("" : "+v"(acc[r])); } } while (0)
    f32x16 cA = IDX_M0(0); cA = IDX_M1(0, cA);
    f32x16 lin = __builtin_amdgcn_mfma_f32_32x32x16_bf16(k0, Q.qb[0][0], (f32x16){}, 0, 0, 0);
    lin = __builtin_amdgcn_mfma_f32_32x32x16_bf16(k1, Q.qb[0][1], lin, 0, 0, 0);
    lin = __builtin_amdgcn_mfma_f32_32x32x16_bf16(k0, Q.qb[1][0], lin, 0, 0, 0);
    lin = __builtin_amdgcn_mfma_f32_32x32x16_bf16(k1, Q.qb[1][1], lin, 0, 0, 0);
#pragma unroll
    for (int r = 0; r < 16; ++r) acc[r] = lin[r];
    __builtin_amdgcn_sched_barrier(0);
#pragma unroll
    for (int h = 0; h < 8; ++h) {
        f32x16 nC;
        if (h < 7) nC = IDX_M0(h + 1);
        IDX_ACC8(h, cA, 0);
        __builtin_amdgcn_sched_barrier(0);
        if (h < 7) nC = IDX_M1(h + 1, nC);
        IDX_ACC8(h, cA, 8);
        __builtin_amdgcn_sched_barrier(0);
        if (h < 7) cA = nC;
    }
#undef IDX_M0
#undef IDX_M1
#undef IDX_ACC8
}
#define GAS __attribute__((address_space(1)))
#define IDX_KLOAD(k0, k1, kt) do { const GAS bf16_t* kp_ = kbase + (size_t)(kt) * 1024 + r32 * 32 + hi * 8; k0 = *(const GAS bf16x8*)kp_; k1 = *(const GAS bf16x8*)(kp_ + 16); } while (0)

struct PassCtx { const GAS bf16_t* kbase; LAS unsigned* hrow; LAS unsigned* lcnt_q; LAS unsigned* blist_q; LAS unsigned* lown; GAS unsigned short* mbase; unsigned pfx, msk; int lane, r32, hi, ktb, kte; bool hi2; };
template <int PASS>
__device__ __forceinline__ void pass_tile(const PassCtx& C, const bf16x8 k0, const bf16x8 k1, const QOps& Q, int kt, unsigned& ncand) {
    if constexpr (PASS == 3) {
        __builtin_amdgcn_sched_barrier(0);
        float acc[16]; score_tile(acc, k0, k1, Q);
        const unsigned tlo = C.pfx << 22, thim1 = tlo | 0x3fffffu, pos = (unsigned)(kt - C.ktb) << 26;
        unsigned bits = 0u, vmask = 0x3fffffu; asm volatile("" : "+v"(vmask));
#pragma unroll
        for (int r = 15; r >= 0; --r) {
            const unsigned k = __float_as_uint(acc[r]) ^ C.msk;
            const bool sel = k > thim1, ge = k >= tlo;
            bits = bits + bits + (sel ? 1u : 0u);
            unsigned pr = ((unsigned)r << 22) | pos; asm volatile("" : "+s"(pr));
            *(LAS unsigned*)ncand = (k & vmask) | pr;
            ncand += (ge != sel) ? 4u : 0u;
        }
        C.mbase[(size_t)(kt >> 1) * 128 + C.lane * 2 + (kt & 1)] = (unsigned short)bits;
        return;
    }
    constexpr int SH_BIN = (PASS == 0 || PASS == 4) ? 22 : ((PASS == 1) ? 11 : 0), SH_PFX = (PASS == 1) ? 22 : 11;
    __builtin_amdgcn_sched_barrier(0);
    float acc[16]; score_tile(acc, k0, k1, Q);
    unsigned bits = 0u, anym = 0u; unsigned keys[16];
#pragma unroll
    for (int r = 0; r < 16; ++r) {
        const unsigned key = f2key(acc[r]), up = key >> SH_PFX, bin = (PASS == 0 || PASS == 4) ? (key >> 22) : ((key >> SH_BIN) & 2047u); if (PASS == 2) keys[r] = key;
        const bool match = (PASS == 0) || (PASS == 4 ? (bin >= C.pfx) : (up == C.pfx));
        if (PASS == 0) __hip_atomic_fetch_add(C.hrow + bin, 1u, __ATOMIC_RELAXED, __HIP_MEMORY_SCOPE_WORKGROUP);
        else if (PASS == 4) { if (match) __hip_atomic_fetch_add(C.hrow + bin, 1u, __ATOMIC_RELAXED, __HIP_MEMORY_SCOPE_WORKGROUP); }
        else if (match) __hip_atomic_fetch_add(C.hrow + (bin >> 1), 1u << ((bin & 1u) * 16u), __ATOMIC_RELAXED, __HIP_MEMORY_SCOPE_WORKGROUP);
        if (PASS == 2) { bits |= (up > C.pfx) ? (1u << r) : 0u; anym |= match ? 1u : 0u; }
    }
    if (PASS == 2) {
        C.mbase[(size_t)(kt >> 1) * 128 + C.lane * 2 + (kt & 1)] = (unsigned short)bits;
        if (__any(anym)) {
#pragma unroll
            for (int r = 0; r < 16; ++r) if ((keys[r] >> 11) == C.pfx) {
                const unsigned sl = __hip_atomic_fetch_add(C.lcnt_q, 1u, __ATOMIC_RELAXED, __HIP_MEMORY_SCOPE_WORKGROUP);
                if (sl < (unsigned)LCAP) C.blist_q[sl] = (keys[r] & 2047u) | ((unsigned)r << 11) | ((unsigned)C.lane << 15) | ((unsigned)kt << 21);
            }
        }
    }
}
#define IDX_KLOADC(k0, k1, kt) do { const GAS bf16_t* kp_ = C.kbase + (size_t)(kt) * 1024 + C.r32 * 32 + C.hi * 8; k0 = *(const GAS bf16x8*)kp_; k1 = *(const GAS bf16x8*)(kp_ + 16); } while (0)
template <int PASS>
__device__ __forceinline__ void pass_loop(const PassCtx& C, const QOps& Q, unsigned& ncand) {
    bf16x8 a0, a1, b0, b1, c0, c1; const int ktb = C.ktb, kte = C.kte;
    if (IDX_PRIO) { if (C.hi2) __builtin_amdgcn_s_setprio(1); }
    if (ktb < kte) IDX_KLOADC(a0, a1, ktb); if (ktb + 1 < kte) IDX_KLOADC(b0, b1, ktb + 1); if (ktb + 2 < kte) IDX_KLOADC(c0, c1, ktb + 2);
    for (int kt = ktb; kt < kte; kt += 3) {
        pass_tile<PASS>(C, a0, a1, Q, kt, ncand); if (kt + 3 < kte) IDX_KLOADC(a0, a1, kt + 3);
        if (kt + 1 < kte) { pass_tile<PASS>(C, b0, b1, Q, kt + 1, ncand); if (kt + 4 < kte) IDX_KLOADC(b0, b1, kt + 4); }
        if (kt + 2 < kte) { pass_tile<PASS>(C, c0, c1, Q, kt + 2, ncand); if (kt + 5 < kte) IDX_KLOADC(c0, c1, kt + 5); }
    }
    if (IDX_PRIO) __builtin_amdgcn_s_setprio(0);
}
#undef IDX_KLOADC

__device__ __forceinline__ int wave_prefix_sum(int v) {
    v += __builtin_amdgcn_update_dpp(0, v, 0x111, 0xf, 0xf, false);
    v += __builtin_amdgcn_update_dpp(0, v, 0x112, 0xf, 0xf, false);
    v += __builtin_amdgcn_update_dpp(0, v, 0x114, 0xf, 0xf, false);
    v += __builtin_amdgcn_update_dpp(0, v, 0x118, 0xf, 0xf, false);
    v += __builtin_amdgcn_update_dpp(0, v, 0x142, 0xa, 0xf, false);
    v += __builtin_amdgcn_update_dpp(0, v, 0x143, 0xc, 0xf, false);
    return v;
}
__device__ __forceinline__ void scan_hist(const LAS unsigned* hist, LAS unsigned* spfx, LAS int* sneed, LAS unsigned* slb, int wid, int pass, bool partial) {
    const int nbits = (pass == 0) ? 10 : 11;
    const int lane = lane_now();
    unsigned wv_[4][16]; int c[4], need[4];
#pragma unroll
    for (int qi = 0; qi < 4; ++qi) {
        const LAS unsigned* hr = hist + (wid * 4 + qi) * HROW + 16 * lane;
#pragma unroll
        for (int i = 0; i < 16; ++i) wv_[qi][i] = hr[i];
        need[qi] = sneed[wid * 4 + qi];
    }
#pragma unroll
    for (int qi = 0; qi < 4; ++qi) {
        int t = 0;
#pragma unroll
        for (int i = 0; i < 16; ++i) t += (pass == 0) ? (int)wv_[qi][i] : (int)(wv_[qi][i] & 0xffffu) + (int)(wv_[qi][i] >> 16);
        c[qi] = t;
    }
#pragma unroll
    for (int qi = 0; qi < 4; ++qi) {
        const int q = wid * 4 + qi, nd = need[qi];
        const int pre = wave_prefix_sum(c[qi]), total = __builtin_amdgcn_readlane(pre, 63);
        const int sfx = total - pre + c[qi], above = sfx - c[qi];
        int run = above, bstar = 0, nn = nd;
        if (pass == 0) {
#pragma unroll
            for (int i = 15; i >= 0; --i) { const int ci = (int)wv_[qi][i]; const bool hit = (run < nd) && (run + ci >= nd); bstar = hit ? 16 * lane + i : bstar; nn = hit ? nd - run : nn; run += ci; }
        } else {
#pragma unroll
            for (int i = 15; i >= 0; --i) {
                const int chi = (int)(wv_[qi][i] >> 16), clo = (int)(wv_[qi][i] & 0xffffu);
                { const bool hit = (run < nd) && (run + chi >= nd); bstar = hit ? 32 * lane + 2 * i + 1 : bstar; nn = hit ? nd - run : nn; run += chi; }
                { const bool hit = (run < nd) && (run + clo >= nd); bstar = hit ? 32 * lane + 2 * i : bstar; nn = hit ? nd - run : nn; run += clo; }
            }
        }
        if (partial && lane == 0) slb[q] = 0u;
        if (sfx >= nd && above < nd) {
            if (partial) slb[q] = (unsigned)bstar; else { spfx[q] = (spfx[q] << nbits) | (unsigned)bstar; sneed[q] = nn; }
        }
    }
}

template <int NJ>
__device__ __forceinline__ unsigned resolve_query(const LAS unsigned* lbase, int cn, int ln, LAS unsigned* wh, int need) {
    int ev[NJ]; const int sub = ln >> 4;
#pragma unroll
    for (int t = 0; t < NJ; ++t) { const int sl = 4 * t + sub; const unsigned w = lbase[sl]; ev[t] = (sl < cn) ? (int)(w & 0x3fffffu) : -1; }
    unsigned tl = 0u;
#pragma unroll
    for (int step = 0; step < 3; ++step) {
        const int sh = (step == 0) ? 14 : ((step == 1) ? 6 : 0), nb = (step == 2) ? 6 : 8, dm = (1 << nb) - 1;
        ((LAS u32x4*)wh)[ln] = (u32x4){0u, 0u, 0u, 0u};
#pragma unroll
        for (int t = 0; t < NJ; ++t) if (ev[t] >= 0) __hip_atomic_fetch_add(wh + ((ev[t] >> sh) & dm), 1u, __ATOMIC_RELAXED, __HIP_MEMORY_SCOPE_WORKGROUP);
        asm volatile("s_waitcnt lgkmcnt(0)" ::: "memory");
        const u32x4 c4 = ((const LAS u32x4*)wh)[ln];
        const int c = (int)(c4.x + c4.y + c4.z + c4.w);
        const int pre = wave_prefix_sum(c), sfx = __builtin_amdgcn_readlane(pre, 63) - pre + c;
        const int above = sfx - c;
        int run = above, dig = 0, nn = need; bool done = false;
        { const int ci = (int)c4.w; if (run + ci >= need) { dig = 4 * ln + 3; nn = need - run; done = true; } else run += ci; }
        { const int ci = (int)c4.z; if (!done) { if (run + ci >= need) { dig = 4 * ln + 2; nn = need - run; done = true; } else run += ci; } }
        { const int ci = (int)c4.y; if (!done) { if (run + ci >= need) { dig = 4 * ln + 1; nn = need - run; done = true; } else run += ci; } }
        { if (!done) { dig = 4 * ln; nn = need - run; } }
        const unsigned long long hm = __ballot(sfx >= need && above < need);
        const int src = (int)__builtin_ctzll(hm | (1ull << 63));
        dig = __builtin_amdgcn_readlane(dig, src); need = __builtin_amdgcn_readlane(nn, src);
        tl = (tl << nb) | (unsigned)dig;
        if (step < 2) {
#pragma unroll
            for (int t = 0; t < NJ; ++t) ev[t] = (((ev[t] >> sh) & dm) == dig) ? ev[t] : -1;
        }
    }
    return tl;
}

__device__ __forceinline__ void unit(int b, int qt, const bf16_t* __restrict__ O1, const bf16_t* __restrict__ KIDX, unsigned* __restrict__ MASK, LAS unsigned char* lds, int wv) {
    const int tid_ = tid_now(wv);
    long long spin_ = 0; long long tw0_ = 0; (void)tw0_;
#define RT_NOW(t) asm volatile("s_waitcnt vmcnt(0) lgkmcnt(0)\n\ts_memrealtime %0\n\ts_waitcnt lgkmcnt(0)" : "=s"(t) :: "memory")
#define SEC_B(id) do { if (PROBE_DUP == (id)) { unsigned long long t_; RT_NOW(t_); tw0_ = (long long)t_; } } while (0)
#define SEC_E(id) do { if (PROBE_DUP == (id)) { unsigned long long t_; RT_NOW(t_); spin_ += (long long)t_ - tw0_; } } while (0)
    SEC_B(90); SEC_B(91); SEC_B(70);
    asm volatile("" : "+s"(O1), "+s"(KIDX), "+s"(MASK));
    const int tid = tid_, lane = tid & 63, r32 = lane & 31, hi = lane >> 5; const int wid = wv;
    const size_t rowbase = (size_t)b * S; const int nkt = 2 * ((qt >> 1) + 1);
    const int kper = (nkt + 7) >> 3, ktb = wid * kper, kte = (ktb + kper < nkt) ? ktb + kper : nkt;
    LAS unsigned* hist = (LAS unsigned*)(lds + L_HIST); LAS unsigned* spfx = (LAS unsigned*)(lds + L_PFX); LAS int* sneed = (LAS int*)(lds + L_NEED);
    QOps Q;
    for (int rq_ = 0; rq_ < ((PROBE_DUP == 78) ? 9 : 1); ++rq_)
    { const GAS bf16_t* qrow = (const GAS bf16_t*)O1 + (rowbase + qt * 32 + r32 + (rq_ >> 4)) * LD1;
      const u32x4 ww = *(const GAS u32x4*)(qrow + O_WIDX);
      Q.wv[0] = bflo(ww.x); Q.wv[1] = bfhi(ww.x); Q.wv[2] = bflo(ww.y); Q.wv[3] = bfhi(ww.y); Q.wv[4] = bflo(ww.z); Q.wv[5] = bfhi(ww.z); Q.wv[6] = bflo(ww.w); Q.wv[7] = bfhi(ww.w);
      float qs[2][8];
#pragma unroll
      for (int s2 = 0; s2 < 2; ++s2)
#pragma unroll
          for (int j = 0; j < 8; ++j) qs[s2][j] = 0.f;
#pragma unroll
      for (int h = 0; h < 8; ++h)
#pragma unroll
          for (int s2 = 0; s2 < 2; ++s2) {
              const u32x4 qv = *(const GAS u32x4*)(qrow + O_QIDX + 32 * h + 16 * s2 + hi * 8);
              Q.qf[h][s2] = __builtin_bit_cast(bf16x8, qv);
              qs[s2][0] = __builtin_fmaf(Q.wv[h], bflo(qv.x), qs[s2][0]); qs[s2][1] = __builtin_fmaf(Q.wv[h], bfhi(qv.x), qs[s2][1]);
              qs[s2][2] = __builtin_fmaf(Q.wv[h], bflo(qv.y), qs[s2][2]); qs[s2][3] = __builtin_fmaf(Q.wv[h], bfhi(qv.y), qs[s2][3]);
              qs[s2][4] = __builtin_fmaf(Q.wv[h], bflo(qv.z), qs[s2][4]); qs[s2][5] = __builtin_fmaf(Q.wv[h], bfhi(qv.z), qs[s2][5]);
              qs[s2][6] = __builtin_fmaf(Q.wv[h], bflo(qv.w), qs[s2][6]); qs[s2][7] = __builtin_fmaf(Q.wv[h], bfhi(qv.w), qs[s2][7]);
          }
#pragma unroll
      for (int s2 = 0; s2 < 2; ++s2) {
          u32x4 hv, lv; unsigned* hp = (unsigned*)&hv; unsigned* lp = (unsigned*)&lv;
#pragma unroll
          for (int j = 0; j < 4; ++j) {
              const unsigned hw = pk2(qs[s2][2 * j], qs[s2][2 * j + 1]);
              hp[j] = hw; lp[j] = pk2(qs[s2][2 * j] - bflo(hw), qs[s2][2 * j + 1] - bfhi(hw));
          }
          Q.qb[0][s2] = __builtin_bit_cast(bf16x8, hv); Q.qb[1][s2] = __builtin_bit_cast(bf16x8, lv);
      } }
    SEC_E(91); SEC_B(92); SEC_E(70);
    const GAS bf16_t* kbase = (const GAS bf16_t*)KIDX + rowbase * 32;
    LAS unsigned* lcnt = (LAS unsigned*)(lds + L_LCNT); LAS unsigned* blist = (LAS unsigned*)(lds + L_LIST);
    GAS unsigned short* mbase = (GAS unsigned short*)MASK + ((size_t)b * att::MASK_TILES_PER_BATCH + att::mask_tile_off(qt)) * 64;
    unsigned tau = 0u;
    bool need_mask_pass = true;
    if (nkt * 32 > 256) {
        LAS unsigned* lists = (LAS unsigned*)(lds + L_HIST); LAS unsigned* scnt = (LAS unsigned*)(lds + L_CNT); LAS unsigned* stau = (LAS unsigned*)(lds + L_TAU); LAS unsigned* sflag = (LAS unsigned*)(lds + L_FLAG); LAS unsigned* slb = (LAS unsigned*)(lds + L_LB);
        if (tid < 32) { spfx[tid] = 0u; sneed[tid] = 256; lcnt[tid] = 0u; if (tid == 0) sflag[0] = ((IDX_FORCE_SLOW || PROBE_DUP == 77) ? 1u : 0u); }
        bool fast = false;
        for (int pass = 0; pass < 3; ++pass) {
            for (int rp_ = 0; rp_ < (((PROBE_DUP == 83 || PROBE_DUP == 89) && pass == 0) ? 2 : 1); ++rp_) {
            if (PROBE_DUP == 89 && tid < 32) { spfx[tid] = 0u; sneed[tid] = 256; }
            { LAS u32x4* h4 = (LAS u32x4*)hist; for (int e = tid_now(wv); e < 32 * HROW / 4; e += 512) h4[e] = (u32x4){0u, 0u, 0u, 0u}; }
            asm volatile("s_waitcnt lgkmcnt(0)\n\ts_barrier" ::: "memory");
            { const int ln = lane_now(), lr = ln & 31;
              PassCtx C; C.kbase = kbase; C.hrow = hist + lr * HROW; C.lcnt_q = lcnt + lr; C.blist_q = blist + lr * LCAP; C.mbase = mbase; C.pfx = spfx[lr];
              C.lane = ln; C.r32 = lr; C.hi = ln >> 5; C.ktb = ktb; C.kte = kte; C.hi2 = (wid >= 4);
              C.lown = nullptr; unsigned nc_ = 0u;
              if (pass == 0) {
                  if (PASS0_SPLIT && nkt >= 64) {
                      const int kmid = (kte > ktb) ? ktb + ((kte - ktb + 3) >> 2) : ktb;
                      C.kte = kmid; pass_loop<0>(C, Q, nc_);
                      asm volatile("s_waitcnt lgkmcnt(0)\n\ts_barrier" ::: "memory");
                      scan_hist(hist, spfx, sneed, slb, wid, 0, true);
                      asm volatile("s_waitcnt lgkmcnt(0)\n\ts_barrier" ::: "memory");
                      C.ktb = kmid; C.kte = kte; C.pfx = slb[lane_now() & 31]; pass_loop<4>(C, Q, nc_);
                  } else pass_loop<0>(C, Q, nc_);
              } else if (pass == 1) pass_loop<1>(C, Q, nc_); else pass_loop<2>(C, Q, nc_); }
            asm volatile("s_waitcnt vmcnt(0) lgkmcnt(0)\n\ts_barrier" ::: "memory");
            if (PROBE_DUP == 89 && pass == 0 && rp_ == 0) { scan_hist(hist, spfx, sneed, slb, wid, pass, false); asm volatile("s_waitcnt lgkmcnt(0)\n\ts_barrier" ::: "memory"); }
            }
            SEC_E(92); SEC_B(93);
            scan_hist(hist, spfx, sneed, slb, wid, pass, false);
            if (PROBE_DUP == 94 && pass == 0) { for (int rp_ = 0; rp_ < 4; ++rp_) { asm volatile("s_waitcnt lgkmcnt(0)\n\ts_barrier" ::: "memory"); scan_hist(hist, spfx, sneed, slb, wid, 0, true); } }
            asm volatile("s_waitcnt lgkmcnt(0)\n\ts_barrier" ::: "memory");
            SEC_E(93);
            if (pass == 0) {
                for (int rpB_ = 0; rpB_ < ((PROBE_DUP == 79) ? 2 : 1); ++rpB_) {
                SEC_B(95);
                for (int rp_ = 0; rp_ < ((PROBE_DUP == 84) ? 2 : 1); ++rp_)
                { const int ln = lane_now(), lr = ln & 31;
                  const unsigned la0 = (unsigned)(size_t)(lists + (wid * 64 + ln) * LSTR); unsigned la = la0;
                  PassCtx C; C.kbase = kbase; C.hrow = nullptr; C.lcnt_q = nullptr; C.blist_q = nullptr; C.lown = nullptr; C.mbase = mbase; C.pfx = spfx[lr]; C.msk = (C.pfx >= 512u) ? 0x80000000u : 0xffffffffu;
                  C.lane = ln; C.r32 = lr; C.hi = ln >> 5; C.ktb = ktb; C.kte = kte; C.hi2 = (wid >= 4);
                  pass_loop<3>(C, Q, la);
                  const unsigned nc = (la - la0) >> 2;
                  scnt[wid * 64 + ln] = nc < (unsigned)LISTN ? nc : (unsigned)LISTN;
                  if (nc > (unsigned)LISTN) sflag[0] = 1u; }
                asm volatile("s_waitcnt vmcnt(0) lgkmcnt(0)\n\ts_barrier" ::: "memory");
                SEC_E(95);
                if (sflag[0] == 0u) {
                    SEC_B(96);
                    for (int rp_ = 0; rp_ < ((PROBE_DUP == 85) ? 2 : 1); ++rp_)
                    { const int ln = lane_now(), li = ln & 15; LAS unsigned* wh = (LAS unsigned*)(lds + L_WH) + wid * 256;
#pragma unroll 1
                      for (int qi = 0; qi < 4; ++qi) {
                          const int q = wid * 4 + qi, L = (li >> 1) * 64 + q + 32 * (li & 1);
                          const int cn = (int)scnt[L];
                          int mx = cn;
                          { int o;
                            o = __builtin_amdgcn_update_dpp(0, mx, 0x111, 0xf, 0xf, false); mx = o > mx ? o : mx;
                            o = __builtin_amdgcn_update_dpp(0, mx, 0x112, 0xf, 0xf, false); mx = o > mx ? o : mx;
                            o = __builtin_amdgcn_update_dpp(0, mx, 0x114, 0xf, 0xf, false); mx = o > mx ? o : mx;
                            o = __builtin_amdgcn_update_dpp(0, mx, 0x118, 0xf, 0xf, false); mx = o > mx ? o : mx; }
                          const int nj = (__builtin_amdgcn_readlane(mx, 15) + 3) >> 2;
                          const int need = __builtin_amdgcn_readfirstlane(sneed[q]);
                          const LAS unsigned* lbase = lists + L * LSTR;
                          unsigned tl;
                          if (nj <= 4) tl = resolve_query<4>(lbase, cn, ln, wh, need); else if (nj <= 8) tl = resolve_query<8>(lbase, cn, ln, wh, need); else tl = resolve_query<16>(lbase, cn, ln, wh, need);
                          if (ln == 0) stau[q] = tl;
                      } }
                    asm volatile("s_waitcnt lgkmcnt(0)\n\ts_barrier" ::: "memory");
                    SEC_E(96); SEC_B(97);
                    for (int rp_ = 0; rp_ < ((PROBE_DUP == 86) ? 2 : 1); ++rp_)
                    { const int ln = lane_now(); const unsigned tq = stau[ln & 31], n = scnt[wid * 64 + ln]; const LAS unsigned* lown = lists + (wid * 64 + ln) * LSTR;
                      for (unsigned i = 0; i < n; ++i) {
                          const unsigned e = lown[i];
                          if ((e & 0x3fffffu) >= tq) {
                              const int ekt = ktb + (int)(e >> 26);
                              (void)__hip_atomic_fetch_or((GAS unsigned*)mbase + (size_t)(ekt >> 1) * 64 + ln, 1u << (((e >> 22) & 15u) + 16u * (unsigned)(ekt & 1)), __ATOMIC_RELAXED, __HIP_MEMORY_SCOPE_AGENT);
                          }
                      } }
                    SEC_E(97);
                    fast = true; need_mask_pass = false;
                }
                if (PROBE_DUP == 79 && rpB_ == 0) asm volatile("s_waitcnt vmcnt(0) lgkmcnt(0)\n\ts_barrier" ::: "memory");
                }
                if (fast) break;
            }
        }
        SEC_B(71);
        const int lane = lane_now(), r32 = lane & 31;
        tau = spfx[r32];
        const bool overflow = fast ? true : (__any(lcnt[r32] > (unsigned)LCAP) != 0);
        if (!overflow) {
            need_mask_pass = false;
            const unsigned n = lcnt[r32], tq = tau & 2047u;
            for (unsigned i = 0; i < n; ++i) {
                const unsigned e = blist[r32 * LCAP + i]; const int ekt = (int)(e >> 21);
                if (((e >> 15) & 63u) == (unsigned)lane && ekt >= ktb && ekt < kte && (e & 2047u) >= tq) {
                    GAS unsigned short* wp = mbase + (size_t)(ekt >> 1) * 128 + lane * 2 + (ekt & 1);
                    *wp = (unsigned short)(*wp | (1u << ((e >> 11) & 15u)));
                }
            }
        }
    }
#define IDX_MASK_BODY(K0, K1, KT) do { float acc[16]; score_tile(acc, K0, K1, Q); unsigned bits = 0u; \
        _Pragma("unroll") for (int r = 0; r < 16; ++r) bits |= (f2key(acc[r]) >= tau) ? (1u << r) : 0u; \
        if (!dryp) mbase[(size_t)((KT) >> 1) * 128 + lane * 2 + ((KT) & 1)] = (unsigned short)bits; else if (bits == 0xffffu && tau == 0x12345679u) mbase[0] = 0; } while (0)
    const int nreal = need_mask_pass ? 1 : 0, nrep = nreal + ((PROBE_DUP == 81) ? 2 : 0);
    for (int rep_ = 0; rep_ < nrep; ++rep_)
    { const bool dryp = (PROBE_DUP == 81) && (rep_ >= nreal);
      bf16x8 a0, a1, b0, b1, c0, c1;
      if (ktb < kte) IDX_KLOAD(a0, a1, ktb); if (ktb + 1 < kte) IDX_KLOAD(b0, b1, ktb + 1); if (ktb + 2 < kte) IDX_KLOAD(c0, c1, ktb + 2);
      for (int kt = ktb; kt < kte; kt += 3) {
          IDX_MASK_BODY(a0, a1, kt); if (kt + 3 < kte) IDX_KLOAD(a0, a1, kt + 3);
          if (kt + 1 < kte) { IDX_MASK_BODY(b0, b1, kt + 1); if (kt + 4 < kte) IDX_KLOAD(b0, b1, kt + 4); }
          if (kt + 2 < kte) { IDX_MASK_BODY(c0, c1, kt + 2); if (kt + 5 < kte) IDX_KLOAD(c0, c1, kt + 5); }
      } }
#undef IDX_MASK_BODY
    SEC_E(90); if (nkt * 32 > 256) SEC_E(71);
    if (PROBE_DUP >= 90 && PROBE_DUP < 100) { const long long t0_ = wall_clock64(); while (wall_clock64() - t0_ < spin_) __builtin_amdgcn_s_sleep(4); }
    asm volatile("s_waitcnt lgkmcnt(0)\n\ts_barrier" ::: "memory");
#undef SEC_B
#undef SEC_E
}
#undef IDX_KLOAD

__device__ __forceinline__ void phase(const bf16_t* O1, const bf16_t* KIDX, unsigned* MASK, LAS unsigned char* lds, int G, int bid, int wv) {
    for (int p = bid; p < 512; p += G) {
        const int b = p & 3, j = p >> 2;
#pragma unroll 1
        for (int u2 = 0; u2 < 2; ++u2) for (int rp_ = 0; rp_ < ((PROBE_DUP == 87) ? 2 : 1); ++rp_) unit(b, u2 ? 255 - j : j, O1, KIDX, MASK, lds, wv);
    }
}
}
struct Frame { LAS unsigned char* lds; int G, bid, wv; Ptrs p; };

__device__ __forceinline__ int win_dest_row(int n) {
    if (n < 672) return n;
    if (n < 3488) return n + 96;
    if (n < 3528) return n - 3488 + 672;
    return n + 56;
}
template <bool MAP>
__device__ __forceinline__ void transpose_item(const float* __restrict__ W, int K, int N, bf16_t* __restrict__ WT, const float* __restrict__ gk, LAS float* scr, int item, int lane) {
    const int nblk = (N + 31) / 32, kb = item / nblk, nb = item % nblk, k0 = 64 * kb, n0 = 32 * nb;
    const int nn = n0 + (lane & 31);
#pragma unroll 8
    for (int i = 0; i < 32; ++i) { const int kk = 2 * i + (lane >> 5); float v = 0.f; if (nn < N) v = W[(size_t)(k0 + kk) * N + nn]; if (gk) v *= gk[k0 + kk]; scr[kk * 33 + (lane & 31)] = v; }
    asm volatile("s_waitcnt lgkmcnt(0)" ::: "memory");
    const int c = lane & 7;
#pragma unroll
    for (int j = 0; j < 4; ++j) { const int n = (lane >> 3) + 8 * j; const LAS float* s = scr + (8 * c) * 33 + n;
        u32x4 o; o.x = pk2(s[0 * 33], s[1 * 33]); o.y = pk2(s[2 * 33], s[3 * 33]); o.z = pk2(s[4 * 33], s[5 * 33]); o.w = pk2(s[6 * 33], s[7 * 33]);
        if (n0 + n < N) { const int dr = MAP ? win_dest_row(n0 + n) : (n0 + n); *(u32x4*)(WT + (size_t)dr * K + k0 + 8 * c) = o; } }
    asm volatile("s_waitcnt lgkmcnt(0)" ::: "memory");
}

__device__ __forceinline__ void phase0(Frame& F) {
    const int t_ = tid_now(F.wv);
    const int tid = t_, lane = tid & 63; const int wave = F.wv; (void)tid; (void)lane; (void)wave;
    unsigned char* ws = F.p.ws;
    LAS float* scr = (LAS float*)(F.lds + wave * 16384);
    const int gw = F.bid * 8 + wave, NGW = F.G * 8;
    constexpr int I_IN = 16 * 175, I_UQ = 6 * 24, I_UKV = 4 * 32, I_OA = 8 * 32, I_OB = 8 * 32, I_OUT = 16 * 32;
    constexpr int NITEMS = I_IN + I_UQ + I_UKV + I_OA + I_OB + I_OUT;
    for (int it = gw; it < NITEMS; it += NGW) {
        int r = it;
        if (r < I_IN) { transpose_item<true>(F.p.w_in, 1024, NIN, (bf16_t*)(ws + WS_WINT), nullptr, scr, r, lane); continue; } r -= I_IN;
        if (r < I_UQ) { transpose_item<false>(F.p.w_uq, 384, 768, (bf16_t*)(ws + WS_WUQT), F.p.g_q, scr, r, lane); continue; } r -= I_UQ;
        if (r < I_UKV) { transpose_item<false>(F.p.w_ukv, 256, 1024, (bf16_t*)(ws + WS_WUKVT), F.p.g_kv, scr, r, lane); continue; } r -= I_UKV;
        if (r < I_OA) { transpose_item<false>(F.p.w_oa, 512, 1024, (bf16_t*)(ws + WS_WOAT), nullptr, scr, r, lane); continue; } r -= I_OA;
        if (r < I_OB) { transpose_item<false>(F.p.w_ob, 512, 1024, (bf16_t*)(ws + WS_WOBT), nullptr, scr, r, lane); continue; } r -= I_OB;
        transpose_item<false>(F.p.w_out, 1024, 1024, (bf16_t*)(ws + WS_WOUTT), nullptr, scr, r, lane);
    }
    { const int gt = F.bid * 512 + tid; if (gt < 7168) ((u32x4*)(ws + WS_WINT + (size_t)712 * 1024 * 2))[gt] = (u32x4){0u, 0u, 0u, 0u}; }
    for (int e = F.bid * 512 + tid; e < S * 16; e += F.G * 512) {
        const int pos = e >> 4, i = e & 15;
        const float freq = powf(10000.f, -(float)i / 16.f); const float ang = (float)pos * freq;
        ((float2*)(ws + WS_ROPE))[e] = make_float2(cosf(ang), sinf(ang));
    }
    bf16_t* H = (bf16_t*)(ws + WS_H);
    for (int row = gw; row < T; row += NGW) {
        const f32x4* xr = (const f32x4*)(F.p.x + (size_t)row * DM);
        f32x4 v[4]; float s = 0.f;
#pragma unroll
        for (int j = 0; j < 4; ++j) { v[j] = xr[lane + 64 * j]; s += (v[j][0] * v[j][0] + v[j][1] * v[j][1]) + (v[j][2] * v[j][2] + v[j][3] * v[j][3]); }
        s = wave_sum(s);
        const float r = rsqrtf(s * (1.f / DM) + 1e-6f);
#pragma unroll
        for (int j = 0; j < 4; ++j) {
            const f32x4 gg = ((const f32x4*)F.p.norm_g)[lane + 64 * j];
            uint2 o; o.x = pk2(v[j][0] * r * gg[0], v[j][1] * r * gg[1]); o.y = pk2(v[j][2] * r * gg[2], v[j][3] * r * gg[3]);
            ((uint2*)(H + (size_t)row * DM))[lane + 64 * j] = o;
        }
    }
}

__device__ __forceinline__ void phase1(Frame& F, int dry = 0) {
    unsigned char* ws = F.p.ws;
    pg8::Gemm g{(const bf16_t*)(ws + WS_H), DM, (const bf16_t*)(ws + WS_WINT), T, LD1, DM, F.wv};
    pg8::StaticOrder So; So.init(T, LD1, F.G, F.bid);
    pg8::EpiIn E{(bf16_t*)(ws + WS_OUT1), (float*)(ws + WS_SSQLAT), dry};
    if (P1_STAGGER_TICKS > 0 && !dry && 2 * F.bid >= F.G) { const long long t0 = wall_clock64(); while (wall_clock64() - t0 < P1_STAGGER_TICKS) __builtin_amdgcn_s_sleep(8); }
    if (PROBE_DUP == 14 && dry) { pg8::Gemm gz{(const bf16_t*)(ws + WS_CTL), 0, (const bf16_t*)(ws + WS_CTL), T, LD1, DM, F.wv}; pg8::SameTileOrder Ss; Ss.S = So; pg8::gemm_phase<pg8::EpiIn, pg8::SameTileOrder, true, true>(F.lds, gz, Ss, E); return; }
    if (PROBE_DUP == 12 && dry) { pg8::SameTileOrder Ss; Ss.S = So; pg8::gemm_phase<pg8::EpiIn, pg8::SameTileOrder, true, true>(F.lds, g, Ss, E); return; }
    pg8::gemm_phase<pg8::EpiIn, pg8::StaticOrder, true, true>(F.lds, g, So, E);
}

__device__ __forceinline__ void probe13(Frame& F, int dry) {
    const long long c0 = clock64(); const long long w0 = wall_clock64();
    phase1(F, dry);
    const long long c1 = clock64(); const long long w1 = wall_clock64();
    const long long ticks = (c1 - c0) * 1000ll / (w1 - w0 + 1);
    const long long t0 = wall_clock64(); while (wall_clock64() - t0 < ticks) __builtin_amdgcn_s_sleep(8);
}

__device__ __forceinline__ void phase1b(Frame& F) {
    const int t_ = tid_now(F.wv);
    const int tid = t_, lane = tid & 63; const int wave = F.wv; (void)tid; (void)lane; (void)wave;
    unsigned char* ws = F.p.ws;
    const bf16_t* O1 = (const bf16_t*)(ws + WS_OUT1);
    {
        bf16_t* KPE = (bf16_t*)(ws + WS_KPE); bf16_t* KIDX = (bf16_t*)(ws + WS_KIDX); const float2* rope = (const float2*)(ws + WS_ROPE);
        for (int e = F.bid * 512 + tid; e < T * 16; e += F.G * 512) {
            const int m = e >> 4, i = e & 15; const bf16_t* src = O1 + (size_t)m * LD1;
            const float2 cs = rope[(size_t)(m & (S - 1)) * 16 + i];
            const float x1 = bf2f(src[O_KROPE + i]), x2 = bf2f(src[O_KROPE + 16 + i]);
            KPE[(size_t)m * 32 + i] = f2bf(x1 * cs.x - x2 * cs.y); KPE[(size_t)m * 32 + 16 + i] = f2bf(x1 * cs.y + x2 * cs.x);
            KIDX[(size_t)m * 32 + i] = src[O_KIDX + i]; KIDX[(size_t)m * 32 + 16 + i] = src[O_KIDX + 16 + i];
        }
    }
    {
        pg8::Gemm g{O1 + O_QLAT, LD1, (const bf16_t*)(ws + WS_WUQT), T, 768, 384, F.wv};
        pg8::StaticOrder So; So.init(T, 768, F.G, F.bid);
        pg8::EpiQ E{(bf16_t*)(ws + WS_Q), (const float*)(ws + WS_SSQLAT), (const float2*)(ws + WS_ROPE)};
        pg8::gemm_phase<pg8::EpiQ, pg8::StaticOrder, true, true>(F.lds, g, So, E);
    }
    {
        pg8::Gemm g{O1 + O_CKV, LD1, (const bf16_t*)(ws + WS_WUKVT), T, 1024, 256, F.wv};
        pg8::StaticOrder So; So.init(T, 1024, F.G, F.bid);
        pg8::EpiKV E{(bf16_t*)(ws + WS_H), (const float*)(ws + WS_SSQLAT)};
        pg8::gemm_phase<pg8::EpiKV, pg8::StaticOrder, true, true>(F.lds, g, So, E);
    }
}

__device__ __forceinline__ void phase4ab(Frame& F) {
    unsigned char* ws = F.p.ws;
    const bf16_t* O1 = (const bf16_t*)(ws + WS_OUT1); bf16_t* MG = (bf16_t*)(ws + WS_H);
    {
        pg8::Gemm g{O1 + O_ZA, LD1, (const bf16_t*)(ws + WS_WOAT), T, 1024, 512, F.wv};
        pg8::StaticOrder So; So.init(T, 1024, F.G, F.bid);
        pg8::EpiGate<false> E{MG, O1, O_GA};
        pg8::gemm_phase<pg8::EpiGate<false>, pg8::StaticOrder, true, true>(F.lds, g, So, E);
    }
    {
        pg8::Gemm g{O1 + O_ZB, LD1, (const bf16_t*)(ws + WS_WOBT), T, 1024, 512, F.wv};
        pg8::StaticOrder So; So.init(T, 1024, F.G, F.bid);
        pg8::EpiGate<true> E{MG, O1, O_GB};
        pg8::gemm_phase<pg8::EpiGate<true>, pg8::StaticOrder, true, true>(F.lds, g, So, E);
    }
}

__device__ __forceinline__ void phase4c(Frame& F) {
    unsigned char* ws = F.p.ws;
    pg8::Gemm g{(const bf16_t*)(ws + WS_H), DM, (const bf16_t*)(ws + WS_WOUTT), T, 1024, 1024, F.wv};
    pg8::StaticOrder So; So.init(T, 1024, F.G, F.bid);
    if (FUSE_FINAL_NORM && F.G == 256) {
        unsigned* ctl = (unsigned*)(ws + WS_CTL);
        pg8::EpiOutNorm E{F.p.x, F.p.out, (float*)(ws + WS_SSQO), F.p.final_g, ctl + CW_PANEL, ctl + CW_TMO, F.lds};
        pg8::gemm_phase<pg8::EpiOutNorm, pg8::StaticOrder, true, true>(F.lds, g, So, E);
        return;
    }
    pg8::EpiOut E{F.p.x, F.p.out, (float*)(ws + WS_SSQO)};
    pg8::gemm_phase<pg8::EpiOut, pg8::StaticOrder, true, true>(F.lds, g, So, E);
}

__device__ __forceinline__ void phase5(Frame& F) {
    const int t_ = tid_now(F.wv);
    const int tid = t_, lane = tid & 63; const int wave = F.wv; (void)tid; (void)lane; (void)wave;
    const float* ssqo = (const float*)(F.p.ws + WS_SSQO);
    const int gw = F.bid * 8 + wave, NGW = F.G * 8;
    for (int row = gw; row < T; row += NGW) {
        float s = (lane < 32) ? ssqo[(size_t)row * 32 + lane] : 0.f;
        s = wave_sum(s);
        const float r = rsqrtf(s * (1.f / DM) + 1e-6f);
        f32x4* xr = (f32x4*)(F.p.out + (size_t)row * DM);
#pragma unroll
        for (int j = 0; j < 4; ++j) { const f32x4 gg = ((const f32x4*)F.p.final_g)[lane + 64 * j]; xr[lane + 64 * j] = xr[lane + 64 * j] * r * gg; }
    }
}

__device__ __forceinline__ void phase_mla(Frame& F, bool dry = false) {
    unsigned char* ws = F.p.ws;
    att::Tensors X{};
    X.Q = (const bf16_t*)(ws + WS_Q); X.ldq = 768; X.hq = 96;
    X.K0 = (const bf16_t*)(ws + WS_H); X.ldk = 1024; X.hk = 128; X.K1 = (const bf16_t*)(ws + WS_KPE);
    X.V = (const bf16_t*)(ws + WS_H) + 64; X.ldv = 1024; X.hv = 128;
    X.O = (bf16_t*)(ws + WS_OUT1) + O_ZA; X.ldo = LD1; X.mask = nullptr; X.rel_bias = nullptr;
    X.wv = F.wv;
    att::phase<false>(X, F.lds, F.G, F.bid, dry);
}
__device__ __forceinline__ void phase_dsa(Frame& F, bool dry = false) {
    unsigned char* ws = F.p.ws; bf16_t* O1 = (bf16_t*)(ws + WS_OUT1);
    att::Tensors X{};
    X.Q = O1 + O_QB; X.ldq = LD1; X.hq = 64;
    X.K0 = O1 + O_KB; X.ldk = LD1; X.hk = 64; X.K1 = nullptr;
    X.V = O1 + O_VB; X.ldv = LD1; X.hv = 64;
    X.O = O1 + O_ZB; X.ldo = LD1; X.mask = (const unsigned long long*)(ws + WS_MASK); X.rel_bias = F.p.rel_bias;
    X.wv = F.wv;
    att::phase<true>(X, F.lds, F.G, F.bid, dry);
}

__device__ __forceinline__ void phase_idx(Frame& F) {
    unsigned char* ws = F.p.ws;
    idx::phase((const bf16_t*)(ws + WS_OUT1), (const bf16_t*)(ws + WS_KIDX), (unsigned*)(ws + WS_MASK), F.lds, F.G, F.bid, F.wv);
}

typedef unsigned long long u64_t;
#define XB_TMO      128
#define XB_XCNT(j)  (256  + 64 * (j))
#define XB_XSUB(j)  (1280 + 64 * (j))
#define XB_XGEN(j)  (2304 + 64 * (j))
#define XB_TOP      3328
#define XB_TOPGEN   3392
#define XCD_BAR_WORDS 3456
#define XB_SPIN_CAP (1u << 18)

__device__ __forceinline__ unsigned xb_ld(unsigned* p)              { return __hip_atomic_load(p, __ATOMIC_RELAXED, __HIP_MEMORY_SCOPE_AGENT); }
__device__ __forceinline__ unsigned xb_add(unsigned* p, unsigned v) { return __hip_atomic_fetch_add(p, v, __ATOMIC_RELAXED, __HIP_MEMORY_SCOPE_AGENT); }
__device__ __forceinline__ unsigned xb_xcc_id() { return (unsigned)__builtin_amdgcn_s_getreg((3 << 11) | 20) & 0xFu; }
#define XB_SPIN(cond, bar) do { unsigned _sp = 0; while (cond) { __builtin_amdgcn_s_sleep(1); \
    if ((++_sp & 255u) == 0u) { if (xb_ld(&(bar)[XB_TMO])) break; if (_sp > XB_SPIN_CAP) { atomicAdd(&(bar)[XB_TMO], 1u); break; } } } } while (0)

struct XcdBarrier {
    unsigned* bar; unsigned x; int wv;
    volatile LAS unsigned* st;
};

__device__ __forceinline__ XcdBarrier xcd_barrier_post(unsigned* bar, volatile LAS unsigned* st, int wv) {
    XcdBarrier b; b.bar = bar; b.x = xb_xcc_id(); b.st = st; b.wv = wv;
    if (threadIdx.x == 0) (void)xb_add(&bar[XB_XCNT(b.x)], 1u);
    return b;
}
__device__ __forceinline__ void xcd_barrier_complete(unsigned* bar, unsigned x, unsigned& nloc, unsigned& nx) {
    const unsigned G = gridDim.x * gridDim.y * gridDim.z;
    unsigned sum, cnt, mine, sp = 0u;
    for (;;) {
        sum = 0u; cnt = 0u; mine = 0u;
#pragma unroll
        for (unsigned j = 0; j < 16; ++j) { const unsigned c = xb_ld(&bar[XB_XCNT(j)]); sum += c; cnt += (c > 0u) ? 1u : 0u; mine = (j == x) ? c : mine; }
        if (sum == G) break;
        __builtin_amdgcn_s_sleep(1);
        if ((++sp & 255u) == 0u) { if (xb_ld(&bar[XB_TMO])) break; if (sp > XB_SPIN_CAP) { atomicAdd(&bar[XB_TMO], 1u); break; } }
    }
    nloc = mine > 0u ? mine : 1u; nx = cnt > 0u ? cnt : 1u;
}

__device__ __forceinline__ void xcd_barrier(const XcdBarrier& b) {
    asm volatile("s_waitcnt vmcnt(0)" ::: "memory");
    __syncthreads();
    if (b.wv == 0 && lane_now() == 0) {
        unsigned* bar = b.bar;
        __builtin_amdgcn_s_waitcnt(0);
        unsigned nloc = b.st[0], nx = b.st[1];
        if (nloc == 0u) { xcd_barrier_complete(bar, b.x, nloc, nx); b.st[0] = nloc; b.st[1] = nx; }
        const unsigned old = xb_add(&bar[XB_XSUB(b.x)], 1u);
        const unsigned gen = old / nloc;
        if (old + 1u == (gen + 1u) * nloc) {
            __builtin_amdgcn_fence(__ATOMIC_RELEASE, "agent");
            asm volatile("s_waitcnt vmcnt(0)" ::: "memory");
            const unsigned og = xb_add(&bar[XB_TOP], 1u);
            const unsigned tg = og / nx;
            if (og + 1u == (tg + 1u) * nx) xb_add(&bar[XB_TOPGEN], 1u);
            else XB_SPIN(xb_ld(&bar[XB_TOPGEN]) == tg, bar);
            __builtin_amdgcn_fence(__ATOMIC_ACQUIRE, "agent");
            xb_add(&bar[XB_XGEN(b.x)], 1u);
            asm volatile("s_waitcnt vmcnt(0)" ::: "memory");
        } else {
            XB_SPIN(xb_ld(&bar[XB_XGEN(b.x)]) == gen, bar);
            __builtin_amdgcn_fence(__ATOMIC_ACQUIRE, "agent");
            asm volatile("s_waitcnt vmcnt(0)" ::: "memory");
        }
    }
    __syncthreads();
}

constexpr int CW_BAR = 4096;
constexpr size_t CTL_ZERO_BYTES = (PROBE_DUP == 14) ? (1u << 20) : 65536;
constexpr int LDS_MISC = 150016;
struct Args { Ptrs p; int ph_lo, ph_hi; };
__global__ void __launch_bounds__(512, 2) mega_fwd(Args a) {
    extern __shared__ __attribute__((aligned(16))) unsigned char lds_raw[];
    Frame F; F.lds = (LAS unsigned char*)lds_raw;
    F.G = gridDim.x; F.bid = blockIdx.x; F.p = a.p;
    cooperative_groups::grid_group grid = cooperative_groups::this_grid();
    volatile LAS unsigned* st = (volatile LAS unsigned*)(F.lds + LDS_MISC);
    if (threadIdx.x < 4) st[threadIdx.x] = 0u;
    F.wv = __builtin_amdgcn_readfirstlane((int)(threadIdx.x >> 6));
    __syncthreads();
    const XcdBarrier bar = xcd_barrier_post((unsigned*)(a.p.ws + WS_CTL) + CW_BAR, st, F.wv);
    static_assert(CW_TMO == CW_BAR + XB_TMO && CW_PANEL * 4 + 64 * 64 <= (int)CTL_ZERO_BYTES, "control words");
    const int lo = a.ph_lo, hi = (FUSE_FINAL_NORM && !DEBUG_FUSE && F.G == 256 && a.ph_hi > 7) ? 7 : a.ph_hi;
struct ClkProbe {
    long long c0, w0;
    __device__ __forceinline__ void begin() { c0 = clock64(); w0 = wall_clock64(); }
    __device__ __forceinline__ void end() { const long long c1 = clock64(); const long long w1 = wall_clock64(); const long long ticks = (c1 - c0) * 1000ll / (w1 - w0 + 1);
        const long long t0 = wall_clock64(); while (wall_clock64() - t0 < ticks) __builtin_amdgcn_s_sleep(8); }
};
#define CLK(code, body) do { if (PROBE_DUP == (code)) { ClkProbe q_; q_.begin(); body; q_.end(); } else { body; } } while (0)
#define RUN(k, body, CG) do { if (lo <= (k) && (k) < hi) { body; if ((k) + 1 < hi) { if (CG) grid.sync(); else { xcd_barrier(bar); } } } } while (0)
    const bool dryrun = (a.ph_hi > 0);
    RUN(0, { CLK(30, phase0(F)); if (PROBE_DUP == 0) phase0(F); }, true);
    RUN(1, { if (PROBE_DUP == 21) { const long long t0 = clock64(); while (clock64() - t0 < 1000000ll) __builtin_amdgcn_s_sleep(8); } CLK(31, phase1(F)); if (PROBE_DUP == 1) phase1(F); if (PROBE_DUP == 11 || PROBE_DUP == 12 || PROBE_DUP == 14) phase1(F, (int)dryrun); if (PROBE_DUP == 13) probe13(F, (int)dryrun); }, false);
    RUN(2, { CLK(32, phase1b(F)); if (PROBE_DUP == 2) phase1b(F); }, false);
    RUN(3, { const bool idx_first = (MIX_ORDER != 0) && (((F.bid >> 3) & 1) != 0); if (idx_first) phase_idx(F); CLK(33, phase_mla(F)); if (PROBE_DUP == 3) phase_mla(F, dryrun); if (!idx_first) CLK(38, phase_idx(F)); if (PROBE_DUP == 8) phase_idx(F); }, false);
    RUN(4, { CLK(34, phase_dsa(F)); if (PROBE_DUP == 4) phase_dsa(F, dryrun); }, false);
    RUN(5, { CLK(35, phase4ab(F)); if (PROBE_DUP == 5) phase4ab(F); }, false);
    RUN(6, { if (PROBE_DUP == 22) { const long long t0 = clock64(); while (clock64() - t0 < 1000000ll) __builtin_amdgcn_s_sleep(8); } CLK(36, phase4c(F)); if (PROBE_DUP == 6) phase4c(F); }, false);
    if (!(FUSE_FINAL_NORM && !DEBUG_FUSE && F.G == 256)) RUN(7, phase5(F), false);
#undef RUN
}

extern "C" void kernel_launch(void* const* d_in, const int* in_sizes, int n_in, void* d_out, int out_size, void* d_ws, size_t ws_size, hipStream_t stream) {
    static int grid = 0;
    if (grid == 0) {
        if (ws_size < WS_END) { fprintf(stderr, "kernel_launch: workspace too small: %zu < %zu\n", ws_size, (size_t)WS_END); grid = -1; return; }
        int dev = 0, cus = 0, per_cu = 0;
        if (hipGetDevice(&dev) != hipSuccess || hipDeviceGetAttribute(&cus, hipDeviceAttributeMultiprocessorCount, dev) != hipSuccess) { grid = -1; return; }
        if (hipFuncSetAttribute((const void*)mega_fwd, hipFuncAttributeMaxDynamicSharedMemorySize, LDS_BYTES) != hipSuccess) { fprintf(stderr, "kernel_launch: hipFuncSetAttribute failed\n"); grid = -1; return; }
        if (hipOccupancyMaxActiveBlocksPerMultiprocessor(&per_cu, (const void*)mega_fwd, 512, LDS_BYTES) != hipSuccess || per_cu < 1) { fprintf(stderr, "kernel_launch: occupancy query failed (%d)\n", per_cu); (void)hipGetLastError(); grid = -1; return; }
        grid = cus;
    }
    if (grid < 0) return;
    if (hipMemsetAsync((char*)d_ws + WS_CTL, 0, CTL_ZERO_BYTES, stream) != hipSuccess) { fprintf(stderr, "kernel_launch: hipMemsetAsync failed\n"); return; }
    Args a{};
    a.p.x = (const float*)d_in[0]; a.p.norm_g = (const float*)d_in[1]; a.p.w_in = (const float*)d_in[2]; a.p.g_q = (const float*)d_in[3]; a.p.w_uq = (const float*)d_in[4];
    a.p.g_kv = (const float*)d_in[5]; a.p.w_ukv = (const float*)d_in[6]; a.p.w_oa = (const float*)d_in[7]; a.p.w_ob = (const float*)d_in[8]; a.p.w_out = (const float*)d_in[9];
    a.p.rel_bias = (const float*)d_in[10]; a.p.final_g = (const float*)d_in[11]; a.p.out = (float*)d_out; a.p.ws = (unsigned char*)d_ws;
    a.ph_lo = 0; a.ph_hi = 8;
    void* args[] = {&a};
    const hipError_t e = hipLaunchCooperativeKernel((const void*)mega_fwd, dim3(grid), dim3(512), args, LDS_BYTES, stream);
    if (e != hipSuccess) fprintf(stderr, "kernel_launch: cooperative launch failed: %s (grid %d)\n", hipGetErrorString(e), grid);
}
```

```cpp
#include <hip/hip_runtime.h>
#include <hip/hip_cooperative_groups.h>
#include <stdint.h>
#include <stdio.h>
#ifndef PROBE_DUP
#define PROBE_DUP -1
#endif

__device__ __forceinline__ int lane_now() { int l; asm volatile("v_mbcnt_lo_u32_b32 %0, -1, 0\n\tv_mbcnt_hi_u32_b32 %0, -1, %0" : "=v"(l)); return l; }
__device__ __forceinline__ int tid_now(int wv) { return (wv << 6) | lane_now(); }

namespace pg8 {
#define PG8_LAS __attribute__((address_space(3)))
typedef unsigned short bf16_t;
typedef short bf16x8 __attribute__((ext_vector_type(8)));
typedef float f32x4 __attribute__((ext_vector_type(4)));
typedef unsigned u32x4 __attribute__((ext_vector_type(4)));
constexpr int BM = 256, BK = 64, HALF = 128, HTB = HALF * BK * 2  , STAGE_BYTES = 8 * HTB, NXCD = 8, WGM = 8;

__host__ __device__ __forceinline__ int lds_byte(int r, int c) { const int st = (r >> 4) * 2 + (c >> 5), rr = r & 15, cc = c & 31, ob = rr * 64 + cc * 2; return st * 1024 + (ob ^ (((ob >> 9) & 1) << 5)); }
__host__ __device__ __forceinline__ void stage_rc(int b, int& R, int& C) { const int st = b / 1024, sb = b % 1024, swz = sb ^ (((sb >> 9) & 1) << 5); R = (st >> 1) * 16 + swz / 64; C = (st & 1) * 32 + (swz % 64) / 2; }
__host__ __device__ __forceinline__ int perm32(int rho) { const int n = rho >> 4, i = rho & 15; return 8 * (i >> 2) + 4 * n + (i & 3); }

struct Unit { int pm, pn, var; };
struct Gemm { const bf16_t* A; int lda; const bf16_t* Bt; int M, N, K; int wv; long dA, dB; };

struct StaticOrder {
    int nM, nN, nwg, G, c;
    __host__ __device__ void init(int M, int N, int G_, int c_) { nM = M / BM; nN = N / BM; nwg = nM * nN; G = G_; c = c_; }
    __host__ __device__ bool next(int i, Unit& u) const {
        const long L = (long)i * G + c; if (L >= nwg) return false;
        int wgid = (int)L; { const int q = nwg / NXCD, r = nwg % NXCD, xcd = wgid % NXCD, off = wgid / NXCD; wgid = (xcd < r ? xcd * (q + 1) : r * (q + 1) + (xcd - r) * q) + off; }
        const int nig = WGM * nN, gid = wgid / nig, fm = gid * WGM, gsz = (nM - fm) < WGM ? (nM - fm) : WGM;
        u.pm = fm + ((wgid % nig) % gsz); u.pn = (wgid % nig) / gsz; u.var = 0; return true;
    }
    __device__ __forceinline__ void a_ready(const Unit&) const {}
    __device__ __forceinline__ void done(const Unit&) const {}
};
struct TwoGemmOrder {
    StaticOrder S;
    __host__ __device__ bool next(int i, Unit& u) const { const bool ok = S.next(i >> 1, u); u.var = i & 1; return ok; }
    __device__ __forceinline__ void a_ready(const Unit&) const {}
    __device__ __forceinline__ void done(const Unit&) const {}
};
struct SameTileOrder {
    StaticOrder S;
    __host__ __device__ bool next(int i, Unit& u) const { const bool ok = S.next(i, u); u.pm = 0; u.pn = 0; return ok; }
    __device__ __forceinline__ void a_ready(const Unit&) const {}
    __device__ __forceinline__ void done(const Unit&) const {}
};

typedef __bf16 bf16x2_t __attribute__((ext_vector_type(2)));
typedef float f32x2_t __attribute__((ext_vector_type(2)));
__device__ __forceinline__ unsigned cvt_pk_bf16(float lo, float hi) { const f32x2_t v = {lo, hi}; return __builtin_bit_cast(unsigned, __builtin_convertvector(v, bf16x2_t)); }
template <class Epi, class Sched, bool ALIGN_EPI = false, bool SP2 = false>
__device__ __forceinline__ void gemm_phase(PG8_LAS unsigned char* lds, const Gemm g, const Sched& S, const Epi& E) {
    const int tid_ = tid_now(g.wv);
    const int tid = tid_, wid = g.wv, lane = tid & 63, wr = wid >> 2, wc = wid & 3, fr = lane & 15, fq = lane >> 4;
    int K_ = g.K; if (g.K < 1024) asm volatile("" : "+s"(K_));
    const int K = K_, nt = K / BK;
    unsigned voffA[2], voffB[2];
#pragma unroll
    for (int i = 0; i < 2; ++i) { int R, C; stage_rc(tid * 16 + i * 8192, R, C); const int Rb = Epi::PERM ? ((R & ~31) + perm32(R & 31)) : R;
        voffA[i] = (unsigned)(R * g.lda + C) * 2u; voffB[i] = (unsigned)(Rb * K + C) * 2u; }
    const size_t kstep = (size_t)(BK * 2);
    const size_t hstepA = (size_t)HALF * g.lda * 2, hstepB = (size_t)HALF * K * 2;
    const size_t tstepA = 2 * hstepA, tstepB = 2 * hstepB;
    const unsigned ldsw = (unsigned)wid * 1024u;
    const int aoff = lds_byte(wr * 64 + fr, fq * 8), boff = lds_byte(wc * 32 + fr, fq * 8);
#define PG8_SA(b, h) (((b) * 2 + (h)) * HTB)
#define PG8_SB(b, h) ((4 + (b) * 2 + (h)) * HTB)
#define PG8_STAGE(bufoff, gbase, voff) do { _Pragma("unroll") for (int _i = 0; _i < 2; ++_i) \
        __builtin_amdgcn_global_load_lds((const unsigned*)((const char*)(gbase) + (voff)[_i]), (PG8_LAS unsigned*)(lds + (bufoff) + ldsw + _i * 8192), 16, 0, 0); } while (0)
#define PG8_LDA(dst, b, h) do { _Pragma("unroll") for (int m = 0; m < 4; ++m) _Pragma("unroll") for (int k = 0; k < 2; ++k) dst[m][k] = *(const PG8_LAS bf16x8*)(lds + PG8_SA(b, h) + aoff + m * 2048 + k * 1024); } while (0)
#define PG8_LDB(dst, b, h) do { _Pragma("unroll") for (int n = 0; n < 2; ++n) _Pragma("unroll") for (int k = 0; k < 2; ++k) dst[n][k] = *(const PG8_LAS bf16x8*)(lds + PG8_SB(b, h) + boff + n * 2048 + k * 1024); } while (0)
#define PG8_MMA(ai, bj, At, Bt) do { __builtin_amdgcn_s_setprio(1); _Pragma("unroll") for (int m = 0; m < 4; ++m) _Pragma("unroll") for (int n = 0; n < 2; ++n) _Pragma("unroll") for (int k = 0; k < 2; ++k) \
        acc[ai][bj][m][n] = __builtin_amdgcn_mfma_f32_16x16x32_bf16(Bt[n][k], At[m][k], acc[ai][bj][m][n], 0, 0, 0); __builtin_amdgcn_s_setprio(0); } while (0)
#define PG8_WAIT_V(n) asm volatile("s_waitcnt vmcnt(" #n ")" ::: "memory")
#define PG8_WAIT_L(n) asm volatile("s_waitcnt lgkmcnt(" #n ")" ::: "memory")
#define PG8_BAR __builtin_amdgcn_s_barrier()
#define PG8_SCHED __builtin_amdgcn_sched_barrier(0)
    Unit cur, nxt; int ui = 0;
    if (!S.next(0, cur)) return;
    f32x4 acc[2][2][4][2];
#pragma unroll
    for (int a = 0; a < 2; ++a)
#pragma unroll
        for (int b = 0; b < 2; ++b)
#pragma unroll
            for (int m = 0; m < 4; ++m)
#pragma unroll
                for (int n = 0; n < 2; ++n) acc[a][b][m][n] = (f32x4){0.f, 0.f, 0.f, 0.f};
    bf16x8 At[4][2], B0[2][2], B1[2][2];
    const char* cA = (const char*)g.A + (size_t)cur.pm * tstepA + cur.var * g.dA; const char* cB = (const char*)g.Bt + (size_t)cur.pn * tstepB + cur.var * g.dB;
    S.a_ready(cur);
    if constexpr (SP2) {
        PG8_STAGE(PG8_SB(0, 0), cB, voffB); PG8_STAGE(PG8_SB(0, 1), cB + hstepB, voffB); PG8_STAGE(PG8_SA(0, 0), cA, voffA); PG8_STAGE(PG8_SA(0, 1), cA + hstepA, voffA);
        if (wr == 1) PG8_BAR;
        PG8_WAIT_V(2); PG8_BAR;
        PG8_STAGE(PG8_SB(1, 0), cB + kstep, voffB); PG8_STAGE(PG8_SA(1, 0), cA + kstep, voffA); PG8_STAGE(PG8_SB(1, 1), cB + hstepB + kstep, voffB);
        PG8_WAIT_V(6); PG8_BAR;
    } else {
        PG8_STAGE(PG8_SB(0, 0), cB, voffB); PG8_STAGE(PG8_SA(0, 0), cA, voffA); PG8_STAGE(PG8_SB(0, 1), cB + hstepB, voffB); PG8_STAGE(PG8_SA(0, 1), cA + hstepA, voffA);
        if (wr == 1) PG8_BAR;
        PG8_WAIT_V(4); PG8_BAR;
        PG8_STAGE(PG8_SB(1, 0), cB + kstep, voffB); PG8_STAGE(PG8_SA(1, 0), cA + kstep, voffA); PG8_STAGE(PG8_SB(1, 1), cB + hstepB + kstep, voffB);
        PG8_WAIT_V(6); PG8_BAR;
    }
    for (;;) {
        const bool has_next = S.next(ui + 1, nxt);
        const char* nA = has_next ? (const char*)g.A + (size_t)nxt.pm * tstepA + nxt.var * g.dA : cA; const char* nB = has_next ? (const char*)g.Bt + (size_t)nxt.pn * tstepB + nxt.var * g.dB : cB;
        for (int t = 0; t < nt; t += 2) {
            const bool last = (t == nt - 2);
            const char* a1 = cA + (size_t)(t + 1) * kstep;
            const char* a2 = last ? nA : cA + (size_t)(t + 2) * kstep; const char* b2 = last ? nB : cB + (size_t)(t + 2) * kstep;
            const char* a3 = a2 + kstep; const char* b3 = b2 + kstep;
            if (last && has_next) S.a_ready(nxt);
            if constexpr (SP2) {
            PG8_LDB(B0, 0, 0); PG8_LDB(B1, 0, 1); PG8_SCHED; PG8_LDA(At, 0, 0); PG8_STAGE(PG8_SA(1, 1), a1 + hstepA, voffA);
            PG8_WAIT_V(8); PG8_WAIT_L(0); PG8_BAR; PG8_MMA(0, 0, At, B0); PG8_MMA(0, 1, At, B1); PG8_BAR; PG8_SCHED;
            PG8_LDA(At, 0, 1); PG8_STAGE(PG8_SB(0, 0), b2, voffB); PG8_STAGE(PG8_SB(0, 1), b2 + hstepB, voffB); PG8_STAGE(PG8_SA(0, 0), a2, voffA);
            PG8_WAIT_V(8); PG8_WAIT_L(0); PG8_BAR; PG8_MMA(1, 0, At, B0); PG8_MMA(1, 1, At, B1); PG8_BAR; PG8_SCHED;
            PG8_LDB(B0, 1, 0); PG8_LDB(B1, 1, 1); PG8_SCHED; PG8_LDA(At, 1, 0); PG8_STAGE(PG8_SA(0, 1), a2 + hstepA, voffA);
            PG8_WAIT_V(8); PG8_WAIT_L(0); PG8_BAR; PG8_MMA(0, 0, At, B0); PG8_MMA(0, 1, At, B1); PG8_BAR; PG8_SCHED;
            PG8_LDA(At, 1, 1); PG8_STAGE(PG8_SB(1, 0), b3, voffB); PG8_STAGE(PG8_SB(1, 1), b3 + hstepB, voffB); PG8_STAGE(PG8_SA(1, 0), a3, voffA);
            PG8_WAIT_V(8); PG8_WAIT_L(0); PG8_BAR; PG8_MMA(1, 0, At, B0); PG8_MMA(1, 1, At, B1); PG8_BAR; PG8_SCHED;
            } else {
            PG8_LDB(B0, 0, 0); PG8_SCHED; PG8_LDA(At, 0, 0); PG8_STAGE(PG8_SA(1, 1), a1 + hstepA, voffA);
            PG8_WAIT_L(8); PG8_BAR; PG8_WAIT_L(0); PG8_MMA(0, 0, At, B0); PG8_BAR; PG8_SCHED;
            PG8_LDB(B1, 0, 1); PG8_STAGE(PG8_SB(0, 0), b2, voffB);
            PG8_BAR; PG8_WAIT_L(0); PG8_MMA(0, 1, At, B1); PG8_BAR;
            PG8_LDA(At, 0, 1); PG8_STAGE(PG8_SA(0, 0), a2, voffA);
            PG8_BAR; PG8_WAIT_L(0); PG8_MMA(1, 0, At, B0); PG8_BAR; PG8_SCHED;
            PG8_STAGE(PG8_SB(0, 1), b2 + hstepB, voffB);
            PG8_WAIT_V(6); PG8_BAR; PG8_MMA(1, 1, At, B1); PG8_BAR;
            PG8_LDB(B0, 1, 0); PG8_SCHED; PG8_LDA(At, 1, 0); PG8_STAGE(PG8_SA(0, 1), a2 + hstepA, voffA);
            PG8_WAIT_L(8); PG8_BAR; PG8_WAIT_L(0); PG8_MMA(0, 0, At, B0); PG8_BAR; PG8_SCHED;
            PG8_LDB(B1, 1, 1); PG8_STAGE(PG8_SB(1, 0), b3, voffB);
            PG8_BAR; PG8_WAIT_L(0); PG8_MMA(0, 1, At, B1); PG8_BAR;
            PG8_LDA(At, 1, 1); PG8_STAGE(PG8_SA(1, 0), a3, voffA);
            PG8_BAR; PG8_WAIT_L(0); PG8_MMA(1, 0, At, B0); PG8_BAR; PG8_SCHED;
            PG8_STAGE(PG8_SB(1, 1), b3 + hstepB, voffB);
            PG8_WAIT_V(6); PG8_BAR; PG8_MMA(1, 1, At, B1); PG8_BAR;
            }
        }
        if constexpr (ALIGN_EPI) { if (wr == 0) PG8_BAR; }
        if constexpr (!Epi::AFTER_DRAIN) { E(acc, cur, wr, wc, fr, fq); S.done(cur); }
        if (!has_next) break;
#pragma unroll
        for (int a = 0; a < 2; ++a)
#pragma unroll
            for (int b = 0; b < 2; ++b)
#pragma unroll
                for (int m = 0; m < 4; ++m)
#pragma unroll
                    for (int n = 0; n < 2; ++n) acc[a][b][m][n] = (f32x4){0.f, 0.f, 0.f, 0.f};
        cur = nxt; cA = nA; cB = nB; ++ui;
        if constexpr (ALIGN_EPI) { if (wr == 1) PG8_BAR; }
    }
    PG8_WAIT_V(0);
    if constexpr (!ALIGN_EPI) { if (wr == 0) PG8_BAR; }
    PG8_BAR;
    if constexpr (Epi::AFTER_DRAIN) { E.fused(acc, cur, wr, wc, fr, fq, lds, wid, lane); S.done(cur); }
#undef PG8_SA
#undef PG8_SB
#undef PG8_STAGE
#undef PG8_LDA
#undef PG8_LDB
#undef PG8_MMA
#undef PG8_WAIT_V
#undef PG8_WAIT_L
#undef PG8_BAR
#undef PG8_SCHED
}
}

typedef unsigned short bf16_t;
typedef float f32x4 __attribute__((ext_vector_type(4)));
typedef unsigned u32x4 __attribute__((ext_vector_type(4)));
#define LAS __attribute__((address_space(3)))
constexpr int NB = 4, S = 8192, DM = 1024, T = NB * S;
constexpr int NIN = 5576;
constexpr int LD1 = 5632;
constexpr int O_QLAT = 0, O_CKV = 384, O_KROPE = 640, O_KIDX = 672, O_WIDX = 704, O_ZA = 768, O_QB = 1280, O_KB = 1792, O_VB = 2304, O_ZB = 2816,
              O_QIDX = 3328, O_GA = 3584, O_GB = 4608;
constexpr size_t MiB = 1u << 20;
constexpr size_t WS_CTL = 0, WS_WUQT = 1 * MiB, WS_WUKVT = 2 * MiB, WS_WOAT = 3 * MiB, WS_WOBT = 4 * MiB, WS_WOUTT = 5 * MiB, WS_ROPE = 7 * MiB,
                 WS_WINT = 8 * MiB, WS_SSQO = 8 * MiB  , WS_SSQLAT = 19 * MiB, WS_KPE = 22 * MiB, WS_KIDX = 24 * MiB, WS_MASK = 26 * MiB,
                 WS_H = 44 * MiB  , WS_Q = 108 * MiB, WS_OUT1 = 156 * MiB, WS_END = 508 * MiB;
constexpr float LOG2E = 1.4426950408889634f;
constexpr float QSCALE_A = 0.10206207261596577f * LOG2E;
constexpr float QSCALE_B = 0.125f * LOG2E;
constexpr int GEMM_LDS = 131072;
constexpr int LDS_BYTES = 155648;
#ifndef FUSE_AFTER_DRAIN
#define FUSE_AFTER_DRAIN 0
#endif
#ifndef DEBUG_FUSE
#define DEBUG_FUSE 0
#endif
#ifndef FUSE_FINAL_NORM
#define FUSE_FINAL_NORM 1
#endif
constexpr int CW_PANEL = 8192, CW_TMO = 4096 + 128;
#ifndef MIX_ORDER
#define MIX_ORDER 0
#endif
#ifndef P1_STAGGER_TICKS
#define P1_STAGGER_TICKS 0
#endif

__device__ __forceinline__ float bf2f(bf16_t v) { return __uint_as_float(((unsigned)v) << 16); }
__device__ __forceinline__ bf16_t f2bf(float f) { unsigned u = __float_as_uint(f); return (bf16_t)((u + 0x7fffu + ((u >> 16) & 1u)) >> 16); }
__device__ __forceinline__ unsigned pk2(float lo, float hi) { return (unsigned)f2bf(lo) | ((unsigned)f2bf(hi) << 16); }
__device__ __forceinline__ float bflo(unsigned w) { return __uint_as_float(w << 16); }
__device__ __forceinline__ float bfhi(unsigned w) { return __uint_as_float(w & 0xffff0000u); }
__device__ __forceinline__ float wave_sum(float v) {
#pragma unroll
    for (int o = 1; o < 64; o <<= 1) v += __shfl_xor(v, o);
    return v;
}
__device__ __forceinline__ float sigmoidf_(float x) { return __builtin_amdgcn_rcpf(1.f + __builtin_amdgcn_exp2f(-LOG2E * x)); }

struct Ptrs {
    const float *x, *norm_g, *w_in, *g_q, *w_uq, *g_kv, *w_ukv, *w_oa, *w_ob, *w_out, *rel_bias, *final_g;
    float* out; unsigned char* ws;
};

namespace pg8 {
struct EpiIn {
    static constexpr bool PERM = true, AFTER_DRAIN = false;
    bf16_t* O; float* ssq; int dry;
    __device__ __forceinline__ void operator()(const f32x4 (&acc)[2][2][4][2], const Unit& u, int wr, int wc, int, int) const {
        const int t_ = lane_now();
        const int fr = t_ & 15, fq = (t_ >> 4) & 3;
        if ((PROBE_DUP >= 11 && PROBE_DUP <= 14) && dry) { f32x4 s4 = {0.f, 0.f, 0.f, 0.f};
#pragma unroll
            for (int a = 0; a < 2; ++a)
#pragma unroll
                for (int b = 0; b < 2; ++b)
#pragma unroll
                    for (int m = 0; m < 4; ++m) { s4 += acc[a][b][m][0]; s4 += acc[a][b][m][1]; }
            if (s4[0] + s4[1] + s4[2] + s4[3] == 1.2345e30f) O[0] = 0; return; }
        const int row0 = u.pm * BM + wr * 64 + fr;
#pragma unroll
        for (int bj = 0; bj < 2; ++bj) {
            const int g = u.pn * 2 + bj;
            const int col0 = g * 128 + wc * 32 + 8 * fq;
            int op = 0;
            if ((g >= 6 && g <= 9) || (g >= 22 && g <= 25)) op = 1; else if (g >= 28) op = 2; else if (g >= 10 && g <= 13) op = 3; else if (g <= 4) op = 4;
#pragma unroll
            for (int ai = 0; ai < 2; ++ai)
#pragma unroll
                for (int m = 0; m < 4; ++m) {
                    const int row = row0 + ai * HALF + m * 16;
                    f32x4 v0 = acc[ai][bj][m][0], v1 = acc[ai][bj][m][1];
                    if (op == 1) {
#pragma unroll
                        for (int e = 0; e < 4; ++e) { v0[e] = v0[e] * sigmoidf_(v0[e]); v1[e] = v1[e] * sigmoidf_(v1[e]); }
                    } else if (op == 2) {
#pragma unroll
                        for (int e = 0; e < 4; ++e) { v0[e] = sigmoidf_(v0[e]); v1[e] = sigmoidf_(v1[e]); }
                    } else if (op == 3) { v0 = v0 * QSCALE_B; v1 = v1 * QSCALE_B; }
                    else if (op == 4) {
                        float s = (v0[0] * v0[0] + v0[1] * v0[1]) + (v0[2] * v0[2] + v0[3] * v0[3]) + (v1[0] * v1[0] + v1[1] * v1[1]) + (v1[2] * v1[2] + v1[3] * v1[3]);
                        s += __shfl_xor(s, 16); s += __shfl_xor(s, 32);
                        if (fq == 0) ssq[(size_t)row * 20 + g * 4 + wc] = s;
                    }
                    u32x4 w; w.x = cvt_pk_bf16(v0[0], v0[1]); w.y = cvt_pk_bf16(v0[2], v0[3]); w.z = cvt_pk_bf16(v1[0], v1[1]); w.w = cvt_pk_bf16(v1[2], v1[3]);
                    *(u32x4*)(O + (size_t)row * LD1 + col0) = w;
                }
        }
    }
};
struct EpiQ {
    static constexpr bool PERM = true, AFTER_DRAIN = false;
    bf16_t* Q; const float* ssq; const float2* rope;
    __device__ __forceinline__ static f32x4 rope4(f32x4 v, const f32x4 ca, const f32x4 cb, bool first) {
        const float cs[4] = {ca[0], ca[2], cb[0], cb[2]}, sn[4] = {ca[1], ca[3], cb[1], cb[3]};
#pragma unroll
        for (int e = 0; e < 4; ++e) { const float pv = __shfl_xor(v[e], 32); v[e] = first ? (v[e] * cs[e] - pv * sn[e]) : (pv * sn[e] + v[e] * cs[e]); }
        return v;
    }
    __device__ __forceinline__ void operator()(const f32x4 (&acc)[2][2][4][2], const Unit& u, int wr, int wc, int, int) const {
        const int t_ = lane_now();
        const int fr = t_ & 15, fq = (t_ >> 4) & 3;
        const int row0 = u.pm * BM + wr * 64 + fr;
#pragma unroll
        for (int ai = 0; ai < 2; ++ai)
#pragma unroll
            for (int m = 0; m < 4; ++m) {
                const int row = row0 + ai * HALF + m * 16;
                const f32x4* sp = (const f32x4*)(ssq + (size_t)row * 20);
                float tot;
                { const f32x4 s0 = sp[0]; tot = (s0[0] + s0[1]) + (s0[2] + s0[3]); }
                { const f32x4 s1 = sp[1]; tot += (s1[0] + s1[1]) + (s1[2] + s1[3]); }
                { const f32x4 s2 = sp[2]; tot += (s2[0] + s2[1]) + (s2[2] + s2[3]); }
                const float rs = rsqrtf(tot * (1.f / 384.f) + 1e-6f) * QSCALE_A;
                const f32x4* rp = (const f32x4*)(rope + (size_t)(row & (S - 1)) * 16 + 8 * (fq & 1));
#pragma unroll
                for (int bj = 0; bj < 2; ++bj) {
                    const int sl = u.pn * 8 + bj * 4 + wc;
                    f32x4 v0 = acc[ai][bj][m][0] * rs, v1 = acc[ai][bj][m][1] * rs;
                    if (sl % 3 == 2) {
                        v0 = rope4(v0, rp[0], rp[1], fq < 2);
                        v1 = rope4(v1, rp[2], rp[3], fq < 2);
                    }
                    u32x4 w; w.x = cvt_pk_bf16(v0[0], v0[1]); w.y = cvt_pk_bf16(v0[2], v0[3]); w.z = cvt_pk_bf16(v1[0], v1[1]); w.w = cvt_pk_bf16(v1[2], v1[3]);
                    *(u32x4*)(Q + (size_t)row * 768 + sl * 32 + 8 * fq) = w;
                    asm volatile("" ::: "memory");
                }
            }
    }
};
struct EpiKV {
    static constexpr bool PERM = true, AFTER_DRAIN = false;
    bf16_t* KV; const float* ssq;
    __device__ __forceinline__ void operator()(const f32x4 (&acc)[2][2][4][2], const Unit& u, int wr, int wc, int, int) const {
        const int t_ = lane_now();
        const int fr = t_ & 15, fq = (t_ >> 4) & 3;
        const int row0 = u.pm * BM + wr * 64 + fr;
#pragma unroll
        for (int ai = 0; ai < 2; ++ai)
#pragma unroll
            for (int m = 0; m < 4; ++m) {
                const int row = row0 + ai * HALF + m * 16;
                const f32x4* sp = (const f32x4*)(ssq + (size_t)row * 20 + 12);
                const f32x4 s0 = sp[0], s1 = sp[1];
                const float tot = ((s0[0] + s0[1]) + (s0[2] + s0[3])) + ((s1[0] + s1[1]) + (s1[2] + s1[3]));
                const float rs = rsqrtf(tot * (1.f / 256.f) + 1e-6f);
#pragma unroll
                for (int bj = 0; bj < 2; ++bj) {
                    const int col0 = u.pn * BM + bj * HALF + wc * 32 + 8 * fq;
                    const f32x4 v0 = acc[ai][bj][m][0] * rs, v1 = acc[ai][bj][m][1] * rs;
                    u32x4 w; w.x = cvt_pk_bf16(v0[0], v0[1]); w.y = cvt_pk_bf16(v0[2], v0[3]); w.z = cvt_pk_bf16(v1[0], v1[1]); w.w = cvt_pk_bf16(v1[2], v1[3]);
                    *(u32x4*)(KV + (size_t)row * 1024 + col0) = w;
                }
                asm volatile("" ::: "memory");
            }
    }
};
template <bool ADD> struct EpiGate {
    static constexpr bool PERM = true, AFTER_DRAIN = false;
    bf16_t* MG; const bf16_t* O1; int gcol;
    __device__ __forceinline__ void operator()(const f32x4 (&acc)[2][2][4][2], const Unit& u, int wr, int wc, int, int) const {
        const int t_ = lane_now();
        const int fr = t_ & 15, fq = (t_ >> 4) & 3;
        const int row0 = u.pm * BM + wr * 64 + fr;
#pragma unroll
        for (int ai = 0; ai < 2; ++ai)
#pragma unroll
            for (int m = 0; m < 4; ++m) {
                const int row = row0 + ai * HALF + m * 16;
#pragma unroll
                for (int bj = 0; bj < 2; ++bj) {
                    const int col0 = u.pn * BM + bj * HALF + wc * 32 + 8 * fq;
                    const u32x4 gw = *(const u32x4*)(O1 + (size_t)row * LD1 + gcol + col0);
                    f32x4 v0 = acc[ai][bj][m][0], v1 = acc[ai][bj][m][1];
                    v0[0] *= bflo(gw.x); v0[1] *= bfhi(gw.x); v0[2] *= bflo(gw.y); v0[3] *= bfhi(gw.y);
                    v1[0] *= bflo(gw.z); v1[1] *= bfhi(gw.z); v1[2] *= bflo(gw.w); v1[3] *= bfhi(gw.w);
                    u32x4* dst = (u32x4*)(MG + (size_t)row * DM + col0);
                    if (ADD) { const u32x4 pw = *dst;
                        v0[0] += bflo(pw.x); v0[1] += bfhi(pw.x); v0[2] += bflo(pw.y); v0[3] += bfhi(pw.y);
                        v1[0] += bflo(pw.z); v1[1] += bfhi(pw.z); v1[2] += bflo(pw.w); v1[3] += bfhi(pw.w); }
                    u32x4 w; w.x = cvt_pk_bf16(v0[0], v0[1]); w.y = cvt_pk_bf16(v0[2], v0[3]); w.z = cvt_pk_bf16(v1[0], v1[1]); w.w = cvt_pk_bf16(v1[2], v1[3]);
                    *dst = w;
                }
                asm volatile("" ::: "memory");
            }
    }
};
struct EpiGate2 {
    static constexpr bool PERM = true, AFTER_DRAIN = false;
    bf16_t* MG; const bf16_t* O1; int gcolA, gcolB;
    __device__ __forceinline__ void operator()(const f32x4 (&acc)[2][2][4][2], const Unit& u, int wr, int wc, int fr, int fq) const {
        if (u.var == 0) { const EpiGate<false> E{MG, O1, gcolA}; E(acc, u, wr, wc, fr, fq); }
        else            { const EpiGate<true>  E{MG, O1, gcolB}; E(acc, u, wr, wc, fr, fq); }
    }
};
struct EpiOut {
    static constexpr bool PERM = true, AFTER_DRAIN = false;
    const float* x; float* out; float* ssqo;
    __device__ __forceinline__ void operator()(const f32x4 (&acc)[2][2][4][2], const Unit& u, int wr, int wc, int, int) const {
        const int t_ = lane_now();
        const int fr = t_ & 15, fq = (t_ >> 4) & 3;
        const int row0 = u.pm * BM + wr * 64 + fr;
#pragma unroll
        for (int ai = 0; ai < 2; ++ai)
#pragma unroll
            for (int m = 0; m < 4; ++m) {
                const int row = row0 + ai * HALF + m * 16;
#pragma unroll
                for (int bj = 0; bj < 2; ++bj) {
                    const int col0 = u.pn * BM + bj * HALF + wc * 32 + 8 * fq;
                    const f32x4* xp = (const f32x4*)(x + (size_t)row * DM + col0);
                    const f32x4 v0 = acc[ai][bj][m][0] + xp[0], v1 = acc[ai][bj][m][1] + xp[1];
                    f32x4* op = (f32x4*)(out + (size_t)row * DM + col0);
                    op[0] = v0; op[1] = v1;
                    float s = (v0[0] * v0[0] + v0[1] * v0[1]) + (v0[2] * v0[2] + v0[3] * v0[3]) + (v1[0] * v1[0] + v1[1] * v1[1]) + (v1[2] * v1[2] + v1[3] * v1[3]);
                    s += __shfl_xor(s, 16); s += __shfl_xor(s, 32);
                    if (fq == 0) ssqo[(size_t)row * 32 + u.pn * 8 + bj * 4 + wc] = s;
                }
                asm volatile("" ::: "memory");
            }
    }
};
struct EpiOutNorm {
    static constexpr bool PERM = true, AFTER_DRAIN = (FUSE_AFTER_DRAIN != 0);
    const float* x; float* out; float* ssqo; const float* fg; unsigned* cnt; unsigned* tmo; PG8_LAS unsigned char* ldsp;
    __device__ __forceinline__ void operator()(const f32x4 (&acc)[2][2][4][2], const Unit& u, int wr, int wc, int fr, int fq) const { if (!AFTER_DRAIN) fused(acc, u, wr, wc, fr, fq, ldsp, wr * 4 + wc, 0); }
    __device__ __forceinline__ void fused(const f32x4 (&acc)[2][2][4][2], const Unit& u, int wr, int wc, int, int, PG8_LAS unsigned char* lds, int wid, int) const {
        const int ln = lane_now(), fr = ln & 15, fq = (ln >> 4) & 3, tid = wid * 64 + ln;
        PG8_LAS float* part = (PG8_LAS float*)(lds + 135168);
        PG8_LAS float* rinv = part + 1024;
        const int rl0 = wr * 64 + fr;
        f32x4 v[2][2][4][2];
#pragma unroll
        for (int ai = 0; ai < 2; ++ai)
#pragma unroll
            for (int m = 0; m < 4; ++m) {
                const int rl = rl0 + ai * HALF + m * 16; const size_t row = (size_t)u.pm * BM + rl;
                float s = 0.f;
#pragma unroll
                for (int bj = 0; bj < 2; ++bj) {
                    const int col0 = u.pn * BM + bj * HALF + wc * 32 + 8 * fq;
                    const f32x4* xp = (const f32x4*)(x + row * DM + col0);
                    const f32x4 v0 = acc[ai][bj][m][0] + xp[0], v1 = acc[ai][bj][m][1] + xp[1];
                    v[ai][bj][m][0] = v0; v[ai][bj][m][1] = v1;
                    s += (v0[0] * v0[0] + v0[1] * v0[1]) + (v0[2] * v0[2] + v0[3] * v0[3]) + (v1[0] * v1[0] + v1[1] * v1[1]) + (v1[2] * v1[2] + v1[3] * v1[3]);
                }
                s += __shfl_xor(s, 16); s += __shfl_xor(s, 32);
                if (fq == 0) part[rl * 4 + wc] = s;
            }
        __syncthreads();
        if (DEBUG_FUSE) {
            if (tid < 256) { const f32x4 p4 = *(const PG8_LAS f32x4*)(part + tid * 4); float* q = ssqo + ((size_t)u.pm * BM + tid) * 32 + u.pn * 8;
                q[0] = (p4[0] + p4[1]) + (p4[2] + p4[3]); for (int i = 1; i < 8; ++i) q[i] = 0.f; }
#pragma unroll
            for (int bj = 0; bj < 2; ++bj)
#pragma unroll
                for (int ai = 0; ai < 2; ++ai)
#pragma unroll
                    for (int m = 0; m < 4; ++m) { const int rl = rl0 + ai * HALF + m * 16; const int col0 = u.pn * BM + bj * HALF + wc * 32 + 8 * fq;
                        f32x4* op = (f32x4*)(out + ((size_t)u.pm * BM + rl) * DM + col0); op[0] = v[ai][bj][m][0]; op[1] = v[ai][bj][m][1]; }
            return;
        }
        if (tid < 256) { const f32x4 p4 = *(const PG8_LAS f32x4*)(part + tid * 4); ssqo[((size_t)u.pm * BM + tid) * 4 + u.pn] = (p4[0] + p4[1]) + (p4[2] + p4[3]); }
        asm volatile("s_waitcnt vmcnt(0)" ::: "memory");
        __syncthreads();
        if (tid == 0) {
            __builtin_amdgcn_fence(__ATOMIC_RELEASE, "agent");
            (void)__hip_atomic_fetch_add(cnt + 16 * u.pm, 1u, __ATOMIC_RELAXED, __HIP_MEMORY_SCOPE_AGENT);
            unsigned sp = 0u;
            while (__hip_atomic_load(cnt + 16 * u.pm, __ATOMIC_RELAXED, __HIP_MEMORY_SCOPE_AGENT) < 4u) {
                __builtin_amdgcn_s_sleep(1);
                if ((++sp & 255u) == 0u) { if (__hip_atomic_load(tmo, __ATOMIC_RELAXED, __HIP_MEMORY_SCOPE_AGENT)) break; if (sp > (1u << 18)) { atomicAdd(tmo, 1u); break; } }
            }
            __builtin_amdgcn_fence(__ATOMIC_ACQUIRE, "agent");
            asm volatile("s_waitcnt vmcnt(0)" ::: "memory");
        }
        __syncthreads();
        if (tid < 256) {
            float* sp4 = ssqo + ((size_t)u.pm * BM + tid) * 4;
            const float t = (__hip_atomic_load(sp4, __ATOMIC_RELAXED, __HIP_MEMORY_SCOPE_AGENT) + __hip_atomic_load(sp4 + 1, __ATOMIC_RELAXED, __HIP_MEMORY_SCOPE_AGENT))
                          + (__hip_atomic_load(sp4 + 2, __ATOMIC_RELAXED, __HIP_MEMORY_SCOPE_AGENT) + __hip_atomic_load(sp4 + 3, __ATOMIC_RELAXED, __HIP_MEMORY_SCOPE_AGENT));
            rinv[tid] = rsqrtf(t * (1.f / DM) + 1e-6f);
        }
        __syncthreads();
#pragma unroll
        for (int bj = 0; bj < 2; ++bj) {
            const int col0 = u.pn * BM + bj * HALF + wc * 32 + 8 * fq;
            const f32x4 g0 = *(const f32x4*)(fg + col0), g1 = *(const f32x4*)(fg + col0 + 4);
#pragma unroll
            for (int ai = 0; ai < 2; ++ai)
#pragma unroll
                for (int m = 0; m < 4; ++m) {
                    const int rl = rl0 + ai * HALF + m * 16; const float r = rinv[rl];
                    f32x4* op = (f32x4*)(out + ((size_t)u.pm * BM + rl) * DM + col0);
                    op[0] = v[ai][bj][m][0] * r * g0; op[1] = v[ai][bj][m][1] * r * g1;
                }
        }
    }
};
}


namespace att {
typedef short bf16x8 __attribute__((ext_vector_type(8)));
typedef short s16x4 __attribute__((ext_vector_type(4)));
typedef float f32x16 __attribute__((ext_vector_type(16)));
typedef unsigned u32x4 __attribute__((ext_vector_type(4)));
typedef const LAS char* lds_cptr;
constexpr int SLOT_K = 12288, SLOT_V = 8192;
constexpr int L_K = 0, L_V = 2 * SLOT_K, L_WS = L_V + 2 * SLOT_V, L_OST = L_WS + 2048, L_BIAS = L_OST + 8 * 4096, L_END = L_BIAS + 2048;
constexpr float THR = 8.f;
#define MFMA32(a, b, c) __builtin_amdgcn_mfma_f32_32x32x16_bf16(a, b, c, 0, 0, 0)
__device__ __forceinline__ int crow(int r, int hi) { return (r & 3) + 8 * (r >> 2) + 4 * hi; }
typedef __bf16 bf16x2_t __attribute__((ext_vector_type(2)));
typedef float f32x2_t __attribute__((ext_vector_type(2)));
__device__ __forceinline__ unsigned cvtpk(float lo, float hi) { const f32x2_t v = {lo, hi}; return __builtin_bit_cast(unsigned, __builtin_convertvector(v, bf16x2_t)); }
__device__ __forceinline__ s16x4 vtr(lds_cptr p) { typedef short v4i16_t __attribute__((ext_vector_type(4))); return __builtin_bit_cast(s16x4, __builtin_amdgcn_ds_read_tr16_b64_v4i16((LAS v4i16_t*)p)); }
#define MX3(a, b, c) __builtin_fmaxf(__builtin_fmaxf((a), (b)), (c))
__device__ __forceinline__ float rowmax(const f32x16& p0, const f32x16& p1) {
    float a = MX3(p0[0], p0[1], p1[0]), b = MX3(p0[2], p0[3], p1[1]); a = MX3(a, p1[2], p1[3]);
#pragma unroll
    for (int r = 4; r < 16; r += 4) { a = MX3(a, p0[r], p0[r + 1]); b = MX3(b, p0[r + 2], p0[r + 3]); a = MX3(a, p1[r], p1[r + 1]); b = MX3(b, p1[r + 2], p1[r + 3]); }
    const float m = __builtin_fmaxf(a, b); auto rr = __builtin_amdgcn_permlane32_swap(__float_as_uint(m), __float_as_uint(m), false, false);
    return __builtin_fmaxf(__uint_as_float(rr[0]), __uint_as_float(rr[1])); }
__device__ __forceinline__ float maskp(float p, unsigned lo, unsigned hi) {
    const unsigned long long mk = ((unsigned long long)hi << 32) | lo; float o;
    asm("v_cndmask_b32_e64 %0, 0, %1, %2" : "=v"(o) : "v"(p), "s"(mk)); return o; }
__host__ __device__ __forceinline__ size_t mask_tile_off(int qt32) { const int J = qt32 >> 1; return (size_t)2 * J * (J + 1) + ((qt32 & 1) ? 2 * (J + 1) : 0); }
constexpr size_t MASK_TILES_PER_BATCH = (size_t)2 * 128 * 129;

struct Tensors {
    const bf16_t* Q; int ldq;
    const bf16_t* K0; int ldk;
    const bf16_t* K1;
    const bf16_t* V; int ldv;
    bf16_t* O; int ldo;
    const unsigned long long* mask;
    const float* rel_bias;
    int hq, hk, hv;
    int wv;
};

template <bool DSA>
__device__ __forceinline__ void unit(int b, int h, int qb, const Tensors& X, LAS unsigned char* lds, bool dry) {
    constexpr int NDQ = DSA ? 4 : 6;
    const int tid_ = tid_now(X.wv);
    const int tid = tid_, lane = tid & 63, r32 = lane & 31, hi = lane >> 5; const int wid = X.wv;
    const size_t rowbase = (size_t)b * S; const int q0 = qb * 256, NT = 4 * qb + 4, NTw = 4 * qb + (wid >> 1) + 1;
    LAS float* wsf = (LAS float*)(lds + L_WS) + wid * 64;
    const bf16_t* ksrc = X.K0 + (rowbase + lane) * X.ldk + h * X.hk + wid * 8;
    const bf16_t* ksrc1 = DSA ? nullptr : X.K1 + (rowbase + lane) * 32 + (wid & 3) * 8;
    const bf16_t* vsrc = X.V + (rowbase + 16 * (wid & 3) + (lane >> 2)) * X.ldv + h * X.hv + (wid >> 2) * 32 + (lane & 3) * 8;
    const size_t kstride = (size_t)64 * X.ldk, vstride = (size_t)64 * X.ldv;
    LAS unsigned char* kdst = lds + L_K + wid * 1024; LAS unsigned char* kdst1 = lds + L_K + (8 + (wid & 3)) * 1024; LAS unsigned char* vdst = lds + L_V + wid * 1024;
    u32x4 sk0, sk1 = {}, sv;
#define ATT_LOAD(t) do { sk0 = *(const u32x4*)(ksrc + (size_t)(t) * kstride); if (!DSA && wid < 4) sk1 = *(const u32x4*)(ksrc1 + (size_t)(t) * 64 * 32); \
                         sv = *(const u32x4*)(vsrc + (size_t)(t) * vstride); } while (0)
#define ATT_WRITE(slot) do { *(LAS u32x4*)(kdst + (slot) * SLOT_K + lane * 16) = sk0; if (!DSA && wid < 4) *(LAS u32x4*)(kdst1 + (slot) * SLOT_K + lane * 16) = sk1; \
                             *(LAS u32x4*)(vdst + (slot) * SLOT_V + lane * 16) = sv; } while (0)
    const lds_cptr vp0 = (lds_cptr)lds + L_V + ((lane >> 4) & 1) * 32 + (lane & 3) * 8 + (4 * hi + ((lane & 15) >> 2)) * 64;
    const lds_cptr kp0 = (lds_cptr)lds + L_K + hi * 1024 + r32 * 16;
    ATT_LOAD(0);
    bf16x8 qr[NDQ];
    { const bf16_t* Qw = X.Q + (rowbase + q0 + wid * 32 + r32) * X.ldq + h * X.hq + hi * 8;
#pragma unroll
      for (int d0 = 0; d0 < NDQ; ++d0) qr[d0] = *(const bf16x8*)(Qw + d0 * 16); }
    if (DSA) {
        LAS float* tab = (LAS float*)(lds + L_BIAS);
        const float c15 = X.rel_bias[15 * 8 + h];
        for (int e = tid; e < 320; e += 512) {
            const int rel = e - 255, n = rel < 0 ? -rel : rel; int v;
            if (n < 8) v = n; else if (n < 12) v = 8; else if (n < 16) v = 9; else if (n < 23) v = 10; else if (n < 32) v = 11; else if (n < 46) v = 12; else if (n < 64) v = 13; else if (n < 91) v = 14; else v = 15;
            tab[e] = (X.rel_bias[((rel > 0 ? 16 : 0) + v) * 8 + h] - c15) * LOG2E;
        }
    }
    ATT_WRITE(0);
    float mhat = 0.f, l_reg = 0.f; f32x16 o0 = {}, o1 = {};
    f32x16 negm = {};
    if (wid >= 4) __builtin_amdgcn_s_setprio(1);
    const int qpos = q0 + wid * 32 + r32;
    for (int t = 0; t < NT; ++t) {
        asm volatile("s_waitcnt vmcnt(0) lgkmcnt(0)\n\ts_barrier" ::: "memory");
        if (t + 1 < NT) ATT_LOAD(t + 1);
        unsigned mw = 0u;
        if (DSA && t < NTw) { const int qt32 = qb * 8 + wid;
            const unsigned* mt = (const unsigned*)((const unsigned short*)X.mask + ((size_t)b * MASK_TILES_PER_BATCH + mask_tile_off(qt32)) * 64) + (size_t)t * 64;
            mw = mt[lane]; }
        if (t < NTw) {
            const int so_k = (t & 1) * SLOT_K, so_v = (t & 1) * SLOT_V;
            f32x16 c0, c1;
            bf16x8 kf[2 * NDQ];
#pragma unroll
            for (int d0 = 0; d0 < NDQ; ++d0) { kf[2 * d0] = *(const LAS bf16x8*)(kp0 + so_k + d0 * 2048); kf[2 * d0 + 1] = *(const LAS bf16x8*)(kp0 + so_k + d0 * 2048 + 512); }
#pragma unroll
            for (int d0 = 0; d0 < NDQ; ++d0) { c0 = MFMA32(kf[2 * d0], qr[d0], d0 == 0 ? negm : c0); c1 = MFMA32(kf[2 * d0 + 1], qr[d0], d0 == 0 ? negm : c1); }
            const lds_cptr vp = vp0 + so_v;
            bf16x8 vf[8];
#pragma unroll
            for (int i = 0; i < 8; ++i) { const s16x4 lo_ = vtr(vp + ((i >> 2) * 4096 + (i & 3) * 1024)), hi_ = vtr(vp + ((i >> 2) * 4096 + (i & 3) * 1024 + 512));
                vf[i] = (bf16x8){lo_[0], lo_[1], lo_[2], lo_[3], hi_[0], hi_[1], hi_[2], hi_[3]}; }
            if (DSA) {
                if (64 * t + 63 - (q0 + wid * 32) > -128) {
                    const LAS float* tab = (const LAS float*)(lds + L_BIAS);
                    const int base = 64 * t + 4 * hi - qpos + 255;
#pragma unroll
                    for (int r = 0; r < 16; ++r) { const int kr = (r & 3) + 8 * (r >> 2); int i0 = base + kr, i1 = base + kr + 32; i0 = i0 < 0 ? 0 : i0; i1 = i1 < 0 ? 0 : i1;
                        c0[r] += tab[i0]; c1[r] += tab[i1]; }
                }
            }
            const float rm = rowmax(c0, c1);
            if (t == 0 || __any(rm > THR)) {
                const float dl = (t == 0) ? rm : __builtin_fmaxf(rm, 0.f); mhat += dl;
                if (t > 0) {
                    const float f = __builtin_amdgcn_exp2f(-dl); l_reg *= f;
                    if (hi == 0) wsf[r32] = f;
                    asm volatile("s_waitcnt lgkmcnt(0)" ::: "memory");
#pragma unroll
                    for (int r = 0; r < 16; ++r) { const float fr = wsf[crow(r, hi)]; o0[r] *= fr; o1[r] *= fr; }
                }
#pragma unroll
                for (int r = 0; r < 16; ++r) { c0[r] -= dl; c1[r] -= dl; negm[r] -= dl; }
            }
#pragma unroll
            for (int r = 0; r < 16; ++r) { c0[r] = __builtin_amdgcn_exp2f(c0[r]); c1[r] = __builtin_amdgcn_exp2f(c1[r]); }
            if (DSA) {
#pragma unroll
                for (int r = 0; r < 16; ++r) {
                    int m0 = __builtin_amdgcn_sbfe((int)mw, r, 1), m1 = __builtin_amdgcn_sbfe((int)mw, 16 + r, 1); asm("" : "+v"(m0), "+v"(m1));
                    c0[r] = __uint_as_float(__float_as_uint(c0[r]) & (unsigned)m0); c1[r] = __uint_as_float(__float_as_uint(c1[r]) & (unsigned)m1); }
            }
            float sacc = 0.f;
#pragma unroll
            for (int r = 0; r < 16; ++r) sacc += c0[r] + c1[r];
            l_reg += sacc;
            u32x4 pw0 = {cvtpk(c0[0], c0[1]), cvtpk(c0[2], c0[3]), cvtpk(c0[4], c0[5]), cvtpk(c0[6], c0[7])};
            u32x4 pw1 = {cvtpk(c0[8], c0[9]), cvtpk(c0[10], c0[11]), cvtpk(c0[12], c0[13]), cvtpk(c0[14], c0[15])};
            u32x4 pw2 = {cvtpk(c1[0], c1[1]), cvtpk(c1[2], c1[3]), cvtpk(c1[4], c1[5]), cvtpk(c1[6], c1[7])};
            u32x4 pw3 = {cvtpk(c1[8], c1[9]), cvtpk(c1[10], c1[11]), cvtpk(c1[12], c1[13]), cvtpk(c1[14], c1[15])};
            o0 = MFMA32(__builtin_bit_cast(bf16x8, pw0), vf[0], o0); o1 = MFMA32(__builtin_bit_cast(bf16x8, pw0), vf[4], o1);
            o0 = MFMA32(__builtin_bit_cast(bf16x8, pw1), vf[1], o0); o1 = MFMA32(__builtin_bit_cast(bf16x8, pw1), vf[5], o1);
            o0 = MFMA32(__builtin_bit_cast(bf16x8, pw2), vf[2], o0); o1 = MFMA32(__builtin_bit_cast(bf16x8, pw2), vf[6], o1);
            o0 = MFMA32(__builtin_bit_cast(bf16x8, pw3), vf[3], o0); o1 = MFMA32(__builtin_bit_cast(bf16x8, pw3), vf[7], o1);
        }
        if (t + 1 < NT) ATT_WRITE((t + 1) & 1);
    }
    __builtin_amdgcn_s_setprio(0);
    bf16_t* Ow = X.O + (rowbase + q0 + wid * 32) * X.ldo + h * 64;
    u32x4 gv4[4];
#pragma unroll
    for (int i = 0; i < 4; ++i) gv4[i] = *(const u32x4*)(Ow + (size_t)(i * 8 + (lane >> 3)) * X.ldo + (lane & 7) * 8);
    { auto rr = __builtin_amdgcn_permlane32_swap(__float_as_uint(l_reg), __float_as_uint(l_reg), false, false); l_reg = __uint_as_float(rr[0]) + __uint_as_float(rr[1]); }
    if (hi == 0) wsf[32 + r32] = l_reg;
    asm volatile("s_waitcnt lgkmcnt(0)" ::: "memory");
    LAS bf16_t* stg = (LAS bf16_t*)(lds + L_OST) + wid * 2048;
#pragma unroll
    for (int r = 0; r < 16; ++r) { const int orow = crow(r, hi); const float rli = __builtin_amdgcn_rcpf(wsf[32 + orow]);
        stg[orow * 64 + r32] = f2bf(o0[r] * rli); stg[orow * 64 + 32 + r32] = f2bf(o1[r] * rli); }
    asm volatile("s_waitcnt lgkmcnt(0)" ::: "memory");
#pragma unroll
    for (int i = 0; i < 4; ++i) { const int row = i * 8 + (lane >> 3), ch = lane & 7;
        const u32x4 ov = *(const LAS u32x4*)(stg + row * 64 + ch * 8); u32x4* gp = (u32x4*)(Ow + (size_t)row * X.ldo + ch * 8); const u32x4 gv = gv4[i];
        u32x4 res; res.x = pk2(bflo(ov.x) * bflo(gv.x), bfhi(ov.x) * bfhi(gv.x)); res.y = pk2(bflo(ov.y) * bflo(gv.y), bfhi(ov.y) * bfhi(gv.y));
        res.z = pk2(bflo(ov.z) * bflo(gv.z), bfhi(ov.z) * bfhi(gv.z)); res.w = pk2(bflo(ov.w) * bflo(gv.w), bfhi(ov.w) * bfhi(gv.w)); if (!dry) *gp = res; }
    asm volatile("s_waitcnt vmcnt(0) lgkmcnt(0)\n\ts_barrier" ::: "memory");
#undef ATT_LOAD
#undef ATT_WRITE
}

template <bool DSA>
__device__ __forceinline__ void phase(const Tensors& X, LAS unsigned char* lds, int G, int bid, bool dry = false) {
    for (int p = bid; p < 512; p += G) {
        const int x = p & 7, kk = p >> 3, bh = x + 8 * (kk >> 4), j = kk & 15;
#pragma unroll 1
        for (int u2 = 0; u2 < 2; ++u2) unit<DSA>(bh >> 3, bh & 7, u2 ? 31 - j : j, X, lds, dry);
    }
}
}


#ifndef IDX_PRIO
#define IDX_PRIO 0
#endif
#ifndef PASS0_SPLIT
#define PASS0_SPLIT 0
#endif
#ifndef IDX_FORCE_SLOW
#define IDX_FORCE_SLOW 0
#endif
namespace idx {
typedef short bf16x8 __attribute__((ext_vector_type(8)));
typedef float f32x16 __attribute__((ext_vector_type(16)));
constexpr int HROW = 1025;
constexpr int LCAP = 32;
constexpr int LISTN = 64, LSTR = 65;
constexpr int L_HIST = 0, LISTS_END = (511 * LSTR + 513) * 4, L_PFX = LISTS_END, L_NEED = L_PFX + 128, L_LCNT = L_NEED + 128, L_LIST = L_LCNT + 128, L_CNT = L_LIST + 32 * LCAP * 4, L_TAU = L_CNT + 512 * 4,
              L_FLAG = L_TAU + 128, L_LB = L_FLAG + 16, L_WH = L_LB + 128, L_END = L_WH + 8 * 1024;
static_assert(LISTS_END % 16 == 0 && LISTS_END >= 32 * HROW * 4, "indexer LDS layout");
__device__ __forceinline__ unsigned f2key(float f) { const unsigned u = __float_as_uint(f); return u ^ ((unsigned)((int)u >> 31) | 0x80000000u); }

struct QOps { bf16x8 qf[8][2]; bf16x8 qb[2][2]; float wv[8]; };
__device__ __forceinline__ void score_tile(float (&acc)[16], const bf16x8 k0, const bf16x8 k1, const QOps& Q) {
#define IDX_M0(h) __builtin_amdgcn_mfma_f32_32x32x16_bf16(k0, Q.qf[h][0], (f32x16){}, 0, 0, 0)
#define IDX_M1(h, c) __builtin_amdgcn_mfma_f32_32x32x16_bf16(k1, Q.qf[h][1], c, 0, 0, 0)
#define IDX_ACC8(h, c, r0) do { _Pragma("unroll") for (int r = (r0); r < (r0) + 8; ++r) { acc[r] = __builtin_fmaf(Q.wv[h], __builtin_fabsf(c[r]), acc[r]); asm volatile("" : "+v"(acc[r])); } } while (0)
    f32x16 cA = IDX_M0(0); cA = IDX_M1(0, cA);
    f32x16 lin = __builtin_amdgcn_mfma_f32_32x32x16_bf16(k0, Q.qb[0][0], (f32x16){}, 0, 0, 0);
    lin = __builtin_amdgcn_mfma_f32_32x32x16_bf16(k1, Q.qb[0][1], lin, 0, 0, 0);
    lin = __builtin_amdgcn_mfma_f32_32x32x16_bf16(k0, Q.qb[1][0], lin, 0, 0, 0);
    lin = __builtin_amdgcn_mfma_f32_32x32x16_bf16(k1, Q.qb[1][1], lin, 0, 0, 0);
#pragma unroll
    for (int r = 0; r < 16; ++r) acc[r] = lin[r];
    __builtin_amdgcn_sched_barrier(0);
#pragma unroll
    for (int h = 0; h < 8; ++h) {
        f32x16 nC;
        if (h < 7) nC = IDX_M0(h + 1);
        IDX_ACC8(h, cA, 0);
        __builtin_amdgcn_sched_barrier(0);
        if (h < 7) nC = IDX_M1(h + 1, nC);
        IDX_ACC8(h, cA, 8);
        __builtin_amdgcn_sched_barrier(0);
        if (h < 7) cA = nC;
    }
#undef IDX_M0
#undef IDX_M1
#undef IDX_ACC8
}
#define GAS __attribute__((address_space(1)))
#define IDX_KLOAD(k0, k1, kt) do { const GAS bf16_t* kp_ = kbase + (size_t)(kt) * 1024 + r32 * 32 + hi * 8; k0 = *(const GAS bf16x8*)kp_; k1 = *(const GAS bf16x8*)(kp_ + 16); } while (0)

struct PassCtx { const GAS bf16_t* kbase; LAS unsigned* hrow; LAS unsigned* lcnt_q; LAS unsigned* blist_q; LAS unsigned* lown; GAS unsigned short* mbase; unsigned pfx, msk; int lane, r32, hi, ktb, kte; bool hi2; };
template <int PASS>
__device__ __forceinline__ void pass_tile(const PassCtx& C, const bf16x8 k0, const bf16x8 k1, const QOps& Q, int kt, unsigned& ncand) {
    if constexpr (PASS == 3) {
        __builtin_amdgcn_sched_barrier(0);
        float acc[16]; score_tile(acc, k0, k1, Q);
        const unsigned tlo = C.pfx << 22, thim1 = tlo | 0x3fffffu, pos = (unsigned)(kt - C.ktb) << 26;
        unsigned bits = 0u, vmask = 0x3fffffu; asm volatile("" : "+v"(vmask));
#pragma unroll
        for (int r = 15; r >= 0; --r) {
            const unsigned k = __float_as_uint(acc[r]) ^ C.msk;
            const bool sel = k > thim1, ge = k >= tlo;
            bits = bits + bits + (sel ? 1u : 0u);
            unsigned pr = ((unsigned)r << 22) | pos; asm volatile("" : "+s"(pr));
            *(LAS unsigned*)ncand = (k & vmask) | pr;
            ncand += (ge != sel) ? 4u : 0u;
        }
        C.mbase[(size_t)(kt >> 1) * 128 + C.lane * 2 + (kt & 1)] = (unsigned short)bits;
        return;
    }
    constexpr int SH_BIN = (PASS == 0 || PASS == 4) ? 22 : ((PASS == 1) ? 11 : 0), SH_PFX = (PASS == 1) ? 22 : 11;
    __builtin_amdgcn_sched_barrier(0);
    float acc[16]; score_tile(acc, k0, k1, Q);
    unsigned bits = 0u, anym = 0u; unsigned keys[16];
#pragma unroll
    for (int r = 0; r < 16; ++r) {
        const unsigned key = f2key(acc[r]), up = key >> SH_PFX, bin = (PASS == 0 || PASS == 4) ? (key >> 22) : ((key >> SH_BIN) & 2047u); if (PASS == 2) keys[r] = key;
        const bool match = (PASS == 0) || (PASS == 4 ? (bin >= C.pfx) : (up == C.pfx));
        if (PASS == 0) __hip_atomic_fetch_add(C.hrow + bin, 1u, __ATOMIC_RELAXED, __HIP_MEMORY_SCOPE_WORKGROUP);
        else if (PASS == 4) { if (match) __hip_atomic_fetch_add(C.hrow + bin, 1u, __ATOMIC_RELAXED, __HIP_MEMORY_SCOPE_WORKGROUP); }
        else if (match) __hip_atomic_fetch_add(C.hrow + (bin >> 1), 1u << ((bin & 1u) * 16u), __ATOMIC_RELAXED, __HIP_MEMORY_SCOPE_WORKGROUP);
        if (PASS == 2) { bits |= (up > C.pfx) ? (1u << r) : 0u; anym |= match ? 1u : 0u; }
    }
    if (PASS == 2) {
        C.mbase[(size_t)(kt >> 1) * 128 + C.lane * 2 + (kt & 1)] = (unsigned short)bits;
        if (__any(anym)) {
#pragma unroll
            for (int r = 0; r < 16; ++r) if ((keys[r] >> 11) == C.pfx) {
                const unsigned sl = __hip_atomic_fetch_add(C.lcnt_q, 1u, __ATOMIC_RELAXED, __HIP_MEMORY_SCOPE_WORKGROUP);
                if (sl < (unsigned)LCAP) C.blist_q[sl] = (keys[r] & 2047u) | ((unsigned)r << 11) | ((unsigned)C.lane << 15) | ((unsigned)kt << 21);
            }
        }
    }
}
#define IDX_KLOADC(k0, k1, kt) do { const GAS bf16_t* kp_ = C.kbase + (size_t)(kt) * 1024 + C.r32 * 32 + C.hi * 8; k0 = *(const GAS bf16x8*)kp_; k1 = *(const GAS bf16x8*)(kp_ + 16); } while (0)
template <int PASS>
__device__ __forceinline__ void pass_loop(const PassCtx& C, const QOps& Q, unsigned& ncand) {
    bf16x8 a0, a1, b0, b1, c0, c1; const int ktb = C.ktb, kte = C.kte;
    if (IDX_PRIO) { if (C.hi2) __builtin_amdgcn_s_setprio(1); }
    if (ktb < kte) IDX_KLOADC(a0, a1, ktb); if (ktb + 1 < kte) IDX_KLOADC(b0, b1, ktb + 1); if (ktb + 2 < kte) IDX_KLOADC(c0, c1, ktb + 2);
    for (int kt = ktb; kt < kte; kt += 3) {
        pass_tile<PASS>(C, a0, a1, Q, kt, ncand); if (kt + 3 < kte) IDX_KLOADC(a0, a1, kt + 3);
        if (kt + 1 < kte) { pass_tile<PASS>(C, b0, b1, Q, kt + 1, ncand); if (kt + 4 < kte) IDX_KLOADC(b0, b1, kt + 4); }
        if (kt + 2 < kte) { pass_tile<PASS>(C, c0, c1, Q, kt + 2, ncand); if (kt + 5 < kte) IDX_KLOADC(c0, c1, kt + 5); }
    }
    if (IDX_PRIO) __builtin_amdgcn_s_setprio(0);
}
#undef IDX_KLOADC

__device__ __forceinline__ int wave_prefix_sum(int v) {
    v += __builtin_amdgcn_update_dpp(0, v, 0x111, 0xf, 0xf, false);
    v += __builtin_amdgcn_update_dpp(0, v, 0x112, 0xf, 0xf, false);
    v += __builtin_amdgcn_update_dpp(0, v, 0x114, 0xf, 0xf, false);
    v += __builtin_amdgcn_update_dpp(0, v, 0x118, 0xf, 0xf, false);
    v += __builtin_amdgcn_update_dpp(0, v, 0x142, 0xa, 0xf, false);
    v += __builtin_amdgcn_update_dpp(0, v, 0x143, 0xc, 0xf, false);
    return v;
}
__device__ __forceinline__ void scan_hist(const LAS unsigned* hist, LAS unsigned* spfx, LAS int* sneed, LAS unsigned* slb, int wid, int pass, bool partial) {
    const int nbits = (pass == 0) ? 10 : 11;
    const int lane = lane_now();
    unsigned wv_[4][16]; int c[4], need[4];
#pragma unroll
    for (int qi = 0; qi < 4; ++qi) {
        const LAS unsigned* hr = hist + (wid * 4 + qi) * HROW + 16 * lane;
#pragma unroll
        for (int i = 0; i < 16; ++i) wv_[qi][i] = hr[i];
        need[qi] = sneed[wid * 4 + qi];
    }
#pragma unroll
    for (int qi = 0; qi < 4; ++qi) {
        int t = 0;
#pragma unroll
        for (int i = 0; i < 16; ++i) t += (pass == 0) ? (int)wv_[qi][i] : (int)(wv_[qi][i] & 0xffffu) + (int)(wv_[qi][i] >> 16);
        c[qi] = t;
    }
#pragma unroll
    for (int qi = 0; qi < 4; ++qi) {
        const int q = wid * 4 + qi, nd = need[qi];
        const int pre = wave_prefix_sum(c[qi]), total = __builtin_amdgcn_readlane(pre, 63);
        const int sfx = total - pre + c[qi], above = sfx - c[qi];
        int run = above, bstar = 0, nn = nd;
        if (pass == 0) {
#pragma unroll
            for (int i = 15; i >= 0; --i) { const int ci = (int)wv_[qi][i]; const bool hit = (run < nd) && (run + ci >= nd); bstar = hit ? 16 * lane + i : bstar; nn = hit ? nd - run : nn; run += ci; }
        } else {
#pragma unroll
            for (int i = 15; i >= 0; --i) {
                const int chi = (int)(wv_[qi][i] >> 16), clo = (int)(wv_[qi][i] & 0xffffu);
                { const bool hit = (run < nd) && (run + chi >= nd); bstar = hit ? 32 * lane + 2 * i + 1 : bstar; nn = hit ? nd - run : nn; run += chi; }
                { const bool hit = (run < nd) && (run + clo >= nd); bstar = hit ? 32 * lane + 2 * i : bstar; nn = hit ? nd - run : nn; run += clo; }
            }
        }
        if (partial && lane == 0) slb[q] = 0u;
        if (sfx >= nd && above < nd) {
            if (partial) slb[q] = (unsigned)bstar; else { spfx[q] = (spfx[q] << nbits) | (unsigned)bstar; sneed[q] = nn; }
        }
    }
}

template <int NJ>
__device__ __forceinline__ unsigned resolve_query(const LAS unsigned* lbase, int cn, int ln, LAS unsigned* wh, int need) {
    int ev[NJ]; const int sub = ln >> 4;
#pragma unroll
    for (int t = 0; t < NJ; ++t) { const int sl = 4 * t + sub; const unsigned w = lbase[sl]; ev[t] = (sl < cn) ? (int)(w & 0x3fffffu) : -1; }
    unsigned tl = 0u;
#pragma unroll
    for (int step = 0; step < 3; ++step) {
        const int sh = (step == 0) ? 14 : ((step == 1) ? 6 : 0), nb = (step == 2) ? 6 : 8, dm = (1 << nb) - 1;
        ((LAS u32x4*)wh)[ln] = (u32x4){0u, 0u, 0u, 0u};
#pragma unroll
        for (int t = 0; t < NJ; ++t) if (ev[t] >= 0) __hip_atomic_fetch_add(wh + ((ev[t] >> sh) & dm), 1u, __ATOMIC_RELAXED, __HIP_MEMORY_SCOPE_WORKGROUP);
        asm volatile("s_waitcnt lgkmcnt(0)" ::: "memory");
        const u32x4 c4 = ((const LAS u32x4*)wh)[ln];
        const int c = (int)(c4.x + c4.y + c4.z + c4.w);
        const int pre = wave_prefix_sum(c), sfx = __builtin_amdgcn_readlane(pre, 63) - pre + c;
        const int above = sfx - c;
        int run = above, dig = 0, nn = need; bool done = false;
        { const int ci = (int)c4.w; if (run + ci >= need) { dig = 4 * ln + 3; nn = need - run; done = true; } else run += ci; }
        { const int ci = (int)c4.z; if (!done) { if (run + ci >= need) { dig = 4 * ln + 2; nn = need - run; done = true; } else run += ci; } }
        { const int ci = (int)c4.y; if (!done) { if (run + ci >= need) { dig = 4 * ln + 1; nn = need - run; done = true; } else run += ci; } }
        { if (!done) { dig = 4 * ln; nn = need - run; } }
        const unsigned long long hm = __ballot(sfx >= need && above < need);
        const int src = (int)__builtin_ctzll(hm | (1ull << 63));
        dig = __builtin_amdgcn_readlane(dig, src); need = __builtin_amdgcn_readlane(nn, src);
        tl = (tl << nb) | (unsigned)dig;
        if (step < 2) {
#pragma unroll
            for (int t = 0; t < NJ; ++t) ev[t] = (((ev[t] >> sh) & dm) == dig) ? ev[t] : -1;
        }
    }
    return tl;
}

__device__ __forceinline__ void unit(int b, int qt, const bf16_t* __restrict__ O1, const bf16_t* __restrict__ KIDX, unsigned* __restrict__ MASK, LAS unsigned char* lds, int wv) {
    const int tid_ = tid_now(wv);
    long long spin_ = 0; long long tw0_ = 0; (void)tw0_;
#define RT_NOW(t) asm volatile("s_waitcnt vmcnt(0) lgkmcnt(0)\n\ts_memrealtime %0\n\ts_waitcnt lgkmcnt(0)" : "=s"(t) :: "memory")
#define SEC_B(id) do { if (PROBE_DUP == (id)) { unsigned long long t_; RT_NOW(t_); tw0_ = (long long)t_; } } while (0)
#define SEC_E(id) do { if (PROBE_DUP == (id)) { unsigned long long t_; RT_NOW(t_); spin_ += (long long)t_ - tw0_; } } while (0)
    SEC_B(90); SEC_B(91); SEC_B(70);
    asm volatile("" : "+s"(O1), "+s"(KIDX), "+s"(MASK));
    const int tid = tid_, lane = tid & 63, r32 = lane & 31, hi = lane >> 5; const int wid = wv;
    const size_t rowbase = (size_t)b * S; const int nkt = 2 * ((qt >> 1) + 1);
    const int kper = (nkt + 7) >> 3, ktb = wid * kper, kte = (ktb + kper < nkt) ? ktb + kper : nkt;
    LAS unsigned* hist = (LAS unsigned*)(lds + L_HIST); LAS unsigned* spfx = (LAS unsigned*)(lds + L_PFX); LAS int* sneed = (LAS int*)(lds + L_NEED);
    QOps Q;
    for (int rq_ = 0; rq_ < ((PROBE_DUP == 78) ? 9 : 1); ++rq_)
    { const GAS bf16_t* qrow = (const GAS bf16_t*)O1 + (rowbase + qt * 32 + r32 + (rq_ >> 4)) * LD1;
      const u32x4 ww = *(const GAS u32x4*)(qrow + O_WIDX);
      Q.wv[0] = bflo(ww.x); Q.wv[1] = bfhi(ww.x); Q.wv[2] = bflo(ww.y); Q.wv[3] = bfhi(ww.y); Q.wv[4] = bflo(ww.z); Q.wv[5] = bfhi(ww.z); Q.wv[6] = bflo(ww.w); Q.wv[7] = bfhi(ww.w);
      float qs[2][8];
#pragma unroll
      for (int s2 = 0; s2 < 2; ++s2)
#pragma unroll
          for (int j = 0; j < 8; ++j) qs[s2][j] = 0.f;
#pragma unroll
      for (int h = 0; h < 8; ++h)
#pragma unroll
          for (int s2 = 0; s2 < 2; ++s2) {
              const u32x4 qv = *(const GAS u32x4*)(qrow + O_QIDX + 32 * h + 16 * s2 + hi * 8);
              Q.qf[h][s2] = __builtin_bit_cast(bf16x8, qv);
              qs[s2][0] = __builtin_fmaf(Q.wv[h], bflo(qv.x), qs[s2][0]); qs[s2][1] = __builtin_fmaf(Q.wv[h], bfhi(qv.x), qs[s2][1]);
              qs[s2][2] = __builtin_fmaf(Q.wv[h], bflo(qv.y), qs[s2][2]); qs[s2][3] = __builtin_fmaf(Q.wv[h], bfhi(qv.y), qs[s2][3]);
              qs[s2][4] = __builtin_fmaf(Q.wv[h], bflo(qv.z), qs[s2][4]); qs[s2][5] = __builtin_fmaf(Q.wv[h], bfhi(qv.z), qs[s2][5]);
              qs[s2][6] = __builtin_fmaf(Q.wv[h], bflo(qv.w), qs[s2][6]); qs[s2][7] = __builtin_fmaf(Q.wv[h], bfhi(qv.w), qs[s2][7]);
          }
#pragma unroll
      for (int s2 = 0; s2 < 2; ++s2) {
          u32x4 hv, lv; unsigned* hp = (unsigned*)&hv; unsigned* lp = (unsigned*)&lv;
#pragma unroll
          for (int j = 0; j < 4; ++j) {
              const unsigned hw = pk2(qs[s2][2 * j], qs[s2][2 * j + 1]);
              hp[j] = hw; lp[j] = pk2(qs[s2][2 * j] - bflo(hw), qs[s2][2 * j + 1] - bfhi(hw));
          }
          Q.qb[0][s2] = __builtin_bit_cast(bf16x8, hv); Q.qb[1][s2] = __builtin_bit_cast(bf16x8, lv);
      } }
    SEC_E(91); SEC_B(92); SEC_E(70);
    const GAS bf16_t* kbase = (const GAS bf16_t*)KIDX + rowbase * 32;
    LAS unsigned* lcnt = (LAS unsigned*)(lds + L_LCNT); LAS unsigned* blist = (LAS unsigned*)(lds + L_LIST);
    GAS unsigned short* mbase = (GAS unsigned short*)MASK + ((size_t)b * att::MASK_TILES_PER_BATCH + att::mask_tile_off(qt)) * 64;
    unsigned tau = 0u;
    bool need_mask_pass = true;
    if (nkt * 32 > 256) {
        LAS unsigned* lists = (LAS unsigned*)(lds + L_HIST); LAS unsigned* scnt = (LAS unsigned*)(lds + L_CNT); LAS unsigned* stau = (LAS unsigned*)(lds + L_TAU); LAS unsigned* sflag = (LAS unsigned*)(lds + L_FLAG); LAS unsigned* slb = (LAS unsigned*)(lds + L_LB);
        if (tid < 32) { spfx[tid] = 0u; sneed[tid] = 256; lcnt[tid] = 0u; if (tid == 0) sflag[0] = ((IDX_FORCE_SLOW || PROBE_DUP == 77) ? 1u : 0u); }
        bool fast = false;
        for (int pass = 0; pass < 3; ++pass) {
            for (int rp_ = 0; rp_ < (((PROBE_DUP == 83 || PROBE_DUP == 89) && pass == 0) ? 2 : 1); ++rp_) {
            if (PROBE_DUP == 89 && tid < 32) { spfx[tid] = 0u; sneed[tid] = 256; }
            { LAS u32x4* h4 = (LAS u32x4*)hist; for (int e = tid_now(wv); e < 32 * HROW / 4; e += 512) h4[e] = (u32x4){0u, 0u, 0u, 0u}; }
            asm volatile("s_waitcnt lgkmcnt(0)\n\ts_barrier" ::: "memory");
            { const int ln = lane_now(), lr = ln & 31;
              PassCtx C; C.kbase = kbase; C.hrow = hist + lr * HROW; C.lcnt_q = lcnt + lr; C.blist_q = blist + lr * LCAP; C.mbase = mbase; C.pfx = spfx[lr];
              C.lane = ln; C.r32 = lr; C.hi = ln >> 5; C.ktb = ktb; C.kte = kte; C.hi2 = (wid >= 4);
              C.lown = nullptr; unsigned nc_ = 0u;
              if (pass == 0) {
                  if (PASS0_SPLIT && nkt >= 64) {
                      const int kmid = (kte > ktb) ? ktb + ((kte - ktb + 3) >> 2) : ktb;
                      C.kte = kmid; pass_loop<0>(C, Q, nc_);
                      asm volatile("s_waitcnt lgkmcnt(0)\n\ts_barrier" ::: "memory");
                      scan_hist(hist, spfx, sneed, slb, wid, 0, true);
                      asm volatile("s_waitcnt lgkmcnt(0)\n\ts_barrier" ::: "memory");
                      C.ktb = kmid; C.kte = kte; C.pfx = slb[lane_now() & 31]; pass_loop<4>(C, Q, nc_);
                  } else pass_loop<0>(C, Q, nc_);
              } else if (pass == 1) pass_loop<1>(C, Q, nc_); else pass_loop<2>(C, Q, nc_); }
            asm volatile("s_waitcnt vmcnt(0) lgkmcnt(0)\n\ts_barrier" ::: "memory");
            if (PROBE_DUP == 89 && pass == 0 && rp_ == 0) { scan_hist(hist, spfx, sneed, slb, wid, pass, false); asm volatile("s_waitcnt lgkmcnt(0)\n\ts_barrier" ::: "memory"); }
            }
            SEC_E(92); SEC_B(93);
            scan_hist(hist, spfx, sneed, slb, wid, pass, false);
            if (PROBE_DUP == 94 && pass == 0) { for (int rp_ = 0; rp_ < 4; ++rp_) { asm volatile("s_waitcnt lgkmcnt(0)\n\ts_barrier" ::: "memory"); scan_hist(hist, spfx, sneed, slb, wid, 0, true); } }
            asm volatile("s_waitcnt lgkmcnt(0)\n\ts_barrier" ::: "memory");
            SEC_E(93);
            if (pass == 0) {
                for (int rpB_ = 0; rpB_ < ((PROBE_DUP == 79) ? 2 : 1); ++rpB_) {
                SEC_B(95);
                for (int rp_ = 0; rp_ < ((PROBE_DUP == 84) ? 2 : 1); ++rp_)
                { const int ln = lane_now(), lr = ln & 31;
                  const unsigned la0 = (unsigned)(size_t)(lists + (wid * 64 + ln) * LSTR); unsigned la = la0;
                  PassCtx C; C.kbase = kbase; C.hrow = nullptr; C.lcnt_q = nullptr; C.blist_q = nullptr; C.lown = nullptr; C.mbase = mbase; C.pfx = spfx[lr]; C.msk = (C.pfx >= 512u) ? 0x80000000u : 0xffffffffu;
                  C.lane = ln; C.r32 = lr; C.hi = ln >> 5; C.ktb = ktb; C.kte = kte; C.hi2 = (wid >= 4);
                  pass_loop<3>(C, Q, la);
                  const unsigned nc = (la - la0) >> 2;
                  scnt[wid * 64 + ln] = nc < (unsigned)LISTN ? nc : (unsigned)LISTN;
                  if (nc > (unsigned)LISTN) sflag[0] = 1u; }
                asm volatile("s_waitcnt vmcnt(0) lgkmcnt(0)\n\ts_barrier" ::: "memory");
                SEC_E(95);
                if (sflag[0] == 0u) {
                    SEC_B(96);
                    for (int rp_ = 0; rp_ < ((PROBE_DUP == 85) ? 2 : 1); ++rp_)
                    { const int ln = lane_now(), li = ln & 15; LAS unsigned* wh = (LAS unsigned*)(lds + L_WH) + wid * 256;
#pragma unroll 1
                      for (int qi = 0; qi < 4; ++qi) {
                          const int q = wid * 4 + qi, L = (li >> 1) * 64 + q + 32 * (li & 1);
                          const int cn = (int)scnt[L];
                          int mx = cn;
                          { int o;
                            o = __builtin_amdgcn_update_dpp(0, mx, 0x111, 0xf, 0xf, false); mx = o > mx ? o : mx;
                            o = __builtin_amdgcn_update_dpp(0, mx, 0x112, 0xf, 0xf, false); mx = o > mx ? o : mx;
                            o = __builtin_amdgcn_update_dpp(0, mx, 0x114, 0xf, 0xf, false); mx = o > mx ? o : mx;
                            o = __builtin_amdgcn_update_dpp(0, mx, 0x118, 0xf, 0xf, false); mx = o > mx ? o : mx; }
                          const int nj = (__builtin_amdgcn_readlane(mx, 15) + 3) >> 2;
                          const int need = __builtin_amdgcn_readfirstlane(sneed[q]);
                          const LAS unsigned* lbase = lists + L * LSTR;
                          unsigned tl;
                          if (nj <= 4) tl = resolve_query<4>(lbase, cn, ln, wh, need); else if (nj <= 8) tl = resolve_query<8>(lbase, cn, ln, wh, need); else tl = resolve_query<16>(lbase, cn, ln, wh, need);
                          if (ln == 0) stau[q] = tl;
                      } }
                    asm volatile("s_waitcnt lgkmcnt(0)\n\ts_barrier" ::: "memory");
                    SEC_E(96); SEC_B(97);
                    for (int rp_ = 0; rp_ < ((PROBE_DUP == 86) ? 2 : 1); ++rp_)
                    { const int ln = lane_now(); const unsigned tq = stau[ln & 31], n = scnt[wid * 64 + ln]; const LAS unsigned* lown = lists + (wid * 64 + ln) * LSTR;
                      for (unsigned i = 0; i < n; ++i) {
                          const unsigned e = lown[i];
                          if ((e & 0x3fffffu) >= tq) {
                              const int ekt = ktb + (int)(e >> 26);
                              (void)__hip_atomic_fetch_or((GAS unsigned*)mbase + (size_t)(ekt >> 1) * 64 + ln, 1u << (((e >> 22) & 15u) + 16u * (unsigned)(ekt & 1)), __ATOMIC_RELAXED, __HIP_MEMORY_SCOPE_AGENT);
                          }
                      } }
                    SEC_E(97);
                    fast = true; need_mask_pass = false;
                }
                if (PROBE_DUP == 79 && rpB_ == 0) asm volatile("s_waitcnt vmcnt(0) lgkmcnt(0)\n\ts_barrier" ::: "memory");
                }
                if (fast) break;
            }
        }
        SEC_B(71);
        const int lane = lane_now(), r32 = lane & 31;
        tau = spfx[r32];
        const bool overflow = fast ? true : (__any(lcnt[r32] > (unsigned)LCAP) != 0);
        if (!overflow) {
            need_mask_pass = false;
            const unsigned n = lcnt[r32], tq = tau & 2047u;
            for (unsigned i = 0; i < n; ++i) {
                const unsigned e = blist[r32 * LCAP + i]; const int ekt = (int)(e >> 21);
                if (((e >> 15) & 63u) == (unsigned)lane && ekt >= ktb && ekt < kte && (e & 2047u) >= tq) {
                    GAS unsigned short* wp = mbase + (size_t)(ekt >> 1) * 128 + lane * 2 + (ekt & 1);
                    *wp = (unsigned short)(*wp | (1u << ((e >> 11) & 15u)));
                }
            }
        }
    }
#define IDX_MASK_BODY(K0, K1, KT) do { float acc[16]; score_tile(acc, K0, K1, Q); unsigned bits = 0u; \
        _Pragma("unroll") for (int r = 0; r < 16; ++r) bits |= (f2key(acc[r]) >= tau) ? (1u << r) : 0u; \
        if (!dryp) mbase[(size_t)((KT) >> 1) * 128 + lane * 2 + ((KT) & 1)] = (unsigned short)bits; else if (bits == 0xffffu && tau == 0x12345679u) mbase[0] = 0; } while (0)
    const int nreal = need_mask_pass ? 1 : 0, nrep = nreal + ((PROBE_DUP == 81) ? 2 : 0);
    for (int rep_ = 0; rep_ < nrep; ++rep_)
    { const bool dryp = (PROBE_DUP == 81) && (rep_ >= nreal);
      bf16x8 a0, a1, b0, b1, c0, c1;
      if (ktb < kte) IDX_KLOAD(a0, a1, ktb); if (ktb + 1 < kte) IDX_KLOAD(b0, b1, ktb + 1); if (ktb + 2 < kte) IDX_KLOAD(c0, c1, ktb + 2);
      for (int kt = ktb; kt < kte; kt += 3) {
          IDX_MASK_BODY(a0, a1, kt); if (kt + 3 < kte) IDX_KLOAD(a0, a1, kt + 3);
          if (kt + 1 < kte) { IDX_MASK_BODY(b0, b1, kt + 1); if (kt + 4 < kte) IDX_KLOAD(b0, b1, kt + 4); }
          if (kt + 2 < kte) { IDX_MASK_BODY(c0, c1, kt + 2); if (kt + 5 < kte) IDX_KLOAD(c0, c1, kt + 5); }
      } }
#undef IDX_MASK_BODY
    SEC_E(90); if (nkt * 32 > 256) SEC_E(71);
    if (PROBE_DUP >= 90 && PROBE_DUP < 100) { const long long t0_ = wall_clock64(); while (wall_clock64() - t0_ < spin_) __builtin_amdgcn_s_sleep(4); }
    asm volatile("s_waitcnt lgkmcnt(0)\n\ts_barrier" ::: "memory");
#undef SEC_B
#undef SEC_E
}
#undef IDX_KLOAD

__device__ __forceinline__ void phase(const bf16_t* O1, const bf16_t* KIDX, unsigned* MASK, LAS unsigned char* lds, int G, int bid, int wv) {
    for (int p = bid; p < 512; p += G) {
        const int b = p & 3, j = p >> 2;
#pragma unroll 1
        for (int u2 = 0; u2 < 2; ++u2) for (int rp_ = 0; rp_ < ((PROBE_DUP == 87) ? 2 : 1); ++rp_) unit(b, u2 ? 255 - j : j, O1, KIDX, MASK, lds, wv);
    }
}
}
struct Frame { LAS unsigned char* lds; int G, bid, wv; Ptrs p; };

__device__ __forceinline__ int win_dest_row(int n) {
    if (n < 672) return n;
    if (n < 3488) return n + 96;
    if (n < 3528) return n - 3488 + 672;
    return n + 56;
}
template <bool MAP>
__device__ __forceinline__ void transpose_item(const float* __restrict__ W, int K, int N, bf16_t* __restrict__ WT, const float* __restrict__ gk, LAS float* scr, int item, int lane) {
    const int nblk = (N + 31) / 32, kb = item / nblk, nb = item % nblk, k0 = 64 * kb, n0 = 32 * nb;
    const int nn = n0 + (lane & 31);
#pragma unroll 8
    for (int i = 0; i < 32; ++i) { const int kk = 2 * i + (lane >> 5); float v = 0.f; if (nn < N) v = W[(size_t)(k0 + kk) * N + nn]; if (gk) v *= gk[k0 + kk]; scr[kk * 33 + (lane & 31)] = v; }
    asm volatile("s_waitcnt lgkmcnt(0)" ::: "memory");
    const int c = lane & 7;
#pragma unroll
    for (int j = 0; j < 4; ++j) { const int n = (lane >> 3) + 8 * j; const LAS float* s = scr + (8 * c) * 33 + n;
        u32x4 o; o.x = pk2(s[0 * 33], s[1 * 33]); o.y = pk2(s[2 * 33], s[3 * 33]); o.z = pk2(s[4 * 33], s[5 * 33]); o.w = pk2(s[6 * 33], s[7 * 33]);
        if (n0 + n < N) { const int dr = MAP ? win_dest_row(n0 + n) : (n0 + n); *(u32x4*)(WT + (size_t)dr * K + k0 + 8 * c) = o; } }
    asm volatile("s_waitcnt lgkmcnt(0)" ::: "memory");
}

__device__ __forceinline__ void phase0(Frame& F) {
    const int t_ = tid_now(F.wv);
    const int tid = t_, lane = tid & 63; const int wave = F.wv; (void)tid; (void)lane; (void)wave;
    unsigned char* ws = F.p.ws;
    LAS float* scr = (LAS float*)(F.lds + wave * 16384);
    const int gw = F.bid * 8 + wave, NGW = F.G * 8;
    constexpr int I_IN = 16 * 175, I_UQ = 6 * 24, I_UKV = 4 * 32, I_OA = 8 * 32, I_OB = 8 * 32, I_OUT = 16 * 32;
    constexpr int NITEMS = I_IN + I_UQ + I_UKV + I_OA + I_OB + I_OUT;
    for (int it = gw; it < NITEMS; it += NGW) {
        int r = it;
        if (r < I_IN) { transpose_item<true>(F.p.w_in, 1024, NIN, (bf16_t*)(ws + WS_WINT), nullptr, scr, r, lane); continue; } r -= I_IN;
        if (r < I_UQ) { transpose_item<false>(F.p.w_uq, 384, 768, (bf16_t*)(ws + WS_WUQT), F.p.g_q, scr, r, lane); continue; } r -= I_UQ;
        if (r < I_UKV) { transpose_item<false>(F.p.w_ukv, 256, 1024, (bf16_t*)(ws + WS_WUKVT), F.p.g_kv, scr, r, lane); continue; } r -= I_UKV;
        if (r < I_OA) { transpose_item<false>(F.p.w_oa, 512, 1024, (bf16_t*)(ws + WS_WOAT), nullptr, scr, r, lane); continue; } r -= I_OA;
        if (r < I_OB) { transpose_item<false>(F.p.w_ob, 512, 1024, (bf16_t*)(ws + WS_WOBT), nullptr, scr, r, lane); continue; } r -= I_OB;
        transpose_item<false>(F.p.w_out, 1024, 1024, (bf16_t*)(ws + WS_WOUTT), nullptr, scr, r, lane);
    }
    { const int gt = F.bid * 512 + tid; if (gt < 7168) ((u32x4*)(ws + WS_WINT + (size_t)712 * 1024 * 2))[gt] = (u32x4){0u, 0u, 0u, 0u}; }
    for (int e = F.bid * 512 + tid; e < S * 16; e += F.G * 512) {
        const int pos = e >> 4, i = e & 15;
        const float freq = powf(10000.f, -(float)i / 16.f); const float ang = (float)pos * freq;
        ((float2*)(ws + WS_ROPE))[e] = make_float2(cosf(ang), sinf(ang));
    }
    bf16_t* H = (bf16_t*)(ws + WS_H);
    for (int row = gw; row < T; row += NGW) {
        const f32x4* xr = (const f32x4*)(F.p.x + (size_t)row * DM);
        f32x4 v[4]; float s = 0.f;
#pragma unroll
        for (int j = 0; j < 4; ++j) { v[j] = xr[lane + 64 * j]; s += (v[j][0] * v[j][0] + v[j][1] * v[j][1]) + (v[j][2] * v[j][2] + v[j][3] * v[j][3]); }
        s = wave_sum(s);
        const float r = rsqrtf(s * (1.f / DM) + 1e-6f);
#pragma unroll
        for (int j = 0; j < 4; ++j) {
            const f32x4 gg = ((const f32x4*)F.p.norm_g)[lane + 64 * j];
            uint2 o; o.x = pk2(v[j][0] * r * gg[0], v[j][1] * r * gg[1]); o.y = pk2(v[j][2] * r * gg[2], v[j][3] * r * gg[3]);
            ((uint2*)(H + (size_t)row * DM))[lane + 64 * j] = o;
        }
    }
}

__device__ __forceinline__ void phase1(Frame& F, int dry = 0) {
    unsigned char* ws = F.p.ws;
    pg8::Gemm g{(const bf16_t*)(ws + WS_H), DM, (const bf16_t*)(ws + WS_WINT), T, LD1, DM, F.wv, 0, 0};
    pg8::StaticOrder So; So.init(T, LD1, F.G, F.bid);
    pg8::EpiIn E{(bf16_t*)(ws + WS_OUT1), (float*)(ws + WS_SSQLAT), dry};
    if (P1_STAGGER_TICKS > 0 && !dry && 2 * F.bid >= F.G) { const long long t0 = wall_clock64(); while (wall_clock64() - t0 < P1_STAGGER_TICKS) __builtin_amdgcn_s_sleep(8); }
    if (PROBE_DUP == 14 && dry) { pg8::Gemm gz{(const bf16_t*)(ws + WS_CTL), 0, (const bf16_t*)(ws + WS_CTL), T, LD1, DM, F.wv, 0, 0}; pg8::SameTileOrder Ss; Ss.S = So; pg8::gemm_phase<pg8::EpiIn, pg8::SameTileOrder, true, true>(F.lds, gz, Ss, E); return; }
    if (PROBE_DUP == 12 && dry) { pg8::SameTileOrder Ss; Ss.S = So; pg8::gemm_phase<pg8::EpiIn, pg8::SameTileOrder, true, true>(F.lds, g, Ss, E); return; }
    pg8::gemm_phase<pg8::EpiIn, pg8::StaticOrder, true, true>(F.lds, g, So, E);
}

__device__ __forceinline__ void probe13(Frame& F, int dry) {
    const long long c0 = clock64(); const long long w0 = wall_clock64();
    phase1(F, dry);
    const long long c1 = clock64(); const long long w1 = wall_clock64();
    const long long ticks = (c1 - c0) * 1000ll / (w1 - w0 + 1);
    const long long t0 = wall_clock64(); while (wall_clock64() - t0 < ticks) __builtin_amdgcn_s_sleep(8);
}

__device__ __forceinline__ void phase1b(Frame& F) {
    const int t_ = tid_now(F.wv);
    const int tid = t_, lane = tid & 63; const int wave = F.wv; (void)tid; (void)lane; (void)wave;
    unsigned char* ws = F.p.ws;
    const bf16_t* O1 = (const bf16_t*)(ws + WS_OUT1);
    {
        bf16_t* KPE = (bf16_t*)(ws + WS_KPE); bf16_t* KIDX = (bf16_t*)(ws + WS_KIDX); const float2* rope = (const float2*)(ws + WS_ROPE);
        for (int e = F.bid * 512 + tid; e < T * 16; e += F.G * 512) {
            const int m = e >> 4, i = e & 15; const bf16_t* src = O1 + (size_t)m * LD1;
            const float2 cs = rope[(size_t)(m & (S - 1)) * 16 + i];
            const float x1 = bf2f(src[O_KROPE + i]), x2 = bf2f(src[O_KROPE + 16 + i]);
            KPE[(size_t)m * 32 + i] = f2bf(x1 * cs.x - x2 * cs.y); KPE[(size_t)m * 32 + 16 + i] = f2bf(x1 * cs.y + x2 * cs.x);
            KIDX[(size_t)m * 32 + i] = src[O_KIDX + i]; KIDX[(size_t)m * 32 + 16 + i] = src[O_KIDX + 16 + i];
        }
    }
    {
        pg8::Gemm g{O1 + O_QLAT, LD1, (const bf16_t*)(ws + WS_WUQT), T, 768, 384, F.wv, 0, 0};
        pg8::StaticOrder So; So.init(T, 768, F.G, F.bid);
        pg8::EpiQ E{(bf16_t*)(ws + WS_Q), (const float*)(ws + WS_SSQLAT), (const float2*)(ws + WS_ROPE)};
        pg8::gemm_phase<pg8::EpiQ, pg8::StaticOrder, true, true>(F.lds, g, So, E);
    }
    {
        pg8::Gemm g{O1 + O_CKV, LD1, (const bf16_t*)(ws + WS_WUKVT), T, 1024, 256, F.wv, 0, 0};
        pg8::StaticOrder So; So.init(T, 1024, F.G, F.bid);
        pg8::EpiKV E{(bf16_t*)(ws + WS_H), (const float*)(ws + WS_SSQLAT)};
        pg8::gemm_phase<pg8::EpiKV, pg8::StaticOrder, true, true>(F.lds, g, So, E);
    }
}

__device__ __forceinline__ void phase4ab(Frame& F) {
    unsigned char* ws = F.p.ws;
    const bf16_t* O1 = (const bf16_t*)(ws + WS_OUT1); bf16_t* MG = (bf16_t*)(ws + WS_H);
    pg8::Gemm g{O1 + O_ZA, LD1, (const bf16_t*)(ws + WS_WOAT), T, 1024, 512, F.wv, (long)(O_ZB - O_ZA) * 2, (long)(WS_WOBT - WS_WOAT)};
    pg8::TwoGemmOrder So; So.S.init(T, 1024, F.G, F.bid);
    pg8::EpiGate2 E{MG, O1, O_GA, O_GB};
    pg8::gemm_phase<pg8::EpiGate2, pg8::TwoGemmOrder, true, true>(F.lds, g, So, E);
}

__device__ __forceinline__ void phase4c(Frame& F) {
    unsigned char* ws = F.p.ws;
    pg8::Gemm g{(const bf16_t*)(ws + WS_H), DM, (const bf16_t*)(ws + WS_WOUTT), T, 1024, 1024, F.wv, 0, 0};
    pg8::StaticOrder So; So.init(T, 1024, F.G, F.bid);
    if (FUSE_FINAL_NORM && F.G == 256) {
        unsigned* ctl = (unsigned*)(ws + WS_CTL);
        pg8::EpiOutNorm E{F.p.x, F.p.out, (float*)(ws + WS_SSQO), F.p.final_g, ctl + CW_PANEL, ctl + CW_TMO, F.lds};
        pg8::gemm_phase<pg8::EpiOutNorm, pg8::StaticOrder, true, true>(F.lds, g, So, E);
        return;
    }
    pg8::EpiOut E{F.p.x, F.p.out, (float*)(ws + WS_SSQO)};
    pg8::gemm_phase<pg8::EpiOut, pg8::StaticOrder, true, true>(F.lds, g, So, E);
}

__device__ __forceinline__ void phase5(Frame& F) {
    const int t_ = tid_now(F.wv);
    const int tid = t_, lane = tid & 63; const int wave = F.wv; (void)tid; (void)lane; (void)wave;
    const float* ssqo = (const float*)(F.p.ws + WS_SSQO);
    const int gw = F.bid * 8 + wave, NGW = F.G * 8;
    for (int row = gw; row < T; row += NGW) {
        float s = (lane < 32) ? ssqo[(size_t)row * 32 + lane] : 0.f;
        s = wave_sum(s);
        const float r = rsqrtf(s * (1.f / DM) + 1e-6f);
        f32x4* xr = (f32x4*)(F.p.out + (size_t)row * DM);
#pragma unroll
        for (int j = 0; j < 4; ++j) { const f32x4 gg = ((const f32x4*)F.p.final_g)[lane + 64 * j]; xr[lane + 64 * j] = xr[lane + 64 * j] * r * gg; }
    }
}

__device__ __forceinline__ void phase_mla(Frame& F, bool dry = false) {
    unsigned char* ws = F.p.ws;
    att::Tensors X{};
    X.Q = (const bf16_t*)(ws + WS_Q); X.ldq = 768; X.hq = 96;
    X.K0 = (const bf16_t*)(ws + WS_H); X.ldk = 1024; X.hk = 128; X.K1 = (const bf16_t*)(ws + WS_KPE);
    X.V = (const bf16_t*)(ws + WS_H) + 64; X.ldv = 1024; X.hv = 128;
    X.O = (bf16_t*)(ws + WS_OUT1) + O_ZA; X.ldo = LD1; X.mask = nullptr; X.rel_bias = nullptr;
    X.wv = F.wv;
    att::phase<false>(X, F.lds, F.G, F.bid, dry);
}
__device__ __forceinline__ void phase_dsa(Frame& F, bool dry = false) {
    unsigned char* ws = F.p.ws; bf16_t* O1 = (bf16_t*)(ws + WS_OUT1);
    att::Tensors X{};
    X.Q = O1 + O_QB; X.ldq = LD1; X.hq = 64;
    X.K0 = O1 + O_KB; X.ldk = LD1; X.hk = 64; X.K1 = nullptr;
    X.V = O1 + O_VB; X.ldv = LD1; X.hv = 64;
    X.O = O1 + O_ZB; X.ldo = LD1; X.mask = (const unsigned long long*)(ws + WS_MASK); X.rel_bias = F.p.rel_bias;
    X.wv = F.wv;
    att::phase<true>(X, F.lds, F.G, F.bid, dry);
}

__device__ __forceinline__ void phase_idx(Frame& F) {
    unsigned char* ws = F.p.ws;
    idx::phase((const bf16_t*)(ws + WS_OUT1), (const bf16_t*)(ws + WS_KIDX), (unsigned*)(ws + WS_MASK), F.lds, F.G, F.bid, F.wv);
}

typedef unsigned long long u64_t;
#define XB_TMO      128
#define XB_XCNT(j)  (256  + 64 * (j))
#define XB_XSUB(j)  (1280 + 64 * (j))
#define XB_XGEN(j)  (2304 + 64 * (j))
#define XB_TOP      3328
#define XB_TOPGEN   3392
#define XCD_BAR_WORDS 3456
#define XB_SPIN_CAP (1u << 18)

__device__ __forceinline__ unsigned xb_ld(unsigned* p)              { return __hip_atomic_load(p, __ATOMIC_RELAXED, __HIP_MEMORY_SCOPE_AGENT); }
__device__ __forceinline__ unsigned xb_add(unsigned* p, unsigned v) { return __hip_atomic_fetch_add(p, v, __ATOMIC_RELAXED, __HIP_MEMORY_SCOPE_AGENT); }
__device__ __forceinline__ unsigned xb_xcc_id() { return (unsigned)__builtin_amdgcn_s_getreg((3 << 11) | 20) & 0xFu; }
#define XB_SPIN(cond, bar) do { unsigned _sp = 0; while (cond) { __builtin_amdgcn_s_sleep(1); \
    if ((++_sp & 255u) == 0u) { if (xb_ld(&(bar)[XB_TMO])) break; if (_sp > XB_SPIN_CAP) { atomicAdd(&(bar)[XB_TMO], 1u); break; } } } } while (0)

struct XcdBarrier {
    unsigned* bar; unsigned x; int wv;
    volatile LAS unsigned* st;
};

__device__ __forceinline__ XcdBarrier xcd_barrier_post(unsigned* bar, volatile LAS unsigned* st, int wv) {
    XcdBarrier b; b.bar = bar; b.x = xb_xcc_id(); b.st = st; b.wv = wv;
    if (threadIdx.x == 0) (void)xb_add(&bar[XB_XCNT(b.x)], 1u);
    return b;
}
__device__ __forceinline__ void xcd_barrier_complete(unsigned* bar, unsigned x, unsigned& nloc, unsigned& nx) {
    const unsigned G = gridDim.x * gridDim.y * gridDim.z;
    unsigned sum, cnt, mine, sp = 0u;
    for (;;) {
        sum = 0u; cnt = 0u; mine = 0u;
#pragma unroll
        for (unsigned j = 0; j < 16; ++j) { const unsigned c = xb_ld(&bar[XB_XCNT(j)]); sum += c; cnt += (c > 0u) ? 1u : 0u; mine = (j == x) ? c : mine; }
        if (sum == G) break;
        __builtin_amdgcn_s_sleep(1);
        if ((++sp & 255u) == 0u) { if (xb_ld(&bar[XB_TMO])) break; if (sp > XB_SPIN_CAP) { atomicAdd(&bar[XB_TMO], 1u); break; } }
    }
    nloc = mine > 0u ? mine : 1u; nx = cnt > 0u ? cnt : 1u;
}

__device__ __forceinline__ void xcd_barrier(const XcdBarrier& b) {
    asm volatile("s_waitcnt vmcnt(0)" ::: "memory");
    __syncthreads();
    if (b.wv == 0 && lane_now() == 0) {
        unsigned* bar = b.bar;
        __builtin_amdgcn_s_waitcnt(0);
        unsigned nloc = b.st[0], nx = b.st[1];
        if (nloc == 0u) { xcd_barrier_complete(bar, b.x, nloc, nx); b.st[0] = nloc; b.st[1] = nx; }
        const unsigned old = xb_add(&bar[XB_XSUB(b.x)], 1u);
        const unsigned gen = old / nloc;
        if (old + 1u == (gen + 1u) * nloc) {
            __builtin_amdgcn_fence(__ATOMIC_RELEASE, "agent");
            asm volatile("s_waitcnt vmcnt(0)" ::: "memory");
            const unsigned og = xb_add(&bar[XB_TOP], 1u);
            const unsigned tg = og / nx;
            if (og + 1u == (tg + 1u) * nx) xb_add(&bar[XB_TOPGEN], 1u);
            else XB_SPIN(xb_ld(&bar[XB_TOPGEN]) == tg, bar);
            __builtin_amdgcn_fence(__ATOMIC_ACQUIRE, "agent");
            xb_add(&bar[XB_XGEN(b.x)], 1u);
            asm volatile("s_waitcnt vmcnt(0)" ::: "memory");
        } else {
            XB_SPIN(xb_ld(&bar[XB_XGEN(b.x)]) == gen, bar);
            __builtin_amdgcn_fence(__ATOMIC_ACQUIRE, "agent");
            asm volatile("s_waitcnt vmcnt(0)" ::: "memory");
        }
    }
    __syncthreads();
}

constexpr int CW_BAR = 4096;
constexpr size_t CTL_ZERO_BYTES = (PROBE_DUP == 14) ? (1u << 20) : 65536;
constexpr int LDS_MISC = 150016;
struct Args { Ptrs p; int ph_lo, ph_hi; };
__global__ void __launch_bounds__(512, 2) mega_fwd(Args a) {
    extern __shared__ __attribute__((aligned(16))) unsigned char lds_raw[];
    Frame F; F.lds = (LAS unsigned char*)lds_raw;
    F.G = gridDim.x; F.bid = blockIdx.x; F.p = a.p;
    cooperative_groups::grid_group grid = cooperative_groups::this_grid();
    volatile LAS unsigned* st = (volatile LAS unsigned*)(F.lds + LDS_MISC);
    if (threadIdx.x < 4) st[threadIdx.x] = 0u;
    F.wv = __builtin_amdgcn_readfirstlane((int)(threadIdx.x >> 6));
    __syncthreads();
    const XcdBarrier bar = xcd_barrier_post((unsigned*)(a.p.ws + WS_CTL) + CW_BAR, st, F.wv);
    static_assert(CW_TMO == CW_BAR + XB_TMO && CW_PANEL * 4 + 64 * 64 <= (int)CTL_ZERO_BYTES, "control words");
    const int lo = a.ph_lo, hi = (FUSE_FINAL_NORM && !DEBUG_FUSE && F.G == 256 && a.ph_hi > 7) ? 7 : a.ph_hi;
struct ClkProbe {
    long long c0, w0;
    __device__ __forceinline__ void begin() { c0 = clock64(); w0 = wall_clock64(); }
    __device__ __forceinline__ void end() { const long long c1 = clock64(); const long long w1 = wall_clock64(); const long long ticks = (c1 - c0) * 1000ll / (w1 - w0 + 1);
        const long long t0 = wall_clock64(); while (wall_clock64() - t0 < ticks) __builtin_amdgcn_s_sleep(8); }
};
#define CLK(code, body) do { if (PROBE_DUP == (code)) { ClkProbe q_; q_.begin(); body; q_.end(); } else { body; } } while (0)
#define RUN(k, body, CG) do { if (lo <= (k) && (k) < hi) { body; if ((k) + 1 < hi) { if (CG) grid.sync(); else { xcd_barrier(bar); } } } } while (0)
    const bool dryrun = (a.ph_hi > 0);
    RUN(0, { CLK(30, phase0(F)); if (PROBE_DUP == 0) phase0(F); }, true);
    RUN(1, { if (PROBE_DUP == 21) { const long long t0 = clock64(); while (clock64() - t0 < 1000000ll) __builtin_amdgcn_s_sleep(8); } CLK(31, phase1(F)); if (PROBE_DUP == 1) phase1(F); if (PROBE_DUP == 11 || PROBE_DUP == 12 || PROBE_DUP == 14) phase1(F, (int)dryrun); if (PROBE_DUP == 13) probe13(F, (int)dryrun); }, false);
    RUN(2, { CLK(32, phase1b(F)); if (PROBE_DUP == 2) phase1b(F); }, false);
    RUN(3, { const bool idx_first = (MIX_ORDER != 0) && (((F.bid >> 3) & 1) != 0); if (idx_first) phase_idx(F); CLK(33, phase_mla(F)); if (PROBE_DUP == 3) phase_mla(F, dryrun); if (!idx_first) CLK(38, phase_idx(F)); if (PROBE_DUP == 8) phase_idx(F); }, false);
    RUN(4, { CLK(34, phase_dsa(F)); if (PROBE_DUP == 4) phase_dsa(F, dryrun); }, false);
    RUN(5, { CLK(35, phase4ab(F)); if (PROBE_DUP == 5) phase4ab(F); }, false);
    RUN(6, { if (PROBE_DUP == 22) { const long long t0 = clock64(); while (clock64() - t0 < 1000000ll) __builtin_amdgcn_s_sleep(8); } CLK(36, phase4c(F)); if (PROBE_DUP == 6) phase4c(F); }, false);
    if (!(FUSE_FINAL_NORM && !DEBUG_FUSE && F.G == 256)) RUN(7, phase5(F), false);
#undef RUN
}

extern "C" void kernel_launch(void* const* d_in, const int* in_sizes, int n_in, void* d_out, int out_size, void* d_ws, size_t ws_size, hipStream_t stream) {
    static int grid = 0;
    if (grid == 0) {
        if (ws_size < WS_END) { fprintf(stderr, "kernel_launch: workspace too small: %zu < %zu\n", ws_size, (size_t)WS_END); grid = -1; return; }
        int dev = 0, cus = 0, per_cu = 0;
        if (hipGetDevice(&dev) != hipSuccess || hipDeviceGetAttribute(&cus, hipDeviceAttributeMultiprocessorCount, dev) != hipSuccess) { grid = -1; return; }
        if (hipFuncSetAttribute((const void*)mega_fwd, hipFuncAttributeMaxDynamicSharedMemorySize, LDS_BYTES) != hipSuccess) { fprintf(stderr, "kernel_launch: hipFuncSetAttribute failed\n"); grid = -1; return; }
        if (hipOccupancyMaxActiveBlocksPerMultiprocessor(&per_cu, (const void*)mega_fwd, 512, LDS_BYTES) != hipSuccess || per_cu < 1) { fprintf(stderr, "kernel_launch: occupancy query failed (%d)\n", per_cu); (void)hipGetLastError(); grid = -1; return; }
        grid = cus;
    }
    if (grid < 0) return;
    if (hipMemsetAsync((char*)d_ws + WS_CTL, 0, CTL_ZERO_BYTES, stream) != hipSuccess) { fprintf(stderr, "kernel_launch: hipMemsetAsync failed\n"); return; }
    Args a{};
    a.p.x = (const float*)d_in[0]; a.p.norm_g = (const float*)d_in[1]; a.p.w_in = (const float*)d_in[2]; a.p.g_q = (const float*)d_in[3]; a.p.w_uq = (const float*)d_in[4];
    a.p.g_kv = (const float*)d_in[5]; a.p.w_ukv = (const float*)d_in[6]; a.p.w_oa = (const float*)d_in[7]; a.p.w_ob = (const float*)d_in[8]; a.p.w_out = (const float*)d_in[9];
    a.p.rel_bias = (const float*)d_in[10]; a.p.final_g = (const float*)d_in[11]; a.p.out = (float*)d_out; a.p.ws = (unsigned char*)d_ws;
    a.ph_lo = 0; a.ph_hi = 8;
    void* args[] = {&a};
    const hipError_t e = hipLaunchCooperativeKernel((const void*)mega_fwd, dim3(grid), dim3(512), args, LDS_BYTES, stream);
    if (e != hipSuccess) fprintf(stderr, "kernel_launch: cooperative launch failed: %s (grid %d)\n", hipGetErrorString(e), grid);
}
```

```cpp
#include <hip/hip_runtime.h>
#include <hip/hip_cooperative_groups.h>
#include <stdint.h>
#include <stdio.h>
#ifndef PROBE_DUP
#define PROBE_DUP -1
#endif

__device__ __forceinline__ int lane_now() { int l; asm volatile("v_mbcnt_lo_u32_b32 %0, -1, 0\n\tv_mbcnt_hi_u32_b32 %0, -1, %0" : "=v"(l)); return l; }
__device__ __forceinline__ int tid_now(int wv) { return (wv << 6) | lane_now(); }

namespace pg8 {
#define PG8_LAS __attribute__((address_space(3)))
typedef unsigned short bf16_t;
typedef short bf16x8 __attribute__((ext_vector_type(8)));
typedef float f32x4 __attribute__((ext_vector_type(4)));
typedef unsigned u32x4 __attribute__((ext_vector_type(4)));
constexpr int BM = 256, BK = 64, HALF = 128, HTB = HALF * BK * 2  , STAGE_BYTES = 8 * HTB, NXCD = 8, WGM = 8;

__host__ __device__ __forceinline__ int lds_byte(int r, int c) { const int st = (r >> 4) * 2 + (c >> 5), rr = r & 15, cc = c & 31, ob = rr * 64 + cc * 2; return st * 1024 + (ob ^ (((ob >> 9) & 1) << 5)); }
__host__ __device__ __forceinline__ void stage_rc(int b, int& R, int& C) { const int st = b / 1024, sb = b % 1024, swz = sb ^ (((sb >> 9) & 1) << 5); R = (st >> 1) * 16 + swz / 64; C = (st & 1) * 32 + (swz % 64) / 2; }
__host__ __device__ __forceinline__ int perm32(int rho) { const int n = rho >> 4, i = rho & 15; return 8 * (i >> 2) + 4 * n + (i & 3); }

struct Unit { int pm, pn; };
struct Gemm { const bf16_t* A; int lda; const bf16_t* Bt; int M, N, K; int wv; };

struct StaticOrder {
    int nM, nN, nwg, G, c;
    __host__ __device__ void init(int M, int N, int G_, int c_) { nM = M / BM; nN = N / BM; nwg = nM * nN; G = G_; c = c_; }
    __host__ __device__ bool next(int i, Unit& u) const {
        const long L = (long)i * G + c; if (L >= nwg) return false;
        int wgid = (int)L; { const int q = nwg / NXCD, r = nwg % NXCD, xcd = wgid % NXCD, off = wgid / NXCD; wgid = (xcd < r ? xcd * (q + 1) : r * (q + 1) + (xcd - r) * q) + off; }
        const int nig = WGM * nN, gid = wgid / nig, fm = gid * WGM, gsz = (nM - fm) < WGM ? (nM - fm) : WGM;
        u.pm = fm + ((wgid % nig) % gsz); u.pn = (wgid % nig) / gsz; return true;
    }
    __device__ __forceinline__ void a_ready(const Unit&) const {}
    __device__ __forceinline__ void done(const Unit&) const {}
};
struct SameTileOrder {
    StaticOrder S;
    __host__ __device__ bool next(int i, Unit& u) const { const bool ok = S.next(i, u); u.pm = 0; u.pn = 0; return ok; }
    __device__ __forceinline__ void a_ready(const Unit&) const {}
    __device__ __forceinline__ void done(const Unit&) const {}
};

typedef __bf16 bf16x2_t __attribute__((ext_vector_type(2)));
typedef float f32x2_t __attribute__((ext_vector_type(2)));
__device__ __forceinline__ unsigned cvt_pk_bf16(float lo, float hi) { const f32x2_t v = {lo, hi}; return __builtin_bit_cast(unsigned, __builtin_convertvector(v, bf16x2_t)); }
template <class Epi, class Sched, bool ALIGN_EPI = false, bool SP2 = false>
__device__ __forceinline__ void gemm_phase(PG8_LAS unsigned char* lds, const Gemm g, const Sched& S, const Epi& E) {
    const int tid_ = tid_now(g.wv);
    const int tid = tid_, wid = g.wv, lane = tid & 63, wr = wid >> 2, wc = wid & 3, fr = lane & 15, fq = lane >> 4;
    int K_ = g.K; if (g.K < 1024) asm volatile("" : "+s"(K_));
    const int K = K_, nt = K / BK;
    unsigned voffA[2], voffB[2];
#pragma unroll
    for (int i = 0; i < 2; ++i) { int R, C; stage_rc(tid * 16 + i * 8192, R, C); const int Rb = Epi::PERM ? ((R & ~31) + perm32(R & 31)) : R;
        voffA[i] = (unsigned)(R * g.lda + C) * 2u; voffB[i] = (unsigned)(Rb * K + C) * 2u; }
    const size_t kstep = (size_t)(BK * 2);
    const size_t hstepA = (size_t)HALF * g.lda * 2, hstepB = (size_t)HALF * K * 2;
    const size_t tstepA = 2 * hstepA, tstepB = 2 * hstepB;
    const unsigned ldsw = (unsigned)wid * 1024u;
    const int aoff = lds_byte(wr * 64 + fr, fq * 8), boff = lds_byte(wc * 32 + fr, fq * 8);
#define PG8_SA(b, h) (((b) * 2 + (h)) * HTB)
#define PG8_SB(b, h) ((4 + (b) * 2 + (h)) * HTB)
#define PG8_STAGE(bufoff, gbase, voff) do { _Pragma("unroll") for (int _i = 0; _i < 2; ++_i) \
        __builtin_amdgcn_global_load_lds((const unsigned*)((const char*)(gbase) + (voff)[_i]), (PG8_LAS unsigned*)(lds + (bufoff) + ldsw + _i * 8192), 16, 0, 0); } while (0)
#define PG8_LDA(dst, b, h) do { _Pragma("unroll") for (int m = 0; m < 4; ++m) _Pragma("unroll") for (int k = 0; k < 2; ++k) dst[m][k] = *(const PG8_LAS bf16x8*)(lds + PG8_SA(b, h) + aoff + m * 2048 + k * 1024); } while (0)
#define PG8_LDB(dst, b, h) do { _Pragma("unroll") for (int n = 0; n < 2; ++n) _Pragma("unroll") for (int k = 0; k < 2; ++k) dst[n][k] = *(const PG8_LAS bf16x8*)(lds + PG8_SB(b, h) + boff + n * 2048 + k * 1024); } while (0)
#define PG8_MMA(ai, bj, At, Bt) do { __builtin_amdgcn_s_setprio(1); _Pragma("unroll") for (int m = 0; m < 4; ++m) _Pragma("unroll") for (int n = 0; n < 2; ++n) _Pragma("unroll") for (int k = 0; k < 2; ++k) \
        acc[ai][bj][m][n] = __builtin_amdgcn_mfma_f32_16x16x32_bf16(Bt[n][k], At[m][k], acc[ai][bj][m][n], 0, 0, 0); __builtin_amdgcn_s_setprio(0); } while (0)
#define PG8_WAIT_V(n) asm volatile("s_waitcnt vmcnt(" #n ")" ::: "memory")
#define PG8_WAIT_L(n) asm volatile("s_waitcnt lgkmcnt(" #n ")" ::: "memory")
#define PG8_BAR __builtin_amdgcn_s_barrier()
#define PG8_SCHED __builtin_amdgcn_sched_barrier(0)
    Unit cur, nxt; int ui = 0;
    if (!S.next(0, cur)) return;
    f32x4 acc[2][2][4][2];
#pragma unroll
    for (int a = 0; a < 2; ++a)
#pragma unroll
        for (int b = 0; b < 2; ++b)
#pragma unroll
            for (int m = 0; m < 4; ++m)
#pragma unroll
                for (int n = 0; n < 2; ++n) acc[a][b][m][n] = (f32x4){0.f, 0.f, 0.f, 0.f};
    bf16x8 At[4][2], B0[2][2], B1[2][2];
    const char* cA = (const char*)g.A + (size_t)cur.pm * tstepA; const char* cB = (const char*)g.Bt + (size_t)cur.pn * tstepB;
    S.a_ready(cur);
    if constexpr (SP2) {
        PG8_STAGE(PG8_SB(0, 0), cB, voffB); PG8_STAGE(PG8_SB(0, 1), cB + hstepB, voffB); PG8_STAGE(PG8_SA(0, 0), cA, voffA); PG8_STAGE(PG8_SA(0, 1), cA + hstepA, voffA);
        if (wr == 1) PG8_BAR;
        PG8_WAIT_V(2); PG8_BAR;
        PG8_STAGE(PG8_SB(1, 0), cB + kstep, voffB); PG8_STAGE(PG8_SA(1, 0), cA + kstep, voffA); PG8_STAGE(PG8_SB(1, 1), cB + hstepB + kstep, voffB);
        PG8_WAIT_V(6); PG8_BAR;
    } else {
        PG8_STAGE(PG8_SB(0, 0), cB, voffB); PG8_STAGE(PG8_SA(0, 0), cA, voffA); PG8_STAGE(PG8_SB(0, 1), cB + hstepB, voffB); PG8_STAGE(PG8_SA(0, 1), cA + hstepA, voffA);
        if (wr == 1) PG8_BAR;
        PG8_WAIT_V(4); PG8_BAR;
        PG8_STAGE(PG8_SB(1, 0), cB + kstep, voffB); PG8_STAGE(PG8_SA(1, 0), cA + kstep, voffA); PG8_STAGE(PG8_SB(1, 1), cB + hstepB + kstep, voffB);
        PG8_WAIT_V(6); PG8_BAR;
    }
    for (;;) {
        const bool has_next = S.next(ui + 1, nxt);
        const char* nA = has_next ? (const char*)g.A + (size_t)nxt.pm * tstepA : cA; const char* nB = has_next ? (const char*)g.Bt + (size_t)nxt.pn * tstepB : cB;
        for (int t = 0; t < nt; t += 2) {
            const bool last = (t == nt - 2);
            const char* a1 = cA + (size_t)(t + 1) * kstep;
            const char* a2 = last ? nA : cA + (size_t)(t + 2) * kstep; const char* b2 = last ? nB : cB + (size_t)(t + 2) * kstep;
            const char* a3 = a2 + kstep; const char* b3 = b2 + kstep;
            if (last && has_next) S.a_ready(nxt);
            if constexpr (SP2) {
            PG8_LDB(B0, 0, 0); PG8_LDB(B1, 0, 1); PG8_SCHED; PG8_LDA(At, 0, 0); PG8_STAGE(PG8_SA(1, 1), a1 + hstepA, voffA);
            PG8_WAIT_V(8); PG8_WAIT_L(0); PG8_BAR; PG8_MMA(0, 0, At, B0); PG8_MMA(0, 1, At, B1); PG8_BAR; PG8_SCHED;
            PG8_LDA(At, 0, 1); PG8_STAGE(PG8_SB(0, 0), b2, voffB); PG8_STAGE(PG8_SB(0, 1), b2 + hstepB, voffB); PG8_STAGE(PG8_SA(0, 0), a2, voffA);
            PG8_WAIT_V(8); PG8_WAIT_L(0); PG8_BAR; PG8_MMA(1, 0, At, B0); PG8_MMA(1, 1, At, B1); PG8_BAR; PG8_SCHED;
            PG8_LDB(B0, 1, 0); PG8_LDB(B1, 1, 1); PG8_SCHED; PG8_LDA(At, 1, 0); PG8_STAGE(PG8_SA(0, 1), a2 + hstepA, voffA);
            PG8_WAIT_V(8); PG8_WAIT_L(0); PG8_BAR; PG8_MMA(0, 0, At, B0); PG8_MMA(0, 1, At, B1); PG8_BAR; PG8_SCHED;
            PG8_LDA(At, 1, 1); PG8_STAGE(PG8_SB(1, 0), b3, voffB); PG8_STAGE(PG8_SB(1, 1), b3 + hstepB, voffB); PG8_STAGE(PG8_SA(1, 0), a3, voffA);
            PG8_WAIT_V(8); PG8_WAIT_L(0); PG8_BAR; PG8_MMA(1, 0, At, B0); PG8_MMA(1, 1, At, B1); PG8_BAR; PG8_SCHED;
            } else {
            PG8_LDB(B0, 0, 0); PG8_SCHED; PG8_LDA(At, 0, 0); PG8_STAGE(PG8_SA(1, 1), a1 + hstepA, voffA);
            PG8_WAIT_L(8); PG8_BAR; PG8_WAIT_L(0); PG8_MMA(0, 0, At, B0); PG8_BAR; PG8_SCHED;
            PG8_LDB(B1, 0, 1); PG8_STAGE(PG8_SB(0, 0), b2, voffB);
            PG8_BAR; PG8_WAIT_L(0); PG8_MMA(0, 1, At, B1); PG8_BAR;
            PG8_LDA(At, 0, 1); PG8_STAGE(PG8_SA(0, 0), a2, voffA);
            PG8_BAR; PG8_WAIT_L(0); PG8_MMA(1, 0, At, B0); PG8_BAR; PG8_SCHED;
            PG8_STAGE(PG8_SB(0, 1), b2 + hstepB, voffB);
            PG8_WAIT_V(6); PG8_BAR; PG8_MMA(1, 1, At, B1); PG8_BAR;
            PG8_LDB(B0, 1, 0); PG8_SCHED; PG8_LDA(At, 1, 0); PG8_STAGE(PG8_SA(0, 1), a2 + hstepA, voffA);
            PG8_WAIT_L(8); PG8_BAR; PG8_WAIT_L(0); PG8_MMA(0, 0, At, B0); PG8_BAR; PG8_SCHED;
            PG8_LDB(B1, 1, 1); PG8_STAGE(PG8_SB(1, 0), b3, voffB);
            PG8_BAR; PG8_WAIT_L(0); PG8_MMA(0, 1, At, B1); PG8_BAR;
            PG8_LDA(At, 1, 1); PG8_STAGE(PG8_SA(1, 0), a3, voffA);
            PG8_BAR; PG8_WAIT_L(0); PG8_MMA(1, 0, At, B0); PG8_BAR; PG8_SCHED;
            PG8_STAGE(PG8_SB(1, 1), b3 + hstepB, voffB);
            PG8_WAIT_V(6); PG8_BAR; PG8_MMA(1, 1, At, B1); PG8_BAR;
            }
        }
        if constexpr (ALIGN_EPI) { if (wr == 0) PG8_BAR; }
        if constexpr (!Epi::AFTER_DRAIN) { E(acc, cur, wr, wc, fr, fq); S.done(cur); }
        if (!has_next) break;
#pragma unroll
        for (int a = 0; a < 2; ++a)
#pragma unroll
            for (int b = 0; b < 2; ++b)
#pragma unroll
                for (int m = 0; m < 4; ++m)
#pragma unroll
                    for (int n = 0; n < 2; ++n) acc[a][b][m][n] = (f32x4){0.f, 0.f, 0.f, 0.f};
        cur = nxt; cA = nA; cB = nB; ++ui;
        if constexpr (ALIGN_EPI) { if (wr == 1) PG8_BAR; }
    }
    PG8_WAIT_V(0);
    if constexpr (!ALIGN_EPI) { if (wr == 0) PG8_BAR; }
    PG8_BAR;
    if constexpr (Epi::AFTER_DRAIN) { E.fused(acc, cur, wr, wc, fr, fq, lds, wid, lane); S.done(cur); }
#undef PG8_SA
#undef PG8_SB
#undef PG8_STAGE
#undef PG8_LDA
#undef PG8_LDB
#undef PG8_MMA
#undef PG8_WAIT_V
#undef PG8_WAIT_L
#undef PG8_BAR
#undef PG8_SCHED
}
}

typedef unsigned short bf16_t;
typedef float f32x4 __attribute__((ext_vector_type(4)));
typedef unsigned u32x4 __attribute__((ext_vector_type(4)));
#define LAS __attribute__((address_space(3)))
constexpr int NB = 4, S = 8192, DM = 1024, T = NB * S;
constexpr int NIN = 5576;
constexpr int LD1 = 5632;
constexpr int O_QLAT = 0, O_CKV = 384, O_KROPE = 640, O_KIDX = 672, O_WIDX = 704, O_ZA = 768, O_QB = 1280, O_KB = 1792, O_VB = 2304, O_ZB = 2816,
              O_QIDX = 3328, O_GA = 3584, O_GB = 4608;
constexpr size_t MiB = 1u << 20;
constexpr size_t WS_CTL = 0, WS_WUQT = 1 * MiB, WS_WUKVT = 2 * MiB, WS_WOAT = 3 * MiB, WS_WOBT = 4 * MiB, WS_WOUTT = 5 * MiB, WS_ROPE = 7 * MiB,
                 WS_WINT = 8 * MiB, WS_SSQO = 8 * MiB  , WS_SSQLAT = 19 * MiB, WS_KPE = 22 * MiB, WS_KIDX = 24 * MiB, WS_MASK = 26 * MiB,
                 WS_H = 44 * MiB  , WS_Q = 108 * MiB, WS_OUT1 = 156 * MiB, WS_END = 508 * MiB;
constexpr float LOG2E = 1.4426950408889634f;
constexpr float QSCALE_A = 0.10206207261596577f * LOG2E;
constexpr float QSCALE_B = 0.125f * LOG2E;
constexpr int GEMM_LDS = 131072;
constexpr int LDS_BYTES = 155648, LDS_SLOT = 150016 + 64;
#ifndef FUSE_AFTER_DRAIN
#define FUSE_AFTER_DRAIN 0
#endif
#ifndef DEBUG_FUSE
#define DEBUG_FUSE 0
#endif
#ifndef FUSE_FINAL_NORM
#define FUSE_FINAL_NORM 1
#endif
constexpr int CW_PANEL = 8192, CW_TMO = 4096 + 128;
#ifndef MIX_ORDER
#define MIX_ORDER 0
#endif
#ifndef P1_STAGGER_TICKS
#define P1_STAGGER_TICKS 0
#endif

__device__ __forceinline__ float bf2f(bf16_t v) { return __uint_as_float(((unsigned)v) << 16); }
__device__ __forceinline__ bf16_t f2bf(float f) { unsigned u = __float_as_uint(f); return (bf16_t)((u + 0x7fffu + ((u >> 16) & 1u)) >> 16); }
__device__ __forceinline__ unsigned pk2(float lo, float hi) { return (unsigned)f2bf(lo) | ((unsigned)f2bf(hi) << 16); }
__device__ __forceinline__ float bflo(unsigned w) { return __uint_as_float(w << 16); }
__device__ __forceinline__ float bfhi(unsigned w) { return __uint_as_float(w & 0xffff0000u); }
__device__ __forceinline__ float wave_sum(float v) {
#pragma unroll
    for (int o = 1; o < 64; o <<= 1) v += __shfl_xor(v, o);
    return v;
}
__device__ __forceinline__ float sigmoidf_(float x) { return __builtin_amdgcn_rcpf(1.f + __builtin_amdgcn_exp2f(-LOG2E * x)); }

struct Ptrs {
    const float *x, *norm_g, *w_in, *g_q, *w_uq, *g_kv, *w_ukv, *w_oa, *w_ob, *w_out, *rel_bias, *final_g;
    float* out; unsigned char* ws;
};

namespace pg8 {
struct EpiIn {
    static constexpr bool PERM = true, AFTER_DRAIN = false;
    bf16_t* O; float* ssq; int dry;
    __device__ __forceinline__ void operator()(const f32x4 (&acc)[2][2][4][2], const Unit& u, int wr, int wc, int, int) const {
        const int t_ = lane_now();
        const int fr = t_ & 15, fq = (t_ >> 4) & 3;
        if ((PROBE_DUP >= 11 && PROBE_DUP <= 14) && dry) { f32x4 s4 = {0.f, 0.f, 0.f, 0.f};
#pragma unroll
            for (int a = 0; a < 2; ++a)
#pragma unroll
                for (int b = 0; b < 2; ++b)
#pragma unroll
                    for (int m = 0; m < 4; ++m) { s4 += acc[a][b][m][0]; s4 += acc[a][b][m][1]; }
            if (s4[0] + s4[1] + s4[2] + s4[3] == 1.2345e30f) O[0] = 0; return; }
        const int row0 = u.pm * BM + wr * 64 + fr;
#pragma unroll
        for (int bj = 0; bj < 2; ++bj) {
            const int g = u.pn * 2 + bj;
            const int col0 = g * 128 + wc * 32 + 8 * fq;
            int op = 0;
            if ((g >= 6 && g <= 9) || (g >= 22 && g <= 25)) op = 1; else if (g >= 28) op = 2; else if (g >= 10 && g <= 13) op = 3; else if (g <= 4) op = 4;
#pragma unroll
            for (int ai = 0; ai < 2; ++ai)
#pragma unroll
                for (int m = 0; m < 4; ++m) {
                    const int row = row0 + ai * HALF + m * 16;
                    f32x4 v0 = acc[ai][bj][m][0], v1 = acc[ai][bj][m][1];
                    if (op == 1) {
#pragma unroll
                        for (int e = 0; e < 4; ++e) { v0[e] = v0[e] * sigmoidf_(v0[e]); v1[e] = v1[e] * sigmoidf_(v1[e]); }
                    } else if (op == 2) {
#pragma unroll
                        for (int e = 0; e < 4; ++e) { v0[e] = sigmoidf_(v0[e]); v1[e] = sigmoidf_(v1[e]); }
                    } else if (op == 3) { v0 = v0 * QSCALE_B; v1 = v1 * QSCALE_B; }
                    else if (op == 4) {
                        float s = (v0[0] * v0[0] + v0[1] * v0[1]) + (v0[2] * v0[2] + v0[3] * v0[3]) + (v1[0] * v1[0] + v1[1] * v1[1]) + (v1[2] * v1[2] + v1[3] * v1[3]);
                        s += __shfl_xor(s, 16); s += __shfl_xor(s, 32);
                        if (fq == 0) ssq[(size_t)row * 20 + g * 4 + wc] = s;
                    }
                    u32x4 w; w.x = cvt_pk_bf16(v0[0], v0[1]); w.y = cvt_pk_bf16(v0[2], v0[3]); w.z = cvt_pk_bf16(v1[0], v1[1]); w.w = cvt_pk_bf16(v1[2], v1[3]);
                    *(u32x4*)(O + (size_t)row * LD1 + col0) = w;
                }
        }
    }
};
struct EpiQ {
    static constexpr bool PERM = true, AFTER_DRAIN = false;
    bf16_t* Q; const float* ssq; const float2* rope;
    __device__ __forceinline__ static f32x4 rope4(f32x4 v, const f32x4 ca, const f32x4 cb, bool first) {
        const float cs[4] = {ca[0], ca[2], cb[0], cb[2]}, sn[4] = {ca[1], ca[3], cb[1], cb[3]};
#pragma unroll
        for (int e = 0; e < 4; ++e) { const float pv = __shfl_xor(v[e], 32); v[e] = first ? (v[e] * cs[e] - pv * sn[e]) : (pv * sn[e] + v[e] * cs[e]); }
        return v;
    }
    __device__ __forceinline__ void operator()(const f32x4 (&acc)[2][2][4][2], const Unit& u, int wr, int wc, int, int) const {
        const int t_ = lane_now();
        const int fr = t_ & 15, fq = (t_ >> 4) & 3;
        const int row0 = u.pm * BM + wr * 64 + fr;
#pragma unroll
        for (int ai = 0; ai < 2; ++ai)
#pragma unroll
            for (int m = 0; m < 4; ++m) {
                const int row = row0 + ai * HALF + m * 16;
                const f32x4* sp = (const f32x4*)(ssq + (size_t)row * 20);
                float tot;
                { const f32x4 s0 = sp[0]; tot = (s0[0] + s0[1]) + (s0[2] + s0[3]); }
                { const f32x4 s1 = sp[1]; tot += (s1[0] + s1[1]) + (s1[2] + s1[3]); }
                { const f32x4 s2 = sp[2]; tot += (s2[0] + s2[1]) + (s2[2] + s2[3]); }
                const float rs = rsqrtf(tot * (1.f / 384.f) + 1e-6f) * QSCALE_A;
                const f32x4* rp = (const f32x4*)(rope + (size_t)(row & (S - 1)) * 16 + 8 * (fq & 1));
#pragma unroll
                for (int bj = 0; bj < 2; ++bj) {
                    const int sl = u.pn * 8 + bj * 4 + wc;
                    f32x4 v0 = acc[ai][bj][m][0] * rs, v1 = acc[ai][bj][m][1] * rs;
                    if (sl % 3 == 2) {
                        v0 = rope4(v0, rp[0], rp[1], fq < 2);
                        v1 = rope4(v1, rp[2], rp[3], fq < 2);
                    }
                    u32x4 w; w.x = cvt_pk_bf16(v0[0], v0[1]); w.y = cvt_pk_bf16(v0[2], v0[3]); w.z = cvt_pk_bf16(v1[0], v1[1]); w.w = cvt_pk_bf16(v1[2], v1[3]);
                    *(u32x4*)(Q + (size_t)row * 768 + sl * 32 + 8 * fq) = w;
                    asm volatile("" ::: "memory");
                }
            }
    }
};
struct EpiKV {
    static constexpr bool PERM = true, AFTER_DRAIN = false;
    bf16_t* KV; const float* ssq;
    __device__ __forceinline__ void operator()(const f32x4 (&acc)[2][2][4][2], const Unit& u, int wr, int wc, int, int) const {
        const int t_ = lane_now();
        const int fr = t_ & 15, fq = (t_ >> 4) & 3;
        const int row0 = u.pm * BM + wr * 64 + fr;
#pragma unroll
        for (int ai = 0; ai < 2; ++ai)
#pragma unroll
            for (int m = 0; m < 4; ++m) {
                const int row = row0 + ai * HALF + m * 16;
                const f32x4* sp = (const f32x4*)(ssq + (size_t)row * 20 + 12);
                const f32x4 s0 = sp[0], s1 = sp[1];
                const float tot = ((s0[0] + s0[1]) + (s0[2] + s0[3])) + ((s1[0] + s1[1]) + (s1[2] + s1[3]));
                const float rs = rsqrtf(tot * (1.f / 256.f) + 1e-6f);
#pragma unroll
                for (int bj = 0; bj < 2; ++bj) {
                    const int col0 = u.pn * BM + bj * HALF + wc * 32 + 8 * fq;
                    const f32x4 v0 = acc[ai][bj][m][0] * rs, v1 = acc[ai][bj][m][1] * rs;
                    u32x4 w; w.x = cvt_pk_bf16(v0[0], v0[1]); w.y = cvt_pk_bf16(v0[2], v0[3]); w.z = cvt_pk_bf16(v1[0], v1[1]); w.w = cvt_pk_bf16(v1[2], v1[3]);
                    *(u32x4*)(KV + (size_t)row * 1024 + col0) = w;
                }
                asm volatile("" ::: "memory");
            }
    }
};
template <bool ADD> struct EpiGate {
    static constexpr bool PERM = true, AFTER_DRAIN = false;
    bf16_t* MG; const bf16_t* O1; int gcol;
    __device__ __forceinline__ void operator()(const f32x4 (&acc)[2][2][4][2], const Unit& u, int wr, int wc, int, int) const {
        const int t_ = lane_now();
        const int fr = t_ & 15, fq = (t_ >> 4) & 3;
        const int row0 = u.pm * BM + wr * 64 + fr;
#pragma unroll
        for (int ai = 0; ai < 2; ++ai)
#pragma unroll
            for (int m = 0; m < 4; ++m) {
                const int row = row0 + ai * HALF + m * 16;
#pragma unroll
                for (int bj = 0; bj < 2; ++bj) {
                    const int col0 = u.pn * BM + bj * HALF + wc * 32 + 8 * fq;
                    const u32x4 gw = *(const u32x4*)(O1 + (size_t)row * LD1 + gcol + col0);
                    f32x4 v0 = acc[ai][bj][m][0], v1 = acc[ai][bj][m][1];
                    v0[0] *= bflo(gw.x); v0[1] *= bfhi(gw.x); v0[2] *= bflo(gw.y); v0[3] *= bfhi(gw.y);
                    v1[0] *= bflo(gw.z); v1[1] *= bfhi(gw.z); v1[2] *= bflo(gw.w); v1[3] *= bfhi(gw.w);
                    u32x4* dst = (u32x4*)(MG + (size_t)row * DM + col0);
                    if (ADD) { const u32x4 pw = *dst;
                        v0[0] += bflo(pw.x); v0[1] += bfhi(pw.x); v0[2] += bflo(pw.y); v0[3] += bfhi(pw.y);
                        v1[0] += bflo(pw.z); v1[1] += bfhi(pw.z); v1[2] += bflo(pw.w); v1[3] += bfhi(pw.w); }
                    u32x4 w; w.x = cvt_pk_bf16(v0[0], v0[1]); w.y = cvt_pk_bf16(v0[2], v0[3]); w.z = cvt_pk_bf16(v1[0], v1[1]); w.w = cvt_pk_bf16(v1[2], v1[3]);
                    *dst = w;
                }
                asm volatile("" ::: "memory");
            }
    }
};
struct EpiOut {
    static constexpr bool PERM = true, AFTER_DRAIN = false;
    const float* x; float* out; float* ssqo;
    __device__ __forceinline__ void operator()(const f32x4 (&acc)[2][2][4][2], const Unit& u, int wr, int wc, int, int) const {
        const int t_ = lane_now();
        const int fr = t_ & 15, fq = (t_ >> 4) & 3;
        const int row0 = u.pm * BM + wr * 64 + fr;
#pragma unroll
        for (int ai = 0; ai < 2; ++ai)
#pragma unroll
            for (int m = 0; m < 4; ++m) {
                const int row = row0 + ai * HALF + m * 16;
#pragma unroll
                for (int bj = 0; bj < 2; ++bj) {
                    const int col0 = u.pn * BM + bj * HALF + wc * 32 + 8 * fq;
                    const f32x4* xp = (const f32x4*)(x + (size_t)row * DM + col0);
                    const f32x4 v0 = acc[ai][bj][m][0] + xp[0], v1 = acc[ai][bj][m][1] + xp[1];
                    f32x4* op = (f32x4*)(out + (size_t)row * DM + col0);
                    op[0] = v0; op[1] = v1;
                    float s = (v0[0] * v0[0] + v0[1] * v0[1]) + (v0[2] * v0[2] + v0[3] * v0[3]) + (v1[0] * v1[0] + v1[1] * v1[1]) + (v1[2] * v1[2] + v1[3] * v1[3]);
                    s += __shfl_xor(s, 16); s += __shfl_xor(s, 32);
                    if (fq == 0) ssqo[(size_t)row * 32 + u.pn * 8 + bj * 4 + wc] = s;
                }
                asm volatile("" ::: "memory");
            }
    }
};
struct EpiOutNorm {
    static constexpr bool PERM = true, AFTER_DRAIN = (FUSE_AFTER_DRAIN != 0);
    const float* x; float* out; float* ssqo; const float* fg; unsigned* cnt; unsigned* tmo; PG8_LAS unsigned char* ldsp;
    __device__ __forceinline__ void operator()(const f32x4 (&acc)[2][2][4][2], const Unit& u, int wr, int wc, int fr, int fq) const { if (!AFTER_DRAIN) fused(acc, u, wr, wc, fr, fq, ldsp, wr * 4 + wc, 0); }
    __device__ __forceinline__ void fused(const f32x4 (&acc)[2][2][4][2], const Unit& u, int wr, int wc, int, int, PG8_LAS unsigned char* lds, int wid, int) const {
        const int ln = lane_now(), fr = ln & 15, fq = (ln >> 4) & 3, tid = wid * 64 + ln;
        PG8_LAS float* part = (PG8_LAS float*)(lds + 135168);
        PG8_LAS float* rinv = part + 1024;
        const int rl0 = wr * 64 + fr;
        f32x4 v[2][2][4][2];
#pragma unroll
        for (int ai = 0; ai < 2; ++ai)
#pragma unroll
            for (int m = 0; m < 4; ++m) {
                const int rl = rl0 + ai * HALF + m * 16; const size_t row = (size_t)u.pm * BM + rl;
                float s = 0.f;
#pragma unroll
                for (int bj = 0; bj < 2; ++bj) {
                    const int col0 = u.pn * BM + bj * HALF + wc * 32 + 8 * fq;
                    const f32x4* xp = (const f32x4*)(x + row * DM + col0);
                    const f32x4 v0 = acc[ai][bj][m][0] + xp[0], v1 = acc[ai][bj][m][1] + xp[1];
                    v[ai][bj][m][0] = v0; v[ai][bj][m][1] = v1;
                    s += (v0[0] * v0[0] + v0[1] * v0[1]) + (v0[2] * v0[2] + v0[3] * v0[3]) + (v1[0] * v1[0] + v1[1] * v1[1]) + (v1[2] * v1[2] + v1[3] * v1[3]);
                }
                s += __shfl_xor(s, 16); s += __shfl_xor(s, 32);
                if (fq == 0) part[rl * 4 + wc] = s;
            }
        __syncthreads();
        if (DEBUG_FUSE) {
            if (tid < 256) { const f32x4 p4 = *(const PG8_LAS f32x4*)(part + tid * 4); float* q = ssqo + ((size_t)u.pm * BM + tid) * 32 + u.pn * 8;
                q[0] = (p4[0] + p4[1]) + (p4[2] + p4[3]); for (int i = 1; i < 8; ++i) q[i] = 0.f; }
#pragma unroll
            for (int bj = 0; bj < 2; ++bj)
#pragma unroll
                for (int ai = 0; ai < 2; ++ai)
#pragma unroll
                    for (int m = 0; m < 4; ++m) { const int rl = rl0 + ai * HALF + m * 16; const int col0 = u.pn * BM + bj * HALF + wc * 32 + 8 * fq;
                        f32x4* op = (f32x4*)(out + ((size_t)u.pm * BM + rl) * DM + col0); op[0] = v[ai][bj][m][0]; op[1] = v[ai][bj][m][1]; }
            return;
        }
        if (tid < 256) { const f32x4 p4 = *(const PG8_LAS f32x4*)(part + tid * 4); ssqo[((size_t)u.pm * BM + tid) * 4 + u.pn] = (p4[0] + p4[1]) + (p4[2] + p4[3]); }
        asm volatile("s_waitcnt vmcnt(0)" ::: "memory");
        __syncthreads();
        if (tid == 0) {
            __builtin_amdgcn_fence(__ATOMIC_RELEASE, "agent");
            (void)__hip_atomic_fetch_add(cnt + 16 * u.pm, 1u, __ATOMIC_RELAXED, __HIP_MEMORY_SCOPE_AGENT);
            unsigned sp = 0u;
            while (__hip_atomic_load(cnt + 16 * u.pm, __ATOMIC_RELAXED, __HIP_MEMORY_SCOPE_AGENT) < 4u) {
                __builtin_amdgcn_s_sleep(1);
                if ((++sp & 255u) == 0u) { if (__hip_atomic_load(tmo, __ATOMIC_RELAXED, __HIP_MEMORY_SCOPE_AGENT)) break; if (sp > (1u << 18)) { atomicAdd(tmo, 1u); break; } }
            }
            __builtin_amdgcn_fence(__ATOMIC_ACQUIRE, "agent");
            asm volatile("s_waitcnt vmcnt(0)" ::: "memory");
        }
        __syncthreads();
        if (tid < 256) {
            float* sp4 = ssqo + ((size_t)u.pm * BM + tid) * 4;
            const float t = (__hip_atomic_load(sp4, __ATOMIC_RELAXED, __HIP_MEMORY_SCOPE_AGENT) + __hip_atomic_load(sp4 + 1, __ATOMIC_RELAXED, __HIP_MEMORY_SCOPE_AGENT))
                          + (__hip_atomic_load(sp4 + 2, __ATOMIC_RELAXED, __HIP_MEMORY_SCOPE_AGENT) + __hip_atomic_load(sp4 + 3, __ATOMIC_RELAXED, __HIP_MEMORY_SCOPE_AGENT));
            rinv[tid] = rsqrtf(t * (1.f / DM) + 1e-6f);
        }
        __syncthreads();
#pragma unroll
        for (int bj = 0; bj < 2; ++bj) {
            const int col0 = u.pn * BM + bj * HALF + wc * 32 + 8 * fq;
            const f32x4 g0 = *(const f32x4*)(fg + col0), g1 = *(const f32x4*)(fg + col0 + 4);
#pragma unroll
            for (int ai = 0; ai < 2; ++ai)
#pragma unroll
                for (int m = 0; m < 4; ++m) {
                    const int rl = rl0 + ai * HALF + m * 16; const float r = rinv[rl];
                    f32x4* op = (f32x4*)(out + ((size_t)u.pm * BM + rl) * DM + col0);
                    op[0] = v[ai][bj][m][0] * r * g0; op[1] = v[ai][bj][m][1] * r * g1;
                }
        }
    }
};
}

constexpr int CW_QUEUE = 10240;
struct WorkQueue {
    unsigned* ctr; int nper, myx; LAS int* slot; int wv;
    __device__ __forceinline__ int issue() const {
        int v = 0;
        if (wv == 0 && lane_now() == 0) v = (int)__hip_atomic_fetch_add(ctr + 16 * myx, 1u, __ATOMIC_RELAXED, __HIP_MEMORY_SCOPE_AGENT);
        return v;
    }
    __device__ __forceinline__ int resolve(int pend, int par) const {
        if (wv == 0 && lane_now() == 0) {
            int r = -1;
            if (pend < nper) r = myx * nper + pend;
            else {
                for (int k = 1; k < 8; ++k) {
                    const int x = (myx + k) & 7; unsigned* c = ctr + 16 * x;
                    if (__hip_atomic_load(c, __ATOMIC_RELAXED, __HIP_MEMORY_SCOPE_AGENT) >= (unsigned)nper) continue;
                    const unsigned i = __hip_atomic_fetch_add(c, 1u, __ATOMIC_RELAXED, __HIP_MEMORY_SCOPE_AGENT);
                    if (i < (unsigned)nper) { r = x * nper + (int)i; break; }
                }
            }
            slot[par] = r;
        }
        asm volatile("s_waitcnt lgkmcnt(0)\n\ts_barrier" ::: "memory");
        const int r = slot[par];
        asm volatile("s_waitcnt lgkmcnt(0)" ::: "memory");
        return __builtin_amdgcn_readfirstlane(r);
    }
};


namespace att {
typedef short bf16x8 __attribute__((ext_vector_type(8)));
typedef short s16x4 __attribute__((ext_vector_type(4)));
typedef float f32x16 __attribute__((ext_vector_type(16)));
typedef unsigned u32x4 __attribute__((ext_vector_type(4)));
typedef const LAS char* lds_cptr;
constexpr int SLOT_K = 12288, SLOT_V = 8192;
constexpr int L_K = 0, L_V = 2 * SLOT_K, L_WS = L_V + 2 * SLOT_V, L_OST = L_WS + 2048, L_BIAS = L_OST + 8 * 4096, L_END = L_BIAS + 2048;
constexpr float THR = 8.f;
#define MFMA32(a, b, c) __builtin_amdgcn_mfma_f32_32x32x16_bf16(a, b, c, 0, 0, 0)
__device__ __forceinline__ int crow(int r, int hi) { return (r & 3) + 8 * (r >> 2) + 4 * hi; }
typedef __bf16 bf16x2_t __attribute__((ext_vector_type(2)));
typedef float f32x2_t __attribute__((ext_vector_type(2)));
__device__ __forceinline__ unsigned cvtpk(float lo, float hi) { const f32x2_t v = {lo, hi}; return __builtin_bit_cast(unsigned, __builtin_convertvector(v, bf16x2_t)); }
__device__ __forceinline__ s16x4 vtr(lds_cptr p) { typedef short v4i16_t __attribute__((ext_vector_type(4))); return __builtin_bit_cast(s16x4, __builtin_amdgcn_ds_read_tr16_b64_v4i16((LAS v4i16_t*)p)); }
#define MX3(a, b, c) __builtin_fmaxf(__builtin_fmaxf((a), (b)), (c))
__device__ __forceinline__ float rowmax(const f32x16& p0, const f32x16& p1) {
    float a = MX3(p0[0], p0[1], p1[0]), b = MX3(p0[2], p0[3], p1[1]); a = MX3(a, p1[2], p1[3]);
#pragma unroll
    for (int r = 4; r < 16; r += 4) { a = MX3(a, p0[r], p0[r + 1]); b = MX3(b, p0[r + 2], p0[r + 3]); a = MX3(a, p1[r], p1[r + 1]); b = MX3(b, p1[r + 2], p1[r + 3]); }
    const float m = __builtin_fmaxf(a, b); auto rr = __builtin_amdgcn_permlane32_swap(__float_as_uint(m), __float_as_uint(m), false, false);
    return __builtin_fmaxf(__uint_as_float(rr[0]), __uint_as_float(rr[1])); }
__device__ __forceinline__ float maskp(float p, unsigned lo, unsigned hi) {
    const unsigned long long mk = ((unsigned long long)hi << 32) | lo; float o;
    asm("v_cndmask_b32_e64 %0, 0, %1, %2" : "=v"(o) : "v"(p), "s"(mk)); return o; }
__host__ __device__ __forceinline__ size_t mask_tile_off(int qt32) { const int J = qt32 >> 1; return (size_t)2 * J * (J + 1) + ((qt32 & 1) ? 2 * (J + 1) : 0); }
constexpr size_t MASK_TILES_PER_BATCH = (size_t)2 * 128 * 129;

struct Tensors {
    const bf16_t* Q; int ldq;
    const bf16_t* K0; int ldk;
    const bf16_t* K1;
    const bf16_t* V; int ldv;
    bf16_t* O; int ldo;
    const unsigned long long* mask;
    const float* rel_bias;
    int hq, hk, hv;
    int wv;
};

template <bool DSA>
__device__ __forceinline__ void unit(int b, int h, int qb, const Tensors& X, LAS unsigned char* lds, bool dry) {
    constexpr int NDQ = DSA ? 4 : 6;
    const int tid_ = tid_now(X.wv);
    const int tid = tid_, lane = tid & 63, r32 = lane & 31, hi = lane >> 5; const int wid = X.wv;
    const size_t rowbase = (size_t)b * S; const int q0 = qb * 256, NT = 4 * qb + 4, NTw = 4 * qb + (wid >> 1) + 1;
    LAS float* wsf = (LAS float*)(lds + L_WS) + wid * 64;
    const bf16_t* ksrc = X.K0 + (rowbase + lane) * X.ldk + h * X.hk + wid * 8;
    const bf16_t* ksrc1 = DSA ? nullptr : X.K1 + (rowbase + lane) * 32 + (wid & 3) * 8;
    const bf16_t* vsrc = X.V + (rowbase + 16 * (wid & 3) + (lane >> 2)) * X.ldv + h * X.hv + (wid >> 2) * 32 + (lane & 3) * 8;
    const size_t kstride = (size_t)64 * X.ldk, vstride = (size_t)64 * X.ldv;
    LAS unsigned char* kdst = lds + L_K + wid * 1024; LAS unsigned char* kdst1 = lds + L_K + (8 + (wid & 3)) * 1024; LAS unsigned char* vdst = lds + L_V + wid * 1024;
    u32x4 sk0, sk1 = {}, sv;
#define ATT_LOAD(t) do { sk0 = *(const u32x4*)(ksrc + (size_t)(t) * kstride); if (!DSA && wid < 4) sk1 = *(const u32x4*)(ksrc1 + (size_t)(t) * 64 * 32); \
                         sv = *(const u32x4*)(vsrc + (size_t)(t) * vstride); } while (0)
#define ATT_WRITE(slot) do { *(LAS u32x4*)(kdst + (slot) * SLOT_K + lane * 16) = sk0; if (!DSA && wid < 4) *(LAS u32x4*)(kdst1 + (slot) * SLOT_K + lane * 16) = sk1; \
                             *(LAS u32x4*)(vdst + (slot) * SLOT_V + lane * 16) = sv; } while (0)
    const lds_cptr vp0 = (lds_cptr)lds + L_V + ((lane >> 4) & 1) * 32 + (lane & 3) * 8 + (4 * hi + ((lane & 15) >> 2)) * 64;
    const lds_cptr kp0 = (lds_cptr)lds + L_K + hi * 1024 + r32 * 16;
    ATT_LOAD(0);
    bf16x8 qr[NDQ];
    { const bf16_t* Qw = X.Q + (rowbase + q0 + wid * 32 + r32) * X.ldq + h * X.hq + hi * 8;
#pragma unroll
      for (int d0 = 0; d0 < NDQ; ++d0) qr[d0] = *(const bf16x8*)(Qw + d0 * 16); }
    if (DSA) {
        LAS float* tab = (LAS float*)(lds + L_BIAS);
        const float c15 = X.rel_bias[15 * 8 + h];
        for (int e = tid; e < 320; e += 512) {
            const int rel = e - 255, n = rel < 0 ? -rel : rel; int v;
            if (n < 8) v = n; else if (n < 12) v = 8; else if (n < 16) v = 9; else if (n < 23) v = 10; else if (n < 32) v = 11; else if (n < 46) v = 12; else if (n < 64) v = 13; else if (n < 91) v = 14; else v = 15;
            tab[e] = (X.rel_bias[((rel > 0 ? 16 : 0) + v) * 8 + h] - c15) * LOG2E;
        }
    }
    ATT_WRITE(0);
    float mhat = 0.f, l_reg = 0.f; f32x16 o0 = {}, o1 = {};
    f32x16 negm = {};
    if (wid >= 4) __builtin_amdgcn_s_setprio(1);
    const int qpos = q0 + wid * 32 + r32;
    for (int t = 0; t < NT; ++t) {
        asm volatile("s_waitcnt vmcnt(0) lgkmcnt(0)\n\ts_barrier" ::: "memory");
        if (t + 1 < NT) ATT_LOAD(t + 1);
        unsigned mw = 0u;
        if (DSA && t < NTw) { const int qt32 = qb * 8 + wid;
            const unsigned* mt = (const unsigned*)((const unsigned short*)X.mask + ((size_t)b * MASK_TILES_PER_BATCH + mask_tile_off(qt32)) * 64) + (size_t)t * 64;
            mw = mt[lane]; }
        if (t < NTw) {
            const int so_k = (t & 1) * SLOT_K, so_v = (t & 1) * SLOT_V;
            f32x16 c0, c1;
            bf16x8 kf[2 * NDQ];
#pragma unroll
            for (int d0 = 0; d0 < NDQ; ++d0) { kf[2 * d0] = *(const LAS bf16x8*)(kp0 + so_k + d0 * 2048); kf[2 * d0 + 1] = *(const LAS bf16x8*)(kp0 + so_k + d0 * 2048 + 512); }
#pragma unroll
            for (int d0 = 0; d0 < NDQ; ++d0) { c0 = MFMA32(kf[2 * d0], qr[d0], d0 == 0 ? negm : c0); c1 = MFMA32(kf[2 * d0 + 1], qr[d0], d0 == 0 ? negm : c1); }
            const lds_cptr vp = vp0 + so_v;
            bf16x8 vf[8];
#pragma unroll
            for (int i = 0; i < 8; ++i) { const s16x4 lo_ = vtr(vp + ((i >> 2) * 4096 + (i & 3) * 1024)), hi_ = vtr(vp + ((i >> 2) * 4096 + (i & 3) * 1024 + 512));
                vf[i] = (bf16x8){lo_[0], lo_[1], lo_[2], lo_[3], hi_[0], hi_[1], hi_[2], hi_[3]}; }
            if (DSA) {
                if (64 * t + 63 - (q0 + wid * 32) > -128) {
                    const LAS float* tab = (const LAS float*)(lds + L_BIAS);
                    const int base = 64 * t + 4 * hi - qpos + 255;
#pragma unroll
                    for (int r = 0; r < 16; ++r) { const int kr = (r & 3) + 8 * (r >> 2); int i0 = base + kr, i1 = base + kr + 32; i0 = i0 < 0 ? 0 : i0; i1 = i1 < 0 ? 0 : i1;
                        c0[r] += tab[i0]; c1[r] += tab[i1]; }
                }
            }
            const float rm = rowmax(c0, c1);
            if (t == 0 || __any(rm > THR)) {
                const float dl = (t == 0) ? rm : __builtin_fmaxf(rm, 0.f); mhat += dl;
                if (t > 0) {
                    const float f = __builtin_amdgcn_exp2f(-dl); l_reg *= f;
                    if (hi == 0) wsf[r32] = f;
                    asm volatile("s_waitcnt lgkmcnt(0)" ::: "memory");
#pragma unroll
                    for (int r = 0; r < 16; ++r) { const float fr = wsf[crow(r, hi)]; o0[r] *= fr; o1[r] *= fr; }
                }
#pragma unroll
                for (int r = 0; r < 16; ++r) { c0[r] -= dl; c1[r] -= dl; negm[r] -= dl; }
            }
#pragma unroll
            for (int r = 0; r < 16; ++r) { c0[r] = __builtin_amdgcn_exp2f(c0[r]); c1[r] = __builtin_amdgcn_exp2f(c1[r]); }
            if (DSA) {
#pragma unroll
                for (int r = 0; r < 16; ++r) {
                    int m0 = __builtin_amdgcn_sbfe((int)mw, r, 1), m1 = __builtin_amdgcn_sbfe((int)mw, 16 + r, 1); asm("" : "+v"(m0), "+v"(m1));
                    c0[r] = __uint_as_float(__float_as_uint(c0[r]) & (unsigned)m0); c1[r] = __uint_as_float(__float_as_uint(c1[r]) & (unsigned)m1); }
            }
            float sacc = 0.f;
#pragma unroll
            for (int r = 0; r < 16; ++r) sacc += c0[r] + c1[r];
            l_reg += sacc;
            u32x4 pw0 = {cvtpk(c0[0], c0[1]), cvtpk(c0[2], c0[3]), cvtpk(c0[4], c0[5]), cvtpk(c0[6], c0[7])};
            u32x4 pw1 = {cvtpk(c0[8], c0[9]), cvtpk(c0[10], c0[11]), cvtpk(c0[12], c0[13]), cvtpk(c0[14], c0[15])};
            u32x4 pw2 = {cvtpk(c1[0], c1[1]), cvtpk(c1[2], c1[3]), cvtpk(c1[4], c1[5]), cvtpk(c1[6], c1[7])};
            u32x4 pw3 = {cvtpk(c1[8], c1[9]), cvtpk(c1[10], c1[11]), cvtpk(c1[12], c1[13]), cvtpk(c1[14], c1[15])};
            o0 = MFMA32(__builtin_bit_cast(bf16x8, pw0), vf[0], o0); o1 = MFMA32(__builtin_bit_cast(bf16x8, pw0), vf[4], o1);
            o0 = MFMA32(__builtin_bit_cast(bf16x8, pw1), vf[1], o0); o1 = MFMA32(__builtin_bit_cast(bf16x8, pw1), vf[5], o1);
            o0 = MFMA32(__builtin_bit_cast(bf16x8, pw2), vf[2], o0); o1 = MFMA32(__builtin_bit_cast(bf16x8, pw2), vf[6], o1);
            o0 = MFMA32(__builtin_bit_cast(bf16x8, pw3), vf[3], o0); o1 = MFMA32(__builtin_bit_cast(bf16x8, pw3), vf[7], o1);
        }
        if (t + 1 < NT) ATT_WRITE((t + 1) & 1);
    }
    __builtin_amdgcn_s_setprio(0);
    bf16_t* Ow = X.O + (rowbase + q0 + wid * 32) * X.ldo + h * 64;
    u32x4 gv4[4];
#pragma unroll
    for (int i = 0; i < 4; ++i) gv4[i] = *(const u32x4*)(Ow + (size_t)(i * 8 + (lane >> 3)) * X.ldo + (lane & 7) * 8);
    { auto rr = __builtin_amdgcn_permlane32_swap(__float_as_uint(l_reg), __float_as_uint(l_reg), false, false); l_reg = __uint_as_float(rr[0]) + __uint_as_float(rr[1]); }
    if (hi == 0) wsf[32 + r32] = l_reg;
    asm volatile("s_waitcnt lgkmcnt(0)" ::: "memory");
    LAS bf16_t* stg = (LAS bf16_t*)(lds + L_OST) + wid * 2048;
#pragma unroll
    for (int r = 0; r < 16; ++r) { const int orow = crow(r, hi); const float rli = __builtin_amdgcn_rcpf(wsf[32 + orow]);
        stg[orow * 64 + r32] = f2bf(o0[r] * rli); stg[orow * 64 + 32 + r32] = f2bf(o1[r] * rli); }
    asm volatile("s_waitcnt lgkmcnt(0)" ::: "memory");
#pragma unroll
    for (int i = 0; i < 4; ++i) { const int row = i * 8 + (lane >> 3), ch = lane & 7;
        const u32x4 ov = *(const LAS u32x4*)(stg + row * 64 + ch * 8); u32x4* gp = (u32x4*)(Ow + (size_t)row * X.ldo + ch * 8); const u32x4 gv = gv4[i];
        u32x4 res; res.x = pk2(bflo(ov.x) * bflo(gv.x), bfhi(ov.x) * bfhi(gv.x)); res.y = pk2(bflo(ov.y) * bflo(gv.y), bfhi(ov.y) * bfhi(gv.y));
        res.z = pk2(bflo(ov.z) * bflo(gv.z), bfhi(ov.z) * bfhi(gv.z)); res.w = pk2(bflo(ov.w) * bflo(gv.w), bfhi(ov.w) * bfhi(gv.w)); if (!dry) *gp = res; }
    asm volatile("s_waitcnt vmcnt(0) lgkmcnt(0)\n\ts_barrier" ::: "memory");
#undef ATT_LOAD
#undef ATT_WRITE
}

template <bool DSA>
__device__ __forceinline__ void phase(const Tensors& X, LAS unsigned char* lds, int G, int bid, bool dry = false) {
    for (int p = bid; p < 512; p += G) {
        const int x = p & 7, kk = p >> 3, bh = x + 8 * (kk >> 4), j = kk & 15;
#pragma unroll 1
        for (int u2 = 0; u2 < 2; ++u2) unit<DSA>(bh >> 3, bh & 7, u2 ? 31 - j : j, X, lds, dry);
    }
}
}


#ifndef IDX_PRIO
#define IDX_PRIO 0
#endif
#ifndef PASS0_SPLIT
#define PASS0_SPLIT 0
#endif
#ifndef IDX_FORCE_SLOW
#define IDX_FORCE_SLOW 0
#endif
namespace idx {
typedef short bf16x8 __attribute__((ext_vector_type(8)));
typedef float f32x16 __attribute__((ext_vector_type(16)));
constexpr int HROW = 1025;
constexpr int LCAP = 32;
constexpr int LISTN = 64, LSTR = 65;
constexpr int L_HIST = 0, LISTS_END = (511 * LSTR + 513) * 4, L_PFX = LISTS_END, L_NEED = L_PFX + 128, L_LCNT = L_NEED + 128, L_LIST = L_LCNT + 128, L_CNT = L_LIST + 32 * LCAP * 4, L_TAU = L_CNT + 512 * 4,
              L_FLAG = L_TAU + 128, L_LB = L_FLAG + 16, L_WH = L_LB + 128, L_END = L_WH + 8 * 1024;
static_assert(LISTS_END % 16 == 0 && LISTS_END >= 32 * HROW * 4, "indexer LDS layout");
__device__ __forceinline__ unsigned f2key(float f) { const unsigned u = __float_as_uint(f); return u ^ ((unsigned)((int)u >> 31) | 0x80000000u); }

struct QOps { bf16x8 qf[8][2]; bf16x8 qb[2][2]; float wv[8]; };
__device__ __forceinline__ void score_tile(float (&acc)[16], const bf16x8 k0, const bf16x8 k1, const QOps& Q) {
#define IDX_M0(h) __builtin_amdgcn_mfma_f32_32x32x16_bf16(k0, Q.qf[h][0], (f32x16){}, 0, 0, 0)
#define IDX_M1(h, c) __builtin_amdgcn_mfma_f32_32x32x16_bf16(k1, Q.qf[h][1], c, 0, 0, 0)
#define IDX_ACC8(h, c, r0) do { _Pragma("unroll") for (int r = (r0); r < (r0) + 8; ++r) { acc[r] = __builtin_fmaf(Q.wv[h], __builtin_fabsf(c[r]), acc[r]); asm volatile("" : "+v"(acc[r])); } } while (0)
    f32x16 cA = IDX_M0(0); cA = IDX_M1(0, cA);
    f32x16 lin = __builtin_amdgcn_mfma_f32_32x32x16_bf16(k0, Q.qb[0][0], (f32x16){}, 0, 0, 0);
    lin = __builtin_amdgcn_mfma_f32_32x32x16_bf16(k1, Q.qb[0][1], lin, 0, 0, 0);
    lin = __builtin_amdgcn_mfma_f32_32x32x16_bf16(k0, Q.qb[1][0], lin, 0, 0, 0);
    lin = __builtin_amdgcn_mfma_f32_32x32x16_bf16(k1, Q.qb[1][1], lin, 0, 0, 0);
#pragma unroll
    for (int r = 0; r < 16; ++r) acc[r] = lin[r];
    __builtin_amdgcn_sched_barrier(0);
#pragma unroll
    for (int h = 0; h < 8; ++h) {
        f32x16 nC;
        if (h < 7) nC = IDX_M0(h + 1);
        IDX_ACC8(h, cA, 0);
        __builtin_amdgcn_sched_barrier(0);
        if (h < 7) nC = IDX_M1(h + 1, nC);
        IDX_ACC8(h, cA, 8);
        __builtin_amdgcn_sched_barrier(0);
        if (h < 7) cA = nC;
    }
#undef IDX_M0
#undef IDX_M1
#undef IDX_ACC8
}
#define GAS __attribute__((address_space(1)))
#define IDX_KLOAD(k0, k1, kt) do { const GAS bf16_t* kp_ = kbase + (size_t)(kt) * 1024 + r32 * 32 + hi * 8; k0 = *(const GAS bf16x8*)kp_; k1 = *(const GAS bf16x8*)(kp_ + 16); } while (0)

struct PassCtx { const GAS bf16_t* kbase; LAS unsigned* hrow; LAS unsigned* lcnt_q; LAS unsigned* blist_q; LAS unsigned* lown; GAS unsigned short* mbase; unsigned pfx, msk; int lane, r32, hi, ktb, kte; bool hi2; };
template <int PASS>
__device__ __forceinline__ void pass_tile(const PassCtx& C, const bf16x8 k0, const bf16x8 k1, const QOps& Q, int kt, unsigned& ncand) {
    if constexpr (PASS == 3) {
        __builtin_amdgcn_sched_barrier(0);
        float acc[16]; score_tile(acc, k0, k1, Q);
        const unsigned tlo = C.pfx << 22, thim1 = tlo | 0x3fffffu, pos = (unsigned)(kt - C.ktb) << 26;
        unsigned bits = 0u, vmask = 0x3fffffu; asm volatile("" : "+v"(vmask));
#pragma unroll
        for (int r = 15; r >= 0; --r) {
            const unsigned k = __float_as_uint(acc[r]) ^ C.msk;
            const bool sel = k > thim1, ge = k >= tlo;
            bits = bits + bits + (sel ? 1u : 0u);
            unsigned pr = ((unsigned)r << 22) | pos; asm volatile("" : "+s"(pr));
            *(LAS unsigned*)ncand = (k & vmask) | pr;
            ncand += (ge != sel) ? 4u : 0u;
        }
        C.mbase[(size_t)(kt >> 1) * 128 + C.lane * 2 + (kt & 1)] = (unsigned short)bits;
        return;
    }
    constexpr int SH_BIN = (PASS == 0 || PASS == 4) ? 22 : ((PASS == 1) ? 11 : 0), SH_PFX = (PASS == 1) ? 22 : 11;
    __builtin_amdgcn_sched_barrier(0);
    float acc[16]; score_tile(acc, k0, k1, Q);
    unsigned bits = 0u, anym = 0u; unsigned keys[16];
#pragma unroll
    for (int r = 0; r < 16; ++r) {
        const unsigned key = f2key(acc[r]), up = key >> SH_PFX, bin = (PASS == 0 || PASS == 4) ? (key >> 22) : ((key >> SH_BIN) & 2047u); if (PASS == 2) keys[r] = key;
        const bool match = (PASS == 0) || (PASS == 4 ? (bin >= C.pfx) : (up == C.pfx));
        if (PASS == 0) __hip_atomic_fetch_add(C.hrow + bin, 1u, __ATOMIC_RELAXED, __HIP_MEMORY_SCOPE_WORKGROUP);
        else if (PASS == 4) { if (match) __hip_atomic_fetch_add(C.hrow + bin, 1u, __ATOMIC_RELAXED, __HIP_MEMORY_SCOPE_WORKGROUP); }
        else if (match) __hip_atomic_fetch_add(C.hrow + (bin >> 1), 1u << ((bin & 1u) * 16u), __ATOMIC_RELAXED, __HIP_MEMORY_SCOPE_WORKGROUP);
        if (PASS == 2) { bits |= (up > C.pfx) ? (1u << r) : 0u; anym |= match ? 1u : 0u; }
    }
    if (PASS == 2) {
        C.mbase[(size_t)(kt >> 1) * 128 + C.lane * 2 + (kt & 1)] = (unsigned short)bits;
        if (__any(anym)) {
#pragma unroll
            for (int r = 0; r < 16; ++r) if ((keys[r] >> 11) == C.pfx) {
                const unsigned sl = __hip_atomic_fetch_add(C.lcnt_q, 1u, __ATOMIC_RELAXED, __HIP_MEMORY_SCOPE_WORKGROUP);
                if (sl < (unsigned)LCAP) C.blist_q[sl] = (keys[r] & 2047u) | ((unsigned)r << 11) | ((unsigned)C.lane << 15) | ((unsigned)kt << 21);
            }
        }
    }
}
#define IDX_KLOADC(k0, k1, kt) do { const GAS bf16_t* kp_ = C.kbase + (size_t)(kt) * 1024 + C.r32 * 32 + C.hi * 8; k0 = *(const GAS bf16x8*)kp_; k1 = *(const GAS bf16x8*)(kp_ + 16); } while (0)
template <int PASS>
__device__ __forceinline__ void pass_loop(const PassCtx& C, const QOps& Q, unsigned& ncand) {
    bf16x8 a0, a1, b0, b1, c0, c1; const int ktb = C.ktb, kte = C.kte;
    if (IDX_PRIO) { if (C.hi2) __builtin_amdgcn_s_setprio(1); }
    if (ktb < kte) IDX_KLOADC(a0, a1, ktb); if (ktb + 1 < kte) IDX_KLOADC(b0, b1, ktb + 1); if (ktb + 2 < kte) IDX_KLOADC(c0, c1, ktb + 2);
    for (int kt = ktb; kt < kte; kt += 3) {
        pass_tile<PASS>(C, a0, a1, Q, kt, ncand); if (kt + 3 < kte) IDX_KLOADC(a0, a1, kt + 3);
        if (kt + 1 < kte) { pass_tile<PASS>(C, b0, b1, Q, kt + 1, ncand); if (kt + 4 < kte) IDX_KLOADC(b0, b1, kt + 4); }
        if (kt + 2 < kte) { pass_tile<PASS>(C, c0, c1, Q, kt + 2, ncand); if (kt + 5 < kte) IDX_KLOADC(c0, c1, kt + 5); }
    }
    if (IDX_PRIO) __builtin_amdgcn_s_setprio(0);
}
#undef IDX_KLOADC

__device__ __forceinline__ int wave_prefix_sum(int v) {
    v += __builtin_amdgcn_update_dpp(0, v, 0x111, 0xf, 0xf, false);
    v += __builtin_amdgcn_update_dpp(0, v, 0x112, 0xf, 0xf, false);
    v += __builtin_amdgcn_update_dpp(0, v, 0x114, 0xf, 0xf, false);
    v += __builtin_amdgcn_update_dpp(0, v, 0x118, 0xf, 0xf, false);
    v += __builtin_amdgcn_update_dpp(0, v, 0x142, 0xa, 0xf, false);
    v += __builtin_amdgcn_update_dpp(0, v, 0x143, 0xc, 0xf, false);
    return v;
}
__device__ __forceinline__ void scan_hist(const LAS unsigned* hist, LAS unsigned* spfx, LAS int* sneed, LAS unsigned* slb, int wid, int pass, bool partial) {
    const int nbits = (pass == 0) ? 10 : 11;
    const int lane = lane_now();
    unsigned wv_[4][16]; int c[4], need[4];
#pragma unroll
    for (int qi = 0; qi < 4; ++qi) {
        const LAS unsigned* hr = hist + (wid * 4 + qi) * HROW + 16 * lane;
#pragma unroll
        for (int i = 0; i < 16; ++i) wv_[qi][i] = hr[i];
        need[qi] = sneed[wid * 4 + qi];
    }
#pragma unroll
    for (int qi = 0; qi < 4; ++qi) {
        int t = 0;
#pragma unroll
        for (int i = 0; i < 16; ++i) t += (pass == 0) ? (int)wv_[qi][i] : (int)(wv_[qi][i] & 0xffffu) + (int)(wv_[qi][i] >> 16);
        c[qi] = t;
    }
#pragma unroll
    for (int qi = 0; qi < 4; ++qi) {
        const int q = wid * 4 + qi, nd = need[qi];
        const int pre = wave_prefix_sum(c[qi]), total = __builtin_amdgcn_readlane(pre, 63);
        const int sfx = total - pre + c[qi], above = sfx - c[qi];
        int run = above, bstar = 0, nn = nd;
        if (pass == 0) {
#pragma unroll
            for (int i = 15; i >= 0; --i) { const int ci = (int)wv_[qi][i]; const bool hit = (run < nd) && (run + ci >= nd); bstar = hit ? 16 * lane + i : bstar; nn = hit ? nd - run : nn; run += ci; }
        } else {
#pragma unroll
            for (int i = 15; i >= 0; --i) {
                const int chi = (int)(wv_[qi][i] >> 16), clo = (int)(wv_[qi][i] & 0xffffu);
                { const bool hit = (run < nd) && (run + chi >= nd); bstar = hit ? 32 * lane + 2 * i + 1 : bstar; nn = hit ? nd - run : nn; run += chi; }
                { const bool hit = (run < nd) && (run + clo >= nd); bstar = hit ? 32 * lane + 2 * i : bstar; nn = hit ? nd - run : nn; run += clo; }
            }
        }
        if (partial && lane == 0) slb[q] = 0u;
        if (sfx >= nd && above < nd) {
            if (partial) slb[q] = (unsigned)bstar; else { spfx[q] = (spfx[q] << nbits) | (unsigned)bstar; sneed[q] = nn; }
        }
    }
}

template <int NJ>
__device__ __forceinline__ unsigned resolve_query(const LAS unsigned* lbase, int cn, int ln, LAS unsigned* wh, int need) {
    int ev[NJ]; const int sub = ln >> 4;
#pragma unroll
    for (int t = 0; t < NJ; ++t) { const int sl = 4 * t + sub; const unsigned w = lbase[sl]; ev[t] = (sl < cn) ? (int)(w & 0x3fffffu) : -1; }
    unsigned tl = 0u;
#pragma unroll
    for (int step = 0; step < 3; ++step) {
        const int sh = (step == 0) ? 14 : ((step == 1) ? 6 : 0), nb = (step == 2) ? 6 : 8, dm = (1 << nb) - 1;
        ((LAS u32x4*)wh)[ln] = (u32x4){0u, 0u, 0u, 0u};
#pragma unroll
        for (int t = 0; t < NJ; ++t) if (ev[t] >= 0) __hip_atomic_fetch_add(wh + ((ev[t] >> sh) & dm), 1u, __ATOMIC_RELAXED, __HIP_MEMORY_SCOPE_WORKGROUP);
        asm volatile("s_waitcnt lgkmcnt(0)" ::: "memory");
        const u32x4 c4 = ((const LAS u32x4*)wh)[ln];
        const int c = (int)(c4.x + c4.y + c4.z + c4.w);
        const int pre = wave_prefix_sum(c), sfx = __builtin_amdgcn_readlane(pre, 63) - pre + c;
        const int above = sfx - c;
        int run = above, dig = 0, nn = need; bool done = false;
        { const int ci = (int)c4.w; if (run + ci >= need) { dig = 4 * ln + 3; nn = need - run; done = true; } else run += ci; }
        { const int ci = (int)c4.z; if (!done) { if (run + ci >= need) { dig = 4 * ln + 2; nn = need - run; done = true; } else run += ci; } }
        { const int ci = (int)c4.y; if (!done) { if (run + ci >= need) { dig = 4 * ln + 1; nn = need - run; done = true; } else run += ci; } }
        { if (!done) { dig = 4 * ln; nn = need - run; } }
        const unsigned long long hm = __ballot(sfx >= need && above < need);
        const int src = (int)__builtin_ctzll(hm | (1ull << 63));
        dig = __builtin_amdgcn_readlane(dig, src); need = __builtin_amdgcn_readlane(nn, src);
        tl = (tl << nb) | (unsigned)dig;
        if (step < 2) {
#pragma unroll
            for (int t = 0; t < NJ; ++t) ev[t] = (((ev[t] >> sh) & dm) == dig) ? ev[t] : -1;
        }
    }
    return tl;
}

__device__ __forceinline__ void unit(int b, int qt, const bf16_t* __restrict__ O1, const bf16_t* __restrict__ KIDX, unsigned* __restrict__ MASK, LAS unsigned char* lds, int wv) {
    const int tid_ = tid_now(wv);
    long long spin_ = 0; long long tw0_ = 0; (void)tw0_;
#define RT_NOW(t) asm volatile("s_waitcnt vmcnt(0) lgkmcnt(0)\n\ts_memrealtime %0\n\ts_waitcnt lgkmcnt(0)" : "=s"(t) :: "memory")
#define SEC_B(id) do { if (PROBE_DUP == (id)) { unsigned long long t_; RT_NOW(t_); tw0_ = (long long)t_; } } while (0)
#define SEC_E(id) do { if (PROBE_DUP == (id)) { unsigned long long t_; RT_NOW(t_); spin_ += (long long)t_ - tw0_; } } while (0)
    SEC_B(90); SEC_B(91); SEC_B(70);
    asm volatile("" : "+s"(O1), "+s"(KIDX), "+s"(MASK));
    const int tid = tid_, lane = tid & 63, r32 = lane & 31, hi = lane >> 5; const int wid = wv;
    const size_t rowbase = (size_t)b * S; const int nkt = 2 * ((qt >> 1) + 1);
    const int kper = (nkt + 7) >> 3, ktb = wid * kper, kte = (ktb + kper < nkt) ? ktb + kper : nkt;
    LAS unsigned* hist = (LAS unsigned*)(lds + L_HIST); LAS unsigned* spfx = (LAS unsigned*)(lds + L_PFX); LAS int* sneed = (LAS int*)(lds + L_NEED);
    QOps Q;
    for (int rq_ = 0; rq_ < ((PROBE_DUP == 78) ? 9 : 1); ++rq_)
    { const GAS bf16_t* qrow = (const GAS bf16_t*)O1 + (rowbase + qt * 32 + r32 + (rq_ >> 4)) * LD1;
      const u32x4 ww = *(const GAS u32x4*)(qrow + O_WIDX);
      Q.wv[0] = bflo(ww.x); Q.wv[1] = bfhi(ww.x); Q.wv[2] = bflo(ww.y); Q.wv[3] = bfhi(ww.y); Q.wv[4] = bflo(ww.z); Q.wv[5] = bfhi(ww.z); Q.wv[6] = bflo(ww.w); Q.wv[7] = bfhi(ww.w);
      float qs[2][8];
#pragma unroll
      for (int s2 = 0; s2 < 2; ++s2)
#pragma unroll
          for (int j = 0; j < 8; ++j) qs[s2][j] = 0.f;
#pragma unroll
      for (int h = 0; h < 8; ++h)
#pragma unroll
          for (int s2 = 0; s2 < 2; ++s2) {
              const u32x4 qv = *(const GAS u32x4*)(qrow + O_QIDX + 32 * h + 16 * s2 + hi * 8);
              Q.qf[h][s2] = __builtin_bit_cast(bf16x8, qv);
              qs[s2][0] = __builtin_fmaf(Q.wv[h], bflo(qv.x), qs[s2][0]); qs[s2][1] = __builtin_fmaf(Q.wv[h], bfhi(qv.x), qs[s2][1]);
              qs[s2][2] = __builtin_fmaf(Q.wv[h], bflo(qv.y), qs[s2][2]); qs[s2][3] = __builtin_fmaf(Q.wv[h], bfhi(qv.y), qs[s2][3]);
              qs[s2][4] = __builtin_fmaf(Q.wv[h], bflo(qv.z), qs[s2][4]); qs[s2][5] = __builtin_fmaf(Q.wv[h], bfhi(qv.z), qs[s2][5]);
              qs[s2][6] = __builtin_fmaf(Q.wv[h], bflo(qv.w), qs[s2][6]); qs[s2][7] = __builtin_fmaf(Q.wv[h], bfhi(qv.w), qs[s2][7]);
          }
#pragma unroll
      for (int s2 = 0; s2 < 2; ++s2) {
          u32x4 hv, lv; unsigned* hp = (unsigned*)&hv; unsigned* lp = (unsigned*)&lv;
#pragma unroll
          for (int j = 0; j < 4; ++j) {
              const unsigned hw = pk2(qs[s2][2 * j], qs[s2][2 * j + 1]);
              hp[j] = hw; lp[j] = pk2(qs[s2][2 * j] - bflo(hw), qs[s2][2 * j + 1] - bfhi(hw));
          }
          Q.qb[0][s2] = __builtin_bit_cast(bf16x8, hv); Q.qb[1][s2] = __builtin_bit_cast(bf16x8, lv);
      } }
    SEC_E(91); SEC_B(92); SEC_E(70);
    const GAS bf16_t* kbase = (const GAS bf16_t*)KIDX + rowbase * 32;
    LAS unsigned* lcnt = (LAS unsigned*)(lds + L_LCNT); LAS unsigned* blist = (LAS unsigned*)(lds + L_LIST);
    GAS unsigned short* mbase = (GAS unsigned short*)MASK + ((size_t)b * att::MASK_TILES_PER_BATCH + att::mask_tile_off(qt)) * 64;
    unsigned tau = 0u;
    bool need_mask_pass = true;
    if (nkt * 32 > 256) {
        LAS unsigned* lists = (LAS unsigned*)(lds + L_HIST); LAS unsigned* scnt = (LAS unsigned*)(lds + L_CNT); LAS unsigned* stau = (LAS unsigned*)(lds + L_TAU); LAS unsigned* sflag = (LAS unsigned*)(lds + L_FLAG); LAS unsigned* slb = (LAS unsigned*)(lds + L_LB);
        if (tid < 32) { spfx[tid] = 0u; sneed[tid] = 256; lcnt[tid] = 0u; if (tid == 0) sflag[0] = ((IDX_FORCE_SLOW || PROBE_DUP == 77) ? 1u : 0u); }
        bool fast = false;
        for (int pass = 0; pass < 3; ++pass) {
            for (int rp_ = 0; rp_ < (((PROBE_DUP == 83 || PROBE_DUP == 89) && pass == 0) ? 2 : 1); ++rp_) {
            if (PROBE_DUP == 89 && tid < 32) { spfx[tid] = 0u; sneed[tid] = 256; }
            { LAS u32x4* h4 = (LAS u32x4*)hist; for (int e = tid_now(wv); e < 32 * HROW / 4; e += 512) h4[e] = (u32x4){0u, 0u, 0u, 0u}; }
            asm volatile("s_waitcnt lgkmcnt(0)\n\ts_barrier" ::: "memory");
            { const int ln = lane_now(), lr = ln & 31;
              PassCtx C; C.kbase = kbase; C.hrow = hist + lr * HROW; C.lcnt_q = lcnt + lr; C.blist_q = blist + lr * LCAP; C.mbase = mbase; C.pfx = spfx[lr];
              C.lane = ln; C.r32 = lr; C.hi = ln >> 5; C.ktb = ktb; C.kte = kte; C.hi2 = (wid >= 4);
              C.lown = nullptr; unsigned nc_ = 0u;
              if (pass == 0) {
                  if (PASS0_SPLIT && nkt >= 64) {
                      const int kmid = (kte > ktb) ? ktb + ((kte - ktb + 3) >> 2) : ktb;
                      C.kte = kmid; pass_loop<0>(C, Q, nc_);
                      asm volatile("s_waitcnt lgkmcnt(0)\n\ts_barrier" ::: "memory");
                      scan_hist(hist, spfx, sneed, slb, wid, 0, true);
                      asm volatile("s_waitcnt lgkmcnt(0)\n\ts_barrier" ::: "memory");
                      C.ktb = kmid; C.kte = kte; C.pfx = slb[lane_now() & 31]; pass_loop<4>(C, Q, nc_);
                  } else pass_loop<0>(C, Q, nc_);
              } else if (pass == 1) pass_loop<1>(C, Q, nc_); else pass_loop<2>(C, Q, nc_); }
            asm volatile("s_waitcnt vmcnt(0) lgkmcnt(0)\n\ts_barrier" ::: "memory");
            if (PROBE_DUP == 89 && pass == 0 && rp_ == 0) { scan_hist(hist, spfx, sneed, slb, wid, pass, false); asm volatile("s_waitcnt lgkmcnt(0)\n\ts_barrier" ::: "memory"); }
            }
            SEC_E(92); SEC_B(93);
            scan_hist(hist, spfx, sneed, slb, wid, pass, false);
            if (PROBE_DUP == 94 && pass == 0) { for (int rp_ = 0; rp_ < 4; ++rp_) { asm volatile("s_waitcnt lgkmcnt(0)\n\ts_barrier" ::: "memory"); scan_hist(hist, spfx, sneed, slb, wid, 0, true); } }
            asm volatile("s_waitcnt lgkmcnt(0)\n\ts_barrier" ::: "memory");
            SEC_E(93);
            if (pass == 0) {
                for (int rpB_ = 0; rpB_ < ((PROBE_DUP == 79) ? 2 : 1); ++rpB_) {
                SEC_B(95);
                for (int rp_ = 0; rp_ < ((PROBE_DUP == 84) ? 2 : 1); ++rp_)
                { const int ln = lane_now(), lr = ln & 31;
                  const unsigned la0 = (unsigned)(size_t)(lists + (wid * 64 + ln) * LSTR); unsigned la = la0;
                  PassCtx C; C.kbase = kbase; C.hrow = nullptr; C.lcnt_q = nullptr; C.blist_q = nullptr; C.lown = nullptr; C.mbase = mbase; C.pfx = spfx[lr]; C.msk = (C.pfx >= 512u) ? 0x80000000u : 0xffffffffu;
                  C.lane = ln; C.r32 = lr; C.hi = ln >> 5; C.ktb = ktb; C.kte = kte; C.hi2 = (wid >= 4);
                  pass_loop<3>(C, Q, la);
                  const unsigned nc = (la - la0) >> 2;
                  scnt[wid * 64 + ln] = nc < (unsigned)LISTN ? nc : (unsigned)LISTN;
                  if (nc > (unsigned)LISTN) sflag[0] = 1u; }
                asm volatile("s_waitcnt vmcnt(0) lgkmcnt(0)\n\ts_barrier" ::: "memory");
                SEC_E(95);
                if (sflag[0] == 0u) {
                    SEC_B(96);
                    for (int rp_ = 0; rp_ < ((PROBE_DUP == 85) ? 2 : 1); ++rp_)
                    { const int ln = lane_now(), li = ln & 15; LAS unsigned* wh = (LAS unsigned*)(lds + L_WH) + wid * 256;
#pragma unroll 1
                      for (int qi = 0; qi < 4; ++qi) {
                          const int q = wid * 4 + qi, L = (li >> 1) * 64 + q + 32 * (li & 1);
                          const int cn = (int)scnt[L];
                          int mx = cn;
                          { int o;
                            o = __builtin_amdgcn_update_dpp(0, mx, 0x111, 0xf, 0xf, false); mx = o > mx ? o : mx;
                            o = __builtin_amdgcn_update_dpp(0, mx, 0x112, 0xf, 0xf, false); mx = o > mx ? o : mx;
                            o = __builtin_amdgcn_update_dpp(0, mx, 0x114, 0xf, 0xf, false); mx = o > mx ? o : mx;
                            o = __builtin_amdgcn_update_dpp(0, mx, 0x118, 0xf, 0xf, false); mx = o > mx ? o : mx; }
                          const int nj = (__builtin_amdgcn_readlane(mx, 15) + 3) >> 2;
                          const int need = __builtin_amdgcn_readfirstlane(sneed[q]);
                          const LAS unsigned* lbase = lists + L * LSTR;
                          unsigned tl;
                          if (nj <= 4) tl = resolve_query<4>(lbase, cn, ln, wh, need); else if (nj <= 8) tl = resolve_query<8>(lbase, cn, ln, wh, need); else tl = resolve_query<16>(lbase, cn, ln, wh, need);
                          if (ln == 0) stau[q] = tl;
                      } }
                    asm volatile("s_waitcnt lgkmcnt(0)\n\ts_barrier" ::: "memory");
                    SEC_E(96); SEC_B(97);
                    for (int rp_ = 0; rp_ < ((PROBE_DUP == 86) ? 2 : 1); ++rp_)
                    { const int ln = lane_now(); const unsigned tq = stau[ln & 31], n = scnt[wid * 64 + ln]; const LAS unsigned* lown = lists + (wid * 64 + ln) * LSTR;
                      for (unsigned i = 0; i < n; ++i) {
                          const unsigned e = lown[i];
                          if ((e & 0x3fffffu) >= tq) {
                              const int ekt = ktb + (int)(e >> 26);
                              (void)__hip_atomic_fetch_or((GAS unsigned*)mbase + (size_t)(ekt >> 1) * 64 + ln, 1u << (((e >> 22) & 15u) + 16u * (unsigned)(ekt & 1)), __ATOMIC_RELAXED, __HIP_MEMORY_SCOPE_AGENT);
                          }
                      } }
                    SEC_E(97);
                    fast = true; need_mask_pass = false;
                }
                if (PROBE_DUP == 79 && rpB_ == 0) asm volatile("s_waitcnt vmcnt(0) lgkmcnt(0)\n\ts_barrier" ::: "memory");
                }
                if (fast) break;
            }
        }
        SEC_B(71);
        const int lane = lane_now(), r32 = lane & 31;
        tau = spfx[r32];
        const bool overflow = fast ? true : (__any(lcnt[r32] > (unsigned)LCAP) != 0);
        if (!overflow) {
            need_mask_pass = false;
            const unsigned n = lcnt[r32], tq = tau & 2047u;
            for (unsigned i = 0; i < n; ++i) {
                const unsigned e = blist[r32 * LCAP + i]; const int ekt = (int)(e >> 21);
                if (((e >> 15) & 63u) == (unsigned)lane && ekt >= ktb && ekt < kte && (e & 2047u) >= tq) {
                    GAS unsigned short* wp = mbase + (size_t)(ekt >> 1) * 128 + lane * 2 + (ekt & 1);
                    *wp = (unsigned short)(*wp | (1u << ((e >> 11) & 15u)));
                }
            }
        }
    }
#define IDX_MASK_BODY(K0, K1, KT) do { float acc[16]; score_tile(acc, K0, K1, Q); unsigned bits = 0u; \
        _Pragma("unroll") for (int r = 0; r < 16; ++r) bits |= (f2key(acc[r]) >= tau) ? (1u << r) : 0u; \
        if (!dryp) mbase[(size_t)((KT) >> 1) * 128 + lane * 2 + ((KT) & 1)] = (unsigned short)bits; else if (bits == 0xffffu && tau == 0x12345679u) mbase[0] = 0; } while (0)
    const int nreal = need_mask_pass ? 1 : 0, nrep = nreal + ((PROBE_DUP == 81) ? 2 : 0);
    for (int rep_ = 0; rep_ < nrep; ++rep_)
    { const bool dryp = (PROBE_DUP == 81) && (rep_ >= nreal);
      bf16x8 a0, a1, b0, b1, c0, c1;
      if (ktb < kte) IDX_KLOAD(a0, a1, ktb); if (ktb + 1 < kte) IDX_KLOAD(b0, b1, ktb + 1); if (ktb + 2 < kte) IDX_KLOAD(c0, c1, ktb + 2);
      for (int kt = ktb; kt < kte; kt += 3) {
          IDX_MASK_BODY(a0, a1, kt); if (kt + 3 < kte) IDX_KLOAD(a0, a1, kt + 3);
          if (kt + 1 < kte) { IDX_MASK_BODY(b0, b1, kt + 1); if (kt + 4 < kte) IDX_KLOAD(b0, b1, kt + 4); }
          if (kt + 2 < kte) { IDX_MASK_BODY(c0, c1, kt + 2); if (kt + 5 < kte) IDX_KLOAD(c0, c1, kt + 5); }
      } }
#undef IDX_MASK_BODY
    SEC_E(90); if (nkt * 32 > 256) SEC_E(71);
    if (PROBE_DUP >= 90 && PROBE_DUP < 100) { const long long t0_ = wall_clock64(); while (wall_clock64() - t0_ < spin_) __builtin_amdgcn_s_sleep(4); }
    asm volatile("s_waitcnt lgkmcnt(0)\n\ts_barrier" ::: "memory");
#undef SEC_B
#undef SEC_E
}
#undef IDX_KLOAD

__device__ __forceinline__ void phase(const bf16_t* O1, const bf16_t* KIDX, unsigned* MASK, LAS unsigned char* lds, const WorkQueue& WQ, int wv) {
    int pend = WQ.issue();
    for (int n = 0;; ++n) {
        const int u = WQ.resolve(pend, n & 1); if (u < 0) break;
        pend = WQ.issue();
        const int x = u >> 7, i = u & 127;
        unit(x & 3, 255 - (2 * i + (x >> 2)), O1, KIDX, MASK, lds, wv);
    }
}
}
struct Frame { LAS unsigned char* lds; int G, bid, wv, xcc; Ptrs p; };

__device__ __forceinline__ int win_dest_row(int n) {
    if (n < 672) return n;
    if (n < 3488) return n + 96;
    if (n < 3528) return n - 3488 + 672;
    return n + 56;
}
template <bool MAP>
__device__ __forceinline__ void transpose_item(const float* __restrict__ W, int K, int N, bf16_t* __restrict__ WT, const float* __restrict__ gk, LAS float* scr, int item, int lane) {
    const int nblk = (N + 31) / 32, kb = item / nblk, nb = item % nblk, k0 = 64 * kb, n0 = 32 * nb;
    const int nn = n0 + (lane & 31);
#pragma unroll 8
    for (int i = 0; i < 32; ++i) { const int kk = 2 * i + (lane >> 5); float v = 0.f; if (nn < N) v = W[(size_t)(k0 + kk) * N + nn]; if (gk) v *= gk[k0 + kk]; scr[kk * 33 + (lane & 31)] = v; }
    asm volatile("s_waitcnt lgkmcnt(0)" ::: "memory");
    const int c = lane & 7;
#pragma unroll
    for (int j = 0; j < 4; ++j) { const int n = (lane >> 3) + 8 * j; const LAS float* s = scr + (8 * c) * 33 + n;
        u32x4 o; o.x = pk2(s[0 * 33], s[1 * 33]); o.y = pk2(s[2 * 33], s[3 * 33]); o.z = pk2(s[4 * 33], s[5 * 33]); o.w = pk2(s[6 * 33], s[7 * 33]);
        if (n0 + n < N) { const int dr = MAP ? win_dest_row(n0 + n) : (n0 + n); *(u32x4*)(WT + (size_t)dr * K + k0 + 8 * c) = o; } }
    asm volatile("s_waitcnt lgkmcnt(0)" ::: "memory");
}

__device__ __forceinline__ void phase0(Frame& F) {
    const int t_ = tid_now(F.wv);
    const int tid = t_, lane = tid & 63; const int wave = F.wv; (void)tid; (void)lane; (void)wave;
    unsigned char* ws = F.p.ws;
    LAS float* scr = (LAS float*)(F.lds + wave * 16384);
    const int gw = F.bid * 8 + wave, NGW = F.G * 8;
    constexpr int I_IN = 16 * 175, I_UQ = 6 * 24, I_UKV = 4 * 32, I_OA = 8 * 32, I_OB = 8 * 32, I_OUT = 16 * 32;
    constexpr int NITEMS = I_IN + I_UQ + I_UKV + I_OA + I_OB + I_OUT;
    for (int it = gw; it < NITEMS; it += NGW) {
        int r = it;
        if (r < I_IN) { transpose_item<true>(F.p.w_in, 1024, NIN, (bf16_t*)(ws + WS_WINT), nullptr, scr, r, lane); continue; } r -= I_IN;
        if (r < I_UQ) { transpose_item<false>(F.p.w_uq, 384, 768, (bf16_t*)(ws + WS_WUQT), F.p.g_q, scr, r, lane); continue; } r -= I_UQ;
        if (r < I_UKV) { transpose_item<false>(F.p.w_ukv, 256, 1024, (bf16_t*)(ws + WS_WUKVT), F.p.g_kv, scr, r, lane); continue; } r -= I_UKV;
        if (r < I_OA) { transpose_item<false>(F.p.w_oa, 512, 1024, (bf16_t*)(ws + WS_WOAT), nullptr, scr, r, lane); continue; } r -= I_OA;
        if (r < I_OB) { transpose_item<false>(F.p.w_ob, 512, 1024, (bf16_t*)(ws + WS_WOBT), nullptr, scr, r, lane); continue; } r -= I_OB;
        transpose_item<false>(F.p.w_out, 1024, 1024, (bf16_t*)(ws + WS_WOUTT), nullptr, scr, r, lane);
    }
    { const int gt = F.bid * 512 + tid; if (gt < 7168) ((u32x4*)(ws + WS_WINT + (size_t)712 * 1024 * 2))[gt] = (u32x4){0u, 0u, 0u, 0u}; }
    for (int e = F.bid * 512 + tid; e < S * 16; e += F.G * 512) {
        const int pos = e >> 4, i = e & 15;
        const float freq = powf(10000.f, -(float)i / 16.f); const float ang = (float)pos * freq;
        ((float2*)(ws + WS_ROPE))[e] = make_float2(cosf(ang), sinf(ang));
    }
    bf16_t* H = (bf16_t*)(ws + WS_H);
    for (int row = gw; row < T; row += NGW) {
        const f32x4* xr = (const f32x4*)(F.p.x + (size_t)row * DM);
        f32x4 v[4]; float s = 0.f;
#pragma unroll
        for (int j = 0; j < 4; ++j) { v[j] = xr[lane + 64 * j]; s += (v[j][0] * v[j][0] + v[j][1] * v[j][1]) + (v[j][2] * v[j][2] + v[j][3] * v[j][3]); }
        s = wave_sum(s);
        const float r = rsqrtf(s * (1.f / DM) + 1e-6f);
#pragma unroll
        for (int j = 0; j < 4; ++j) {
            const f32x4 gg = ((const f32x4*)F.p.norm_g)[lane + 64 * j];
            uint2 o; o.x = pk2(v[j][0] * r * gg[0], v[j][1] * r * gg[1]); o.y = pk2(v[j][2] * r * gg[2], v[j][3] * r * gg[3]);
            ((uint2*)(H + (size_t)row * DM))[lane + 64 * j] = o;
        }
    }
}

__device__ __forceinline__ void phase1(Frame& F, int dry = 0) {
    unsigned char* ws = F.p.ws;
    pg8::Gemm g{(const bf16_t*)(ws + WS_H), DM, (const bf16_t*)(ws + WS_WINT), T, LD1, DM, F.wv};
    pg8::StaticOrder So; So.init(T, LD1, F.G, F.bid);
    pg8::EpiIn E{(bf16_t*)(ws + WS_OUT1), (float*)(ws + WS_SSQLAT), dry};
    if (P1_STAGGER_TICKS > 0 && !dry && 2 * F.bid >= F.G) { const long long t0 = wall_clock64(); while (wall_clock64() - t0 < P1_STAGGER_TICKS) __builtin_amdgcn_s_sleep(8); }
    if (PROBE_DUP == 14 && dry) { pg8::Gemm gz{(const bf16_t*)(ws + WS_CTL), 0, (const bf16_t*)(ws + WS_CTL), T, LD1, DM, F.wv}; pg8::SameTileOrder Ss; Ss.S = So; pg8::gemm_phase<pg8::EpiIn, pg8::SameTileOrder, true, true>(F.lds, gz, Ss, E); return; }
    if (PROBE_DUP == 12 && dry) { pg8::SameTileOrder Ss; Ss.S = So; pg8::gemm_phase<pg8::EpiIn, pg8::SameTileOrder, true, true>(F.lds, g, Ss, E); return; }
    pg8::gemm_phase<pg8::EpiIn, pg8::StaticOrder, true, true>(F.lds, g, So, E);
}

__device__ __forceinline__ void probe13(Frame& F, int dry) {
    const long long c0 = clock64(); const long long w0 = wall_clock64();
    phase1(F, dry);
    const long long c1 = clock64(); const long long w1 = wall_clock64();
    const long long ticks = (c1 - c0) * 1000ll / (w1 - w0 + 1);
    const long long t0 = wall_clock64(); while (wall_clock64() - t0 < ticks) __builtin_amdgcn_s_sleep(8);
}

__device__ __forceinline__ void phase1b(Frame& F) {
    const int t_ = tid_now(F.wv);
    const int tid = t_, lane = tid & 63; const int wave = F.wv; (void)tid; (void)lane; (void)wave;
    unsigned char* ws = F.p.ws;
    const bf16_t* O1 = (const bf16_t*)(ws + WS_OUT1);
    {
        bf16_t* KPE = (bf16_t*)(ws + WS_KPE); bf16_t* KIDX = (bf16_t*)(ws + WS_KIDX); const float2* rope = (const float2*)(ws + WS_ROPE);
        for (int e = F.bid * 512 + tid; e < T * 16; e += F.G * 512) {
            const int m = e >> 4, i = e & 15; const bf16_t* src = O1 + (size_t)m * LD1;
            const float2 cs = rope[(size_t)(m & (S - 1)) * 16 + i];
            const float x1 = bf2f(src[O_KROPE + i]), x2 = bf2f(src[O_KROPE + 16 + i]);
            KPE[(size_t)m * 32 + i] = f2bf(x1 * cs.x - x2 * cs.y); KPE[(size_t)m * 32 + 16 + i] = f2bf(x1 * cs.y + x2 * cs.x);
            KIDX[(size_t)m * 32 + i] = src[O_KIDX + i]; KIDX[(size_t)m * 32 + 16 + i] = src[O_KIDX + 16 + i];
        }
    }
    {
        pg8::Gemm g{O1 + O_QLAT, LD1, (const bf16_t*)(ws + WS_WUQT), T, 768, 384, F.wv};
        pg8::StaticOrder So; So.init(T, 768, F.G, F.bid);
        pg8::EpiQ E{(bf16_t*)(ws + WS_Q), (const float*)(ws + WS_SSQLAT), (const float2*)(ws + WS_ROPE)};
        pg8::gemm_phase<pg8::EpiQ, pg8::StaticOrder, true, true>(F.lds, g, So, E);
    }
    {
        pg8::Gemm g{O1 + O_CKV, LD1, (const bf16_t*)(ws + WS_WUKVT), T, 1024, 256, F.wv};
        pg8::StaticOrder So; So.init(T, 1024, F.G, F.bid);
        pg8::EpiKV E{(bf16_t*)(ws + WS_H), (const float*)(ws + WS_SSQLAT)};
        pg8::gemm_phase<pg8::EpiKV, pg8::StaticOrder, true, true>(F.lds, g, So, E);
    }
}

__device__ __forceinline__ void phase4ab(Frame& F) {
    unsigned char* ws = F.p.ws;
    const bf16_t* O1 = (const bf16_t*)(ws + WS_OUT1); bf16_t* MG = (bf16_t*)(ws + WS_H);
    {
        pg8::Gemm g{O1 + O_ZA, LD1, (const bf16_t*)(ws + WS_WOAT), T, 1024, 512, F.wv};
        pg8::StaticOrder So; So.init(T, 1024, F.G, F.bid);
        pg8::EpiGate<false> E{MG, O1, O_GA};
        pg8::gemm_phase<pg8::EpiGate<false>, pg8::StaticOrder, true, true>(F.lds, g, So, E);
    }
    {
        pg8::Gemm g{O1 + O_ZB, LD1, (const bf16_t*)(ws + WS_WOBT), T, 1024, 512, F.wv};
        pg8::StaticOrder So; So.init(T, 1024, F.G, F.bid);
        pg8::EpiGate<true> E{MG, O1, O_GB};
        pg8::gemm_phase<pg8::EpiGate<true>, pg8::StaticOrder, true, true>(F.lds, g, So, E);
    }
}

__device__ __forceinline__ void phase4c(Frame& F) {
    unsigned char* ws = F.p.ws;
    pg8::Gemm g{(const bf16_t*)(ws + WS_H), DM, (const bf16_t*)(ws + WS_WOUTT), T, 1024, 1024, F.wv};
    pg8::StaticOrder So; So.init(T, 1024, F.G, F.bid);
    if (FUSE_FINAL_NORM && F.G == 256) {
        unsigned* ctl = (unsigned*)(ws + WS_CTL);
        pg8::EpiOutNorm E{F.p.x, F.p.out, (float*)(ws + WS_SSQO), F.p.final_g, ctl + CW_PANEL, ctl + CW_TMO, F.lds};
        pg8::gemm_phase<pg8::EpiOutNorm, pg8::StaticOrder, true, true>(F.lds, g, So, E);
        return;
    }
    pg8::EpiOut E{F.p.x, F.p.out, (float*)(ws + WS_SSQO)};
    pg8::gemm_phase<pg8::EpiOut, pg8::StaticOrder, true, true>(F.lds, g, So, E);
}

__device__ __forceinline__ void phase5(Frame& F) {
    const int t_ = tid_now(F.wv);
    const int tid = t_, lane = tid & 63; const int wave = F.wv; (void)tid; (void)lane; (void)wave;
    const float* ssqo = (const float*)(F.p.ws + WS_SSQO);
    const int gw = F.bid * 8 + wave, NGW = F.G * 8;
    for (int row = gw; row < T; row += NGW) {
        float s = (lane < 32) ? ssqo[(size_t)row * 32 + lane] : 0.f;
        s = wave_sum(s);
        const float r = rsqrtf(s * (1.f / DM) + 1e-6f);
        f32x4* xr = (f32x4*)(F.p.out + (size_t)row * DM);
#pragma unroll
        for (int j = 0; j < 4; ++j) { const f32x4 gg = ((const f32x4*)F.p.final_g)[lane + 64 * j]; xr[lane + 64 * j] = xr[lane + 64 * j] * r * gg; }
    }
}

__device__ __forceinline__ void phase_mla(Frame& F, bool dry = false) {
    unsigned char* ws = F.p.ws;
    att::Tensors X{};
    X.Q = (const bf16_t*)(ws + WS_Q); X.ldq = 768; X.hq = 96;
    X.K0 = (const bf16_t*)(ws + WS_H); X.ldk = 1024; X.hk = 128; X.K1 = (const bf16_t*)(ws + WS_KPE);
    X.V = (const bf16_t*)(ws + WS_H) + 64; X.ldv = 1024; X.hv = 128;
    X.O = (bf16_t*)(ws + WS_OUT1) + O_ZA; X.ldo = LD1; X.mask = nullptr; X.rel_bias = nullptr;
    X.wv = F.wv;
    att::phase<false>(X, F.lds, F.G, F.bid, dry);
}
__device__ __forceinline__ void phase_dsa(Frame& F, bool dry = false) {
    unsigned char* ws = F.p.ws; bf16_t* O1 = (bf16_t*)(ws + WS_OUT1);
    att::Tensors X{};
    X.Q = O1 + O_QB; X.ldq = LD1; X.hq = 64;
    X.K0 = O1 + O_KB; X.ldk = LD1; X.hk = 64; X.K1 = nullptr;
    X.V = O1 + O_VB; X.ldv = LD1; X.hv = 64;
    X.O = O1 + O_ZB; X.ldo = LD1; X.mask = (const unsigned long long*)(ws + WS_MASK); X.rel_bias = F.p.rel_bias;
    X.wv = F.wv;
    att::phase<true>(X, F.lds, F.G, F.bid, dry);
}

__device__ __forceinline__ void phase_idx(Frame& F) {
    unsigned char* ws = F.p.ws;
    const WorkQueue WQ{(unsigned*)(ws + WS_CTL) + CW_QUEUE + 256, 128, F.xcc, (LAS int*)(F.lds + LDS_SLOT), F.wv};
    idx::phase((const bf16_t*)(ws + WS_OUT1), (const bf16_t*)(ws + WS_KIDX), (unsigned*)(ws + WS_MASK), F.lds, WQ, F.wv);
}

typedef unsigned long long u64_t;
#define XB_TMO      128
#define XB_XCNT(j)  (256  + 64 * (j))
#define XB_XSUB(j)  (1280 + 64 * (j))
#define XB_XGEN(j)  (2304 + 64 * (j))
#define XB_TOP      3328
#define XB_TOPGEN   3392
#define XCD_BAR_WORDS 3456
#define XB_SPIN_CAP (1u << 18)

__device__ __forceinline__ unsigned xb_ld(unsigned* p)              { return __hip_atomic_load(p, __ATOMIC_RELAXED, __HIP_MEMORY_SCOPE_AGENT); }
__device__ __forceinline__ unsigned xb_add(unsigned* p, unsigned v) { return __hip_atomic_fetch_add(p, v, __ATOMIC_RELAXED, __HIP_MEMORY_SCOPE_AGENT); }
__device__ __forceinline__ unsigned xb_xcc_id() { return (unsigned)__builtin_amdgcn_s_getreg((3 << 11) | 20) & 0xFu; }
#define XB_SPIN(cond, bar) do { unsigned _sp = 0; while (cond) { __builtin_amdgcn_s_sleep(1); \
    if ((++_sp & 255u) == 0u) { if (xb_ld(&(bar)[XB_TMO])) break; if (_sp > XB_SPIN_CAP) { atomicAdd(&(bar)[XB_TMO], 1u); break; } } } } while (0)

struct XcdBarrier {
    unsigned* bar; unsigned x; int wv;
    volatile LAS unsigned* st;
};

__device__ __forceinline__ XcdBarrier xcd_barrier_post(unsigned* bar, volatile LAS unsigned* st, int wv) {
    XcdBarrier b; b.bar = bar; b.x = xb_xcc_id(); b.st = st; b.wv = wv;
    if (threadIdx.x == 0) (void)xb_add(&bar[XB_XCNT(b.x)], 1u);
    return b;
}
__device__ __forceinline__ void xcd_barrier_complete(unsigned* bar, unsigned x, unsigned& nloc, unsigned& nx) {
    const unsigned G = gridDim.x * gridDim.y * gridDim.z;
    unsigned sum, cnt, mine, sp = 0u;
    for (;;) {
        sum = 0u; cnt = 0u; mine = 0u;
#pragma unroll
        for (unsigned j = 0; j < 16; ++j) { const unsigned c = xb_ld(&bar[XB_XCNT(j)]); sum += c; cnt += (c > 0u) ? 1u : 0u; mine = (j == x) ? c : mine; }
        if (sum == G) break;
        __builtin_amdgcn_s_sleep(1);
        if ((++sp & 255u) == 0u) { if (xb_ld(&bar[XB_TMO])) break; if (sp > XB_SPIN_CAP) { atomicAdd(&bar[XB_TMO], 1u); break; } }
    }
    nloc = mine > 0u ? mine : 1u; nx = cnt > 0u ? cnt : 1u;
}

__device__ __forceinline__ void xcd_barrier(const XcdBarrier& b) {
    asm volatile("s_waitcnt vmcnt(0)" ::: "memory");
    __syncthreads();
    if (b.wv == 0 && lane_now() == 0) {
        unsigned* bar = b.bar;
        __builtin_amdgcn_s_waitcnt(0);
        unsigned nloc = b.st[0], nx = b.st[1];
        if (nloc == 0u) { xcd_barrier_complete(bar, b.x, nloc, nx); b.st[0] = nloc; b.st[1] = nx; }
        const unsigned old = xb_add(&bar[XB_XSUB(b.x)], 1u);
        const unsigned gen = old / nloc;
        if (old + 1u == (gen + 1u) * nloc) {
            __builtin_amdgcn_fence(__ATOMIC_RELEASE, "agent");
            asm volatile("s_waitcnt vmcnt(0)" ::: "memory");
            const unsigned og = xb_add(&bar[XB_TOP], 1u);
            const unsigned tg = og / nx;
            if (og + 1u == (tg + 1u) * nx) xb_add(&bar[XB_TOPGEN], 1u);
            else XB_SPIN(xb_ld(&bar[XB_TOPGEN]) == tg, bar);
            __builtin_amdgcn_fence(__ATOMIC_ACQUIRE, "agent");
            xb_add(&bar[XB_XGEN(b.x)], 1u);
            asm volatile("s_waitcnt vmcnt(0)" ::: "memory");
        } else {
            XB_SPIN(xb_ld(&bar[XB_XGEN(b.x)]) == gen, bar);
            __builtin_amdgcn_fence(__ATOMIC_ACQUIRE, "agent");
            asm volatile("s_waitcnt vmcnt(0)" ::: "memory");
        }
    }
    __syncthreads();
}

constexpr int CW_BAR = 4096;
constexpr size_t CTL_ZERO_BYTES = (PROBE_DUP == 14) ? (1u << 20) : 65536;
constexpr int LDS_MISC = 150016;
struct Args { Ptrs p; int ph_lo, ph_hi; };
__global__ void __launch_bounds__(512, 2) mega_fwd(Args a) {
    extern __shared__ __attribute__((aligned(16))) unsigned char lds_raw[];
    Frame F; F.lds = (LAS unsigned char*)lds_raw;
    F.G = gridDim.x; F.bid = blockIdx.x; F.p = a.p;
    cooperative_groups::grid_group grid = cooperative_groups::this_grid();
    volatile LAS unsigned* st = (volatile LAS unsigned*)(F.lds + LDS_MISC);
    if (threadIdx.x < 4) st[threadIdx.x] = 0u;
    F.wv = __builtin_amdgcn_readfirstlane((int)(threadIdx.x >> 6));
    F.xcc = (int)(xb_xcc_id() & 7u);
    static_assert(LDS_SLOT == LDS_MISC + 64 && LDS_SLOT + 8 <= LDS_BYTES, "work-queue slots");
    __syncthreads();
    const XcdBarrier bar = xcd_barrier_post((unsigned*)(a.p.ws + WS_CTL) + CW_BAR, st, F.wv);
    static_assert(CW_TMO == CW_BAR + XB_TMO && CW_PANEL * 4 + 64 * 64 <= (int)CTL_ZERO_BYTES, "control words");
    const int lo = a.ph_lo, hi = (FUSE_FINAL_NORM && !DEBUG_FUSE && F.G == 256 && a.ph_hi > 7) ? 7 : a.ph_hi;
struct ClkProbe {
    long long c0, w0;
    __device__ __forceinline__ void begin() { c0 = clock64(); w0 = wall_clock64(); }
    __device__ __forceinline__ void end() { const long long c1 = clock64(); const long long w1 = wall_clock64(); const long long ticks = (c1 - c0) * 1000ll / (w1 - w0 + 1);
        const long long t0 = wall_clock64(); while (wall_clock64() - t0 < ticks) __builtin_amdgcn_s_sleep(8); }
};
#define CLK(code, body) do { if (PROBE_DUP == (code)) { ClkProbe q_; q_.begin(); body; q_.end(); } else { body; } } while (0)
#define RUN(k, body, CG) do { if (lo <= (k) && (k) < hi) { body; if ((k) + 1 < hi) { if (CG) grid.sync(); else { xcd_barrier(bar); } } } } while (0)
    const bool dryrun = (a.ph_hi > 0);
    RUN(0, { CLK(30, phase0(F)); if (PROBE_DUP == 0) phase0(F); }, true);
    RUN(1, { if (PROBE_DUP == 21) { const long long t0 = clock64(); while (clock64() - t0 < 1000000ll) __builtin_amdgcn_s_sleep(8); } CLK(31, phase1(F)); if (PROBE_DUP == 1) phase1(F); if (PROBE_DUP == 11 || PROBE_DUP == 12 || PROBE_DUP == 14) phase1(F, (int)dryrun); if (PROBE_DUP == 13) probe13(F, (int)dryrun); }, false);
    RUN(2, { CLK(32, phase1b(F)); if (PROBE_DUP == 2) phase1b(F); }, false);
    RUN(3, { const bool idx_first = (MIX_ORDER != 0) && (((F.bid >> 3) & 1) != 0); if (idx_first) phase_idx(F); CLK(33, phase_mla(F)); if (PROBE_DUP == 3) phase_mla(F, dryrun); if (!idx_first) CLK(38, phase_idx(F)); if (PROBE_DUP == 8) phase_idx(F); }, false);
    RUN(4, { CLK(34, phase_dsa(F)); if (PROBE_DUP == 4) phase_dsa(F, dryrun); }, false);
    RUN(5, { CLK(35, phase4ab(F)); if (PROBE_DUP == 5) phase4ab(F); }, false);
    RUN(6, { if (PROBE_DUP == 22) { const long long t0 = clock64(); while (clock64() - t0 < 1000000ll) __builtin_amdgcn_s_sleep(8); } CLK(36, phase4c(F)); if (PROBE_DUP == 6) phase4c(F); }, false);
    if (!(FUSE_FINAL_NORM && !DEBUG_FUSE && F.G == 256)) RUN(7, phase5(F), false);
#undef RUN
}

extern "C" void kernel_launch(void* const* d_in, const int* in_sizes, int n_in, void* d_out, int out_size, void* d_ws, size_t ws_size, hipStream_t stream) {
    static int grid = 0;
    if (grid == 0) {
        if (ws_size < WS_END) { fprintf(stderr, "kernel_launch: workspace too small: %zu < %zu\n", ws_size, (size_t)WS_END); grid = -1; return; }
        int dev = 0, cus = 0, per_cu = 0;
        if (hipGetDevice(&dev) != hipSuccess || hipDeviceGetAttribute(&cus, hipDeviceAttributeMultiprocessorCount, dev) != hipSuccess) { grid = -1; return; }
        if (hipFuncSetAttribute((const void*)mega_fwd, hipFuncAttributeMaxDynamicSharedMemorySize, LDS_BYTES) != hipSuccess) { fprintf(stderr, "kernel_launch: hipFuncSetAttribute failed\n"); grid = -1; return; }
        if (hipOccupancyMaxActiveBlocksPerMultiprocessor(&per_cu, (const void*)mega_fwd, 512, LDS_BYTES) != hipSuccess || per_cu < 1) { fprintf(stderr, "kernel_launch: occupancy query failed (%d)\n", per_cu); (void)hipGetLastError(); grid = -1; return; }
        grid = cus;
    }
    if (grid < 0) return;
    if (hipMemsetAsync((char*)d_ws + WS_CTL, 0, CTL_ZERO_BYTES, stream) != hipSuccess) { fprintf(stderr, "kernel_launch: hipMemsetAsync failed\n"); return; }
    Args a{};
    a.p.x = (const float*)d_in[0]; a.p.norm_g = (const float*)d_in[1]; a.p.w_in = (const float*)d_in[2]; a.p.g_q = (const float*)d_in[3]; a.p.w_uq = (const float*)d_in[4];
    a.p.g_kv = (const float*)d_in[5]; a.p.w_ukv = (const float*)d_in[6]; a.p.w_oa = (const float*)d_in[7]; a.p.w_ob = (const float*)d_in[8]; a.p.w_out = (const float*)d_in[9];
    a.p.rel_bias = (const float*)d_in[10]; a.p.final_g = (const float*)d_in[11]; a.p.out = (float*)d_out; a.p.ws = (unsigned char*)d_ws;
    a.ph_lo = 0; a.ph_hi = 8;
    void* args[] = {&a};
    const hipError_t e = hipLaunchCooperativeKernel((const void*)mega_fwd, dim3(grid), dim3(512), args, LDS_BYTES, stream);
    if (e != hipSuccess) fprintf(stderr, "kernel_launch: cooperative launch failed: %s (grid %d)\n", hipGetErrorString(e), grid);
}
```
